# Optimizing an MI355X kernel written in HIP

```python
import jax
import jax.numpy as jnp
from jax import lax
import numpy as np

D_MODEL = 1024
BATCH = 8
SEQ = 2048
DEPTH = 4
DEC_BATCH = 32
DEC_SEQ = 4
PAST_LEN = 16384
PAGE_SIZE = 128

N_A_LAYERS = DEPTH // 2
N_B_LAYERS = DEPTH - N_A_LAYERS
POOL_WINDOWS = (2, 4, 8, 16)
N_POOL_GROUPS = len(POOL_WINDOWS)
POOL_WIDTH = D_MODEL
POOL_GROUP = POOL_WIDTH // N_POOL_GROUPS
POOL_BUF = max(POOL_WINDOWS) - 1
MLA_HEADS = 8
QK_NOPE = 128
QK_ROPE = 64
V_HEAD = 128
KV_RANK = 256
Q_RANK = 384
MLA_WIDTH = MLA_HEADS * V_HEAD
MLA_SCALE = (QK_NOPE + QK_ROPE) ** -0.5
ROPE_THETA = 10000.0
Q_BLOCK = 128
MEM_TOKENS = 256
MEM_HEADS = 4
MEM_HEAD_DIM = 128
MEM_WIDTH = MEM_HEADS * MEM_HEAD_DIM
MEM_SCALE = MEM_HEAD_DIM ** -0.5
IN_A = 2 * POOL_WIDTH + 2 * MEM_WIDTH
IN_B = Q_RANK + MLA_WIDTH + 2 * MEM_WIDTH
OUT_W = POOL_WIDTH + MEM_WIDTH
EPS = 1e-6

kernel_name = 'yoco_pool_mla_memory_decoder'


def rmsnorm(x, g):
    xf = x.astype(jnp.float32)
    y = xf * lax.rsqrt(jnp.mean(xf * xf, axis=-1, keepdims=True) + EPS)
    return (y * g.astype(jnp.float32)).astype(x.dtype)


def rope(x, pos):
    half = x.shape[-1] // 2
    inv = ROPE_THETA ** (-jnp.arange(half, dtype=jnp.float32) / half)
    ang = pos.astype(jnp.float32)[:, None] * inv[None, :]
    cos = jnp.cos(ang)[None, :, None, :]
    sin = jnp.sin(ang)[None, :, None, :]
    xf = x.astype(jnp.float32)
    x1, x2 = xf[..., :half], xf[..., half:]
    return jnp.concatenate([x1 * cos - x2 * sin, x1 * sin + x2 * cos], axis=-1).astype(x.dtype)


def pool_mix(u_ext, pos, w_grp, scale):
    B = u_ext.shape[0]
    T = pos.shape[0]
    uf = u_ext.astype(jnp.float32)
    cs = jnp.concatenate([jnp.zeros((B, 1, POOL_WIDTH), jnp.float32), jnp.cumsum(uf, axis=1)], axis=1)
    end = cs[:, POOL_BUF + 1:]
    cur = uf[:, POOL_BUF:]
    groups = []
    for g, w in enumerate(POOL_WINDOWS):
        c0, c1 = g * POOL_GROUP, (g + 1) * POOL_GROUP
        start = cs[:, POOL_BUF + 1 - w: POOL_BUF + 1 - w + T, c0:c1]
        cnt = jnp.minimum(pos + 1, w).astype(jnp.float32)[None, :, None]
        groups.append((end[..., c0:c1] - start) / cnt - cur[..., c0:c1])
    pooled = jnp.stack(groups, axis=2)
    mixed = jnp.einsum('btgc,gcd->btgd', pooled, w_grp.astype(jnp.float32))
    return (mixed.reshape(B, T, POOL_WIDTH) * scale.astype(jnp.float32)).astype(u_ext.dtype)


def mem_project(mem, g, w):
    B, M, _ = mem.shape
    return (rmsnorm(mem, g) @ w).reshape(B, M, MEM_HEADS, MEM_HEAD_DIM)


def mem_attend(q, mk, mv):
    B, T = q.shape[0], q.shape[1]
    s = jnp.einsum('bthd,bmhd->bhtm', q, mk).astype(jnp.float32) * MEM_SCALE
    p = jax.nn.softmax(s, axis=-1).astype(mv.dtype)
    return jnp.einsum('bhtm,bmhd->bthd', p, mv).reshape(B, T, MEM_WIDTH)


def shared_latent_kv(x, pos, g_kv_in, w_kv_down, g_kv_latent):
    kv = rmsnorm(x, g_kv_in) @ w_kv_down
    ckv = rmsnorm(kv[..., :KV_RANK], g_kv_latent)
    krope = rope(kv[..., KV_RANK:][:, :, None, :], pos)[:, :, 0, :]
    return ckv, krope


def mla_attend(q_lat, q_rope, ckv, krope, qpos, kpos):
    s = (jnp.einsum('bthc,bsc->bhts', q_lat, ckv).astype(jnp.float32)
         + jnp.einsum('bthr,bsr->bhts', q_rope, krope).astype(jnp.float32)) * MLA_SCALE
    mask = kpos[None, :] <= qpos[:, None]
    s = jnp.where(mask[None, None], s, -1e30)
    p = jax.nn.softmax(s, axis=-1).astype(ckv.dtype)
    return jnp.einsum('bhts,bsc->bthc', p, ckv)


def mla_mix(c_q, pos, ckv, krope, g_q, w_q_up, w_k_up, w_v_up):
    B, T, _ = c_q.shape
    q = (rmsnorm(c_q, g_q) @ w_q_up).reshape(B, T, MLA_HEADS, QK_NOPE + QK_ROPE)
    q_rope = rope(q[..., QK_NOPE:], pos)
    q_lat = jnp.einsum('bthd,chd->bthc', q[..., :QK_NOPE], w_k_up)
    kpos = jnp.arange(ckv.shape[1], dtype=jnp.int32)
    if T >= Q_BLOCK and T % Q_BLOCK == 0:
        nb = T // Q_BLOCK
        ql = q_lat.reshape(B, nb, Q_BLOCK, MLA_HEADS, KV_RANK).swapaxes(0, 1)
        qr = q_rope.reshape(B, nb, Q_BLOCK, MLA_HEADS, QK_ROPE).swapaxes(0, 1)
        qp = pos.reshape(nb, Q_BLOCK)
        o = lax.map(lambda a: mla_attend(a[0], a[1], ckv, krope, a[2], kpos), (ql, qr, qp))
        o_lat = o.swapaxes(0, 1).reshape(B, T, MLA_HEADS, KV_RANK)
    else:
        o_lat = mla_attend(q_lat, q_rope, ckv, krope, pos, kpos)
    return jnp.einsum('bthc,chd->bthd', o_lat, w_v_up).reshape(B, T, MLA_WIDTH)


def trunk(x, pos, pool_prev, ckv_past, krope_past, mem_k, mem_v,
          g_norm, w_in_a, w_pool_grp, pool_scale, w_in_b, g_q_latent, w_q_up,
          g_kv_in, w_kv_down, g_kv_latent, w_k_up, w_v_up, w_out, g_final):
    B, T, _ = x.shape
    pool_new = []
    ckv_new = krope_new = ckv_all = krope_all = None
    for l in range(DEPTH):
        if l == N_A_LAYERS:
            ckv_new, krope_new = shared_latent_kv(x, pos, g_kv_in, w_kv_down, g_kv_latent)
            if ckv_past is None:
                ckv_all, krope_all = ckv_new, krope_new
            else:
                ckv_all = jnp.concatenate([ckv_past, ckv_new], axis=1)
                krope_all = jnp.concatenate([krope_past, krope_new], axis=1)
        h = rmsnorm(x, g_norm[l])
        if l < N_A_LAYERS:
            z = h @ w_in_a[l]
            u, gate_t, q_m, gate_m = jnp.split(z, [POOL_WIDTH, 2 * POOL_WIDTH, 2 * POOL_WIDTH + MEM_WIDTH], axis=-1)
            prev = jnp.zeros((B, POOL_BUF, POOL_WIDTH), u.dtype) if pool_prev is None else pool_prev[l]
            u_ext = jnp.concatenate([prev, u], axis=1)
            pool_new.append(u_ext[:, -POOL_BUF:])
            tok = pool_mix(u_ext, pos, w_pool_grp[l], pool_scale[l])
        else:
            j = l - N_A_LAYERS
            z = h @ w_in_b[j]
            c_q, gate_t, q_m, gate_m = jnp.split(z, [Q_RANK, Q_RANK + MLA_WIDTH, Q_RANK + MLA_WIDTH + MEM_WIDTH], axis=-1)
            tok = mla_mix(c_q, pos, ckv_all, krope_all, g_q_latent[j], w_q_up[j], w_k_up, w_v_up)
        mem_o = mem_attend(q_m.reshape(B, T, MEM_HEADS, MEM_HEAD_DIM), mem_k[l], mem_v[l])
        mixed = jnp.concatenate([tok * jax.nn.silu(gate_t), mem_o * jax.nn.silu(gate_m)], axis=-1)
        x = x + mixed @ w_out[l]
    return rmsnorm(x, g_final), jnp.stack(pool_new, axis=0), ckv_new, krope_new


def setup_inputs(seed: int = 0) -> dict:
    key = jax.random.key(seed)
    ks = jax.random.split(key, 32)
    f32 = jnp.float32

    def nrm(k, shape, scale=1.0):
        return jax.random.normal(k, shape, f32) * scale

    def gain(k, shape):
        return 1.0 + 0.02 * jax.random.normal(k, shape, f32)

    n_pages = PAST_LEN // PAGE_SIZE
    n_used = DEC_BATCH * n_pages
    n_pool = n_used + max(1, n_used // 4)
    page_table = jax.random.permutation(ks[7], n_pool)[:n_used].reshape(DEC_BATCH, n_pages).astype(jnp.int32)
    return {
        'x_prompt': nrm(ks[0], (BATCH, SEQ, D_MODEL)),
        'x_sample': nrm(ks[1], (DEC_BATCH, DEC_SEQ, D_MODEL)),
        'state_pool': nrm(ks[2], (N_A_LAYERS, DEC_BATCH, POOL_BUF, POOL_WIDTH)),
        'cache_ckv': nrm(ks[3], (n_pool, PAGE_SIZE, KV_RANK)),
        'cache_krope': nrm(ks[4], (n_pool, PAGE_SIZE, QK_ROPE)),
        'cache_mem_k': nrm(ks[5], (DEPTH, DEC_BATCH, MEM_TOKENS, MEM_HEADS, MEM_HEAD_DIM)),
        'cache_mem_v': nrm(ks[6], (DEPTH, DEC_BATCH, MEM_TOKENS, MEM_HEADS, MEM_HEAD_DIM)),
        'page_table': page_table,
        'mem_prompt': nrm(ks[8], (BATCH, MEM_TOKENS, D_MODEL)),
        'g_norm': gain(ks[9], (DEPTH, D_MODEL)),
        'w_in_a': nrm(ks[10], (N_A_LAYERS, D_MODEL, IN_A), D_MODEL ** -0.5),
        'w_pool_grp': nrm(ks[11], (N_A_LAYERS, N_POOL_GROUPS, POOL_GROUP, POOL_GROUP), POOL_GROUP ** -0.5),
        'pool_scale': gain(ks[12], (N_A_LAYERS, POOL_WIDTH)),
        'w_in_b': nrm(ks[13], (N_B_LAYERS, D_MODEL, IN_B), D_MODEL ** -0.5),
        'g_q_latent': gain(ks[14], (N_B_LAYERS, Q_RANK)),
        'w_q_up': nrm(ks[15], (N_B_LAYERS, Q_RANK, MLA_HEADS * (QK_NOPE + QK_ROPE)), Q_RANK ** -0.5),
        'g_kv_in': gain(ks[16], (D_MODEL,)),
        'w_kv_down': nrm(ks[17], (D_MODEL, KV_RANK + QK_ROPE), D_MODEL ** -0.5),
        'g_kv_latent': gain(ks[18], (KV_RANK,)),
        'w_k_up': nrm(ks[19], (KV_RANK, MLA_HEADS, QK_NOPE), KV_RANK ** -0.5),
        'w_v_up': nrm(ks[20], (KV_RANK, MLA_HEADS, V_HEAD), KV_RANK ** -0.5),
        'g_mem': gain(ks[21], (DEPTH, D_MODEL)),
        'w_mem_k': nrm(ks[22], (DEPTH, D_MODEL, MEM_WIDTH), D_MODEL ** -0.5),
        'w_mem_v': nrm(ks[23], (DEPTH, D_MODEL, MEM_WIDTH), D_MODEL ** -0.5),
        'w_out': nrm(ks[24], (DEPTH, OUT_W, D_MODEL), OUT_W ** -0.5),
        'g_final': gain(ks[25], (D_MODEL,)),
    }


def reference(x_prompt, x_sample, state_pool, cache_ckv, cache_krope, cache_mem_k, cache_mem_v,
              page_table, mem_prompt, g_norm, w_in_a, w_pool_grp, pool_scale, w_in_b, g_q_latent,
              w_q_up, g_kv_in, w_kv_down, g_kv_latent, w_k_up, w_v_up, g_mem, w_mem_k, w_mem_v,
              w_out, g_final):
    weights = (g_norm, w_in_a, w_pool_grp, pool_scale, w_in_b, g_q_latent, w_q_up,
               g_kv_in, w_kv_down, g_kv_latent, w_k_up, w_v_up, w_out, g_final)
    pos_p = jnp.arange(x_prompt.shape[1], dtype=jnp.int32)
    mem_k_p = jnp.stack([mem_project(mem_prompt, g_mem[l], w_mem_k[l]) for l in range(DEPTH)], axis=0)
    mem_v_p = jnp.stack([mem_project(mem_prompt, g_mem[l], w_mem_v[l]) for l in range(DEPTH)], axis=0)
    y_p, pool_p, ckv_p, krope_p = trunk(x_prompt, pos_p, None, None, None, mem_k_p, mem_v_p, *weights)
    db, n_pages = page_table.shape
    past = n_pages * cache_ckv.shape[1]
    ckv_past = cache_ckv[page_table].reshape(db, past, KV_RANK)
    krope_past = cache_krope[page_table].reshape(db, past, QK_ROPE)
    pos_s = past + jnp.arange(x_sample.shape[1], dtype=jnp.int32)
    y_s, pool_s, ckv_s, krope_s = trunk(x_sample, pos_s, state_pool, ckv_past, krope_past,
                                        cache_mem_k, cache_mem_v, *weights)
    return (y_p, y_s, pool_p, pool_s, ckv_p, krope_p, ckv_s, krope_s, mem_k_p, mem_v_p)
```

```cpp
#include <hip/hip_runtime.h>
#include <cstdio>
#include <cstdint>

#define LAS __attribute__((address_space(3)))
typedef unsigned char uchar;
typedef unsigned short bf16_t;
typedef short bf16x8 __attribute__((ext_vector_type(8)));
typedef short s16x4 __attribute__((ext_vector_type(4)));
typedef float f32x2 __attribute__((ext_vector_type(2)));
typedef float f32x4 __attribute__((ext_vector_type(4)));
typedef float f32x16 __attribute__((ext_vector_type(16)));
typedef unsigned u32x2 __attribute__((ext_vector_type(2)));
typedef unsigned u32x4 __attribute__((ext_vector_type(4)));

constexpr int DM = 1024, PB = 8, PT = 2048, PM = PB * PT, SB = 32, ST = 4, SM = SB * ST, RP = 16640;
constexpr int KVR = 256, ROPE = 64, NOPE = 128, QRANK = 384, MLAH = 8, QHD = 192, QW = MLAH * QHD;
constexpr int MEMT = 256, MEMH = 4, MEMW = 512;
constexpr int INA = 3072, INB = 2432, OUTW = 1536, LDZ = 3072, NB2 = 2816, NB3 = 2560;
constexpr int NPAGES = 128, PAGE = 128, PAST = 16384, POOLBUF = 15;
constexpr float EPS = 1e-6f;
constexpr int ZA_U = 0, ZA_GT = 1024, ZA_QM = 2048, ZA_GM = 2560;
constexpr int ZB_CQ = 0, ZB_KR = 384, ZB_GT = 512, ZB_QM = 1536, ZB_GM = 2048, ZB_KV = 2560;

constexpr size_t O_YP = 0, O_YS = O_YP + (size_t)PM * DM, O_PSP = O_YS + (size_t)SM * DM, O_PSS = O_PSP + (size_t)2 * PB * 15 * DM, O_CKVP = O_PSS + (size_t)2 * SB * 15 * DM,
                 O_KRP = O_CKVP + (size_t)PM * KVR, O_CKVS = O_KRP + (size_t)PM * ROPE, O_KRS = O_CKVS + (size_t)SM * KVR, O_MEMK = O_KRS + (size_t)SM * ROPE,
                 O_MEMV = O_MEMK + (size_t)4 * PB * MEMT * MEMW, O_END = O_MEMV + (size_t)4 * PB * MEMT * MEMW;

constexpr size_t al256(size_t x) { return (x + 255) / 256 * 256; }
constexpr size_t WS_CTL = 0, CTL_BYTES = 65536;
constexpr size_t WS_ROPE = WS_CTL + CTL_BYTES;
constexpr size_t WS_WINA = al256(WS_ROPE + (size_t)2052 * 32 * 8);
constexpr size_t WS_WGRP = al256(WS_WINA + (size_t)2 * INA * DM * 2);
constexpr size_t WS_WINB = al256(WS_WGRP + (size_t)2 * 4 * 256 * 256 * 2);
constexpr size_t WS_WQUP = al256(WS_WINB + (size_t)2 * NB2 * DM * 2);
constexpr size_t WS_WKV  = al256(WS_WQUP + (size_t)2 * QW * QRANK * 2);
constexpr size_t WS_WKUPN = al256(WS_WKV + (size_t)2048 * 256 * 2);
constexpr size_t WS_WMEM = al256(WS_WKUPN + (size_t)256 * 1024 * 2);
constexpr size_t WS_WOUT = al256(WS_WMEM + (size_t)4096 * 1024 * 2);
constexpr size_t WS_MHAT = al256(WS_WOUT + (size_t)4 * DM * OUTW * 2);
constexpr size_t WS_MEMB = al256(WS_MHAT + (size_t)2048 * 1024 * 2);
constexpr size_t WS_XRES = al256(WS_MEMB + (size_t)2048 * 4096 * 2);
constexpr size_t WS_XB   = al256(WS_XRES + (size_t)RP * DM * 4);
constexpr size_t WS_SSP  = al256(WS_XB + (size_t)RP * DM * 2);
constexpr size_t WS_SSPS = al256(WS_SSP + (size_t)PM * 16 * 4);
constexpr size_t WS_SSQ  = al256(WS_SSPS + (size_t)SM * 32 * 4);
constexpr size_t WS_Z    = al256(WS_SSQ + (size_t)RP * 12 * 4);
constexpr size_t WS_POOLED = al256(WS_Z + (size_t)RP * LDZ * 2);
constexpr size_t WS_MIXED = al256(WS_POOLED + (size_t)RP * DM * 2);
constexpr size_t WS_Q    = al256(WS_MIXED + (size_t)RP * OUTW * 2);
constexpr size_t WS_KVRAW = al256(WS_Q + (size_t)RP * QW * 2);
constexpr size_t WS_CKVB = al256(WS_KVRAW + (size_t)RP * 320 * 4);
constexpr size_t WS_KROPEB = al256(WS_CKVB + (size_t)RP * 256 * 2);
constexpr size_t WS_KN   = al256(WS_KROPEB + (size_t)RP * 64 * 2);
constexpr size_t WS_VV   = al256(WS_KN + (size_t)PM * 1024 * 2);
constexpr size_t WS_QDEC = al256(WS_VV + (size_t)PM * 1024 * 2);
constexpr size_t WS_OPART = al256(WS_QDEC + (size_t)SB * 32 * 320 * 2);
constexpr size_t WS_ML   = al256(WS_OPART + (size_t)SB * 8 * 32 * 256 * 4);
constexpr size_t WS_OLAT = al256(WS_ML + (size_t)SB * 8 * 32 * 2 * 4);
constexpr size_t WS_END  = al256(WS_OLAT + (size_t)SM * 2048 * 2);

__device__ __forceinline__ unsigned cvt_pk_bf16(float lo, float hi) { unsigned r; asm volatile("v_cvt_pk_bf16_f32 %0, %1, %2" : "=v"(r) : "v"(lo), "v"(hi)); return r; }
__device__ __forceinline__ float bf_lo(unsigned w) { return __uint_as_float(w << 16); }
__device__ __forceinline__ float bf_hi(unsigned w) { return __uint_as_float(w & 0xffff0000u); }
__device__ __forceinline__ float bf2f(bf16_t b) { return __uint_as_float(((unsigned)b) << 16); }
__device__ __forceinline__ float silu(float x) { return x * __builtin_amdgcn_rcpf(1.0f + __expf(-x)); }
__device__ __forceinline__ void unpack8(const u32x4 w, float (&f)[8]) {
    f[0] = bf_lo(w.x); f[1] = bf_hi(w.x); f[2] = bf_lo(w.y); f[3] = bf_hi(w.y); f[4] = bf_lo(w.z); f[5] = bf_hi(w.z); f[6] = bf_lo(w.w); f[7] = bf_hi(w.w); }
__device__ __forceinline__ u32x4 pack8(const float (&f)[8]) { u32x4 w; w.x = cvt_pk_bf16(f[0], f[1]); w.y = cvt_pk_bf16(f[2], f[3]); w.z = cvt_pk_bf16(f[4], f[5]); w.w = cvt_pk_bf16(f[6], f[7]); return w; }
__device__ __forceinline__ float sum4(const f32x4 a) { return (a[0] + a[1]) + (a[2] + a[3]); }
__device__ __forceinline__ float rs_from16(const float* p) {
    const f32x4 a = *(const f32x4*)p, b = *(const f32x4*)(p + 4), c = *(const f32x4*)(p + 8), d = *(const f32x4*)(p + 12);
    return rsqrtf(((sum4(a) + sum4(b)) + (sum4(c) + sum4(d))) * (1.0f / 1024.0f) + EPS); }
__device__ __forceinline__ float rs_from32(const float* p) { float s = 0.f;
#pragma unroll
    for (int i = 0; i < 8; ++i) s += sum4(*(const f32x4*)(p + 4 * i));
    return rsqrtf(s * (1.0f / 1024.0f) + EPS); }
__device__ __forceinline__ float rsq_from12(const float* p) {
    const f32x4 a = *(const f32x4*)p, b = *(const f32x4*)(p + 4), c = *(const f32x4*)(p + 8);
    return rsqrtf((sum4(a) + sum4(b) + sum4(c)) * (1.0f / 384.0f) + EPS); }
__device__ __forceinline__ int crow(int r, int hi) { return (r & 3) + 8 * (r >> 2) + 4 * hi; }
static_assert(WS_VV == WS_KN + (size_t)PM * 1024 * 2, "VV must follow KN");
namespace pg8 {
constexpr int BM = 256, BK = 64, HALF = 128, HTB = HALF * BK * 2, STAGE_BYTES = 8 * HTB, NXCD = 8, WGM = 8;
__device__ __forceinline__ int lds_byte(int r, int c) { const int st = (r >> 4) * 2 + (c >> 5), rr = r & 15, cc = c & 31, ob = rr * 64 + cc * 2; return st * 1024 + (ob ^ (((ob >> 9) & 1) << 5)); }
__device__ __forceinline__ void stage_rc(int b, int& R, int& C) { const int st = b / 1024, sb = b % 1024, swz = sb ^ (((sb >> 9) & 1) << 5); R = (st >> 1) * 16 + swz / 64; C = (st & 1) * 32 + (swz % 64) / 2; }
__device__ __forceinline__ int perm32(int rho) { const int n = rho >> 4, i = rho & 15; return 8 * (i >> 2) + 4 * n + (i & 3); }

struct Unit { int pm, pn; };
struct Gemm { const bf16_t* A; const bf16_t* Bt; int lda, ldb, K, a_pn; };

struct StaticOrder {
    int nM, nN, nwg, G, c;
    __device__ void init(int nM_, int nN_, int G_, int c_) { nM = nM_; nN = nN_; nwg = nM * nN; G = G_; c = c_; }
    __device__ bool next(int i, Unit& u) const {
        const long L = (long)i * G + c; if (L >= nwg) return false;
        int wgid = (int)L; { const int q = nwg / NXCD, r = nwg % NXCD, xcd = wgid % NXCD, off = wgid / NXCD; wgid = (xcd < r ? xcd * (q + 1) : r * (q + 1) + (xcd - r) * q) + off; }
        const int nig = WGM * nN, gid = wgid / nig, fm = gid * WGM, gsz = (nM - fm) < WGM ? (nM - fm) : WGM;
        u.pm = fm + ((wgid % nig) % gsz); u.pn = (wgid % nig) / gsz; return true;
    }
};

template <class Epi>
__device__ __forceinline__ void gemm_phase(LAS uchar* lds, const Gemm g, const StaticOrder& S, const Epi& E) {
    int tid_ = threadIdx.x; asm volatile("" : "+v"(tid_));
    const int tid = tid_, wid = __builtin_amdgcn_readfirstlane(tid >> 6), lane = tid & 63, wr = wid >> 2, wc = wid & 3, fr = lane & 15, fq = lane >> 4;
    int K_ = g.K; asm volatile("" : "+s"(K_));
    const int K = K_, nt = K / BK;
    unsigned voffA[2], voffB[2];
#pragma unroll
    for (int i = 0; i < 2; ++i) { int R, C; stage_rc(tid * 16 + i * 8192, R, C); const int Rb = Epi::PERM ? ((R & ~31) + perm32(R & 31)) : R;
        voffA[i] = (unsigned)(R * g.lda + C) * 2u; voffB[i] = (unsigned)(Rb * g.ldb + C) * 2u; }
    const size_t kstep = (size_t)(BK * 2);
    const size_t hstepA = (size_t)HALF * g.lda * 2, hstepB = (size_t)HALF * g.ldb * 2;
    const size_t tstepA = 2 * hstepA, tstepB = 2 * hstepB;
    const unsigned ldsw = (unsigned)wid * 1024u;
    const int aoff = lds_byte(wr * 64 + fr, fq * 8), boff = lds_byte(wc * 32 + fr, fq * 8);
#define PG8_SA(b, h) (((b) * 2 + (h)) * HTB)
#define PG8_SB(b, h) ((4 + (b) * 2 + (h)) * HTB)
#define PG8_STAGE(bufoff, gbase, voff) do { _Pragma("unroll") for (int _i = 0; _i < 2; ++_i) \
        __builtin_amdgcn_global_load_lds((const unsigned*)((const char*)(gbase) + (voff)[_i]), (LAS unsigned*)(lds + (bufoff) + ldsw + _i * 8192), 16, 0, 0); } while (0)
#define PG8_LDA(dst, b, h) do { _Pragma("unroll") for (int m = 0; m < 4; ++m) _Pragma("unroll") for (int k = 0; k < 2; ++k) dst[m][k] = *(const LAS bf16x8*)(lds + PG8_SA(b, h) + aoff + m * 2048 + k * 1024); } while (0)
#define PG8_LDB(dst, b, h) do { _Pragma("unroll") for (int n = 0; n < 2; ++n) _Pragma("unroll") for (int k = 0; k < 2; ++k) dst[n][k] = *(const LAS bf16x8*)(lds + PG8_SB(b, h) + boff + n * 2048 + k * 1024); } while (0)
#define PG8_MMA(ai, bj, At, Bt) do { __builtin_amdgcn_s_setprio(1); _Pragma("unroll") for (int m = 0; m < 4; ++m) _Pragma("unroll") for (int n = 0; n < 2; ++n) _Pragma("unroll") for (int k = 0; k < 2; ++k) \
        acc[ai][bj][m][n] = __builtin_amdgcn_mfma_f32_16x16x32_bf16(Bt[n][k], At[m][k], acc[ai][bj][m][n], 0, 0, 0); __builtin_amdgcn_s_setprio(0); } while (0)
#define PG8_WAIT_V(n) asm volatile("s_waitcnt vmcnt(" #n ")" ::: "memory")
#define PG8_WAIT_L(n) asm volatile("s_waitcnt lgkmcnt(" #n ")" ::: "memory")
#define PG8_BAR __builtin_amdgcn_s_barrier()
#define PG8_SCHED __builtin_amdgcn_sched_barrier(0)
    Unit cur, nxt; int ui = 0;
    if (!S.next(0, cur)) return;
    f32x4 acc[2][2][4][2];
#pragma unroll
    for (int a = 0; a < 2; ++a)
#pragma unroll
        for (int b = 0; b < 2; ++b)
#pragma unroll
            for (int m = 0; m < 4; ++m)
#pragma unroll
                for (int n = 0; n < 2; ++n) acc[a][b][m][n] = (f32x4){0.f, 0.f, 0.f, 0.f};
    bf16x8 At[4][2], B0[2][2], B1[2][2];
    const char* cA = (const char*)g.A + (size_t)cur.pm * tstepA + (size_t)cur.pn * g.a_pn * 2; const char* cB = (const char*)g.Bt + (size_t)cur.pn * tstepB;
    PG8_STAGE(PG8_SB(0, 0), cB, voffB); PG8_STAGE(PG8_SA(0, 0), cA, voffA); PG8_STAGE(PG8_SB(0, 1), cB + hstepB, voffB); PG8_STAGE(PG8_SA(0, 1), cA + hstepA, voffA);
    if (wr == 1) PG8_BAR;
    PG8_WAIT_V(4); PG8_BAR;
    PG8_STAGE(PG8_SB(1, 0), cB + kstep, voffB); PG8_STAGE(PG8_SA(1, 0), cA + kstep, voffA); PG8_STAGE(PG8_SB(1, 1), cB + hstepB + kstep, voffB);
    PG8_WAIT_V(6); PG8_BAR;
    for (;;) {
        const bool has_next = S.next(ui + 1, nxt);
        const char* nA = has_next ? (const char*)g.A + (size_t)nxt.pm * tstepA + (size_t)nxt.pn * g.a_pn * 2 : cA; const char* nB = has_next ? (const char*)g.Bt + (size_t)nxt.pn * tstepB : cB;
        for (int t = 0; t < nt; t += 2) {
            const bool last = (t == nt - 2);
            const char* a1 = cA + (size_t)(t + 1) * kstep;
            const char* a2 = last ? nA : cA + (size_t)(t + 2) * kstep; const char* b2 = last ? nB : cB + (size_t)(t + 2) * kstep;
            const char* a3 = a2 + kstep; const char* b3 = b2 + kstep;
            PG8_LDB(B0, 0, 0); PG8_SCHED; PG8_LDA(At, 0, 0); PG8_STAGE(PG8_SA(1, 1), a1 + hstepA, voffA);
            PG8_WAIT_L(8); PG8_BAR; PG8_WAIT_L(0); PG8_MMA(0, 0, At, B0); PG8_BAR; PG8_SCHED;
            PG8_LDB(B1, 0, 1); PG8_STAGE(PG8_SB(0, 0), b2, voffB);
            PG8_BAR; PG8_WAIT_L(0); PG8_MMA(0, 1, At, B1); PG8_BAR;
            PG8_LDA(At, 0, 1); PG8_STAGE(PG8_SA(0, 0), a2, voffA);
            PG8_BAR; PG8_WAIT_L(0); PG8_MMA(1, 0, At, B0); PG8_BAR; PG8_SCHED;
            PG8_STAGE(PG8_SB(0, 1), b2 + hstepB, voffB);
            PG8_WAIT_V(6); PG8_BAR; PG8_MMA(1, 1, At, B1); PG8_BAR;
            PG8_LDB(B0, 1, 0); PG8_SCHED; PG8_LDA(At, 1, 0); PG8_STAGE(PG8_SA(0, 1), a2 + hstepA, voffA);
            PG8_WAIT_L(8); PG8_BAR; PG8_WAIT_L(0); PG8_MMA(0, 0, At, B0); PG8_BAR; PG8_SCHED;
            PG8_LDB(B1, 1, 1); PG8_STAGE(PG8_SB(1, 0), b3, voffB);
            PG8_BAR; PG8_WAIT_L(0); PG8_MMA(0, 1, At, B1); PG8_BAR;
            PG8_LDA(At, 1, 1); PG8_STAGE(PG8_SA(1, 0), a3, voffA);
            PG8_BAR; PG8_WAIT_L(0); PG8_MMA(1, 0, At, B0); PG8_BAR; PG8_SCHED;
            PG8_STAGE(PG8_SB(1, 1), b3 + hstepB, voffB);
            PG8_WAIT_V(6); PG8_BAR; PG8_MMA(1, 1, At, B1); PG8_BAR;
        }
        E(acc, cur, wr, wc, fr, fq);
        if (!has_next) break;
#pragma unroll
        for (int a = 0; a < 2; ++a)
#pragma unroll
            for (int b = 0; b < 2; ++b)
#pragma unroll
                for (int m = 0; m < 4; ++m)
#pragma unroll
                    for (int n = 0; n < 2; ++n) acc[a][b][m][n] = (f32x4){0.f, 0.f, 0.f, 0.f};
        cur = nxt; cA = nA; cB = nB; ++ui;
    }
    PG8_WAIT_V(0);
    if (wr == 0) PG8_BAR;
    PG8_BAR;
#undef PG8_SA
#undef PG8_SB
#undef PG8_STAGE
#undef PG8_LDA
#undef PG8_LDB
#undef PG8_MMA
#undef PG8_WAIT_V
#undef PG8_WAIT_L
#undef PG8_BAR
#undef PG8_SCHED
}

typedef f32x4 Acc[2][2][4][2];
struct EpiZ { static constexpr bool PERM = true;
    bf16_t* Z; const float* ssp; float* ssq; float* kvraw;
    __device__ __forceinline__ void operator()(const Acc& acc, const Unit& u, int wr, int wc, int fr, int fq) const {
        const int rbase = u.pm * BM + wr * 64 + fr, col0 = u.pn * BM + wc * 32 + 8 * fq;
        const bool kvt = (kvraw != nullptr) && u.pn == 10, wantq = (ssq != nullptr) && u.pn <= 1;
#pragma unroll
        for (int ai = 0; ai < 2; ++ai)
#pragma unroll
            for (int m = 0; m < 4; ++m) { const int row = rbase + ai * HALF + m * 16; const float rs = rs_from16(ssp + (size_t)row * 16);
#pragma unroll
                for (int bj = 0; bj < 2; ++bj) { const f32x4 v0 = acc[ai][bj][m][0] * rs, v1 = acc[ai][bj][m][1] * rs; const int c = col0 + bj * HALF;
                    if (!kvt) { u32x4 w; w.x = cvt_pk_bf16(v0[0], v0[1]); w.y = cvt_pk_bf16(v0[2], v0[3]); w.z = cvt_pk_bf16(v1[0], v1[1]); w.w = cvt_pk_bf16(v1[2], v1[3]);
                        *(u32x4*)(Z + (size_t)row * LDZ + c) = w; }
                    else { float* p = kvraw + (size_t)row * 320 + (c - ZB_KV); *(f32x4*)p = v0; *(f32x4*)(p + 4) = v1; }
                    if (kvraw != nullptr && u.pn == 1 && bj == 1 && wc < 2) { float* p = kvraw + (size_t)row * 320 + 256 + (c - ZB_KR); *(f32x4*)p = v0; *(f32x4*)(p + 4) = v1; }
                    if (wantq && (u.pn == 0 || bj == 0)) { float s = sum4(v0 * v0) + sum4(v1 * v1); s += __shfl_xor(s, 16); s += __shfl_xor(s, 32);
                        if (fq == 0) ssq[(size_t)row * 12 + (u.pn == 0 ? bj * 4 + wc : 8 + wc)] = s; } } }
    }
};
struct EpiGrp { static constexpr bool PERM = true;
    const bf16_t* Z; bf16_t* MX;
    __device__ __forceinline__ void operator()(const Acc& acc, const Unit& u, int wr, int wc, int fr, int fq) const {
        const int rbase = u.pm * BM + wr * 64 + fr, col0 = u.pn * BM + wc * 32 + 8 * fq;
#pragma unroll
        for (int ai = 0; ai < 2; ++ai)
#pragma unroll
            for (int m = 0; m < 4; ++m) { const int row = rbase + ai * HALF + m * 16;
                const u32x4 g0 = *(const u32x4*)(Z + (size_t)row * LDZ + ZA_GT + col0), g1 = *(const u32x4*)(Z + (size_t)row * LDZ + ZA_GT + col0 + HALF);
#pragma unroll
                for (int bj = 0; bj < 2; ++bj) { const int c = col0 + bj * HALF; float gt[8]; unpack8(bj ? g1 : g0, gt);
                    const f32x4 v0 = acc[ai][bj][m][0], v1 = acc[ai][bj][m][1]; float o[8];
#pragma unroll
                    for (int j = 0; j < 4; ++j) { o[j] = v0[j] * silu(gt[j]); o[4 + j] = v1[j] * silu(gt[4 + j]); }
                    *(u32x4*)(MX + (size_t)row * OUTW + c) = pack8(o); }
                asm volatile("" ::: "memory"); }
    }
};
struct EpiQ { static constexpr bool PERM = true;
    bf16_t* Q; const float* ssq;
    __device__ __forceinline__ void operator()(const Acc& acc, const Unit& u, int wr, int wc, int fr, int fq) const {
        const int rbase = u.pm * BM + wr * 64 + fr, col0 = u.pn * BM + wc * 32 + 8 * fq;
#pragma unroll
        for (int ai = 0; ai < 2; ++ai)
#pragma unroll
            for (int m = 0; m < 4; ++m) { const int row = rbase + ai * HALF + m * 16; const float rs = rsq_from12(ssq + (size_t)row * 12);
#pragma unroll
                for (int bj = 0; bj < 2; ++bj) { const f32x4 v0 = acc[ai][bj][m][0] * rs, v1 = acc[ai][bj][m][1] * rs;
                    u32x4 w; w.x = cvt_pk_bf16(v0[0], v0[1]); w.y = cvt_pk_bf16(v0[2], v0[3]); w.z = cvt_pk_bf16(v1[0], v1[1]); w.w = cvt_pk_bf16(v1[2], v1[3]);
                    *(u32x4*)(Q + (size_t)row * QW + col0 + bj * HALF) = w; } }
    }
};
struct EpiKV { static constexpr bool PERM = true;
    bf16_t* KN;
    __device__ __forceinline__ void operator()(const Acc& acc, const Unit& u, int wr, int wc, int fr, int fq) const {
        const int rbase = u.pm * BM + wr * 64 + fr, col0 = (u.pn & 3) * BM + wc * 32 + 8 * fq; bf16_t* O = KN + (size_t)(u.pn >> 2) * ((size_t)PM * 1024);
#pragma unroll
        for (int ai = 0; ai < 2; ++ai)
#pragma unroll
            for (int m = 0; m < 4; ++m) { const int row = rbase + ai * HALF + m * 16;
#pragma unroll
                for (int bj = 0; bj < 2; ++bj) { const f32x4 v0 = acc[ai][bj][m][0], v1 = acc[ai][bj][m][1];
                    u32x4 w; w.x = cvt_pk_bf16(v0[0], v0[1]); w.y = cvt_pk_bf16(v0[2], v0[3]); w.z = cvt_pk_bf16(v1[0], v1[1]); w.w = cvt_pk_bf16(v1[2], v1[3]);
                    *(u32x4*)(O + (size_t)row * 1024 + col0 + bj * HALF) = w; } }
    }
};
struct EpiMem { static constexpr bool PERM = false;
    float* OK; bf16_t* MB;
    __device__ __forceinline__ void operator()(const Acc& acc, const Unit& u, int wr, int wc, int fr, int fq) const {
        const int rbase = u.pm * BM + wr * 64 + fr, col0 = u.pn * BM + wc * 32 + 4 * fq;
#pragma unroll
        for (int ai = 0; ai < 2; ++ai)
#pragma unroll
            for (int m = 0; m < 4; ++m) { const int row = rbase + ai * HALF + m * 16;
#pragma unroll
                for (int bj = 0; bj < 2; ++bj)
#pragma unroll
                    for (int n = 0; n < 2; ++n) { const int c = col0 + bj * HALF + n * 16; const int l = c >> 10, kv = (c >> 9) & 1, cc = c & 511; const f32x4 v = acc[ai][bj][m][n];
                        *(f32x4*)(OK + (size_t)kv * (O_MEMV - O_MEMK) + ((size_t)l * 2048 + row) * 512 + cc) = v;
                        u32x2 w; w.x = cvt_pk_bf16(v[0], v[1]); w.y = cvt_pk_bf16(v[2], v[3]); *(u32x2*)(MB + (size_t)row * 4096 + c) = w; } }
    }
};
struct EpiOut { static constexpr bool PERM = false;
    const float* base; float* XR; bf16_t* XB; float* ssp;
    __device__ __forceinline__ void operator()(const Acc& acc, const Unit& u, int wr, int wc, int fr, int fq) const {
        const int rbase = u.pm * BM + wr * 64 + fr, col0 = u.pn * BM + wc * 32 + 4 * fq;
#pragma unroll
        for (int ai = 0; ai < 2; ++ai)
#pragma unroll
            for (int m = 0; m < 4; ++m) { const int row = rbase + ai * HALF + m * 16; float s = 0.f;
#pragma unroll
                for (int bj = 0; bj < 2; ++bj)
#pragma unroll
                    for (int n = 0; n < 2; ++n) { const size_t o = (size_t)row * DM + col0 + bj * HALF + n * 16; const f32x4 v = *(const f32x4*)(base + o) + acc[ai][bj][m][n];
                        *(f32x4*)(XR + o) = v; u32x2 w; w.x = cvt_pk_bf16(v[0], v[1]); w.y = cvt_pk_bf16(v[2], v[3]); *(u32x2*)(XB + o) = w; s += sum4(v * v); }
                s += __shfl_xor(s, 16); s += __shfl_xor(s, 32);
                if (fq == 0) ssp[(size_t)row * 16 + u.pn * 4 + wc] = s; }
    }
};
}
namespace sg {
constexpr int BUF = 24576, LDS_BYTES = 2 * BUF;
template <class Epi>
__device__ __forceinline__ void sgemm_unit(LAS uchar* lds, const bf16_t* A, int lda, const bf16_t* Bt, int ldb, int K, int n0, const Epi& E) {
    int tid_ = threadIdx.x; asm volatile("" : "+v"(tid_));
    const int tid = tid_, wid = tid >> 6, lane = tid & 63, r32 = lane & 31, hi = lane >> 5, rb = wid & 3, cb = wid >> 2;
    const int srow = tid >> 3, sch = tid & 7;
    const bf16_t* ap0 = A + (size_t)srow * lda + sch * 8; const bf16_t* ap1 = ap0 + (size_t)64 * lda; const bf16_t* bp = Bt + (size_t)(n0 + srow) * ldb + sch * 8;
    const int aw0 = srow * 128 + ((sch ^ (srow & 7)) << 4), aw1 = aw0 + 64 * 128, bw = 16384 + aw0;
    const int arow = rb * 32 + r32, brow = cb * 32 + r32;
    const int ard = arow * 128, brd = 16384 + brow * 128, asw = arow & 7, bsw = brow & 7;
    u32x4 ra0[2], ra1[2], rbv[2];
    f32x16 acc = {};
    const int nk = K / 64;
#define SG_LOAD(s, kt) do { ra0[s] = *(const u32x4*)(ap0 + (size_t)(kt) * 64); ra1[s] = *(const u32x4*)(ap1 + (size_t)(kt) * 64); rbv[s] = *(const u32x4*)(bp + (size_t)(kt) * 64); } while (0)
#define SG_WRITE(s, b) do { *(LAS u32x4*)(lds + (b) * BUF + aw0) = ra0[s]; *(LAS u32x4*)(lds + (b) * BUF + aw1) = ra1[s]; *(LAS u32x4*)(lds + (b) * BUF + bw) = rbv[s]; } while (0)
#define SG_COMPUTE(b) do { _Pragma("unroll") for (int kk = 0; kk < 4; ++kk) { \
        const bf16x8 af = *(const LAS bf16x8*)(lds + (b) * BUF + ard + (((2 * kk + hi) ^ asw) << 4)); \
        const bf16x8 bf = *(const LAS bf16x8*)(lds + (b) * BUF + brd + (((2 * kk + hi) ^ bsw) << 4)); \
        acc = __builtin_amdgcn_mfma_f32_32x32x16_bf16(bf, af, acc, 0, 0, 0); } } while (0)
    SG_LOAD(0, 0); SG_LOAD(1, 1);
    for (int kt = 0; kt < nk; kt += 2) {
        SG_WRITE(0, 0); __syncthreads(); if (kt + 2 < nk) SG_LOAD(0, kt + 2);
        SG_COMPUTE(0);
        SG_WRITE(1, 1); __syncthreads(); if (kt + 3 < nk) SG_LOAD(1, kt + 3);
        SG_COMPUTE(1);
    }
#undef SG_LOAD
#undef SG_WRITE
#undef SG_COMPUTE
    E(acc, rb * 32 + r32, n0 + cb * 32, hi);
}

struct EpiZ { bf16_t* Z; const float* ssps; float* ssq; float* kvraw;
    __device__ __forceinline__ void operator()(const f32x16& acc, int row, int cbase, int hi) const {
        const float rs = rs_from32(ssps + row * 32); const size_t grow = (size_t)PM + row; float s = 0.f;
#pragma unroll
        for (int g = 0; g < 4; ++g) { const f32x4 v = (f32x4){acc[4 * g], acc[4 * g + 1], acc[4 * g + 2], acc[4 * g + 3]} * rs; const int c = cbase + 8 * g + 4 * hi;
            if (kvraw != nullptr && cbase >= ZB_KV) *(f32x4*)(kvraw + grow * 320 + (c - ZB_KV)) = v;
            else { u32x2 w; w.x = cvt_pk_bf16(v[0], v[1]); w.y = cvt_pk_bf16(v[2], v[3]); *(u32x2*)(Z + grow * LDZ + c) = w; }
            if (kvraw != nullptr && cbase >= ZB_KR && cbase < ZB_KR + 64) *(f32x4*)(kvraw + grow * 320 + 256 + (c - ZB_KR)) = v;
            s += sum4(v * v); }
        if (ssq != nullptr && cbase < QRANK) { s += __shfl_xor(s, 32); if (hi == 0) ssq[grow * 12 + (cbase >> 5)] = s; }
    }
};
struct EpiGrp { const bf16_t* Z; bf16_t* MX; int cofs;
    __device__ __forceinline__ void operator()(const f32x16& acc, int row, int cbase, int hi) const {
        const size_t grow = (size_t)PM + row;
#pragma unroll
        for (int g = 0; g < 4; ++g) { const int c = cofs + cbase + 8 * g + 4 * hi; const u32x2 gw = *(const u32x2*)(Z + grow * LDZ + ZA_GT + c);
            const float o0 = acc[4 * g] * silu(bf_lo(gw.x)), o1 = acc[4 * g + 1] * silu(bf_hi(gw.x)), o2 = acc[4 * g + 2] * silu(bf_lo(gw.y)), o3 = acc[4 * g + 3] * silu(bf_hi(gw.y));
            u32x2 w; w.x = cvt_pk_bf16(o0, o1); w.y = cvt_pk_bf16(o2, o3); *(u32x2*)(MX + grow * OUTW + c) = w; }
    }
};
struct EpiOut { const float* base; float* XR; bf16_t* XB; float* ssps;
    __device__ __forceinline__ void operator()(const f32x16& acc, int row, int cbase, int hi) const {
        const size_t grow = (size_t)PM + row; float s = 0.f;
#pragma unroll
        for (int g = 0; g < 4; ++g) { const int c = cbase + 8 * g + 4 * hi; const f32x4 v = *(const f32x4*)(base + (size_t)row * DM + c) + (f32x4){acc[4 * g], acc[4 * g + 1], acc[4 * g + 2], acc[4 * g + 3]};
            *(f32x4*)(XR + grow * DM + c) = v; u32x2 w; w.x = cvt_pk_bf16(v[0], v[1]); w.y = cvt_pk_bf16(v[2], v[3]); *(u32x2*)(XB + grow * DM + c) = w; s += sum4(v * v); }
        s += __shfl_xor(s, 32); if (hi == 0) ssps[row * 32 + (cbase >> 5)] = s;
    }
};
struct EpiQ { bf16_t* Q; const float* ssq;
    __device__ __forceinline__ void operator()(const f32x16& acc, int row, int cbase, int hi) const {
        const size_t grow = (size_t)PM + row; const float rs = rsq_from12(ssq + grow * 12);
#pragma unroll
        for (int g = 0; g < 4; ++g) { const int c = cbase + 8 * g + 4 * hi; u32x2 w; w.x = cvt_pk_bf16(acc[4 * g] * rs, acc[4 * g + 1] * rs); w.y = cvt_pk_bf16(acc[4 * g + 2] * rs, acc[4 * g + 3] * rs);
            *(u32x2*)(Q + grow * QW + c) = w; }
    }
};
struct EpiAbsorb { bf16_t* QD; int h;
    __device__ __forceinline__ void operator()(const f32x16& acc, int row, int cbase, int hi) const {
        const int b = row >> 2, t = row & 3; bf16_t* o = QD + ((size_t)b * 32 + t * 8 + h) * 320;
#pragma unroll
        for (int g = 0; g < 4; ++g) { const int c = cbase + 8 * g + 4 * hi; u32x2 w; w.x = cvt_pk_bf16(acc[4 * g], acc[4 * g + 1]); w.y = cvt_pk_bf16(acc[4 * g + 2], acc[4 * g + 3]); *(u32x2*)(o + c) = w; }
    }
};
struct EpiVup { const bf16_t* Z; bf16_t* MX; int h;
    __device__ __forceinline__ void operator()(const f32x16& acc, int row, int cbase, int hi) const {
        const size_t grow = (size_t)PM + row;
#pragma unroll
        for (int g = 0; g < 4; ++g) { const int c = h * 128 + cbase + 8 * g + 4 * hi; const u32x2 gw = *(const u32x2*)(Z + grow * LDZ + ZB_GT + c);
            const float o0 = acc[4 * g] * silu(bf_lo(gw.x)), o1 = acc[4 * g + 1] * silu(bf_hi(gw.x)), o2 = acc[4 * g + 2] * silu(bf_lo(gw.y)), o3 = acc[4 * g + 3] * silu(bf_hi(gw.y));
            u32x2 w; w.x = cvt_pk_bf16(o0, o1); w.y = cvt_pk_bf16(o2, o3); *(u32x2*)(MX + grow * OUTW + c) = w; }
    }
};
}
namespace att {
constexpr int NW = 8, QBLK = 32, KVBLK = 64;
constexpr int SHM_V = KVBLK * 128 * 2, SHM_K = KVBLK * 128 * 2, SHM_KR = KVBLK * 64 * 2;
constexpr int OFF_V = 0, OFF_K = 2 * SHM_V, OFF_KR = OFF_K + 2 * SHM_K, OFF_WS = OFF_KR + 2 * SHM_KR, OFF_QR = OFF_WS + NW * 64 * 4, LDS_BYTES = OFF_QR + NW * 4096;
constexpr float THR = 8.f;
#define KSWZ(row, colB) ((row) * 256 + ((colB) ^ (((row) & 7) << 4)))
#define KRSWZ(row, colB) ((row) * 128 + ((colB) ^ (((row) & 7) << 4)))
#define SBAR() __builtin_amdgcn_sched_barrier(0)
template <int DQK> struct Cst { static constexpr float SCALE = (DQK == 128) ? 0.08838834764831845f : 0.07216878364870322f; };

template <int DQK>
__device__ __forceinline__ void partialSM(f32x16& p0, f32x16& p1, float& m_reg, float& mn, float& alpha) {
    constexpr float SCALE = Cst<DQK>::SCALE, C = SCALE * 1.4426950408889634f;
    float pmax = p0[0];
#pragma unroll
    for (int r = 1; r < 16; ++r) pmax = fmaxf(pmax, p0[r]);
#pragma unroll
    for (int r = 0; r < 16; ++r) pmax = fmaxf(pmax, p1[r]);
    { auto rr = __builtin_amdgcn_permlane32_swap(__float_as_uint(pmax), __float_as_uint(pmax), false, false);
      pmax = fmaxf(__uint_as_float(rr[0]), __uint_as_float(rr[1])); }
    if (__builtin_expect(__all(pmax - m_reg <= THR / SCALE), 1)) { mn = m_reg; alpha = 1.f; }
    else { mn = fmaxf(m_reg, pmax); alpha = __builtin_amdgcn_exp2f((m_reg - mn) * C); m_reg = mn; }
    const float mnC = -mn * C;
#pragma unroll
    for (int r = 0; r < 16; ++r) p0[r] = fmaf(p0[r], C, mnC);
#pragma unroll
    for (int r = 0; r < 16; ++r) p1[r] = fmaf(p1[r], C, mnC);
#pragma unroll
    for (int r = 0; r < 16; ++r) p0[r] = __builtin_amdgcn_exp2f(p0[r]);
}
__device__ __forceinline__ void finishSM(f32x16& p0, f32x16& p1, float alpha, float& l_reg, bf16x8& pa0, bf16x8& pa1, bf16x8& pa2, bf16x8& pa3) {
#pragma unroll
    for (int r = 0; r < 16; ++r) p1[r] = __builtin_amdgcn_exp2f(p1[r]);
    float ps = 0;
#pragma unroll
    for (int r = 0; r < 16; ++r) ps += p0[r];
#pragma unroll
    for (int r = 0; r < 16; ++r) ps += p1[r];
    { auto rr = __builtin_amdgcn_permlane32_swap(__float_as_uint(ps), __float_as_uint(ps), false, false);
      ps = __uint_as_float(rr[0]) + __uint_as_float(rr[1]); }
    l_reg = l_reg * alpha + ps;
#define PK4(P, BASE, OUT) do { unsigned a0 = cvt_pk_bf16(P[BASE + 0], P[BASE + 1]), a1 = cvt_pk_bf16(P[BASE + 2], P[BASE + 3]);   \
    unsigned b0 = cvt_pk_bf16(P[BASE + 4], P[BASE + 5]), b1 = cvt_pk_bf16(P[BASE + 6], P[BASE + 7]);                              \
    auto r0 = __builtin_amdgcn_permlane32_swap(a0, b0, false, false); auto r1 = __builtin_amdgcn_permlane32_swap(a1, b1, false, false); \
    u32x4 w = {r0[0], r1[0], r0[1], r1[1]}; OUT = *reinterpret_cast<bf16x8*>(&w); } while (0)
    PK4(p0, 0, pa0); PK4(p0, 8, pa1); PK4(p1, 0, pa2); PK4(p1, 8, pa3);
#undef PK4
}
template <int DQK>
__device__ __forceinline__ void qkt(f32x16& p0, f32x16& p1, const LAS uchar* Ks, const LAS uchar* Krs, const bf16x8* qr, const LAS uchar* qrl  , int r32, int hi) {
    p0 = f32x16{}; p1 = f32x16{};
#pragma unroll
    for (int d0 = 0; d0 < 8; ++d0) { const int cb = (d0 * 16 + hi * 8) * 2;
        const bf16x8 b0 = *(const LAS bf16x8*)(Ks + KSWZ(r32, cb));
        const bf16x8 b1 = *(const LAS bf16x8*)(Ks + KSWZ(32 + r32, cb));
        p0 = __builtin_amdgcn_mfma_f32_32x32x16_bf16(b0, qr[d0], p0, 0, 0, 0);
        p1 = __builtin_amdgcn_mfma_f32_32x32x16_bf16(b1, qr[d0], p1, 0, 0, 0); }
    if constexpr (DQK == 192) {
#pragma unroll
        for (int d0 = 0; d0 < 4; ++d0) { const int cb = (d0 * 16 + hi * 8) * 2;
            const bf16x8 b0 = *(const LAS bf16x8*)(Krs + KRSWZ(r32, cb));
            const bf16x8 b1 = *(const LAS bf16x8*)(Krs + KRSWZ(32 + r32, cb));
            const bf16x8 qf = *(const LAS bf16x8*)(qrl + d0 * 1024);
            p0 = __builtin_amdgcn_mfma_f32_32x32x16_bf16(b0, qf, p0, 0, 0, 0);
            p1 = __builtin_amdgcn_mfma_f32_32x32x16_bf16(b1, qf, p1, 0, 0, 0); }
    }
}
__device__ __forceinline__ int v_st(int k, int c) { const int kk = (k & ~0xC) | ((k & 4) << 1) | ((k & 8) >> 1); return ((kk >> 3) * 4 + (c >> 5)) * 512 + ((kk & 7) * 32 + (c & 31)) * 2; }
__device__ __forceinline__ int v_rd_base(int lane) { return ((lane & 3) << 3) | (((lane >> 2) & 3) << 6) | (((lane >> 4) & 1) << 5) | (((lane >> 5) & 1) << 8); }
constexpr int v_rd_off(int d0, int ks, int half) { return d0 * 512 + ks * 4096 + half * 2048; }
template <int OFF> __device__ __forceinline__ s16x4 tr_read(int vb) {
    s16x4 r; asm volatile("ds_read_b64_tr_b16 %0, %1 offset:%2" : "=&v"(r) : "v"(vb), "i"(OFF) : "memory"); return r;
}
template <int D0> __device__ __forceinline__ void pv_one(f32x16& od, int vb, bf16x8 pa0, bf16x8 pa1, bf16x8 pa2, bf16x8 pa3) {
    const s16x4 l0 = tr_read<v_rd_off(D0, 0, 0)>(vb), h0 = tr_read<v_rd_off(D0, 0, 1)>(vb), l1 = tr_read<v_rd_off(D0, 1, 0)>(vb), h1 = tr_read<v_rd_off(D0, 1, 1)>(vb);
    const s16x4 l2 = tr_read<v_rd_off(D0, 2, 0)>(vb), h2 = tr_read<v_rd_off(D0, 2, 1)>(vb), l3 = tr_read<v_rd_off(D0, 3, 0)>(vb), h3 = tr_read<v_rd_off(D0, 3, 1)>(vb);
    asm volatile("s_waitcnt lgkmcnt(0)" ::: "memory"); SBAR();
#define PK(L, H) (bf16x8){L[0], L[1], L[2], L[3], H[0], H[1], H[2], H[3]}
    od = __builtin_amdgcn_mfma_f32_32x32x16_bf16(pa0, PK(l0, h0), od, 0, 0, 0);
    od = __builtin_amdgcn_mfma_f32_32x32x16_bf16(pa1, PK(l1, h1), od, 0, 0, 0);
    od = __builtin_amdgcn_mfma_f32_32x32x16_bf16(pa2, PK(l2, h2), od, 0, 0, 0);
    od = __builtin_amdgcn_mfma_f32_32x32x16_bf16(pa3, PK(l3, h3), od, 0, 0, 0);
#undef PK
}
__device__ __forceinline__ void pv_d0(f32x16* o, int vb, bf16x8 pa0, bf16x8 pa1, bf16x8 pa2, bf16x8 pa3) {
    pv_one<0>(o[0], vb, pa0, pa1, pa2, pa3); pv_one<1>(o[1], vb, pa0, pa1, pa2, pa3); pv_one<2>(o[2], vb, pa0, pa1, pa2, pa3); pv_one<3>(o[3], vb, pa0, pa1, pa2, pa3);
}
__device__ __forceinline__ void causal_mask(f32x16& p0, f32x16& p1, int jj, int rowrel, int hi) {
#pragma unroll
    for (int r = 0; r < 16; ++r) { const int k0 = 64 * jj + crow(r, hi); if (k0 > rowrel) p0[r] = -1e30f; if (k0 + 32 > rowrel) p1[r] = -1e30f; }
}

template <int DQK, bool CAUSAL, int SD, int LDQ, int LDK>
__device__ __forceinline__ void attn_body(const bf16_t* __restrict__ Qb, const bf16_t* __restrict__ Kh, const bf16_t* __restrict__ Vh, const bf16_t* __restrict__ Krp,
                                          const f32x2* __restrict__ ropeq, const bf16_t* __restrict__ gate, bf16_t* __restrict__ outp, int NT, int diag0, LAS uchar* lds) {
    constexpr int NQ = 8;
    int tid_ = threadIdx.x; asm volatile("" : "+v"(tid_));
    const int tid = tid_, wid = tid >> 6, lane = tid & 63, r32 = lane & 31, hi = lane >> 5;
    LAS uchar* V_lds = lds + OFF_V; LAS uchar* K_lds = lds + OFF_K; LAS uchar* Kr_lds = lds + OFF_KR;
    LAS float* ws = (LAS float*)(lds + OFF_WS) + wid * 64; LAS float* li_l = ws; LAS float* al_l = ws + 32; LAS uchar* qrl = lds + OFF_QR + wid * 4096 + lane * 16;
    float m_reg = -1e30f, l_reg = 0; f32x16 o[4] = {}; bf16x8 qr[NQ];
    const bf16_t* Qw = Qb + (size_t)(wid * QBLK + r32) * LDQ + hi * 8;
#pragma unroll
    for (int d0 = 0; d0 < 8; ++d0) qr[d0] = *(const bf16x8*)(Qw + d0 * 16);
    if constexpr (DQK == 192) {
#pragma unroll
        for (int a = 0; a < 2; ++a) {
            const u32x4 w1 = *(const u32x4*)(Qw + 128 + 16 * a), w2 = *(const u32x4*)(Qw + 160 + 16 * a); float x1[8], x2[8], o1[8], o2[8]; unpack8(w1, x1); unpack8(w2, x2);
            const f32x2* tb = ropeq + (size_t)(wid * QBLK + r32) * 32 + 16 * a + 8 * hi;
#pragma unroll
            for (int j = 0; j < 8; ++j) { const f32x2 cs = tb[j]; o1[j] = x1[j] * cs.x - x2[j] * cs.y; o2[j] = x1[j] * cs.y + x2[j] * cs.x; }
            *(LAS u32x4*)(qrl + a * 1024) = pack8(o1); *(LAS u32x4*)(qrl + (2 + a) * 1024) = pack8(o2);
        }
    }
    const int sr = tid >> 4, sc = (tid & 15) * 8, vst0 = v_st(sr, sc), vst1 = v_st(32 + sr, sc);
    const int krow = tid >> 3, kcc = (tid & 7) * 8;
    const int vb0 = (int)(unsigned)(uintptr_t)V_lds + v_rd_base(lane);
    struct { bf16x8 vs0, vs1, ks0, ks1, kr; } sr_[SD];
#define SLOAD(i, k0) do { sr_[i].vs0 = *(const bf16x8*)(Vh + (size_t)((k0) + sr) * LDK + sc); sr_[i].vs1 = *(const bf16x8*)(Vh + (size_t)((k0) + 32 + sr) * LDK + sc); \
    sr_[i].ks0 = *(const bf16x8*)(Kh + (size_t)((k0) + sr) * LDK + sc); sr_[i].ks1 = *(const bf16x8*)(Kh + (size_t)((k0) + 32 + sr) * LDK + sc); \
    if constexpr (DQK == 192) sr_[i].kr = *(const bf16x8*)(Krp + (size_t)((k0) + krow) * 64 + kcc); } while (0)
#define SWRITE(b, i) do { *(LAS bf16x8*)(V_lds + (b) * SHM_V + vst0) = sr_[i].vs0; *(LAS bf16x8*)(V_lds + (b) * SHM_V + vst1) = sr_[i].vs1; const int kc = sc * 2; \
    *(LAS bf16x8*)(K_lds + (b) * SHM_K + KSWZ(sr, kc)) = sr_[i].ks0; *(LAS bf16x8*)(K_lds + (b) * SHM_K + KSWZ(32 + sr, kc)) = sr_[i].ks1; \
    if constexpr (DQK == 192) *(LAS bf16x8*)(Kr_lds + (b) * SHM_KR + KRSWZ(krow, kcc * 2)) = sr_[i].kr; } while (0)
#define SWAIT() do { if constexpr (SD == 2) { if constexpr (DQK == 192) asm volatile("s_waitcnt vmcnt(5)" ::: "memory"); else asm volatile("s_waitcnt vmcnt(4)" ::: "memory"); } \
    else asm volatile("s_waitcnt vmcnt(0)" ::: "memory"); } while (0)
#define RESC(a) do { if (__any((a) < 1.f)) { if (hi == 0) al_l[r32] = (a); asm volatile("s_waitcnt lgkmcnt(0)" ::: "memory"); \
    _Pragma("unroll") for (int d = 0; d < 4; ++d) _Pragma("unroll") for (int r = 0; r < 16; ++r) o[d][r] *= al_l[crow(r, hi)]; } } while (0)
#define MASK(P0, P1, tile) do { if constexpr (CAUSAL) { if ((tile) >= diag0) causal_mask(P0, P1, (tile) - diag0, wid * QBLK + r32, hi); } } while (0)
    f32x16 pA0, pA1, pB0, pB1; float mnA, mnB, alA, alB; bf16x8 pa0, pa1, pa2, pa3;
    constexpr int SE = 0, SO = SD - 1;
    SLOAD(SE, 0); asm volatile("s_waitcnt vmcnt(0)" ::: "memory"); SWRITE(0, SE); __syncthreads();
    qkt<DQK>(pA0, pA1, K_lds, Kr_lds, qr, qrl, r32, hi); MASK(pA0, pA1, 0); partialSM<DQK>(pA0, pA1, m_reg, mnA, alA);
    SLOAD(SO, KVBLK); if constexpr (SD == 2) { if (2 < NT) SLOAD(SE, 2 * KVBLK); }
    SWAIT(); SWRITE(1, SO); __syncthreads();
    for (int j = 1; j + 1 < NT; j += 2) {
        SBAR(); qkt<DQK>(pB0, pB1, K_lds + SHM_K, Kr_lds + SHM_KR, qr, qrl, r32, hi); MASK(pB0, pB1, j);
        finishSM(pA0, pA1, alA, l_reg, pa0, pa1, pa2, pa3); SBAR();
        SLOAD(SO, (j + SD) * KVBLK); SBAR();
        pv_d0(o, vb0, pa0, pa1, pa2, pa3); partialSM<DQK>(pB0, pB1, m_reg, mnB, alB);
        __syncthreads(); SWAIT(); SWRITE(0, SE);
        RESC(alB); __syncthreads();
        SBAR(); qkt<DQK>(pA0, pA1, K_lds, Kr_lds, qr, qrl, r32, hi); MASK(pA0, pA1, j + 1);
        finishSM(pB0, pB1, alB, l_reg, pa0, pa1, pa2, pa3); SBAR();
        if (SD == 1 || j + 3 < NT) SLOAD(SE, (j + 1 + SD) * KVBLK); SBAR();
        pv_d0(o, vb0 + SHM_V, pa0, pa1, pa2, pa3); partialSM<DQK>(pA0, pA1, m_reg, mnA, alA);
        __syncthreads(); SWAIT(); SWRITE(1, SO);
        RESC(alA); __syncthreads();
    }
    SBAR(); qkt<DQK>(pB0, pB1, K_lds + SHM_K, Kr_lds + SHM_KR, qr, qrl, r32, hi); MASK(pB0, pB1, NT - 1);
    finishSM(pA0, pA1, alA, l_reg, pa0, pa1, pa2, pa3); SBAR();
    pv_d0(o, vb0, pa0, pa1, pa2, pa3); partialSM<DQK>(pB0, pB1, m_reg, mnB, alB);
    __syncthreads(); RESC(alB);
    finishSM(pB0, pB1, alB, l_reg, pa0, pa1, pa2, pa3); SBAR();
    pv_d0(o, vb0 + SHM_V, pa0, pa1, pa2, pa3);
    if (hi == 0) li_l[r32] = l_reg; asm volatile("s_waitcnt lgkmcnt(0)" ::: "memory");
    float rli[16];
#pragma unroll
    for (int r = 0; r < 16; ++r) rli[r] = __builtin_amdgcn_rcpf(li_l[crow(r, hi)]);
#pragma unroll
    for (int r = 0; r < 16; ++r) { const size_t orow = (size_t)(wid * QBLK + crow(r, hi));
#pragma unroll
        for (int d0 = 0; d0 < 4; ++d0) { const int col = d0 * 32 + r32; const float g = bf2f(gate[orow * LDZ + col]);
            outp[orow * OUTW + col] = (bf16_t)(cvt_pk_bf16(o[d0][r] * rli[r] * silu(g), 0.f) & 0xffffu); } }
#undef SLOAD
#undef SWRITE
#undef SWAIT
#undef RESC
#undef MASK
}
}
namespace dec {
constexpr int BUFB = 40960, OFF_KR = 32768, OFF_WS = 2 * BUFB, LDS_BYTES = OFF_WS + 8 * 64 * 4;
__device__ __forceinline__ unsigned off_b(unsigned row, unsigned ch) { return 256u * row + 16u * (ch ^ (((row & 3) << 2) | ((row >> 2) & 3))); }
__device__ __forceinline__ unsigned row_read_addr(unsigned lane, unsigned s) { return off_b(lane & 31, 2 * s + (lane >> 5)); }
__device__ __forceinline__ unsigned tr_read_addr(unsigned lane, unsigned c, unsigned ks, unsigned t) {
    const unsigned h = lane >> 5, blk = (lane >> 4) & 1, q = (lane & 15) >> 2, p = lane & 3;
    return off_b(16 * ks + 8 * h + 4 * t + q, 4 * c + 2 * blk + (p >> 1)) + 8 * (p & 1);
}
__device__ __forceinline__ s16x4 tr_rd(unsigned addr) { s16x4 r; asm volatile("ds_read_b64_tr_b16 %0, %1" : "=&v"(r) : "v"(addr) : "memory"); return r; }

__device__ __forceinline__ void decode_unit(const bf16_t* __restrict__ Qd, const float* __restrict__ cckv, const float* __restrict__ ckr, const int* __restrict__ pt,
                                            float* __restrict__ Opart, float* __restrict__ ML, LAS uchar* lds) {
    int tid_ = threadIdx.x; asm volatile("" : "+v"(tid_));
    const int tid = tid_, wid = tid >> 6, lane = tid & 63, r32 = lane & 31, hi = lane >> 5;
    LAS float* al_l = (LAS float*)(lds + OFF_WS) + wid * 64;
    bf16x8 qr[20];
#pragma unroll
    for (int s = 0; s < 20; ++s) qr[s] = *(const bf16x8*)(Qd + (size_t)r32 * 320 + s * 16 + hi * 8);
    float m_reg = -1e30f, l_reg = 0.f; f32x16 o = {};
    const int skey = tid >> 3, sub = tid & 7;
    f32x4 sv[10];
    unsigned wa[4];
#pragma unroll
    for (int i = 0; i < 4; ++i) { const int ci = sub * 4 + i; wa[i] = (unsigned)(((ci >> 4) * 2 + (skey >> 5)) * 8192) + off_b(skey & 31, ci & 15); }
    const unsigned wkr = OFF_KR + skey * 128 + ((sub ^ (skey & 7)) << 4);
    const unsigned ldsb = (unsigned)(uintptr_t)lds;
    const int pw = wid >> 2, cw = wid & 3;
#define DLOAD(j) do { const int page = pt[(j) >> 1]; const size_t krow = (size_t)page * 128 + ((j) & 1) * 64 + skey; \
    const float* s0 = cckv + krow * 256 + sub * 32; const float* s1 = ckr + krow * 64 + sub * 8; \
    _Pragma("unroll") for (int i = 0; i < 8; ++i) sv[i] = __builtin_nontemporal_load((const f32x4*)s0 + i); \
    sv[8] = __builtin_nontemporal_load((const f32x4*)s1); sv[9] = __builtin_nontemporal_load((const f32x4*)s1 + 1); } while (0)
#define DWRITE(b) do { _Pragma("unroll") for (int i = 0; i < 5; ++i) { u32x4 w; w.x = cvt_pk_bf16(sv[2 * i][0], sv[2 * i][1]); w.y = cvt_pk_bf16(sv[2 * i][2], sv[2 * i][3]); \
        w.z = cvt_pk_bf16(sv[2 * i + 1][0], sv[2 * i + 1][1]); w.w = cvt_pk_bf16(sv[2 * i + 1][2], sv[2 * i + 1][3]); \
        *(LAS u32x4*)(lds + (b) * BUFB + (i < 4 ? wa[i < 4 ? i : 0] : wkr)) = w; } } while (0)
    constexpr int NT = 32;
    DLOAD(0); DWRITE(0); __syncthreads();
    for (int j = 0; j < NT; ++j) {
        const int b = j & 1;
        if (j + 1 < NT) DLOAD(j + 1);
        const LAS uchar* B = lds + b * BUFB;
        f32x16 p0 = {}, p1 = {};
#pragma unroll
        for (int s = 0; s < 16; ++s) { const unsigned ra = row_read_addr(lane, s & 7);
            const bf16x8 k0 = *(const LAS bf16x8*)(B + ((s >> 3) * 2 + 0) * 8192 + ra), k1 = *(const LAS bf16x8*)(B + ((s >> 3) * 2 + 1) * 8192 + ra);
            p0 = __builtin_amdgcn_mfma_f32_32x32x16_bf16(k0, qr[s], p0, 0, 0, 0); p1 = __builtin_amdgcn_mfma_f32_32x32x16_bf16(k1, qr[s], p1, 0, 0, 0); }
#pragma unroll
        for (int s = 0; s < 4; ++s) { const int chk = 2 * s + hi;
            const bf16x8 k0 = *(const LAS bf16x8*)(B + OFF_KR + r32 * 128 + ((chk ^ (r32 & 7)) << 4)), k1 = *(const LAS bf16x8*)(B + OFF_KR + (32 + r32) * 128 + ((chk ^ (r32 & 7)) << 4));
            p0 = __builtin_amdgcn_mfma_f32_32x32x16_bf16(k0, qr[16 + s], p0, 0, 0, 0); p1 = __builtin_amdgcn_mfma_f32_32x32x16_bf16(k1, qr[16 + s], p1, 0, 0, 0); }
        float mn, alpha; att::partialSM<192>(p0, p1, m_reg, mn, alpha);
        if (__any(alpha < 1.f)) { if (hi == 0) al_l[r32] = alpha; asm volatile("s_waitcnt lgkmcnt(0)" ::: "memory");
#pragma unroll
            for (int r = 0; r < 16; ++r) o[r] *= al_l[crow(r, hi)]; }
        bf16x8 pa[4]; att::finishSM(p0, p1, alpha, l_reg, pa[0], pa[1], pa[2], pa[3]);
        s16x4 vl[4], vh[4];
#pragma unroll
        for (int ks = 0; ks < 4; ++ks) { const unsigned vb = ldsb + b * BUFB + (pw * 2 + (ks >> 1)) * 8192;
            vl[ks] = tr_rd(vb + tr_read_addr(lane, cw, ks & 1, 0)); vh[ks] = tr_rd(vb + tr_read_addr(lane, cw, ks & 1, 1)); }
        asm volatile("s_waitcnt lgkmcnt(0)" ::: "memory"); __builtin_amdgcn_sched_barrier(0);
#pragma unroll
        for (int ks = 0; ks < 4; ++ks) o = __builtin_amdgcn_mfma_f32_32x32x16_bf16(pa[ks], ((bf16x8){vl[ks][0], vl[ks][1], vl[ks][2], vl[ks][3], vh[ks][0], vh[ks][1], vh[ks][2], vh[ks][3]}), o, 0, 0, 0);
        if (j + 1 < NT) DWRITE(b ^ 1);
        __syncthreads();
    }
#undef DLOAD
#undef DWRITE
    if (wid == 0 && hi == 0) { ML[r32 * 2] = m_reg; ML[r32 * 2 + 1] = l_reg; }
#pragma unroll
    for (int r = 0; r < 16; ++r) Opart[(size_t)crow(r, hi) * 256 + 32 * wid + r32] = o[r];
}

__device__ __forceinline__ void combine_row(int b, int row32, int lane, const bf16_t* __restrict__ Qdec, const float* __restrict__ Opart, const float* __restrict__ ML,
                                            const float* __restrict__ ckvn, const float* __restrict__ krn, bf16_t* __restrict__ olat) {
    constexpr float C = 0.07216878364870322f * 1.4426950408889634f;
    const int t = row32 >> 3, h = row32 & 7;
    const bf16_t* q = Qdec + ((size_t)b * 32 + row32) * 320;
    const u32x2 qw = *(const u32x2*)(q + 4 * lane); const float q0 = bf_lo(qw.x), q1 = bf_hi(qw.x), q2 = bf_lo(qw.y), q3 = bf_hi(qw.y); const float qrp = bf2f(q[256 + lane]);
    float sj[4]; f32x4 cn[4];
#pragma unroll
    for (int j = 0; j < 4; ++j) { cn[j] = *(const f32x4*)(ckvn + ((size_t)b * 4 + j) * 256 + 4 * lane); float s = q0 * cn[j][0] + q1 * cn[j][1] + q2 * cn[j][2] + q3 * cn[j][3] + qrp * krn[((size_t)b * 4 + j) * 64 + lane];
#pragma unroll
        for (int o = 32; o >= 1; o >>= 1) s += __shfl_xor(s, o);
        sj[j] = (j <= t) ? s : -1e30f; }
    float mc[8], lc[8], M = fmaxf(fmaxf(sj[0], sj[1]), fmaxf(sj[2], sj[3]));
#pragma unroll
    for (int c = 0; c < 8; ++c) { const f32x2 ml = *(const f32x2*)(ML + (((size_t)b * 8 + c) * 32 + row32) * 2); mc[c] = ml.x; lc[c] = ml.y; M = fmaxf(M, mc[c]); }
    float L = 0.f; f32x4 acc = {0.f, 0.f, 0.f, 0.f};
#pragma unroll
    for (int c = 0; c < 8; ++c) { const float w = __builtin_amdgcn_exp2f((mc[c] - M) * C); L += lc[c] * w; acc += *(const f32x4*)(Opart + (((size_t)b * 8 + c) * 32 + row32) * 256 + 4 * lane) * w; }
#pragma unroll
    for (int j = 0; j < 4; ++j) { const float e = (j <= t) ? __builtin_amdgcn_exp2f((sj[j] - M) * C) : 0.f; L += e; acc += cn[j] * e; }
    const float rl = 1.0f / L; u32x2 w; w.x = cvt_pk_bf16(acc[0] * rl, acc[1] * rl); w.y = cvt_pk_bf16(acc[2] * rl, acc[3] * rl);
    *(u32x2*)(olat + ((size_t)b * 4 + t) * 2048 + h * 256 + 4 * lane) = w;
}

constexpr int SMEM_LDS = 4096 + 32768;
__device__ __forceinline__ void smem_unit(const bf16_t* __restrict__ Zq  , const bf16_t* __restrict__ Zg  , const float* __restrict__ Kc, const float* __restrict__ Vc  ,
                                          bf16_t* __restrict__ outp  , LAS uchar* lds) {
    int tid_ = threadIdx.x; asm volatile("" : "+v"(tid_));
    const int tid = tid_, wid = tid >> 6, lane = tid & 63, l32 = lane & 31, hi = lane >> 5;
    LAS float* sc = (LAS float*)lds; LAS float* red = (LAS float*)(lds + 4096);
    float qv[4][4];
#pragma unroll
    for (int t = 0; t < 4; ++t) { const u32x2 w = *(const u32x2*)(Zq + (size_t)t * LDZ + 4 * l32); qv[t][0] = bf_lo(w.x); qv[t][1] = bf_hi(w.x); qv[t][2] = bf_lo(w.y); qv[t][3] = bf_hi(w.y); }
#pragma unroll 4
    for (int i = 0; i < 16; ++i) { const int m = wid * 32 + 2 * i + hi; const f32x4 kv = *(const f32x4*)(Kc + (size_t)m * 512 + 4 * l32); float p[4];
#pragma unroll
        for (int t = 0; t < 4; ++t) { p[t] = kv[0] * qv[t][0] + kv[1] * qv[t][1] + kv[2] * qv[t][2] + kv[3] * qv[t][3];
#pragma unroll
            for (int o = 16; o >= 1; o >>= 1) p[t] += __shfl_xor(p[t], o); }
        if (l32 == 0) {
#pragma unroll
            for (int t = 0; t < 4; ++t) sc[t * 256 + m] = p[t] * 0.08838834764831845f; } }
    __syncthreads();
    if (wid < 4) { float v[4], mx = -1e30f;
#pragma unroll
        for (int i = 0; i < 4; ++i) { v[i] = sc[wid * 256 + lane + 64 * i]; mx = fmaxf(mx, v[i]); }
#pragma unroll
        for (int o = 32; o >= 1; o >>= 1) mx = fmaxf(mx, __shfl_xor(mx, o));
        float s = 0.f;
#pragma unroll
        for (int i = 0; i < 4; ++i) { v[i] = __expf(v[i] - mx); s += v[i]; }
#pragma unroll
        for (int o = 32; o >= 1; o >>= 1) s += __shfl_xor(s, o);
        const float rs = 1.0f / s;
#pragma unroll
        for (int i = 0; i < 4; ++i) sc[wid * 256 + lane + 64 * i] = v[i] * rs; }
    __syncthreads();
    { const int d4 = (tid & 31) * 4, mg = tid >> 5; f32x4 a[4] = {};
#pragma unroll 4
      for (int mm = 0; mm < 16; ++mm) { const int m = mg * 16 + mm; const f32x4 vv = *(const f32x4*)(Vc + (size_t)m * 512 + d4);
#pragma unroll
          for (int t = 0; t < 4; ++t) a[t] += vv * sc[t * 256 + m]; }
#pragma unroll
      for (int t = 0; t < 4; ++t) *(LAS f32x4*)(red + (mg * 4 + t) * 128 + d4) = a[t]; }
    __syncthreads();
    { const int t = tid >> 7, d = tid & 127; float s = 0.f;
#pragma unroll
      for (int mg = 0; mg < 16; ++mg) s += red[(mg * 4 + t) * 128 + d];
      const float g = bf2f(Zg[(size_t)t * LDZ + d]);
      outp[(size_t)t * OUTW + d] = (bf16_t)(cvt_pk_bf16(s * silu(g), 0.f) & 0xffffu); }
    __syncthreads();
}
}
namespace ew {
__device__ __forceinline__ int otid() { int t = threadIdx.x; asm volatile("" : "+v"(t)); return t; }
struct TJ { const float* src; int sld, K, ncols; const float* gain; const float* cscale; bf16_t* dst; int dld; };
constexpr int NTJ = 32;
__device__ __forceinline__ TJ get_tj(int j, const float* const* in, uchar* ws) {
    TJ t; t.gain = nullptr; t.cscale = nullptr;
    bf16_t* WINA = (bf16_t*)(ws + WS_WINA); bf16_t* WGRP = (bf16_t*)(ws + WS_WGRP); bf16_t* WINB = (bf16_t*)(ws + WS_WINB); bf16_t* WQUP = (bf16_t*)(ws + WS_WQUP);
    bf16_t* WKV = (bf16_t*)(ws + WS_WKV); bf16_t* WMEM = (bf16_t*)(ws + WS_WMEM); bf16_t* WOUT = (bf16_t*)(ws + WS_WOUT);
    if (j < 2) { t.src = in[10] + (size_t)j * DM * INA; t.sld = INA; t.K = DM; t.ncols = INA; t.gain = in[9] + j * DM; t.dst = WINA + (size_t)j * INA * DM; t.dld = DM; }
    else if (j < 10) { const int i = j - 2; t.src = in[11] + (size_t)i * 65536; t.sld = 256; t.K = 256; t.ncols = 256; t.cscale = in[12] + i * 256; t.dst = WGRP + (size_t)i * 65536; t.dld = 256; }
    else if (j < 12) { const int i = j - 10; t.src = in[13] + (size_t)i * DM * INB; t.sld = INB; t.K = DM; t.ncols = QRANK; t.gain = in[9] + (2 + i) * DM; t.dst = WINB + (size_t)i * NB2 * DM; t.dld = DM; }
    else if (j < 14) { const int i = j - 12; t.src = in[13] + (size_t)i * DM * INB + QRANK; t.sld = INB; t.K = DM; t.ncols = INB - QRANK; t.gain = in[9] + (2 + i) * DM; t.dst = WINB + ((size_t)i * NB2 + ZB_GT) * DM; t.dld = DM; }
    else if (j == 14) { t.src = in[17] + KVR; t.sld = 320; t.K = DM; t.ncols = ROPE; t.gain = in[16]; t.dst = WINB + (size_t)ZB_KR * DM; t.dld = DM; }
    else if (j == 15) { t.src = in[17]; t.sld = 320; t.K = DM; t.ncols = KVR; t.gain = in[16]; t.dst = WINB + (size_t)ZB_KV * DM; t.dld = DM; }
    else if (j < 18) { const int i = j - 16; t.src = in[15] + (size_t)i * QRANK * QW; t.sld = QW; t.K = QRANK; t.ncols = QW; t.gain = in[14] + i * QRANK; t.dst = WQUP + (size_t)i * QW * QRANK; t.dld = QRANK; }
    else if (j == 18) { t.src = in[19]; t.sld = 1024; t.K = 256; t.ncols = 1024; t.dst = WKV; t.dld = 256; }
    else if (j == 19) { t.src = in[20]; t.sld = 1024; t.K = 256; t.ncols = 1024; t.dst = WKV + (size_t)1024 * 256; t.dld = 256; }
    else if (j < 28) { const int i = j - 20, l = i >> 1, kv = i & 1; t.src = (kv ? in[23] : in[22]) + (size_t)l * DM * MEMW; t.sld = MEMW; t.K = DM; t.ncols = MEMW; t.gain = in[21] + l * DM; t.dst = WMEM + (size_t)(l * 2 + kv) * MEMW * DM; t.dld = DM; }
    else { const int l = j - 28; t.src = in[24] + (size_t)l * OUTW * DM; t.sld = DM; t.K = OUTW; t.ncols = DM; t.dst = WOUT + (size_t)l * DM * OUTW; t.dld = OUTW; }
    return t;
}
__device__ __forceinline__ int tj_tiles(int j) {
    if (j < 2) return 16 * 48; if (j < 10) return 16; if (j < 12) return 16 * 6; if (j < 14) return 16 * 32; if (j == 14) return 16; if (j == 15) return 64;
    if (j < 18) return 6 * 24; if (j < 20) return 4 * 16; if (j < 28) return 16 * 8; return 24 * 16;
}
constexpr int TJ_TOTAL = 2 * 768 + 8 * 16 + 2 * 96 + 2 * 512 + 16 + 64 + 2 * 144 + 2 * 64 + 8 * 128 + 4 * 384;
__device__ __forceinline__ void transpose_tile(const TJ& t, int tile, LAS float* tl, int tid) {
    const int nkt = t.K / 64, kt = tile % nkt, nt = tile / nkt, k0 = kt * 64, n0 = nt * 64;
    { const int k = tid >> 3, n8 = (tid & 7) * 8; const float* s = t.src + (size_t)(k0 + k) * t.sld + n0 + n8; const float g = t.gain ? t.gain[k0 + k] : 1.0f;
      const f32x4 a = *(const f32x4*)s * g, b = *(const f32x4*)(s + 4) * g;
#pragma unroll
      for (int j = 0; j < 4; ++j) { tl[k * 65 + n8 + j] = a[j]; tl[k * 65 + n8 + 4 + j] = b[j]; } }
    __syncthreads();
    { const int n = tid >> 3, k8 = (tid & 7) * 8; const float cs = t.cscale ? t.cscale[n0 + n] : 1.0f; float v[8];
#pragma unroll
      for (int j = 0; j < 8; ++j) v[j] = tl[(k8 + j) * 65 + n] * cs;
      *(u32x4*)(t.dst + (size_t)(n0 + n) * t.dld + k0 + k8) = pack8(v); }
    __syncthreads();
}
__device__ __forceinline__ void sincos_d(float angf, float& c, float& s) {
    const double x = (double)angf; const double kd = rint(x * 0.63661977236758134308); const int q = (int)((long long)kd & 3);
    double r = fma(-kd, 1.57079632679489655800e+00, x); r = fma(-kd, 6.12323399573676603587e-17, r);
    const double r2 = r * r;
    double sp = -7.6471637318198164759e-13; sp = fma(sp, r2, 1.6059043836821614599e-10); sp = fma(sp, r2, -2.5052108385441718775e-08); sp = fma(sp, r2, 2.7557319223985890653e-06);
    sp = fma(sp, r2, -1.9841269841269841270e-04); sp = fma(sp, r2, 8.3333333333333333333e-03); sp = fma(sp, r2, -1.6666666666666666667e-01); const double sn = fma(sp * r2, r, r);
    double cp = 4.7794773323873852974e-14; cp = fma(cp, r2, -1.1470745597729724714e-11); cp = fma(cp, r2, 2.0876756987868098979e-09); cp = fma(cp, r2, -2.7557319223985890653e-07);
    cp = fma(cp, r2, 2.4801587301587301587e-05); cp = fma(cp, r2, -1.3888888888888888889e-03); cp = fma(cp, r2, 4.1666666666666666667e-02); cp = fma(cp, r2, -0.5); const double cn = fma(cp, r2, 1.0);
    const double ss = (q == 0) ? sn : (q == 1) ? cn : (q == 2) ? -sn : -cn, cc = (q == 0) ? cn : (q == 1) ? -sn : (q == 2) ? -cn : sn;
    c = (float)cc; s = (float)ss;
}

__device__ __forceinline__ void prologue(const float* const* in, float* out, uchar* ws, LAS uchar* lds, int G, int bid) {
    const int tid = otid(), lane = tid & 63, wid = tid >> 6;
    for (int gt = bid; gt < TJ_TOTAL; gt += G) { int j = 0, r = gt; for (; j < NTJ; ++j) { const int n = tj_tiles(j); if (r < n) break; r -= n; }
        const TJ t = get_tj(j, in, ws); transpose_tile(t, r, (LAS float*)lds, tid); }
    const size_t gtid = (size_t)bid * 512 + tid, gstride = (size_t)G * 512;
    { bf16_t* WINB = (bf16_t*)(ws + WS_WINB);
      for (size_t i = gtid; i < (size_t)(64 + 128) * DM / 8; i += gstride) { const size_t e = i * 8; bf16_t* p = (e < (size_t)64 * DM) ? WINB + (size_t)448 * DM + e : WINB + ((size_t)NB2 + 384) * DM + (e - (size_t)64 * DM);
          *(u32x4*)p = (u32x4){0u, 0u, 0u, 0u}; }
      bf16_t* WKUPN = (bf16_t*)(ws + WS_WKUPN);
      for (size_t i = gtid; i < (size_t)256 * 1024 / 8; i += gstride) { const float* s = in[19] + i * 8; const f32x4 a = *(const f32x4*)s, b = *(const f32x4*)(s + 4);
          const float v[8] = {a[0], a[1], a[2], a[3], b[0], b[1], b[2], b[3]}; *(u32x4*)(WKUPN + i * 8) = pack8(v); } }
    { bf16_t* XB = (bf16_t*)(ws + WS_XB); bf16_t* MH = (bf16_t*)(ws + WS_MHAT); float* ssp = (float*)(ws + WS_SSP); float* ssps = (float*)(ws + WS_SSPS);
      const int nrows = PM + SM + 2048;
      for (int row = bid * 8 + wid; row < nrows; row += G * 8) {
          const float* src = row < PM ? in[0] + (size_t)row * DM : row < PM + SM ? in[1] + (size_t)(row - PM) * DM : in[8] + (size_t)(row - PM - SM) * DM;
          f32x4 v[4]; float s = 0.f;
#pragma unroll
          for (int i = 0; i < 4; ++i) { v[i] = *(const f32x4*)(src + 256 * i + 4 * lane); s += sum4(v[i] * v[i]); }
#pragma unroll
          for (int o = 32; o >= 1; o >>= 1) s += __shfl_xor(s, o);
          float sc = 1.0f; bf16_t* dst;
          if (row < PM + SM) { dst = XB + (size_t)row * DM; if (row < PM) { if (lane < 16) ssp[(size_t)row * 16 + lane] = lane == 0 ? s : 0.f; } else { if (lane < 32) ssps[(row - PM) * 32 + lane] = lane == 0 ? s : 0.f; } }
          else { dst = MH + (size_t)(row - PM - SM) * DM; sc = rsqrtf(s * (1.0f / 1024.0f) + EPS); }
#pragma unroll
          for (int i = 0; i < 4; ++i) { u32x2 w; w.x = cvt_pk_bf16(v[i][0] * sc, v[i][1] * sc); w.y = cvt_pk_bf16(v[i][2] * sc, v[i][3] * sc); *(u32x2*)(dst + 256 * i + 4 * lane) = w; } } }
    { f32x2* tab = (f32x2*)(ws + WS_ROPE);
      for (size_t e = gtid; e < (size_t)2052 * 32; e += gstride) { const int p = (int)(e >> 5), i = (int)(e & 31); const int pos = p < 2048 ? p : PAST + (p - 2048);
          const float inv = (float)exp2(-(double)i * (13.287712379549449 / 32.0)); const float ang = (float)pos * inv; float c, s; sincos_d(ang, c, s); tab[e] = (f32x2){c, s}; } }
    { for (size_t e = gtid; e < (size_t)2 * SB * 11 * DM / 4; e += gstride) { const size_t f = e * 4; const int c = (int)(f % DM); const size_t rr = f / DM; const int i = (int)(rr % 11); const size_t lb = rr / 11;
          *(f32x4*)(out + O_PSS + (lb * 15 + i) * DM + c) = *(const f32x4*)(in[2] + (lb * 15 + 4 + i) * DM + c); } }
}

__device__ __forceinline__ void pooling(int l, const float* const* in, float* out, uchar* ws, int G, int bid) {
    const bf16_t* Z = (const bf16_t*)(ws + WS_Z); bf16_t* PO = (bf16_t*)(ws + WS_POOLED);
    const size_t gtid = (size_t)bid * 512 + otid(), gstride = (size_t)G * 512;
    for (size_t idx = gtid; idx < (size_t)PM * 128; idx += gstride) { const int row = (int)(idx >> 7), cv = (int)(idx & 127), g = cv >> 5, w = 2 << g, t = row & (PT - 1), n = (t + 1 < w) ? t + 1 : w;
        const bf16_t* p = Z + (size_t)row * LDZ + cv * 8; float ut[8], s[8]; unpack8(*(const u32x4*)p, ut);
#pragma unroll
        for (int j = 0; j < 8; ++j) s[j] = ut[j];
        for (int i = 1; i < n; ++i) { float x[8]; unpack8(*(const u32x4*)(p - (size_t)i * LDZ), x);
#pragma unroll
            for (int j = 0; j < 8; ++j) s[j] += x[j]; }
        const float rn = 1.0f / (float)n; float o[8];
#pragma unroll
        for (int j = 0; j < 8; ++j) o[j] = s[j] * rn - ut[j];
        *(u32x4*)(PO + (size_t)row * DM + cv * 8) = pack8(o);
        if (t >= PT - POOLBUF) { float* q = out + O_PSP + (((size_t)l * PB + (row >> 11)) * 15 + (t - (PT - POOLBUF))) * DM + cv * 8; *(f32x4*)q = (f32x4){ut[0], ut[1], ut[2], ut[3]}; *(f32x4*)(q + 4) = (f32x4){ut[4], ut[5], ut[6], ut[7]}; } }
    for (size_t idx = gtid; idx < (size_t)SM * 128; idx += gstride) { const int r = (int)(idx >> 7), cv = (int)(idx & 127), g = cv >> 5, w = 2 << g, b = r >> 2, t = r & 3;
        const float* prev = in[2] + ((size_t)l * SB + b) * 15 * DM + cv * 8; const bf16_t* us = Z + ((size_t)PM + b * 4) * LDZ + cv * 8; float ut[8], s[8];
        unpack8(*(const u32x4*)(us + (size_t)t * LDZ), ut);
#pragma unroll
        for (int j = 0; j < 8; ++j) s[j] = ut[j];
        for (int i = 1; i < w; ++i) { const int e = 15 + t - i; float x[8];
            if (e >= 15) unpack8(*(const u32x4*)(us + (size_t)(e - 15) * LDZ), x);
            else { const f32x4 a = *(const f32x4*)(prev + (size_t)e * DM), bb = *(const f32x4*)(prev + (size_t)e * DM + 4); x[0] = a[0]; x[1] = a[1]; x[2] = a[2]; x[3] = a[3]; x[4] = bb[0]; x[5] = bb[1]; x[6] = bb[2]; x[7] = bb[3]; }
#pragma unroll
            for (int j = 0; j < 8; ++j) s[j] += x[j]; }
        const float rn = 1.0f / (float)w; float o[8];
#pragma unroll
        for (int j = 0; j < 8; ++j) o[j] = s[j] * rn - ut[j];
        *(u32x4*)(PO + ((size_t)PM + r) * DM + cv * 8) = pack8(o);
        float* q = out + O_PSS + (((size_t)l * SB + b) * 15 + 11 + t) * DM + cv * 8; *(f32x4*)q = (f32x4){ut[0], ut[1], ut[2], ut[3]}; *(f32x4*)(q + 4) = (f32x4){ut[4], ut[5], ut[6], ut[7]}; }
}

__device__ __forceinline__ void kvpost(const float* const* in, float* out, uchar* ws, int G, int bid) {
    const float* KV = (const float*)(ws + WS_KVRAW); bf16_t* CB = (bf16_t*)(ws + WS_CKVB); bf16_t* KB = (bf16_t*)(ws + WS_KROPEB); const f32x2* tab = (const f32x2*)(ws + WS_ROPE);
    const int tid = otid(), lane = tid & 63, wid = tid >> 6; const f32x4 gl = *(const f32x4*)(in[18] + 4 * lane);
    for (int row = bid * 8 + wid; row < PM + SM; row += G * 8) { const float* p = KV + (size_t)row * 320; const f32x4 v = *(const f32x4*)(p + 4 * lane); float s = sum4(v * v);
#pragma unroll
        for (int o = 32; o >= 1; o >>= 1) s += __shfl_xor(s, o);
        const float rs = rsqrtf(s * (1.0f / 256.0f) + EPS); const f32x4 c = v * rs * gl;
        float* oc = row < PM ? out + O_CKVP + (size_t)row * KVR : out + O_CKVS + (size_t)(row - PM) * KVR; float* ok = row < PM ? out + O_KRP + (size_t)row * ROPE : out + O_KRS + (size_t)(row - PM) * ROPE;
        *(f32x4*)(oc + 4 * lane) = c; u32x2 w; w.x = cvt_pk_bf16(c[0], c[1]); w.y = cvt_pk_bf16(c[2], c[3]); *(u32x2*)(CB + (size_t)row * KVR + 4 * lane) = w;
        if (lane < 32) { const int ti = row < PM ? (row & (PT - 1)) : 2048 + ((row - PM) & 3); const f32x2 cs = tab[(size_t)ti * 32 + lane]; const float x1 = p[256 + lane], x2 = p[288 + lane];
            const float o1 = x1 * cs.x - x2 * cs.y, o2 = x1 * cs.y + x2 * cs.x; ok[lane] = o1; ok[32 + lane] = o2;
            KB[(size_t)row * ROPE + lane] = (bf16_t)(cvt_pk_bf16(o1, 0.f) & 0xffffu); KB[(size_t)row * ROPE + 32 + lane] = (bf16_t)(cvt_pk_bf16(o2, 0.f) & 0xffffu); } }
}
__device__ __forceinline__ void sq_rope(uchar* ws, int G, int bid) {
    const bf16_t* Q = (const bf16_t*)(ws + WS_Q); bf16_t* QD = (bf16_t*)(ws + WS_QDEC); const f32x2* tab = (const f32x2*)(ws + WS_ROPE);
    for (size_t e = (size_t)bid * 512 + otid(); e < (size_t)SM * MLAH * 32; e += (size_t)G * 512) { const int i = (int)(e & 31), h = (int)((e >> 5) & 7), r = (int)(e >> 8), b = r >> 2, t = r & 3;
        const bf16_t* q = Q + ((size_t)PM + r) * QW + h * QHD + NOPE; const float x1 = bf2f(q[i]), x2 = bf2f(q[32 + i]); const f32x2 cs = tab[(size_t)(2048 + t) * 32 + i];
        bf16_t* o = QD + ((size_t)b * 32 + t * 8 + h) * 320 + 256; o[i] = (bf16_t)(cvt_pk_bf16(x1 * cs.x - x2 * cs.y, 0.f) & 0xffffu); o[32 + i] = (bf16_t)(cvt_pk_bf16(x1 * cs.y + x2 * cs.x, 0.f) & 0xffffu); }
}
__device__ __forceinline__ void final_norm(const float* const* in, float* out, uchar* ws, int G, int bid) {
    const float* XR = (const float*)(ws + WS_XRES); const float* ssp = (const float*)(ws + WS_SSP); const float* ssps = (const float*)(ws + WS_SSPS);
    const int tid = otid(), lane = tid & 63, wid = tid >> 6;
    for (int row = bid * 8 + wid; row < PM + SM; row += G * 8) { const float rs = row < PM ? rs_from16(ssp + (size_t)row * 16) : rs_from32(ssps + (row - PM) * 32);
        float* o = row < PM ? out + O_YP + (size_t)row * DM : out + O_YS + (size_t)(row - PM) * DM; const float* x = XR + (size_t)row * DM;
#pragma unroll
        for (int i = 0; i < 4; ++i) { const int c = 256 * i + 4 * lane; *(f32x4*)(o + c) = *(const f32x4*)(x + c) * rs * *(const f32x4*)(in[25] + c); } }
}
}
#define XB_TMO      128
#define XB_XCNT(j)  (256  + 64 * (j))
#define XB_XSUB(j)  (1280 + 64 * (j))
#define XB_XGEN(j)  (2304 + 64 * (j))
#define XB_TOP      3328
#define XB_TOPGEN   3392
#define XCD_BAR_WORDS 3456
#define XB_SPIN_CAP (1u << 22)
__device__ __forceinline__ unsigned xb_ld(unsigned* p)              { return __hip_atomic_load(p, __ATOMIC_RELAXED, __HIP_MEMORY_SCOPE_AGENT); }
__device__ __forceinline__ unsigned xb_add(unsigned* p, unsigned v) { return __hip_atomic_fetch_add(p, v, __ATOMIC_RELAXED, __HIP_MEMORY_SCOPE_AGENT); }
__device__ __forceinline__ unsigned xb_xcc_id() { return (unsigned)__builtin_amdgcn_s_getreg((3 << 11) | 20) & 0xFu; }
#define XB_SPIN(cond, bar) do { unsigned _sp = 0; while (cond) { __builtin_amdgcn_s_sleep(1); \
    if ((++_sp & 255u) == 0u) { if (xb_ld(&(bar)[XB_TMO])) break; if (_sp > XB_SPIN_CAP) { atomicAdd(&(bar)[XB_TMO], 1u); break; } } } } while (0)
struct XcdBarrier { unsigned* bar; unsigned x; volatile LAS unsigned* st; };
__device__ __forceinline__ XcdBarrier xcd_barrier_post(unsigned* bar, volatile LAS unsigned* st) {
    XcdBarrier b; b.bar = bar; b.x = xb_xcc_id(); b.st = st;
    if (threadIdx.x == 0) (void)xb_add(&bar[XB_XCNT(b.x)], 1u);
    return b;
}
__device__ __forceinline__ void xcd_barrier_complete(unsigned* bar, unsigned x, unsigned& nloc, unsigned& nx) {
    const unsigned G = gridDim.x * gridDim.y * gridDim.z;
    unsigned sum, cnt, mine, sp = 0u;
    for (;;) {
        sum = 0u; cnt = 0u; mine = 0u;
#pragma unroll
        for (unsigned j = 0; j < 16; ++j) { const unsigned c = xb_ld(&bar[XB_XCNT(j)]); sum += c; cnt += (c > 0u) ? 1u : 0u; mine = (j == x) ? c : mine; }
        if (sum == G) break;
        __builtin_amdgcn_s_sleep(1);
        if ((++sp & 255u) == 0u) { if (xb_ld(&bar[XB_TMO])) break; if (sp > XB_SPIN_CAP) { atomicAdd(&bar[XB_TMO], 1u); break; } }
    }
    nloc = mine > 0u ? mine : 1u; nx = cnt > 0u ? cnt : 1u;
}
__device__ __forceinline__ void xcd_barrier(const XcdBarrier& b) {
    asm volatile("s_waitcnt vmcnt(0)" ::: "memory");
    __syncthreads();
    if (threadIdx.x == 0) {
        unsigned* bar = b.bar;
        __builtin_amdgcn_s_waitcnt(0);
        unsigned nloc = b.st[0], nx = b.st[1];
        if (nloc == 0u) { xcd_barrier_complete(bar, b.x, nloc, nx); b.st[0] = nloc; b.st[1] = nx; }
        const unsigned old = xb_add(&bar[XB_XSUB(b.x)], 1u);
        const unsigned gen = old / nloc;
        if (old + 1u == (gen + 1u) * nloc) {
            __builtin_amdgcn_fence(__ATOMIC_RELEASE, "agent");
            asm volatile("s_waitcnt vmcnt(0)" ::: "memory");
            const unsigned og = xb_add(&bar[XB_TOP], 1u);
            const unsigned tg = og / nx;
            if (og + 1u == (tg + 1u) * nx) xb_add(&bar[XB_TOPGEN], 1u);
            else XB_SPIN(xb_ld(&bar[XB_TOPGEN]) == tg, bar);
            __builtin_amdgcn_fence(__ATOMIC_ACQUIRE, "agent");
            xb_add(&bar[XB_XGEN(b.x)], 1u);
            asm volatile("s_waitcnt vmcnt(0)" ::: "memory");
        } else {
            XB_SPIN(xb_ld(&bar[XB_XGEN(b.x)]) == gen, bar);
            __builtin_amdgcn_fence(__ATOMIC_ACQUIRE, "agent");
            asm volatile("s_waitcnt vmcnt(0)" ::: "memory");
        }
    }
    __syncthreads();
}

constexpr int LDS_BYTES = 144 * 1024, MISC_OFF = 136 * 1024;
static_assert(pg8::STAGE_BYTES <= MISC_OFF && att::LDS_BYTES <= MISC_OFF && dec::LDS_BYTES <= MISC_OFF && sg::LDS_BYTES <= MISC_OFF && dec::SMEM_LDS <= MISC_OFF, "LDS budget");
constexpr int NPHASE = 24;
struct Params { const float* in[26]; float* out; uchar* ws; int ph_lo, ph_hi; };

template <class T> __device__ __forceinline__ T* launder(T* p) { asm volatile("" : "+s"(p)); return p; }
#define PHASE_PTRS \
    uchar* const ws = launder(P.ws); float* const out = launder(P.out); const float* const* in = P.in; (void)in; (void)out; \
    bf16_t* const XB = (bf16_t*)(ws + WS_XB); float* const XR = (float*)(ws + WS_XRES); bf16_t* const Z = (bf16_t*)(ws + WS_Z); bf16_t* const MX = (bf16_t*)(ws + WS_MIXED); \
    bf16_t* const PO = (bf16_t*)(ws + WS_POOLED); bf16_t* const QB = (bf16_t*)(ws + WS_Q); float* const ssp = (float*)(ws + WS_SSP); float* const ssps = (float*)(ws + WS_SSPS); \
    float* const ssq = (float*)(ws + WS_SSQ); float* const KVRAW = (float*)(ws + WS_KVRAW); bf16_t* const MEMB = (bf16_t*)(ws + WS_MEMB); \
    (void)XB; (void)XR; (void)Z; (void)MX; (void)PO; (void)QB; (void)ssp; (void)ssps; (void)ssq; (void)KVRAW; (void)MEMB;

__global__ void __launch_bounds__(512, 2) yoco_fwd(Params P) {
    extern __shared__ __attribute__((aligned(16))) uchar lds_raw[];
    LAS uchar* lds = (LAS uchar*)lds_raw;
    const int tid = threadIdx.x, G = gridDim.x, bid = blockIdx.x;
    volatile LAS unsigned* misc = (volatile LAS unsigned*)(lds + MISC_OFF);
    if (tid < 4) misc[tid] = 0u;
    __syncthreads();
    const int lo = P.ph_lo, hi = P.ph_hi; const bool multi = (hi - lo) > 1;
    XcdBarrier bar; bar.bar = (unsigned*)(P.ws + WS_CTL); bar.x = 0; bar.st = misc;
    if (multi) bar = xcd_barrier_post((unsigned*)(P.ws + WS_CTL), misc);
#ifndef EN_MASK
#define EN_MASK 0xffff
#endif
#define EN(t) ((EN_MASK >> (t)) & 1)
#define IN(k) (lo <= (k) && (k) < hi)
#define SEAM(k) do { if (IN(k) && IN((k) + 1)) xcd_barrier(bar); } while (0)
#define SUNITS(u, n) for (int u = G - 1 - bid; u < (n); u += G)

    if (EN(0) && IN(0)) { PHASE_PTRS ew::prologue(in, out, ws, lds, G, bid); }
    SEAM(0);

#pragma unroll 1
    for (int l = 0; l < 2; ++l) {
        const int pb = 1 + 4 * l;
        if (EN(1) && IN(pb)) {
            PHASE_PTRS
            { pg8::Gemm g{XB, (const bf16_t*)(ws + WS_WINA) + (size_t)l * INA * DM, DM, DM, DM, 0}; pg8::StaticOrder S; S.init(PM / 256, INA / 256, G, bid);
              pg8::EpiZ E{Z, ssp, nullptr, nullptr}; pg8::gemm_phase(lds, g, S, E); }
            if (l == 0) { pg8::Gemm g{(const bf16_t*)(ws + WS_MHAT), (const bf16_t*)(ws + WS_WMEM), DM, DM, DM, 0}; pg8::StaticOrder S; S.init(2048 / 256, 4096 / 256, G, bid);
              pg8::EpiMem E{out + O_MEMK, MEMB}; pg8::gemm_phase(lds, g, S, E); }
            SUNITS(u, INA / 64) { sg::EpiZ E{Z, ssps, nullptr, nullptr}; sg::sgemm_unit(lds, XB + (size_t)PM * DM, DM, (const bf16_t*)(ws + WS_WINA) + (size_t)l * INA * DM, DM, DM, u * 64, E); }
        }
        SEAM(pb);
        if (EN(2) && IN(pb + 1)) {
            PHASE_PTRS
            ew::pooling(l, in, out, ws, G, bid);
            for (int u = bid; u < PB * MEMH * 8; u += G) { const int b = u >> 5, h = (u >> 3) & 3, x = u & 7; const size_t r0 = (size_t)b * PT + 256 * x;
                const bf16_t* Kh = MEMB + (size_t)b * 256 * 4096 + l * 1024 + h * 128;
                att::attn_body<128, false, 1, LDZ, 4096>(Z + r0 * LDZ + ZA_QM + h * 128, Kh, Kh + 512, nullptr, nullptr, Z + r0 * LDZ + ZA_GM + h * 128, MX + r0 * OUTW + 1024 + h * 128, 4, 0, lds);
                __syncthreads(); }
            SUNITS(u, SB * MEMH) { const int b = u >> 2, h = u & 3; const size_t r0 = (size_t)PM + b * 4; const size_t ko = (((size_t)l * SB + b) * MEMT * MEMH + h) * 128;
                dec::smem_unit(Z + r0 * LDZ + ZA_QM + h * 128, Z + r0 * LDZ + ZA_GM + h * 128, in[5] + ko, in[6] + ko, MX + r0 * OUTW + 1024 + h * 128, lds); }
        }
        SEAM(pb + 1);
        if (EN(3) && IN(pb + 2)) {
            PHASE_PTRS
            { pg8::Gemm g{PO, (const bf16_t*)(ws + WS_WGRP) + (size_t)l * 4 * 65536, DM, 256, 256, 256}; pg8::StaticOrder S; S.init(PM / 256, 4, G, bid);
              pg8::EpiGrp E{Z, MX}; pg8::gemm_phase(lds, g, S, E); }
            SUNITS(u, 16) { const int g = u >> 2; sg::EpiGrp E{Z, MX, g * 256};
                sg::sgemm_unit(lds, PO + (size_t)PM * DM + g * 256, DM, (const bf16_t*)(ws + WS_WGRP) + ((size_t)l * 4 + g) * 65536, 256, 256, (u & 3) * 64, E); }
        }
        SEAM(pb + 2);
        if (EN(4) && IN(pb + 3)) {
            PHASE_PTRS
            const float* baseP = l == 0 ? in[0] : XR; const float* baseS = l == 0 ? in[1] : XR + (size_t)PM * DM;
            { pg8::Gemm g{MX, (const bf16_t*)(ws + WS_WOUT) + (size_t)l * DM * OUTW, OUTW, OUTW, OUTW, 0}; pg8::StaticOrder S; S.init(PM / 256, DM / 256, G, bid);
              pg8::EpiOut E{baseP, XR, XB, ssp}; pg8::gemm_phase(lds, g, S, E); }
            SUNITS(u, DM / 64) { sg::EpiOut E{baseS, XR, XB, ssps};
                sg::sgemm_unit(lds, MX + (size_t)PM * OUTW, OUTW, (const bf16_t*)(ws + WS_WOUT) + (size_t)l * DM * OUTW, OUTW, OUTW, u * 64, E); }
        }
        SEAM(pb + 3);
    }

#pragma unroll 1
    for (int j = 0; j < 2; ++j) {
        const int l = 2 + j, pb = 9 + 7 * j; const int NB = j == 0 ? NB2 : NB3;
        if (EN(5) && IN(pb)) {
            PHASE_PTRS
            const bf16_t* WB = (const bf16_t*)(ws + WS_WINB) + (size_t)j * NB2 * DM; float* kvr = j == 0 ? KVRAW : nullptr;
            { pg8::Gemm g{XB, WB, DM, DM, DM, 0}; pg8::StaticOrder S; S.init(PM / 256, NB / 256, G, bid);
              pg8::EpiZ E{Z, ssp, ssq, kvr}; pg8::gemm_phase(lds, g, S, E); }
            SUNITS(u, NB / 64) { sg::EpiZ E{Z, ssps, ssq, kvr}; sg::sgemm_unit(lds, XB + (size_t)PM * DM, DM, WB, DM, DM, u * 64, E); }
        }
        SEAM(pb);
        if (EN(6) && IN(pb + 1)) {
            PHASE_PTRS
            if (j == 0) ew::kvpost(in, out, ws, G, bid);
            { pg8::Gemm g{Z + ZB_CQ, (const bf16_t*)(ws + WS_WQUP) + (size_t)j * QW * QRANK, LDZ, QRANK, QRANK, 0}; pg8::StaticOrder S; S.init(PM / 256, QW / 256, G, bid);
              pg8::EpiQ E{QB, ssq}; pg8::gemm_phase(lds, g, S, E); }
            for (int u = bid; u < PB * MEMH * 8; u += G) { const int b = u >> 5, h = (u >> 3) & 3, x = u & 7; const size_t r0 = (size_t)b * PT + 256 * x;
                const bf16_t* Kh = MEMB + (size_t)b * 256 * 4096 + l * 1024 + h * 128;
                att::attn_body<128, false, 1, LDZ, 4096>(Z + r0 * LDZ + ZB_QM + h * 128, Kh, Kh + 512, nullptr, nullptr, Z + r0 * LDZ + ZB_GM + h * 128, MX + r0 * OUTW + 1024 + h * 128, 4, 0, lds);
                __syncthreads(); }
            SUNITS(u, QW / 64) { sg::EpiQ E{QB, ssq}; sg::sgemm_unit(lds, Z + (size_t)PM * LDZ + ZB_CQ, LDZ, (const bf16_t*)(ws + WS_WQUP) + (size_t)j * QW * QRANK, QRANK, QRANK, u * 64, E); }
            SUNITS(u, SB * MEMH) { const int b = u >> 2, h = u & 3; const size_t r0 = (size_t)PM + b * 4; const size_t ko = (((size_t)l * SB + b) * MEMT * MEMH + h) * 128;
                dec::smem_unit(Z + r0 * LDZ + ZB_QM + h * 128, Z + r0 * LDZ + ZB_GM + h * 128, in[5] + ko, in[6] + ko, MX + r0 * OUTW + 1024 + h * 128, lds); }
        }
        SEAM(pb + 1);
        if (EN(7) && IN(pb + 2)) {
            PHASE_PTRS
            if (j == 0) { pg8::Gemm g{(const bf16_t*)(ws + WS_CKVB), (const bf16_t*)(ws + WS_WKV), KVR, KVR, KVR, 0}; pg8::StaticOrder S; S.init(PM / 256, 2048 / 256, G, bid);
              pg8::EpiKV E{(bf16_t*)(ws + WS_KN)}; pg8::gemm_phase(lds, g, S, E); }
            SUNITS(u, MLAH * 4) { const int h = u >> 2; sg::EpiAbsorb E{(bf16_t*)(ws + WS_QDEC), h};
                sg::sgemm_unit(lds, QB + (size_t)PM * QW + h * QHD, QW, (const bf16_t*)(ws + WS_WKUPN) + h * 128, 1024, 128, (u & 3) * 64, E); }
            ew::sq_rope(ws, G, bid);
        }
        SEAM(pb + 2);
        if (EN(8) && IN(pb + 3)) {
            PHASE_PTRS
            for (int u = bid; u < PB * MLAH * 4; u += G) { const int b = u >> 5, h = (u >> 2) & 7, xp = u & 3;
#pragma unroll 1
                for (int s = 0; s < 2; ++s) { const int x = s == 0 ? 7 - xp : xp; const size_t b0 = (size_t)b * PT, r0 = b0 + 256 * x;
                    att::attn_body<192, true, 1, QW, 1024>(QB + r0 * QW + h * QHD, (const bf16_t*)(ws + WS_KN) + b0 * 1024 + h * 128, (const bf16_t*)(ws + WS_VV) + b0 * 1024 + h * 128,
                        (const bf16_t*)(ws + WS_KROPEB) + b0 * ROPE, (const f32x2*)(ws + WS_ROPE) + (size_t)(256 * x) * 32, Z + r0 * LDZ + ZB_GT + h * 128, MX + r0 * OUTW + h * 128, 4 * (x + 1), 4 * x, lds);
                    __syncthreads(); } }
            for (int u = bid; u < SB * 8; u += G) { const int b = u >> 3, ch = u & 7;
                dec::decode_unit((const bf16_t*)(ws + WS_QDEC) + (size_t)b * 32 * 320, in[3], in[4], (const int*)in[7] + b * NPAGES + ch * 16,
                                 (float*)(ws + WS_OPART) + ((size_t)b * 8 + ch) * 32 * 256, (float*)(ws + WS_ML) + ((size_t)b * 8 + ch) * 32 * 2, lds);
                __syncthreads(); }
        }
        SEAM(pb + 3);
        if (EN(9) && IN(pb + 4)) {
            PHASE_PTRS
            const int ct = ew::otid();
            for (int w = bid * 8 + (ct >> 6); w < SB * 32; w += G * 8)
                dec::combine_row(w >> 5, w & 31, ct & 63, (const bf16_t*)(ws + WS_QDEC), (const float*)(ws + WS_OPART), (const float*)(ws + WS_ML), out + O_CKVS, out + O_KRS, (bf16_t*)(ws + WS_OLAT));
        }
        SEAM(pb + 4);
        if (EN(10) && IN(pb + 5)) {
            PHASE_PTRS
            SUNITS(u, MLAH * 2) { const int h = u >> 1; sg::EpiVup E{Z, MX, h};
                sg::sgemm_unit(lds, (const bf16_t*)(ws + WS_OLAT) + h * 256, 2048, (const bf16_t*)(ws + WS_WKV) + ((size_t)1024 + h * 128) * 256, 256, 256, (u & 1) * 64, E); }
        }
        SEAM(pb + 5);
        if (EN(11) && IN(pb + 6)) {
            PHASE_PTRS
            { pg8::Gemm g{MX, (const bf16_t*)(ws + WS_WOUT) + (size_t)l * DM * OUTW, OUTW, OUTW, OUTW, 0}; pg8::StaticOrder S; S.init(PM / 256, DM / 256, G, bid);
              pg8::EpiOut E{XR, XR, XB, ssp}; pg8::gemm_phase(lds, g, S, E); }
            SUNITS(u, DM / 64) { sg::EpiOut E{XR + (size_t)PM * DM, XR, XB, ssps};
                sg::sgemm_unit(lds, MX + (size_t)PM * OUTW, OUTW, (const bf16_t*)(ws + WS_WOUT) + (size_t)l * DM * OUTW, OUTW, OUTW, u * 64, E); }
        }
        SEAM(pb + 6);
    }
    if (EN(12) && IN(23)) { PHASE_PTRS ew::final_norm(in, out, ws, G, bid); }
#undef IN
#undef SEAM
#undef SUNITS
}

#ifndef MK_LAUNCHES
#define MK_LAUNCHES NPHASE
#endif
extern "C" void kernel_launch(void* const* d_in, const int* in_sizes, int n_in, void* d_out, int out_size, void* d_ws, size_t ws_size, hipStream_t stream) {
    static int grid = 0;
    if (grid == 0) {
        if (n_in != 26 || (size_t)out_size != O_END || ws_size < WS_END) { fprintf(stderr, "kernel_launch: unexpected shapes: n_in %d out %d ws %zu (need out %zu ws %zu)\n", n_in, out_size, ws_size, (size_t)O_END, (size_t)WS_END); grid = -1; return; }
        int dev = 0, cus = 0, per_cu = 0;
        if (hipGetDevice(&dev) != hipSuccess || hipDeviceGetAttribute(&cus, hipDeviceAttributeMultiprocessorCount, dev) != hipSuccess) { grid = -1; return; }
        if (hipFuncSetAttribute((const void*)yoco_fwd, hipFuncAttributeMaxDynamicSharedMemorySize, LDS_BYTES) != hipSuccess) { fprintf(stderr, "kernel_launch: hipFuncSetAttribute failed\n"); grid = -1; return; }
        if (hipOccupancyMaxActiveBlocksPerMultiprocessor(&per_cu, (const void*)yoco_fwd, 512, LDS_BYTES) != hipSuccess || per_cu < 1) { fprintf(stderr, "kernel_launch: occupancy query says %d blocks per CU\n", per_cu); (void)hipGetLastError(); grid = -1; return; }
        grid = cus;
    }
    if (grid < 0) return;
    (void)hipMemsetAsync((char*)d_ws + WS_CTL, 0, CTL_BYTES, stream);
    Params p{};
    for (int i = 0; i < 26; ++i) p.in[i] = (const float*)d_in[i];
    p.out = (float*)d_out; p.ws = (uchar*)d_ws;
    if (MK_LAUNCHES == 1) { p.ph_lo = 0; p.ph_hi = NPHASE; hipLaunchKernelGGL(yoco_fwd, dim3(grid), dim3(512), LDS_BYTES, stream, p); }
    else for (int k = 0; k < NPHASE; ++k) { p.ph_lo = k; p.ph_hi = k + 1; hipLaunchKernelGGL(yoco_fwd, dim3(grid), dim3(512), LDS_BYTES, stream, p); }
    const hipError_t le = hipPeekAtLastError();
    if (le != hipSuccess) fprintf(stderr, "kernel_launch: launch failed: %s\n", hipGetErrorName(le));
}
```

```cpp
#include <hip/hip_runtime.h>
#include <cstdio>
#include <cstdint>

#define LAS __attribute__((address_space(3)))
typedef unsigned char uchar;
typedef unsigned short bf16_t;
typedef short bf16x8 __attribute__((ext_vector_type(8)));
typedef short s16x4 __attribute__((ext_vector_type(4)));
typedef float f32x2 __attribute__((ext_vector_type(2)));
typedef float f32x4 __attribute__((ext_vector_type(4)));
typedef float f32x16 __attribute__((ext_vector_type(16)));
typedef unsigned u32x2 __attribute__((ext_vector_type(2)));
typedef unsigned u32x4 __attribute__((ext_vector_type(4)));

constexpr int DM = 1024, PB = 8, PT = 2048, PM = PB * PT, SB = 32, ST = 4, SM = SB * ST, RP = 16640;
constexpr int KVR = 256, ROPE = 64, NOPE = 128, QRANK = 384, MLAH = 8, QHD = 192, QW = MLAH * QHD;
constexpr int MEMT = 256, MEMH = 4, MEMW = 512;
constexpr int INA = 3072, INB = 2432, OUTW = 1536, LDZ = 3072, NB2 = 2816, NB3 = 2560;
constexpr int NPAGES = 128, PAGE = 128, PAST = 16384, POOLBUF = 15;
constexpr float EPS = 1e-6f;
constexpr int ZA_U = 0, ZA_GT = 1024, ZA_QM = 2048, ZA_GM = 2560;
constexpr int ZB_CQ = 0, ZB_KR = 384, ZB_GT = 512, ZB_QM = 1536, ZB_GM = 2048, ZB_KV = 2560;

constexpr size_t O_YP = 0, O_YS = O_YP + (size_t)PM * DM, O_PSP = O_YS + (size_t)SM * DM, O_PSS = O_PSP + (size_t)2 * PB * 15 * DM, O_CKVP = O_PSS + (size_t)2 * SB * 15 * DM,
                 O_KRP = O_CKVP + (size_t)PM * KVR, O_CKVS = O_KRP + (size_t)PM * ROPE, O_KRS = O_CKVS + (size_t)SM * KVR, O_MEMK = O_KRS + (size_t)SM * ROPE,
                 O_MEMV = O_MEMK + (size_t)4 * PB * MEMT * MEMW, O_END = O_MEMV + (size_t)4 * PB * MEMT * MEMW;

constexpr size_t al256(size_t x) { return (x + 255) / 256 * 256; }
constexpr size_t WS_CTL = 0, CTL_BYTES = 65536;
constexpr size_t WS_ROPE = WS_CTL + CTL_BYTES;
constexpr size_t WS_WINA = al256(WS_ROPE + (size_t)2052 * 32 * 8);
constexpr size_t WS_WGRP = al256(WS_WINA + (size_t)2 * INA * DM * 2);
constexpr size_t WS_WINB = al256(WS_WGRP + (size_t)2 * 4 * 256 * 256 * 2);
constexpr size_t WS_WQUP = al256(WS_WINB + (size_t)2 * NB2 * DM * 2);
constexpr size_t WS_WKV  = al256(WS_WQUP + (size_t)2 * QW * QRANK * 2);
constexpr size_t WS_WKUPN = al256(WS_WKV + (size_t)2048 * 256 * 2);
constexpr size_t WS_WMEM = al256(WS_WKUPN + (size_t)256 * 1024 * 2);
constexpr size_t WS_WOUT = al256(WS_WMEM + (size_t)4096 * 1024 * 2);
constexpr size_t WS_MHAT = al256(WS_WOUT + (size_t)4 * DM * OUTW * 2);
constexpr size_t WS_MEMB = al256(WS_MHAT + (size_t)2048 * 1024 * 2);
constexpr size_t WS_XRES = al256(WS_MEMB + (size_t)2048 * 4096 * 2);
constexpr size_t WS_XB   = al256(WS_XRES + (size_t)RP * DM * 4);
constexpr size_t WS_SSP  = al256(WS_XB + (size_t)RP * DM * 2);
constexpr size_t WS_SSPS = al256(WS_SSP + (size_t)PM * 16 * 4);
constexpr size_t WS_SSQ  = al256(WS_SSPS + (size_t)SM * 32 * 4);
constexpr size_t WS_Z    = al256(WS_SSQ + (size_t)RP * 12 * 4);
constexpr size_t WS_POOLED = al256(WS_Z + (size_t)RP * LDZ * 2);
constexpr size_t WS_MIXED = al256(WS_POOLED + (size_t)RP * DM * 2);
constexpr size_t WS_Q    = al256(WS_MIXED + (size_t)RP * OUTW * 2);
constexpr size_t WS_KVRAW = al256(WS_Q + (size_t)RP * QW * 2);
constexpr size_t WS_CKVB = al256(WS_KVRAW + (size_t)RP * 320 * 4);
constexpr size_t WS_KROPEB = al256(WS_CKVB + (size_t)RP * 256 * 2);
constexpr size_t WS_KN   = al256(WS_KROPEB + (size_t)RP * 64 * 2);
constexpr size_t WS_VV   = al256(WS_KN + (size_t)PM * 1024 * 2);
constexpr size_t WS_QDEC = al256(WS_VV + (size_t)PM * 1024 * 2);
constexpr size_t WS_OPART = al256(WS_QDEC + (size_t)SB * 32 * 320 * 2);
constexpr size_t WS_ML   = al256(WS_OPART + (size_t)SB * 8 * 32 * 256 * 4);
constexpr size_t WS_OLAT = al256(WS_ML + (size_t)SB * 8 * 32 * 2 * 4);
constexpr size_t WS_END  = al256(WS_OLAT + (size_t)SM * 2048 * 2);

__device__ __forceinline__ unsigned cvt_pk_bf16(float lo, float hi) { unsigned r; asm volatile("v_cvt_pk_bf16_f32 %0, %1, %2" : "=v"(r) : "v"(lo), "v"(hi)); return r; }
__device__ __forceinline__ float bf_lo(unsigned w) { return __uint_as_float(w << 16); }
__device__ __forceinline__ float bf_hi(unsigned w) { return __uint_as_float(w & 0xffff0000u); }
__device__ __forceinline__ float bf2f(bf16_t b) { return __uint_as_float(((unsigned)b) << 16); }
__device__ __forceinline__ float silu(float x) { return x * __builtin_amdgcn_rcpf(1.0f + __expf(-x)); }
__device__ __forceinline__ void unpack8(const u32x4 w, float (&f)[8]) {
    f[0] = bf_lo(w.x); f[1] = bf_hi(w.x); f[2] = bf_lo(w.y); f[3] = bf_hi(w.y); f[4] = bf_lo(w.z); f[5] = bf_hi(w.z); f[6] = bf_lo(w.w); f[7] = bf_hi(w.w); }
__device__ __forceinline__ u32x4 pack8(const float (&f)[8]) { u32x4 w; w.x = cvt_pk_bf16(f[0], f[1]); w.y = cvt_pk_bf16(f[2], f[3]); w.z = cvt_pk_bf16(f[4], f[5]); w.w = cvt_pk_bf16(f[6], f[7]); return w; }
__device__ __forceinline__ float sum4(const f32x4 a) { return (a[0] + a[1]) + (a[2] + a[3]); }
__device__ __forceinline__ float rs_from16(const float* p) {
    const f32x4 a = *(const f32x4*)p, b = *(const f32x4*)(p + 4), c = *(const f32x4*)(p + 8), d = *(const f32x4*)(p + 12);
    return rsqrtf(((sum4(a) + sum4(b)) + (sum4(c) + sum4(d))) * (1.0f / 1024.0f) + EPS); }
__device__ __forceinline__ float rs_from32(const float* p) { float s = 0.f;
#pragma unroll
    for (int i = 0; i < 8; ++i) s += sum4(*(const f32x4*)(p + 4 * i));
    return rsqrtf(s * (1.0f / 1024.0f) + EPS); }
__device__ __forceinline__ float rsq_from12(const float* p) {
    const f32x4 a = *(const f32x4*)p, b = *(const f32x4*)(p + 4), c = *(const f32x4*)(p + 8);
    return rsqrtf((sum4(a) + sum4(b) + sum4(c)) * (1.0f / 384.0f) + EPS); }
__device__ __forceinline__ int crow(int r, int hi) { return (r & 3) + 8 * (r >> 2) + 4 * hi; }
static_assert(WS_VV == WS_KN + (size_t)PM * 1024 * 2, "VV must follow KN");
namespace pg8 {
constexpr int BM = 256, BK = 64, HALF = 128, HTB = HALF * BK * 2, STAGE_BYTES = 8 * HTB, NXCD = 8, WGM = 8;
__device__ __forceinline__ int lds_byte(int r, int c) { const int st = (r >> 4) * 2 + (c >> 5), rr = r & 15, cc = c & 31, ob = rr * 64 + cc * 2; return st * 1024 + (ob ^ (((ob >> 9) & 1) << 5)); }
__device__ __forceinline__ void stage_rc(int b, int& R, int& C) { const int st = b / 1024, sb = b % 1024, swz = sb ^ (((sb >> 9) & 1) << 5); R = (st >> 1) * 16 + swz / 64; C = (st & 1) * 32 + (swz % 64) / 2; }
__device__ __forceinline__ int perm32(int rho) { const int n = rho >> 4, i = rho & 15; return 8 * (i >> 2) + 4 * n + (i & 3); }

struct Unit { int pm, pn; };
struct Gemm { const bf16_t* A; const bf16_t* Bt; int lda, ldb, K, a_pn; };

struct StaticOrder {
    int nM, nN, nwg, G, c;
    __device__ void init(int nM_, int nN_, int G_, int c_) { nM = nM_; nN = nN_; nwg = nM * nN; G = G_; c = c_; }
    __device__ bool next(int i, Unit& u) const {
        const long L = (long)i * G + c; if (L >= nwg) return false;
        int wgid = (int)L; { const int q = nwg / NXCD, r = nwg % NXCD, xcd = wgid % NXCD, off = wgid / NXCD; wgid = (xcd < r ? xcd * (q + 1) : r * (q + 1) + (xcd - r) * q) + off; }
        const int nig = WGM * nN, gid = wgid / nig, fm = gid * WGM, gsz = (nM - fm) < WGM ? (nM - fm) : WGM;
        u.pm = fm + ((wgid % nig) % gsz); u.pn = (wgid % nig) / gsz; return true;
    }
};

template <class Epi>
__device__ __forceinline__ void gemm_phase(LAS uchar* lds, const Gemm g, const StaticOrder& S, const Epi& E) {
    int tid_ = threadIdx.x; asm volatile("" : "+v"(tid_));
    const int tid = tid_, wid = __builtin_amdgcn_readfirstlane(tid >> 6), lane = tid & 63, wr = wid >> 2, wc = wid & 3, fr = lane & 15, fq = lane >> 4;
    int K_ = g.K; asm volatile("" : "+s"(K_));
    const int K = K_, nt = K / BK;
    unsigned voffA[2], voffB[2];
#pragma unroll
    for (int i = 0; i < 2; ++i) { int R, C; stage_rc(tid * 16 + i * 8192, R, C); const int Rb = Epi::PERM ? ((R & ~31) + perm32(R & 31)) : R;
        voffA[i] = (unsigned)(R * g.lda + C) * 2u; voffB[i] = (unsigned)(Rb * g.ldb + C) * 2u; }
    const size_t kstep = (size_t)(BK * 2);
    const size_t hstepA = (size_t)HALF * g.lda * 2, hstepB = (size_t)HALF * g.ldb * 2;
    const size_t tstepA = 2 * hstepA, tstepB = 2 * hstepB;
    const unsigned ldsw = (unsigned)wid * 1024u;
    const int aoff = lds_byte(wr * 64 + fr, fq * 8), boff = lds_byte(wc * 32 + fr, fq * 8);
#define PG8_SA(b, h) (((b) * 2 + (h)) * HTB)
#define PG8_SB(b, h) ((4 + (b) * 2 + (h)) * HTB)
#define PG8_STAGE(bufoff, gbase, voff) do { _Pragma("unroll") for (int _i = 0; _i < 2; ++_i) \
        __builtin_amdgcn_global_load_lds((const unsigned*)((const char*)(gbase) + (voff)[_i]), (LAS unsigned*)(lds + (bufoff) + ldsw + _i * 8192), 16, 0, 0); } while (0)
#define PG8_LDA(dst, b, h) do { _Pragma("unroll") for (int m = 0; m < 4; ++m) _Pragma("unroll") for (int k = 0; k < 2; ++k) dst[m][k] = *(const LAS bf16x8*)(lds + PG8_SA(b, h) + aoff + m * 2048 + k * 1024); } while (0)
#define PG8_LDB(dst, b, h) do { _Pragma("unroll") for (int n = 0; n < 2; ++n) _Pragma("unroll") for (int k = 0; k < 2; ++k) dst[n][k] = *(const LAS bf16x8*)(lds + PG8_SB(b, h) + boff + n * 2048 + k * 1024); } while (0)
#define PG8_MMA(ai, bj, At, Bt) do { __builtin_amdgcn_s_setprio(1); _Pragma("unroll") for (int m = 0; m < 4; ++m) _Pragma("unroll") for (int n = 0; n < 2; ++n) _Pragma("unroll") for (int k = 0; k < 2; ++k) \
        acc[ai][bj][m][n] = __builtin_amdgcn_mfma_f32_16x16x32_bf16(Bt[n][k], At[m][k], acc[ai][bj][m][n], 0, 0, 0); __builtin_amdgcn_s_setprio(0); } while (0)
#define PG8_WAIT_V(n) asm volatile("s_waitcnt vmcnt(" #n ")" ::: "memory")
#define PG8_WAIT_L(n) asm volatile("s_waitcnt lgkmcnt(" #n ")" ::: "memory")
#define PG8_BAR __builtin_amdgcn_s_barrier()
#define PG8_SCHED __builtin_amdgcn_sched_barrier(0)
    Unit cur, nxt; int ui = 0;
    if (!S.next(0, cur)) return;
    f32x4 acc[2][2][4][2];
#pragma unroll
    for (int a = 0; a < 2; ++a)
#pragma unroll
        for (int b = 0; b < 2; ++b)
#pragma unroll
            for (int m = 0; m < 4; ++m)
#pragma unroll
                for (int n = 0; n < 2; ++n) acc[a][b][m][n] = (f32x4){0.f, 0.f, 0.f, 0.f};
    bf16x8 At[4][2], B0[2][2], B1[2][2];
    const char* cA = (const char*)g.A + (size_t)cur.pm * tstepA + (size_t)cur.pn * g.a_pn * 2; const char* cB = (const char*)g.Bt + (size_t)cur.pn * tstepB;
    PG8_STAGE(PG8_SB(0, 0), cB, voffB); PG8_STAGE(PG8_SA(0, 0), cA, voffA); PG8_STAGE(PG8_SB(0, 1), cB + hstepB, voffB); PG8_STAGE(PG8_SA(0, 1), cA + hstepA, voffA);
    if (wr == 1) PG8_BAR;
    PG8_WAIT_V(4); PG8_BAR;
    PG8_STAGE(PG8_SB(1, 0), cB + kstep, voffB); PG8_STAGE(PG8_SA(1, 0), cA + kstep, voffA); PG8_STAGE(PG8_SB(1, 1), cB + hstepB + kstep, voffB);
    PG8_WAIT_V(6); PG8_BAR;
    for (;;) {
        const bool has_next = S.next(ui + 1, nxt);
        const char* nA = has_next ? (const char*)g.A + (size_t)nxt.pm * tstepA + (size_t)nxt.pn * g.a_pn * 2 : cA; const char* nB = has_next ? (const char*)g.Bt + (size_t)nxt.pn * tstepB : cB;
        for (int t = 0; t < nt; t += 2) {
            const bool last = (t == nt - 2);
            const char* a1 = cA + (size_t)(t + 1) * kstep;
            const char* a2 = last ? nA : cA + (size_t)(t + 2) * kstep; const char* b2 = last ? nB : cB + (size_t)(t + 2) * kstep;
            const char* a3 = a2 + kstep; const char* b3 = b2 + kstep;
            PG8_LDB(B0, 0, 0); PG8_SCHED; PG8_LDA(At, 0, 0); PG8_STAGE(PG8_SA(1, 1), a1 + hstepA, voffA);
            PG8_WAIT_L(8); PG8_BAR; PG8_WAIT_L(0); PG8_MMA(0, 0, At, B0); PG8_BAR; PG8_SCHED;
            PG8_LDB(B1, 0, 1); PG8_STAGE(PG8_SB(0, 0), b2, voffB);
            PG8_BAR; PG8_WAIT_L(0); PG8_MMA(0, 1, At, B1); PG8_BAR;
            PG8_LDA(At, 0, 1); PG8_STAGE(PG8_SA(0, 0), a2, voffA);
            PG8_BAR; PG8_WAIT_L(0); PG8_MMA(1, 0, At, B0); PG8_BAR; PG8_SCHED;
            PG8_STAGE(PG8_SB(0, 1), b2 + hstepB, voffB);
            PG8_WAIT_V(6); PG8_BAR; PG8_MMA(1, 1, At, B1); PG8_BAR;
            PG8_LDB(B0, 1, 0); PG8_SCHED; PG8_LDA(At, 1, 0); PG8_STAGE(PG8_SA(0, 1), a2 + hstepA, voffA);
            PG8_WAIT_L(8); PG8_BAR; PG8_WAIT_L(0); PG8_MMA(0, 0, At, B0); PG8_BAR; PG8_SCHED;
            PG8_LDB(B1, 1, 1); PG8_STAGE(PG8_SB(1, 0), b3, voffB);
            PG8_BAR; PG8_WAIT_L(0); PG8_MMA(0, 1, At, B1); PG8_BAR;
            PG8_LDA(At, 1, 1); PG8_STAGE(PG8_SA(1, 0), a3, voffA);
            PG8_BAR; PG8_WAIT_L(0); PG8_MMA(1, 0, At, B0); PG8_BAR; PG8_SCHED;
            PG8_STAGE(PG8_SB(1, 1), b3 + hstepB, voffB);
            PG8_WAIT_V(6); PG8_BAR; PG8_MMA(1, 1, At, B1); PG8_BAR;
        }
        E(acc, cur, wr, wc, fr, fq);
        if (!has_next) break;
#pragma unroll
        for (int a = 0; a < 2; ++a)
#pragma unroll
            for (int b = 0; b < 2; ++b)
#pragma unroll
                for (int m = 0; m < 4; ++m)
#pragma unroll
                    for (int n = 0; n < 2; ++n) acc[a][b][m][n] = (f32x4){0.f, 0.f, 0.f, 0.f};
        cur = nxt; cA = nA; cB = nB; ++ui;
    }
    PG8_WAIT_V(0);
    if (wr == 0) PG8_BAR;
    PG8_BAR;
#undef PG8_SA
#undef PG8_SB
#undef PG8_STAGE
#undef PG8_LDA
#undef PG8_LDB
#undef PG8_MMA
#undef PG8_WAIT_V
#undef PG8_WAIT_L
#undef PG8_BAR
#undef PG8_SCHED
}

typedef f32x4 Acc[2][2][4][2];
struct EpiZ { static constexpr bool PERM = true;
    bf16_t* Z; const float* ssp; float* ssq; float* kvraw;
    __device__ __forceinline__ void operator()(const Acc& acc, const Unit& u, int wr, int wc, int fr, int fq) const {
        const int rbase = u.pm * BM + wr * 64 + fr, col0 = u.pn * BM + wc * 32 + 8 * fq;
        const bool kvt = (kvraw != nullptr) && u.pn == 10, wantq = (ssq != nullptr) && u.pn <= 1;
#pragma unroll
        for (int ai = 0; ai < 2; ++ai)
#pragma unroll
            for (int m = 0; m < 4; ++m) { const int row = rbase + ai * HALF + m * 16; const float rs = rs_from16(ssp + (size_t)row * 16);
#pragma unroll
                for (int bj = 0; bj < 2; ++bj) { const f32x4 v0 = acc[ai][bj][m][0] * rs, v1 = acc[ai][bj][m][1] * rs; const int c = col0 + bj * HALF;
                    if (!kvt) { u32x4 w; w.x = cvt_pk_bf16(v0[0], v0[1]); w.y = cvt_pk_bf16(v0[2], v0[3]); w.z = cvt_pk_bf16(v1[0], v1[1]); w.w = cvt_pk_bf16(v1[2], v1[3]);
                        *(u32x4*)(Z + (size_t)row * LDZ + c) = w; }
                    else { float* p = kvraw + (size_t)row * 320 + (c - ZB_KV); *(f32x4*)p = v0; *(f32x4*)(p + 4) = v1; }
                    if (kvraw != nullptr && u.pn == 1 && bj == 1 && wc < 2) { float* p = kvraw + (size_t)row * 320 + 256 + (c - ZB_KR); *(f32x4*)p = v0; *(f32x4*)(p + 4) = v1; }
                    if (wantq && (u.pn == 0 || bj == 0)) { float s = sum4(v0 * v0) + sum4(v1 * v1); s += __shfl_xor(s, 16); s += __shfl_xor(s, 32);
                        if (fq == 0) ssq[(size_t)row * 12 + (u.pn == 0 ? bj * 4 + wc : 8 + wc)] = s; } } }
    }
};
struct EpiGrp { static constexpr bool PERM = true;
    const bf16_t* Z; bf16_t* MX;
    __device__ __forceinline__ void operator()(const Acc& acc, const Unit& u, int wr, int wc, int fr, int fq) const {
        const int rbase = u.pm * BM + wr * 64 + fr, col0 = u.pn * BM + wc * 32 + 8 * fq;
#pragma unroll
        for (int ai = 0; ai < 2; ++ai)
#pragma unroll
            for (int m = 0; m < 4; ++m) { const int row = rbase + ai * HALF + m * 16;
                const u32x4 g0 = *(const u32x4*)(Z + (size_t)row * LDZ + ZA_GT + col0), g1 = *(const u32x4*)(Z + (size_t)row * LDZ + ZA_GT + col0 + HALF);
#pragma unroll
                for (int bj = 0; bj < 2; ++bj) { const int c = col0 + bj * HALF; float gt[8]; unpack8(bj ? g1 : g0, gt);
                    const f32x4 v0 = acc[ai][bj][m][0], v1 = acc[ai][bj][m][1]; float o[8];
#pragma unroll
                    for (int j = 0; j < 4; ++j) { o[j] = v0[j] * silu(gt[j]); o[4 + j] = v1[j] * silu(gt[4 + j]); }
                    *(u32x4*)(MX + (size_t)row * OUTW + c) = pack8(o); }
                asm volatile("" ::: "memory"); }
    }
};
struct EpiQ { static constexpr bool PERM = true;
    bf16_t* Q; const float* ssq;
    __device__ __forceinline__ void operator()(const Acc& acc, const Unit& u, int wr, int wc, int fr, int fq) const {
        const int rbase = u.pm * BM + wr * 64 + fr, col0 = u.pn * BM + wc * 32 + 8 * fq;
#pragma unroll
        for (int ai = 0; ai < 2; ++ai)
#pragma unroll
            for (int m = 0; m < 4; ++m) { const int row = rbase + ai * HALF + m * 16; const float rs = rsq_from12(ssq + (size_t)row * 12);
#pragma unroll
                for (int bj = 0; bj < 2; ++bj) { const f32x4 v0 = acc[ai][bj][m][0] * rs, v1 = acc[ai][bj][m][1] * rs;
                    u32x4 w; w.x = cvt_pk_bf16(v0[0], v0[1]); w.y = cvt_pk_bf16(v0[2], v0[3]); w.z = cvt_pk_bf16(v1[0], v1[1]); w.w = cvt_pk_bf16(v1[2], v1[3]);
                    *(u32x4*)(Q + (size_t)row * QW + col0 + bj * HALF) = w; } }
    }
};
struct EpiKV { static constexpr bool PERM = true;
    bf16_t* KN;
    __device__ __forceinline__ void operator()(const Acc& acc, const Unit& u, int wr, int wc, int fr, int fq) const {
        const int rbase = u.pm * BM + wr * 64 + fr, col0 = (u.pn & 3) * BM + wc * 32 + 8 * fq; bf16_t* O = KN + (size_t)(u.pn >> 2) * ((size_t)PM * 1024);
#pragma unroll
        for (int ai = 0; ai < 2; ++ai)
#pragma unroll
            for (int m = 0; m < 4; ++m) { const int row = rbase + ai * HALF + m * 16;
#pragma unroll
                for (int bj = 0; bj < 2; ++bj) { const f32x4 v0 = acc[ai][bj][m][0], v1 = acc[ai][bj][m][1];
                    u32x4 w; w.x = cvt_pk_bf16(v0[0], v0[1]); w.y = cvt_pk_bf16(v0[2], v0[3]); w.z = cvt_pk_bf16(v1[0], v1[1]); w.w = cvt_pk_bf16(v1[2], v1[3]);
                    *(u32x4*)(O + (size_t)row * 1024 + col0 + bj * HALF) = w; } }
    }
};
struct EpiMem { static constexpr bool PERM = false;
    float* OK; bf16_t* MB;
    __device__ __forceinline__ void operator()(const Acc& acc, const Unit& u, int wr, int wc, int fr, int fq) const {
        const int rbase = u.pm * BM + wr * 64 + fr, col0 = u.pn * BM + wc * 32 + 4 * fq;
#pragma unroll
        for (int ai = 0; ai < 2; ++ai)
#pragma unroll
            for (int m = 0; m < 4; ++m) { const int row = rbase + ai * HALF + m * 16;
#pragma unroll
                for (int bj = 0; bj < 2; ++bj)
#pragma unroll
                    for (int n = 0; n < 2; ++n) { const int c = col0 + bj * HALF + n * 16; const int l = c >> 10, kv = (c >> 9) & 1, cc = c & 511; const f32x4 v = acc[ai][bj][m][n];
                        *(f32x4*)(OK + (size_t)kv * (O_MEMV - O_MEMK) + ((size_t)l * 2048 + row) * 512 + cc) = v;
                        u32x2 w; w.x = cvt_pk_bf16(v[0], v[1]); w.y = cvt_pk_bf16(v[2], v[3]); *(u32x2*)(MB + (size_t)row * 4096 + c) = w; } }
    }
};
struct EpiOut { static constexpr bool PERM = false;
    const float* base; float* XR; bf16_t* XB; float* ssp;
    __device__ __forceinline__ void operator()(const Acc& acc, const Unit& u, int wr, int wc, int fr, int fq) const {
        const int rbase = u.pm * BM + wr * 64 + fr, col0 = u.pn * BM + wc * 32 + 4 * fq;
#pragma unroll
        for (int ai = 0; ai < 2; ++ai)
#pragma unroll
            for (int m = 0; m < 4; ++m) { const int row = rbase + ai * HALF + m * 16; float s = 0.f;
#pragma unroll
                for (int bj = 0; bj < 2; ++bj)
#pragma unroll
                    for (int n = 0; n < 2; ++n) { const size_t o = (size_t)row * DM + col0 + bj * HALF + n * 16; const f32x4 v = *(const f32x4*)(base + o) + acc[ai][bj][m][n];
                        *(f32x4*)(XR + o) = v; u32x2 w; w.x = cvt_pk_bf16(v[0], v[1]); w.y = cvt_pk_bf16(v[2], v[3]); *(u32x2*)(XB + o) = w; s += sum4(v * v); }
                s += __shfl_xor(s, 16); s += __shfl_xor(s, 32);
                if (fq == 0) ssp[(size_t)row * 16 + u.pn * 4 + wc] = s; }
    }
};
}
namespace sg {
constexpr int BUF = 24576, LDS_BYTES = 2 * BUF;
template <class Epi>
__device__ __forceinline__ void sgemm_unit(LAS uchar* lds, const bf16_t* A, int lda, const bf16_t* Bt, int ldb, int K, int n0, const Epi& E) {
    int tid_ = threadIdx.x; asm volatile("" : "+v"(tid_));
    const int tid = tid_, wid = tid >> 6, lane = tid & 63, r32 = lane & 31, hi = lane >> 5, rb = wid & 3, cb = wid >> 2;
    const int srow = tid >> 3, sch = tid & 7;
    const bf16_t* ap0 = A + (size_t)srow * lda + sch * 8; const bf16_t* ap1 = ap0 + (size_t)64 * lda; const bf16_t* bp = Bt + (size_t)(n0 + srow) * ldb + sch * 8;
    const int aw0 = srow * 128 + ((sch ^ (srow & 7)) << 4), aw1 = aw0 + 64 * 128, bw = 16384 + aw0;
    const int arow = rb * 32 + r32, brow = cb * 32 + r32;
    const int ard = arow * 128, brd = 16384 + brow * 128, asw = arow & 7, bsw = brow & 7;
    u32x4 ra0[2], ra1[2], rbv[2];
    f32x16 acc = {};
    const int nk = K / 64;
#define SG_LOAD(s, kt) do { ra0[s] = *(const u32x4*)(ap0 + (size_t)(kt) * 64); ra1[s] = *(const u32x4*)(ap1 + (size_t)(kt) * 64); rbv[s] = *(const u32x4*)(bp + (size_t)(kt) * 64); } while (0)
#define SG_WRITE(s, b) do { *(LAS u32x4*)(lds + (b) * BUF + aw0) = ra0[s]; *(LAS u32x4*)(lds + (b) * BUF + aw1) = ra1[s]; *(LAS u32x4*)(lds + (b) * BUF + bw) = rbv[s]; } while (0)
#define SG_COMPUTE(b) do { _Pragma("unroll") for (int kk = 0; kk < 4; ++kk) { \
        const bf16x8 af = *(const LAS bf16x8*)(lds + (b) * BUF + ard + (((2 * kk + hi) ^ asw) << 4)); \
        const bf16x8 bf = *(const LAS bf16x8*)(lds + (b) * BUF + brd + (((2 * kk + hi) ^ bsw) << 4)); \
        acc = __builtin_amdgcn_mfma_f32_32x32x16_bf16(bf, af, acc, 0, 0, 0); } } while (0)
    SG_LOAD(0, 0); SG_LOAD(1, 1);
    for (int kt = 0; kt < nk; kt += 2) {
        SG_WRITE(0, 0); __syncthreads(); if (kt + 2 < nk) SG_LOAD(0, kt + 2);
        SG_COMPUTE(0);
        SG_WRITE(1, 1); __syncthreads(); if (kt + 3 < nk) SG_LOAD(1, kt + 3);
        SG_COMPUTE(1);
    }
#undef SG_LOAD
#undef SG_WRITE
#undef SG_COMPUTE
    E(acc, rb * 32 + r32, n0 + cb * 32, hi);
}

struct EpiZ { bf16_t* Z; const float* ssps; float* ssq; float* kvraw;
    __device__ __forceinline__ void operator()(const f32x16& acc, int row, int cbase, int hi) const {
        const float rs = rs_from32(ssps + row * 32); const size_t grow = (size_t)PM + row; float s = 0.f;
#pragma unroll
        for (int g = 0; g < 4; ++g) { const f32x4 v = (f32x4){acc[4 * g], acc[4 * g + 1], acc[4 * g + 2], acc[4 * g + 3]} * rs; const int c = cbase + 8 * g + 4 * hi;
            if (kvraw != nullptr && cbase >= ZB_KV) *(f32x4*)(kvraw + grow * 320 + (c - ZB_KV)) = v;
            else { u32x2 w; w.x = cvt_pk_bf16(v[0], v[1]); w.y = cvt_pk_bf16(v[2], v[3]); *(u32x2*)(Z + grow * LDZ + c) = w; }
            if (kvraw != nullptr && cbase >= ZB_KR && cbase < ZB_KR + 64) *(f32x4*)(kvraw + grow * 320 + 256 + (c - ZB_KR)) = v;
            s += sum4(v * v); }
        if (ssq != nullptr && cbase < QRANK) { s += __shfl_xor(s, 32); if (hi == 0) ssq[grow * 12 + (cbase >> 5)] = s; }
    }
};
struct EpiGrp { const bf16_t* Z; bf16_t* MX; int cofs;
    __device__ __forceinline__ void operator()(const f32x16& acc, int row, int cbase, int hi) const {
        const size_t grow = (size_t)PM + row;
#pragma unroll
        for (int g = 0; g < 4; ++g) { const int c = cofs + cbase + 8 * g + 4 * hi; const u32x2 gw = *(const u32x2*)(Z + grow * LDZ + ZA_GT + c);
            const float o0 = acc[4 * g] * silu(bf_lo(gw.x)), o1 = acc[4 * g + 1] * silu(bf_hi(gw.x)), o2 = acc[4 * g + 2] * silu(bf_lo(gw.y)), o3 = acc[4 * g + 3] * silu(bf_hi(gw.y));
            u32x2 w; w.x = cvt_pk_bf16(o0, o1); w.y = cvt_pk_bf16(o2, o3); *(u32x2*)(MX + grow * OUTW + c) = w; }
    }
};
struct EpiOut { const float* base; float* XR; bf16_t* XB; float* ssps;
    __device__ __forceinline__ void operator()(const f32x16& acc, int row, int cbase, int hi) const {
        const size_t grow = (size_t)PM + row; float s = 0.f;
#pragma unroll
        for (int g = 0; g < 4; ++g) { const int c = cbase + 8 * g + 4 * hi; const f32x4 v = *(const f32x4*)(base + (size_t)row * DM + c) + (f32x4){acc[4 * g], acc[4 * g + 1], acc[4 * g + 2], acc[4 * g + 3]};
            *(f32x4*)(XR + grow * DM + c) = v; u32x2 w; w.x = cvt_pk_bf16(v[0], v[1]); w.y = cvt_pk_bf16(v[2], v[3]); *(u32x2*)(XB + grow * DM + c) = w; s += sum4(v * v); }
        s += __shfl_xor(s, 32); if (hi == 0) ssps[row * 32 + (cbase >> 5)] = s;
    }
};
struct EpiQ { bf16_t* Q; const float* ssq;
    __device__ __forceinline__ void operator()(const f32x16& acc, int row, int cbase, int hi) const {
        const size_t grow = (size_t)PM + row; const float rs = rsq_from12(ssq + grow * 12);
#pragma unroll
        for (int g = 0; g < 4; ++g) { const int c = cbase + 8 * g + 4 * hi; u32x2 w; w.x = cvt_pk_bf16(acc[4 * g] * rs, acc[4 * g + 1] * rs); w.y = cvt_pk_bf16(acc[4 * g + 2] * rs, acc[4 * g + 3] * rs);
            *(u32x2*)(Q + grow * QW + c) = w; }
    }
};
struct EpiAbsorb { bf16_t* QD; int h;
    __device__ __forceinline__ void operator()(const f32x16& acc, int row, int cbase, int hi) const {
        const int b = row >> 2, t = row & 3; bf16_t* o = QD + ((size_t)b * 32 + t * 8 + h) * 320;
#pragma unroll
        for (int g = 0; g < 4; ++g) { const int c = cbase + 8 * g + 4 * hi; u32x2 w; w.x = cvt_pk_bf16(acc[4 * g], acc[4 * g + 1]); w.y = cvt_pk_bf16(acc[4 * g + 2], acc[4 * g + 3]); *(u32x2*)(o + c) = w; }
    }
};
struct EpiVup { const bf16_t* Z; bf16_t* MX; int h;
    __device__ __forceinline__ void operator()(const f32x16& acc, int row, int cbase, int hi) const {
        const size_t grow = (size_t)PM + row;
#pragma unroll
        for (int g = 0; g < 4; ++g) { const int c = h * 128 + cbase + 8 * g + 4 * hi; const u32x2 gw = *(const u32x2*)(Z + grow * LDZ + ZB_GT + c);
            const float o0 = acc[4 * g] * silu(bf_lo(gw.x)), o1 = acc[4 * g + 1] * silu(bf_hi(gw.x)), o2 = acc[4 * g + 2] * silu(bf_lo(gw.y)), o3 = acc[4 * g + 3] * silu(bf_hi(gw.y));
            u32x2 w; w.x = cvt_pk_bf16(o0, o1); w.y = cvt_pk_bf16(o2, o3); *(u32x2*)(MX + grow * OUTW + c) = w; }
    }
};
}
namespace att {
constexpr int NW = 8, QBLK = 32, KVBLK = 64;
constexpr int SHM_V = KVBLK * 128 * 2, SHM_K = KVBLK * 128 * 2, SHM_KR = KVBLK * 64 * 2;
constexpr int OFF_V = 0, OFF_K = 2 * SHM_V, OFF_KR = OFF_K + 2 * SHM_K, OFF_WS = OFF_KR + 2 * SHM_KR, OFF_QR = OFF_WS + NW * 64 * 4, LDS_BYTES = OFF_QR + NW * 4096;
constexpr float THR = 8.f;
#define KSWZ(row, colB) ((row) * 256 + ((colB) ^ (((row) & 7) << 4)))
#define KRSWZ(row, colB) ((row) * 128 + ((colB) ^ (((row) & 7) << 4)))
#define SBAR() __builtin_amdgcn_sched_barrier(0)
template <int DQK> struct Cst { static constexpr float SCALE = (DQK == 128) ? 0.08838834764831845f : 0.07216878364870322f; };

template <int DQK>
__device__ __forceinline__ void partialSM(f32x16& p0, f32x16& p1, float& m_reg, float& mn, float& alpha) {
    constexpr float SCALE = Cst<DQK>::SCALE, C = SCALE * 1.4426950408889634f;
    float pmax = p0[0];
#pragma unroll
    for (int r = 1; r < 16; ++r) pmax = fmaxf(pmax, p0[r]);
#pragma unroll
    for (int r = 0; r < 16; ++r) pmax = fmaxf(pmax, p1[r]);
    { auto rr = __builtin_amdgcn_permlane32_swap(__float_as_uint(pmax), __float_as_uint(pmax), false, false);
      pmax = fmaxf(__uint_as_float(rr[0]), __uint_as_float(rr[1])); }
    if (__builtin_expect(__all(pmax - m_reg <= THR / SCALE), 1)) { mn = m_reg; alpha = 1.f; }
    else { mn = fmaxf(m_reg, pmax); alpha = __builtin_amdgcn_exp2f((m_reg - mn) * C); m_reg = mn; }
    const float mnC = -mn * C;
#pragma unroll
    for (int r = 0; r < 16; ++r) p0[r] = fmaf(p0[r], C, mnC);
#pragma unroll
    for (int r = 0; r < 16; ++r) p1[r] = fmaf(p1[r], C, mnC);
#pragma unroll
    for (int r = 0; r < 16; ++r) p0[r] = __builtin_amdgcn_exp2f(p0[r]);
}
__device__ __forceinline__ void finishSM(f32x16& p0, f32x16& p1, float alpha, float& l_reg, bf16x8& pa0, bf16x8& pa1, bf16x8& pa2, bf16x8& pa3) {
#pragma unroll
    for (int r = 0; r < 16; ++r) p1[r] = __builtin_amdgcn_exp2f(p1[r]);
    float ps = 0;
#pragma unroll
    for (int r = 0; r < 16; ++r) ps += p0[r];
#pragma unroll
    for (int r = 0; r < 16; ++r) ps += p1[r];
    { auto rr = __builtin_amdgcn_permlane32_swap(__float_as_uint(ps), __float_as_uint(ps), false, false);
      ps = __uint_as_float(rr[0]) + __uint_as_float(rr[1]); }
    l_reg = l_reg * alpha + ps;
#define PK4(P, BASE, OUT) do { unsigned a0 = cvt_pk_bf16(P[BASE + 0], P[BASE + 1]), a1 = cvt_pk_bf16(P[BASE + 2], P[BASE + 3]);   \
    unsigned b0 = cvt_pk_bf16(P[BASE + 4], P[BASE + 5]), b1 = cvt_pk_bf16(P[BASE + 6], P[BASE + 7]);                              \
    auto r0 = __builtin_amdgcn_permlane32_swap(a0, b0, false, false); auto r1 = __builtin_amdgcn_permlane32_swap(a1, b1, false, false); \
    u32x4 w = {r0[0], r1[0], r0[1], r1[1]}; OUT = *reinterpret_cast<bf16x8*>(&w); } while (0)
    PK4(p0, 0, pa0); PK4(p0, 8, pa1); PK4(p1, 0, pa2); PK4(p1, 8, pa3);
#undef PK4
}
template <int DQK>
__device__ __forceinline__ void qkt(f32x16& p0, f32x16& p1, const LAS uchar* Ks, const LAS uchar* Krs, const bf16x8* qr, const LAS uchar* qrl  , int r32, int hi) {
    p0 = f32x16{}; p1 = f32x16{};
#pragma unroll
    for (int d0 = 0; d0 < 8; ++d0) { const int cb = (d0 * 16 + hi * 8) * 2;
        const bf16x8 b0 = *(const LAS bf16x8*)(Ks + KSWZ(r32, cb));
        const bf16x8 b1 = *(const LAS bf16x8*)(Ks + KSWZ(32 + r32, cb));
        p0 = __builtin_amdgcn_mfma_f32_32x32x16_bf16(b0, qr[d0], p0, 0, 0, 0);
        p1 = __builtin_amdgcn_mfma_f32_32x32x16_bf16(b1, qr[d0], p1, 0, 0, 0); }
    if constexpr (DQK == 192) {
#pragma unroll
        for (int d0 = 0; d0 < 4; ++d0) { const int cb = (d0 * 16 + hi * 8) * 2;
            const bf16x8 b0 = *(const LAS bf16x8*)(Krs + KRSWZ(r32, cb));
            const bf16x8 b1 = *(const LAS bf16x8*)(Krs + KRSWZ(32 + r32, cb));
            const bf16x8 qf = *(const LAS bf16x8*)(qrl + d0 * 1024);
            p0 = __builtin_amdgcn_mfma_f32_32x32x16_bf16(b0, qf, p0, 0, 0, 0);
            p1 = __builtin_amdgcn_mfma_f32_32x32x16_bf16(b1, qf, p1, 0, 0, 0); }
    }
}
__device__ __forceinline__ int v_st(int k, int c) { const int kk = (k & ~0xC) | ((k & 4) << 1) | ((k & 8) >> 1); return ((kk >> 3) * 4 + (c >> 5)) * 512 + ((kk & 7) * 32 + (c & 31)) * 2; }
__device__ __forceinline__ int v_rd_base(int lane) { return ((lane & 3) << 3) | (((lane >> 2) & 3) << 6) | (((lane >> 4) & 1) << 5) | (((lane >> 5) & 1) << 8); }
constexpr int v_rd_off(int d0, int ks, int half) { return d0 * 512 + ks * 4096 + half * 2048; }
template <int OFF> __device__ __forceinline__ s16x4 tr_read(int vb) {
    s16x4 r; asm volatile("ds_read_b64_tr_b16 %0, %1 offset:%2" : "=&v"(r) : "v"(vb), "i"(OFF) : "memory"); return r;
}
template <int D0> __device__ __forceinline__ void pv_one(f32x16& od, int vb, bf16x8 pa0, bf16x8 pa1, bf16x8 pa2, bf16x8 pa3) {
    const s16x4 l0 = tr_read<v_rd_off(D0, 0, 0)>(vb), h0 = tr_read<v_rd_off(D0, 0, 1)>(vb), l1 = tr_read<v_rd_off(D0, 1, 0)>(vb), h1 = tr_read<v_rd_off(D0, 1, 1)>(vb);
    const s16x4 l2 = tr_read<v_rd_off(D0, 2, 0)>(vb), h2 = tr_read<v_rd_off(D0, 2, 1)>(vb), l3 = tr_read<v_rd_off(D0, 3, 0)>(vb), h3 = tr_read<v_rd_off(D0, 3, 1)>(vb);
    asm volatile("s_waitcnt lgkmcnt(0)" ::: "memory"); SBAR();
#define PK(L, H) (bf16x8){L[0], L[1], L[2], L[3], H[0], H[1], H[2], H[3]}
    od = __builtin_amdgcn_mfma_f32_32x32x16_bf16(pa0, PK(l0, h0), od, 0, 0, 0);
    od = __builtin_amdgcn_mfma_f32_32x32x16_bf16(pa1, PK(l1, h1), od, 0, 0, 0);
    od = __builtin_amdgcn_mfma_f32_32x32x16_bf16(pa2, PK(l2, h2), od, 0, 0, 0);
    od = __builtin_amdgcn_mfma_f32_32x32x16_bf16(pa3, PK(l3, h3), od, 0, 0, 0);
#undef PK
}
__device__ __forceinline__ void pv_d0(f32x16* o, int vb, bf16x8 pa0, bf16x8 pa1, bf16x8 pa2, bf16x8 pa3) {
    pv_one<0>(o[0], vb, pa0, pa1, pa2, pa3); pv_one<1>(o[1], vb, pa0, pa1, pa2, pa3); pv_one<2>(o[2], vb, pa0, pa1, pa2, pa3); pv_one<3>(o[3], vb, pa0, pa1, pa2, pa3);
}
__device__ __forceinline__ void causal_mask(f32x16& p0, f32x16& p1, int jj, int rowrel, int hi) {
#pragma unroll
    for (int r = 0; r < 16; ++r) { const int k0 = 64 * jj + crow(r, hi); if (k0 > rowrel) p0[r] = -1e30f; if (k0 + 32 > rowrel) p1[r] = -1e30f; }
}

template <int DQK, bool CAUSAL, int SD, int LDQ, int LDK>
__device__ __forceinline__ void attn_body(const bf16_t* __restrict__ Qb, const bf16_t* __restrict__ Kh, const bf16_t* __restrict__ Vh, const bf16_t* __restrict__ Krp,
                                          const f32x2* __restrict__ ropeq, const bf16_t* __restrict__ gate, bf16_t* __restrict__ outp, int NT, int diag0, LAS uchar* lds) {
    constexpr int NQ = 8;
    int tid_ = threadIdx.x; asm volatile("" : "+v"(tid_));
    const int tid = tid_, wid = tid >> 6, lane = tid & 63, r32 = lane & 31, hi = lane >> 5;
    LAS uchar* V_lds = lds + OFF_V; LAS uchar* K_lds = lds + OFF_K; LAS uchar* Kr_lds = lds + OFF_KR;
    LAS float* ws = (LAS float*)(lds + OFF_WS) + wid * 64; LAS float* li_l = ws; LAS float* al_l = ws + 32; LAS uchar* qrl = lds + OFF_QR + wid * 4096 + lane * 16;
    float m_reg = -1e30f, l_reg = 0; f32x16 o[4] = {}; bf16x8 qr[NQ];
    const bf16_t* Qw = Qb + (size_t)(wid * QBLK + r32) * LDQ + hi * 8;
#pragma unroll
    for (int d0 = 0; d0 < 8; ++d0) qr[d0] = *(const bf16x8*)(Qw + d0 * 16);
    if constexpr (DQK == 192) {
#pragma unroll
        for (int a = 0; a < 2; ++a) {
            const u32x4 w1 = *(const u32x4*)(Qw + 128 + 16 * a), w2 = *(const u32x4*)(Qw + 160 + 16 * a); float x1[8], x2[8], o1[8], o2[8]; unpack8(w1, x1); unpack8(w2, x2);
            const f32x2* tb = ropeq + (size_t)(wid * QBLK + r32) * 32 + 16 * a + 8 * hi;
#pragma unroll
            for (int j = 0; j < 8; ++j) { const f32x2 cs = tb[j]; o1[j] = x1[j] * cs.x - x2[j] * cs.y; o2[j] = x1[j] * cs.y + x2[j] * cs.x; }
            *(LAS u32x4*)(qrl + a * 1024) = pack8(o1); *(LAS u32x4*)(qrl + (2 + a) * 1024) = pack8(o2);
        }
    }
    const int sr = tid >> 4, sc = (tid & 15) * 8, vst0 = v_st(sr, sc), vst1 = v_st(32 + sr, sc);
    const int krow = tid >> 3, kcc = (tid & 7) * 8;
    const int vb0 = (int)(unsigned)(uintptr_t)V_lds + v_rd_base(lane);
    struct { bf16x8 vs0, vs1, ks0, ks1, kr; } sr_[SD];
#define SLOAD(i, k0) do { sr_[i].vs0 = *(const bf16x8*)(Vh + (size_t)((k0) + sr) * LDK + sc); sr_[i].vs1 = *(const bf16x8*)(Vh + (size_t)((k0) + 32 + sr) * LDK + sc); \
    sr_[i].ks0 = *(const bf16x8*)(Kh + (size_t)((k0) + sr) * LDK + sc); sr_[i].ks1 = *(const bf16x8*)(Kh + (size_t)((k0) + 32 + sr) * LDK + sc); \
    if constexpr (DQK == 192) sr_[i].kr = *(const bf16x8*)(Krp + (size_t)((k0) + krow) * 64 + kcc); } while (0)
#define SWRITE(b, i) do { *(LAS bf16x8*)(V_lds + (b) * SHM_V + vst0) = sr_[i].vs0; *(LAS bf16x8*)(V_lds + (b) * SHM_V + vst1) = sr_[i].vs1; const int kc = sc * 2; \
    *(LAS bf16x8*)(K_lds + (b) * SHM_K + KSWZ(sr, kc)) = sr_[i].ks0; *(LAS bf16x8*)(K_lds + (b) * SHM_K + KSWZ(32 + sr, kc)) = sr_[i].ks1; \
    if constexpr (DQK == 192) *(LAS bf16x8*)(Kr_lds + (b) * SHM_KR + KRSWZ(krow, kcc * 2)) = sr_[i].kr; } while (0)
#define SWAIT() do { if constexpr (SD == 2) { if constexpr (DQK == 192) asm volatile("s_waitcnt vmcnt(5)" ::: "memory"); else asm volatile("s_waitcnt vmcnt(4)" ::: "memory"); } \
    else asm volatile("s_waitcnt vmcnt(0)" ::: "memory"); } while (0)
#define RESC(a) do { if (__any((a) < 1.f)) { if (hi == 0) al_l[r32] = (a); asm volatile("s_waitcnt lgkmcnt(0)" ::: "memory"); \
    _Pragma("unroll") for (int d = 0; d < 4; ++d) _Pragma("unroll") for (int r = 0; r < 16; ++r) o[d][r] *= al_l[crow(r, hi)]; } } while (0)
#define MASK(P0, P1, tile) do { if constexpr (CAUSAL) { if ((tile) >= diag0) causal_mask(P0, P1, (tile) - diag0, wid * QBLK + r32, hi); } } while (0)
    f32x16 pA0, pA1, pB0, pB1; float mnA, mnB, alA, alB; bf16x8 pa0, pa1, pa2, pa3;
    constexpr int SE = 0, SO = SD - 1;
    SLOAD(SE, 0); asm volatile("s_waitcnt vmcnt(0)" ::: "memory"); SWRITE(0, SE); __syncthreads();
    qkt<DQK>(pA0, pA1, K_lds, Kr_lds, qr, qrl, r32, hi); MASK(pA0, pA1, 0); partialSM<DQK>(pA0, pA1, m_reg, mnA, alA);
    SLOAD(SO, KVBLK); if constexpr (SD == 2) { if (2 < NT) SLOAD(SE, 2 * KVBLK); }
    SWAIT(); SWRITE(1, SO); __syncthreads();
    for (int j = 1; j + 1 < NT; j += 2) {
        SBAR(); qkt<DQK>(pB0, pB1, K_lds + SHM_K, Kr_lds + SHM_KR, qr, qrl, r32, hi); MASK(pB0, pB1, j);
        finishSM(pA0, pA1, alA, l_reg, pa0, pa1, pa2, pa3); SBAR();
        SLOAD(SO, (j + SD) * KVBLK); SBAR();
        pv_d0(o, vb0, pa0, pa1, pa2, pa3); partialSM<DQK>(pB0, pB1, m_reg, mnB, alB);
        __syncthreads(); SWAIT(); SWRITE(0, SE);
        RESC(alB); __syncthreads();
        SBAR(); qkt<DQK>(pA0, pA1, K_lds, Kr_lds, qr, qrl, r32, hi); MASK(pA0, pA1, j + 1);
        finishSM(pB0, pB1, alB, l_reg, pa0, pa1, pa2, pa3); SBAR();
        if (SD == 1 || j + 3 < NT) SLOAD(SE, (j + 1 + SD) * KVBLK); SBAR();
        pv_d0(o, vb0 + SHM_V, pa0, pa1, pa2, pa3); partialSM<DQK>(pA0, pA1, m_reg, mnA, alA);
        __syncthreads(); SWAIT(); SWRITE(1, SO);
        RESC(alA); __syncthreads();
    }
    SBAR(); qkt<DQK>(pB0, pB1, K_lds + SHM_K, Kr_lds + SHM_KR, qr, qrl, r32, hi); MASK(pB0, pB1, NT - 1);
    finishSM(pA0, pA1, alA, l_reg, pa0, pa1, pa2, pa3); SBAR();
    pv_d0(o, vb0, pa0, pa1, pa2, pa3); partialSM<DQK>(pB0, pB1, m_reg, mnB, alB);
    __syncthreads(); RESC(alB);
    finishSM(pB0, pB1, alB, l_reg, pa0, pa1, pa2, pa3); SBAR();
    pv_d0(o, vb0 + SHM_V, pa0, pa1, pa2, pa3);
    if (hi == 0) li_l[r32] = l_reg; asm volatile("s_waitcnt lgkmcnt(0)" ::: "memory");
    float rli[16];
#pragma unroll
    for (int r = 0; r < 16; ++r) rli[r] = __builtin_amdgcn_rcpf(li_l[crow(r, hi)]);
#pragma unroll
    for (int r = 0; r < 16; ++r) { const size_t orow = (size_t)(wid * QBLK + crow(r, hi));
#pragma unroll
        for (int d0 = 0; d0 < 4; ++d0) { const int col = d0 * 32 + r32; const float g = bf2f(gate[orow * LDZ + col]);
            outp[orow * OUTW + col] = (bf16_t)(cvt_pk_bf16(o[d0][r] * rli[r] * silu(g), 0.f) & 0xffffu); } }
#undef SLOAD
#undef SWRITE
#undef SWAIT
#undef RESC
#undef MASK
}
}
namespace dec {
constexpr int BUFB = 40960, OFF_KR = 32768, OFF_WS = 2 * BUFB, LDS_BYTES = OFF_WS + 8 * 64 * 4;
__device__ __forceinline__ unsigned off_b(unsigned row, unsigned ch) { return 256u * row + 16u * (ch ^ (((row & 3) << 2) | ((row >> 2) & 3))); }
__device__ __forceinline__ unsigned row_read_addr(unsigned lane, unsigned s) { return off_b(lane & 31, 2 * s + (lane >> 5)); }
__device__ __forceinline__ unsigned tr_read_addr(unsigned lane, unsigned c, unsigned ks, unsigned t) {
    const unsigned h = lane >> 5, blk = (lane >> 4) & 1, q = (lane & 15) >> 2, p = lane & 3;
    return off_b(16 * ks + 8 * h + 4 * t + q, 4 * c + 2 * blk + (p >> 1)) + 8 * (p & 1);
}
__device__ __forceinline__ s16x4 tr_rd(unsigned addr) { s16x4 r; asm volatile("ds_read_b64_tr_b16 %0, %1" : "=&v"(r) : "v"(addr) : "memory"); return r; }

__device__ __forceinline__ void decode_unit(const bf16_t* __restrict__ Qd, const float* __restrict__ cckv, const float* __restrict__ ckr, const int* __restrict__ pt,
                                            float* __restrict__ Opart, float* __restrict__ ML, LAS uchar* lds) {
    int tid_ = threadIdx.x; asm volatile("" : "+v"(tid_));
    const int tid = tid_, wid = tid >> 6, lane = tid & 63, r32 = lane & 31, hi = lane >> 5;
    LAS float* al_l = (LAS float*)(lds + OFF_WS) + wid * 64;
    bf16x8 qr[20];
#pragma unroll
    for (int s = 0; s < 20; ++s) qr[s] = *(const bf16x8*)(Qd + (size_t)r32 * 320 + s * 16 + hi * 8);
    float m_reg = -1e30f, l_reg = 0.f; f32x16 o = {};
    const int skey = tid >> 3, sub = tid & 7;
    f32x4 sv[10];
    unsigned wa[4];
#pragma unroll
    for (int i = 0; i < 4; ++i) { const int ci = sub * 4 + i; wa[i] = (unsigned)(((ci >> 4) * 2 + (skey >> 5)) * 8192) + off_b(skey & 31, ci & 15); }
    const unsigned wkr = OFF_KR + skey * 128 + ((sub ^ (skey & 7)) << 4);
    const unsigned ldsb = (unsigned)(uintptr_t)lds;
    const int pw = wid >> 2, cw = wid & 3;
#define DLOAD(j) do { const int page = pt[(j) >> 1]; const size_t krow = (size_t)page * 128 + ((j) & 1) * 64 + skey; \
    const float* s0 = cckv + krow * 256 + sub * 32; const float* s1 = ckr + krow * 64 + sub * 8; \
    _Pragma("unroll") for (int i = 0; i < 8; ++i) sv[i] = __builtin_nontemporal_load((const f32x4*)s0 + i); \
    sv[8] = __builtin_nontemporal_load((const f32x4*)s1); sv[9] = __builtin_nontemporal_load((const f32x4*)s1 + 1); } while (0)
#define DWRITE(b) do { _Pragma("unroll") for (int i = 0; i < 5; ++i) { u32x4 w; w.x = cvt_pk_bf16(sv[2 * i][0], sv[2 * i][1]); w.y = cvt_pk_bf16(sv[2 * i][2], sv[2 * i][3]); \
        w.z = cvt_pk_bf16(sv[2 * i + 1][0], sv[2 * i + 1][1]); w.w = cvt_pk_bf16(sv[2 * i + 1][2], sv[2 * i + 1][3]); \
        *(LAS u32x4*)(lds + (b) * BUFB + (i < 4 ? wa[i < 4 ? i : 0] : wkr)) = w; } } while (0)
    constexpr int NT = 32;
    DLOAD(0); DWRITE(0); __syncthreads();
    for (int j = 0; j < NT; ++j) {
        const int b = j & 1;
        if (j + 1 < NT) DLOAD(j + 1);
        const LAS uchar* B = lds + b * BUFB;
        f32x16 p0 = {}, p1 = {};
#pragma unroll
        for (int s = 0; s < 16; ++s) { const unsigned ra = row_read_addr(lane, s & 7);
            const bf16x8 k0 = *(const LAS bf16x8*)(B + ((s >> 3) * 2 + 0) * 8192 + ra), k1 = *(const LAS bf16x8*)(B + ((s >> 3) * 2 + 1) * 8192 + ra);
            p0 = __builtin_amdgcn_mfma_f32_32x32x16_bf16(k0, qr[s], p0, 0, 0, 0); p1 = __builtin_amdgcn_mfma_f32_32x32x16_bf16(k1, qr[s], p1, 0, 0, 0); }
#pragma unroll
        for (int s = 0; s < 4; ++s) { const int chk = 2 * s + hi;
            const bf16x8 k0 = *(const LAS bf16x8*)(B + OFF_KR + r32 * 128 + ((chk ^ (r32 & 7)) << 4)), k1 = *(const LAS bf16x8*)(B + OFF_KR + (32 + r32) * 128 + ((chk ^ (r32 & 7)) << 4));
            p0 = __builtin_amdgcn_mfma_f32_32x32x16_bf16(k0, qr[16 + s], p0, 0, 0, 0); p1 = __builtin_amdgcn_mfma_f32_32x32x16_bf16(k1, qr[16 + s], p1, 0, 0, 0); }
        float mn, alpha; att::partialSM<192>(p0, p1, m_reg, mn, alpha);
        if (__any(alpha < 1.f)) { if (hi == 0) al_l[r32] = alpha; asm volatile("s_waitcnt lgkmcnt(0)" ::: "memory");
#pragma unroll
            for (int r = 0; r < 16; ++r) o[r] *= al_l[crow(r, hi)]; }
        bf16x8 pa[4]; att::finishSM(p0, p1, alpha, l_reg, pa[0], pa[1], pa[2], pa[3]);
        s16x4 vl[4], vh[4];
#pragma unroll
        for (int ks = 0; ks < 4; ++ks) { const unsigned vb = ldsb + b * BUFB + (pw * 2 + (ks >> 1)) * 8192;
            vl[ks] = tr_rd(vb + tr_read_addr(lane, cw, ks & 1, 0)); vh[ks] = tr_rd(vb + tr_read_addr(lane, cw, ks & 1, 1)); }
        asm volatile("s_waitcnt lgkmcnt(0)" ::: "memory"); __builtin_amdgcn_sched_barrier(0);
#pragma unroll
        for (int ks = 0; ks < 4; ++ks) o = __builtin_amdgcn_mfma_f32_32x32x16_bf16(pa[ks], ((bf16x8){vl[ks][0], vl[ks][1], vl[ks][2], vl[ks][3], vh[ks][0], vh[ks][1], vh[ks][2], vh[ks][3]}), o, 0, 0, 0);
        if (j + 1 < NT) DWRITE(b ^ 1);
        __syncthreads();
    }
#undef DLOAD
#undef DWRITE
    if (wid == 0 && hi == 0) { ML[r32 * 2] = m_reg; ML[r32 * 2 + 1] = l_reg; }
#pragma unroll
    for (int r = 0; r < 16; ++r) Opart[(size_t)crow(r, hi) * 256 + 32 * wid + r32] = o[r];
}

__device__ __forceinline__ void combine_row(int b, int row32, int lane, const bf16_t* __restrict__ Qdec, const float* __restrict__ Opart, const float* __restrict__ ML,
                                            const float* __restrict__ ckvn, const float* __restrict__ krn, bf16_t* __restrict__ olat) {
    constexpr float C = 0.07216878364870322f * 1.4426950408889634f;
    const int t = row32 >> 3, h = row32 & 7;
    const bf16_t* q = Qdec + ((size_t)b * 32 + row32) * 320;
    const u32x2 qw = *(const u32x2*)(q + 4 * lane); const float q0 = bf_lo(qw.x), q1 = bf_hi(qw.x), q2 = bf_lo(qw.y), q3 = bf_hi(qw.y); const float qrp = bf2f(q[256 + lane]);
    float sj[4]; f32x4 cn[4];
#pragma unroll
    for (int j = 0; j < 4; ++j) { cn[j] = *(const f32x4*)(ckvn + ((size_t)b * 4 + j) * 256 + 4 * lane); float s = q0 * cn[j][0] + q1 * cn[j][1] + q2 * cn[j][2] + q3 * cn[j][3] + qrp * krn[((size_t)b * 4 + j) * 64 + lane];
#pragma unroll
        for (int o = 32; o >= 1; o >>= 1) s += __shfl_xor(s, o);
        sj[j] = (j <= t) ? s : -1e30f; }
    float mc[8], lc[8], M = fmaxf(fmaxf(sj[0], sj[1]), fmaxf(sj[2], sj[3]));
#pragma unroll
    for (int c = 0; c < 8; ++c) { const f32x2 ml = *(const f32x2*)(ML + (((size_t)b * 8 + c) * 32 + row32) * 2); mc[c] = ml.x; lc[c] = ml.y; M = fmaxf(M, mc[c]); }
    float L = 0.f; f32x4 acc = {0.f, 0.f, 0.f, 0.f};
#pragma unroll
    for (int c = 0; c < 8; ++c) { const float w = __builtin_amdgcn_exp2f((mc[c] - M) * C); L += lc[c] * w; acc += *(const f32x4*)(Opart + (((size_t)b * 8 + c) * 32 + row32) * 256 + 4 * lane) * w; }
#pragma unroll
    for (int j = 0; j < 4; ++j) { const float e = (j <= t) ? __builtin_amdgcn_exp2f((sj[j] - M) * C) : 0.f; L += e; acc += cn[j] * e; }
    const float rl = 1.0f / L; u32x2 w; w.x = cvt_pk_bf16(acc[0] * rl, acc[1] * rl); w.y = cvt_pk_bf16(acc[2] * rl, acc[3] * rl);
    *(u32x2*)(olat + ((size_t)b * 4 + t) * 2048 + h * 256 + 4 * lane) = w;
}

constexpr int SMEM_LDS = 4096 + 32768;
__device__ __forceinline__ void smem_unit(const bf16_t* __restrict__ Zq  , const bf16_t* __restrict__ Zg  , const float* __restrict__ Kc, const float* __restrict__ Vc  ,
                                          bf16_t* __restrict__ outp  , LAS uchar* lds) {
    int tid_ = threadIdx.x; asm volatile("" : "+v"(tid_));
    const int tid = tid_, wid = tid >> 6, lane = tid & 63, l32 = lane & 31, hi = lane >> 5;
    LAS float* sc = (LAS float*)lds; LAS float* red = (LAS float*)(lds + 4096);
    float qv[4][4];
#pragma unroll
    for (int t = 0; t < 4; ++t) { const u32x2 w = *(const u32x2*)(Zq + (size_t)t * LDZ + 4 * l32); qv[t][0] = bf_lo(w.x); qv[t][1] = bf_hi(w.x); qv[t][2] = bf_lo(w.y); qv[t][3] = bf_hi(w.y); }
#pragma unroll 4
    for (int i = 0; i < 16; ++i) { const int m = wid * 32 + 2 * i + hi; const f32x4 kv = *(const f32x4*)(Kc + (size_t)m * 512 + 4 * l32); float p[4];
#pragma unroll
        for (int t = 0; t < 4; ++t) { p[t] = kv[0] * qv[t][0] + kv[1] * qv[t][1] + kv[2] * qv[t][2] + kv[3] * qv[t][3];
#pragma unroll
            for (int o = 16; o >= 1; o >>= 1) p[t] += __shfl_xor(p[t], o); }
        if (l32 == 0) {
#pragma unroll
            for (int t = 0; t < 4; ++t) sc[t * 256 + m] = p[t] * 0.08838834764831845f; } }
    __syncthreads();
    if (wid < 4) { float v[4], mx = -1e30f;
#pragma unroll
        for (int i = 0; i < 4; ++i) { v[i] = sc[wid * 256 + lane + 64 * i]; mx = fmaxf(mx, v[i]); }
#pragma unroll
        for (int o = 32; o >= 1; o >>= 1) mx = fmaxf(mx, __shfl_xor(mx, o));
        float s = 0.f;
#pragma unroll
        for (int i = 0; i < 4; ++i) { v[i] = __expf(v[i] - mx); s += v[i]; }
#pragma unroll
        for (int o = 32; o >= 1; o >>= 1) s += __shfl_xor(s, o);
        const float rs = 1.0f / s;
#pragma unroll
        for (int i = 0; i < 4; ++i) sc[wid * 256 + lane + 64 * i] = v[i] * rs; }
    __syncthreads();
    { const int d4 = (tid & 31) * 4, mg = tid >> 5; f32x4 a[4] = {};
#pragma unroll 4
      for (int mm = 0; mm < 16; ++mm) { const int m = mg * 16 + mm; const f32x4 vv = *(const f32x4*)(Vc + (size_t)m * 512 + d4);
#pragma unroll
          for (int t = 0; t < 4; ++t) a[t] += vv * sc[t * 256 + m]; }
#pragma unroll
      for (int t = 0; t < 4; ++t) *(LAS f32x4*)(red + (mg * 4 + t) * 128 + d4) = a[t]; }
    __syncthreads();
    { const int t = tid >> 7, d = tid & 127; float s = 0.f;
#pragma unroll
      for (int mg = 0; mg < 16; ++mg) s += red[(mg * 4 + t) * 128 + d];
      const float g = bf2f(Zg[(size_t)t * LDZ + d]);
      outp[(size_t)t * OUTW + d] = (bf16_t)(cvt_pk_bf16(s * silu(g), 0.f) & 0xffffu); }
    __syncthreads();
}
}
namespace ew {
__device__ __forceinline__ int otid() { int t = threadIdx.x; asm volatile("" : "+v"(t)); return t; }
struct TJ { const float* src; int sld, K, ncols; const float* gain; const float* cscale; bf16_t* dst; int dld; };
constexpr int NTJ = 32;
__device__ __forceinline__ TJ get_tj(int j, const float* const* in, uchar* ws) {
    TJ t; t.gain = nullptr; t.cscale = nullptr;
    bf16_t* WINA = (bf16_t*)(ws + WS_WINA); bf16_t* WGRP = (bf16_t*)(ws + WS_WGRP); bf16_t* WINB = (bf16_t*)(ws + WS_WINB); bf16_t* WQUP = (bf16_t*)(ws + WS_WQUP);
    bf16_t* WKV = (bf16_t*)(ws + WS_WKV); bf16_t* WMEM = (bf16_t*)(ws + WS_WMEM); bf16_t* WOUT = (bf16_t*)(ws + WS_WOUT);
    if (j < 2) { t.src = in[10] + (size_t)j * DM * INA; t.sld = INA; t.K = DM; t.ncols = INA; t.gain = in[9] + j * DM; t.dst = WINA + (size_t)j * INA * DM; t.dld = DM; }
    else if (j < 10) { const int i = j - 2; t.src = in[11] + (size_t)i * 65536; t.sld = 256; t.K = 256; t.ncols = 256; t.cscale = in[12] + i * 256; t.dst = WGRP + (size_t)i * 65536; t.dld = 256; }
    else if (j < 12) { const int i = j - 10; t.src = in[13] + (size_t)i * DM * INB; t.sld = INB; t.K = DM; t.ncols = QRANK; t.gain = in[9] + (2 + i) * DM; t.dst = WINB + (size_t)i * NB2 * DM; t.dld = DM; }
    else if (j < 14) { const int i = j - 12; t.src = in[13] + (size_t)i * DM * INB + QRANK; t.sld = INB; t.K = DM; t.ncols = INB - QRANK; t.gain = in[9] + (2 + i) * DM; t.dst = WINB + ((size_t)i * NB2 + ZB_GT) * DM; t.dld = DM; }
    else if (j == 14) { t.src = in[17] + KVR; t.sld = 320; t.K = DM; t.ncols = ROPE; t.gain = in[16]; t.dst = WINB + (size_t)ZB_KR * DM; t.dld = DM; }
    else if (j == 15) { t.src = in[17]; t.sld = 320; t.K = DM; t.ncols = KVR; t.gain = in[16]; t.dst = WINB + (size_t)ZB_KV * DM; t.dld = DM; }
    else if (j < 18) { const int i = j - 16; t.src = in[15] + (size_t)i * QRANK * QW; t.sld = QW; t.K = QRANK; t.ncols = QW; t.gain = in[14] + i * QRANK; t.dst = WQUP + (size_t)i * QW * QRANK; t.dld = QRANK; }
    else if (j == 18) { t.src = in[19]; t.sld = 1024; t.K = 256; t.ncols = 1024; t.dst = WKV; t.dld = 256; }
    else if (j == 19) { t.src = in[20]; t.sld = 1024; t.K = 256; t.ncols = 1024; t.dst = WKV + (size_t)1024 * 256; t.dld = 256; }
    else if (j < 28) { const int i = j - 20, l = i >> 1, kv = i & 1; t.src = (kv ? in[23] : in[22]) + (size_t)l * DM * MEMW; t.sld = MEMW; t.K = DM; t.ncols = MEMW; t.gain = in[21] + l * DM; t.dst = WMEM + (size_t)(l * 2 + kv) * MEMW * DM; t.dld = DM; }
    else { const int l = j - 28; t.src = in[24] + (size_t)l * OUTW * DM; t.sld = DM; t.K = OUTW; t.ncols = DM; t.dst = WOUT + (size_t)l * DM * OUTW; t.dld = OUTW; }
    return t;
}
__device__ __forceinline__ int tj_tiles(int j) {
    if (j < 2) return 16 * 48; if (j < 10) return 16; if (j < 12) return 16 * 6; if (j < 14) return 16 * 32; if (j == 14) return 16; if (j == 15) return 64;
    if (j < 18) return 6 * 24; if (j < 20) return 4 * 16; if (j < 28) return 16 * 8; return 24 * 16;
}
constexpr int TJ_TOTAL = 2 * 768 + 8 * 16 + 2 * 96 + 2 * 512 + 16 + 64 + 2 * 144 + 2 * 64 + 8 * 128 + 4 * 384;
__device__ __forceinline__ void transpose_tile(const TJ& t, int tile, LAS float* tl, int tid) {
    const int nkt = t.K / 64, kt = tile % nkt, nt = tile / nkt, k0 = kt * 64, n0 = nt * 64;
    { const int k = tid >> 3, n8 = (tid & 7) * 8; const float* s = t.src + (size_t)(k0 + k) * t.sld + n0 + n8; const float g = t.gain ? t.gain[k0 + k] : 1.0f;
      const f32x4 a = *(const f32x4*)s * g, b = *(const f32x4*)(s + 4) * g;
#pragma unroll
      for (int j = 0; j < 4; ++j) { tl[k * 65 + n8 + j] = a[j]; tl[k * 65 + n8 + 4 + j] = b[j]; } }
    __syncthreads();
    { const int n = tid >> 3, k8 = (tid & 7) * 8; const float cs = t.cscale ? t.cscale[n0 + n] : 1.0f; float v[8];
#pragma unroll
      for (int j = 0; j < 8; ++j) v[j] = tl[(k8 + j) * 65 + n] * cs;
      *(u32x4*)(t.dst + (size_t)(n0 + n) * t.dld + k0 + k8) = pack8(v); }
    __syncthreads();
}
__device__ __forceinline__ void sincos_d(float angf, float& c, float& s) {
    const double x = (double)angf; const double kd = rint(x * 0.63661977236758134308); const int q = (int)((long long)kd & 3);
    double r = fma(-kd, 1.57079632679489655800e+00, x); r = fma(-kd, 6.12323399573676603587e-17, r);
    const double r2 = r * r;
    double sp = -7.6471637318198164759e-13; sp = fma(sp, r2, 1.6059043836821614599e-10); sp = fma(sp, r2, -2.5052108385441718775e-08); sp = fma(sp, r2, 2.7557319223985890653e-06);
    sp = fma(sp, r2, -1.9841269841269841270e-04); sp = fma(sp, r2, 8.3333333333333333333e-03); sp = fma(sp, r2, -1.6666666666666666667e-01); const double sn = fma(sp * r2, r, r);
    double cp = 4.7794773323873852974e-14; cp = fma(cp, r2, -1.1470745597729724714e-11); cp = fma(cp, r2, 2.0876756987868098979e-09); cp = fma(cp, r2, -2.7557319223985890653e-07);
    cp = fma(cp, r2, 2.4801587301587301587e-05); cp = fma(cp, r2, -1.3888888888888888889e-03); cp = fma(cp, r2, 4.1666666666666666667e-02); cp = fma(cp, r2, -0.5); const double cn = fma(cp, r2, 1.0);
    const double ss = (q == 0) ? sn : (q == 1) ? cn : (q == 2) ? -sn : -cn, cc = (q == 0) ? cn : (q == 1) ? -sn : (q == 2) ? -cn : sn;
    c = (float)cc; s = (float)ss;
}

__device__ __forceinline__ void prologue(const float* const* in, float* out, uchar* ws, LAS uchar* lds, int G, int bid) {
    const int tid = otid(), lane = tid & 63, wid = tid >> 6;
    for (int gt = bid; gt < TJ_TOTAL; gt += G) { int j = 0, r = gt; for (; j < NTJ; ++j) { const int n = tj_tiles(j); if (r < n) break; r -= n; }
        const TJ t = get_tj(j, in, ws); transpose_tile(t, r, (LAS float*)lds, tid); }
    const size_t gtid = (size_t)bid * 512 + tid, gstride = (size_t)G * 512;
    { bf16_t* WINB = (bf16_t*)(ws + WS_WINB);
      for (size_t i = gtid; i < (size_t)(64 + 128) * DM / 8; i += gstride) { const size_t e = i * 8; bf16_t* p = (e < (size_t)64 * DM) ? WINB + (size_t)448 * DM + e : WINB + ((size_t)NB2 + 384) * DM + (e - (size_t)64 * DM);
          *(u32x4*)p = (u32x4){0u, 0u, 0u, 0u}; }
      bf16_t* WKUPN = (bf16_t*)(ws + WS_WKUPN);
      for (size_t i = gtid; i < (size_t)256 * 1024 / 8; i += gstride) { const float* s = in[19] + i * 8; const f32x4 a = *(const f32x4*)s, b = *(const f32x4*)(s + 4);
          const float v[8] = {a[0], a[1], a[2], a[3], b[0], b[1], b[2], b[3]}; *(u32x4*)(WKUPN + i * 8) = pack8(v); } }
    { bf16_t* XB = (bf16_t*)(ws + WS_XB); bf16_t* MH = (bf16_t*)(ws + WS_MHAT); float* ssp = (float*)(ws + WS_SSP); float* ssps = (float*)(ws + WS_SSPS);
      const int nrows = PM + SM + 2048;
      for (int row = bid * 8 + wid; row < nrows; row += G * 8) {
          const float* src = row < PM ? in[0] + (size_t)row * DM : row < PM + SM ? in[1] + (size_t)(row - PM) * DM : in[8] + (size_t)(row - PM - SM) * DM;
          f32x4 v[4]; float s = 0.f;
#pragma unroll
          for (int i = 0; i < 4; ++i) { v[i] = *(const f32x4*)(src + 256 * i + 4 * lane); s += sum4(v[i] * v[i]); }
#pragma unroll
          for (int o = 32; o >= 1; o >>= 1) s += __shfl_xor(s, o);
          float sc = 1.0f; bf16_t* dst;
          if (row < PM + SM) { dst = XB + (size_t)row * DM; if (row < PM) { if (lane < 16) ssp[(size_t)row * 16 + lane] = lane == 0 ? s : 0.f; } else { if (lane < 32) ssps[(row - PM) * 32 + lane] = lane == 0 ? s : 0.f; } }
          else { dst = MH + (size_t)(row - PM - SM) * DM; sc = rsqrtf(s * (1.0f / 1024.0f) + EPS); }
#pragma unroll
          for (int i = 0; i < 4; ++i) { u32x2 w; w.x = cvt_pk_bf16(v[i][0] * sc, v[i][1] * sc); w.y = cvt_pk_bf16(v[i][2] * sc, v[i][3] * sc); *(u32x2*)(dst + 256 * i + 4 * lane) = w; } } }
    { f32x2* tab = (f32x2*)(ws + WS_ROPE);
      for (size_t e = gtid; e < (size_t)2052 * 32; e += gstride) { const int p = (int)(e >> 5), i = (int)(e & 31); const int pos = p < 2048 ? p : PAST + (p - 2048);
          const float inv = (float)exp2(-(double)i * (13.287712379549449 / 32.0)); const float ang = (float)pos * inv; float c, s; sincos_d(ang, c, s); tab[e] = (f32x2){c, s}; } }
    { for (size_t e = gtid; e < (size_t)2 * SB * 11 * DM / 4; e += gstride) { const size_t f = e * 4; const int c = (int)(f % DM); const size_t rr = f / DM; const int i = (int)(rr % 11); const size_t lb = rr / 11;
          *(f32x4*)(out + O_PSS + (lb * 15 + i) * DM + c) = *(const f32x4*)(in[2] + (lb * 15 + 4 + i) * DM + c); } }
}

__device__ __forceinline__ void pooling(int l, const float* const* in, float* out, uchar* ws, int G, int bid) {
    const bf16_t* Z = (const bf16_t*)(ws + WS_Z); bf16_t* PO = (bf16_t*)(ws + WS_POOLED);
    const size_t gtid = (size_t)bid * 512 + otid(), gstride = (size_t)G * 512;
    for (size_t idx = gtid; idx < (size_t)PM * 128; idx += gstride) { const int row = (int)(idx >> 7), cv = (int)(idx & 127), g = cv >> 5, w = 2 << g, t = row & (PT - 1), n = (t + 1 < w) ? t + 1 : w;
        const bf16_t* p = Z + (size_t)row * LDZ + cv * 8; float ut[8], s[8]; unpack8(*(const u32x4*)p, ut);
#pragma unroll
        for (int j = 0; j < 8; ++j) s[j] = ut[j];
        for (int i = 1; i < n; ++i) { float x[8]; unpack8(*(const u32x4*)(p - (size_t)i * LDZ), x);
#pragma unroll
            for (int j = 0; j < 8; ++j) s[j] += x[j]; }
        const float rn = 1.0f / (float)n; float o[8];
#pragma unroll
        for (int j = 0; j < 8; ++j) o[j] = s[j] * rn - ut[j];
        *(u32x4*)(PO + (size_t)row * DM + cv * 8) = pack8(o);
        if (t >= PT - POOLBUF) { float* q = out + O_PSP + (((size_t)l * PB + (row >> 11)) * 15 + (t - (PT - POOLBUF))) * DM + cv * 8; *(f32x4*)q = (f32x4){ut[0], ut[1], ut[2], ut[3]}; *(f32x4*)(q + 4) = (f32x4){ut[4], ut[5], ut[6], ut[7]}; } }
    for (size_t idx = gtid; idx < (size_t)SM * 128; idx += gstride) { const int r = (int)(idx >> 7), cv = (int)(idx & 127), g = cv >> 5, w = 2 << g, b = r >> 2, t = r & 3;
        const float* prev = in[2] + ((size_t)l * SB + b) * 15 * DM + cv * 8; const bf16_t* us = Z + ((size_t)PM + b * 4) * LDZ + cv * 8; float ut[8], s[8];
        unpack8(*(const u32x4*)(us + (size_t)t * LDZ), ut);
#pragma unroll
        for (int j = 0; j < 8; ++j) s[j] = ut[j];
        for (int i = 1; i < w; ++i) { const int e = 15 + t - i; float x[8];
            if (e >= 15) unpack8(*(const u32x4*)(us + (size_t)(e - 15) * LDZ), x);
            else { const f32x4 a = *(const f32x4*)(prev + (size_t)e * DM), bb = *(const f32x4*)(prev + (size_t)e * DM + 4); x[0] = a[0]; x[1] = a[1]; x[2] = a[2]; x[3] = a[3]; x[4] = bb[0]; x[5] = bb[1]; x[6] = bb[2]; x[7] = bb[3]; }
#pragma unroll
            for (int j = 0; j < 8; ++j) s[j] += x[j]; }
        const float rn = 1.0f / (float)w; float o[8];
#pragma unroll
        for (int j = 0; j < 8; ++j) o[j] = s[j] * rn - ut[j];
        *(u32x4*)(PO + ((size_t)PM + r) * DM + cv * 8) = pack8(o);
        float* q = out + O_PSS + (((size_t)l * SB + b) * 15 + 11 + t) * DM + cv * 8; *(f32x4*)q = (f32x4){ut[0], ut[1], ut[2], ut[3]}; *(f32x4*)(q + 4) = (f32x4){ut[4], ut[5], ut[6], ut[7]}; }
}

__device__ __forceinline__ void kvpost(const float* const* in, float* out, uchar* ws, int G, int bid) {
    const float* KV = (const float*)(ws + WS_KVRAW); bf16_t* CB = (bf16_t*)(ws + WS_CKVB); bf16_t* KB = (bf16_t*)(ws + WS_KROPEB); const f32x2* tab = (const f32x2*)(ws + WS_ROPE);
    const int tid = otid(), lane = tid & 63, wid = tid >> 6; const f32x4 gl = *(const f32x4*)(in[18] + 4 * lane);
    for (int row = bid * 8 + wid; row < PM + SM; row += G * 8) { const float* p = KV + (size_t)row * 320; const f32x4 v = *(const f32x4*)(p + 4 * lane); float s = sum4(v * v);
#pragma unroll
        for (int o = 32; o >= 1; o >>= 1) s += __shfl_xor(s, o);
        const float rs = rsqrtf(s * (1.0f / 256.0f) + EPS); const f32x4 c = v * rs * gl;
        float* oc = row < PM ? out + O_CKVP + (size_t)row * KVR : out + O_CKVS + (size_t)(row - PM) * KVR; float* ok = row < PM ? out + O_KRP + (size_t)row * ROPE : out + O_KRS + (size_t)(row - PM) * ROPE;
        *(f32x4*)(oc + 4 * lane) = c; u32x2 w; w.x = cvt_pk_bf16(c[0], c[1]); w.y = cvt_pk_bf16(c[2], c[3]); *(u32x2*)(CB + (size_t)row * KVR + 4 * lane) = w;
        if (lane < 32) { const int ti = row < PM ? (row & (PT - 1)) : 2048 + ((row - PM) & 3); const f32x2 cs = tab[(size_t)ti * 32 + lane]; const float x1 = p[256 + lane], x2 = p[288 + lane];
            const float o1 = x1 * cs.x - x2 * cs.y, o2 = x1 * cs.y + x2 * cs.x; ok[lane] = o1; ok[32 + lane] = o2;
            KB[(size_t)row * ROPE + lane] = (bf16_t)(cvt_pk_bf16(o1, 0.f) & 0xffffu); KB[(size_t)row * ROPE + 32 + lane] = (bf16_t)(cvt_pk_bf16(o2, 0.f) & 0xffffu); } }
}
__device__ __forceinline__ void sq_rope(uchar* ws, int G, int bid) {
    const bf16_t* Q = (const bf16_t*)(ws + WS_Q); bf16_t* QD = (bf16_t*)(ws + WS_QDEC); const f32x2* tab = (const f32x2*)(ws + WS_ROPE);
    for (size_t e = (size_t)bid * 512 + otid(); e < (size_t)SM * MLAH * 32; e += (size_t)G * 512) { const int i = (int)(e & 31), h = (int)((e >> 5) & 7), r = (int)(e >> 8), b = r >> 2, t = r & 3;
        const bf16_t* q = Q + ((size_t)PM + r) * QW + h * QHD + NOPE; const float x1 = bf2f(q[i]), x2 = bf2f(q[32 + i]); const f32x2 cs = tab[(size_t)(2048 + t) * 32 + i];
        bf16_t* o = QD + ((size_t)b * 32 + t * 8 + h) * 320 + 256; o[i] = (bf16_t)(cvt_pk_bf16(x1 * cs.x - x2 * cs.y, 0.f) & 0xffffu); o[32 + i] = (bf16_t)(cvt_pk_bf16(x1 * cs.y + x2 * cs.x, 0.f) & 0xffffu); }
}
__device__ __forceinline__ void final_norm(const float* const* in, float* out, uchar* ws, int G, int bid) {
    const float* XR = (const float*)(ws + WS_XRES); const float* ssp = (const float*)(ws + WS_SSP); const float* ssps = (const float*)(ws + WS_SSPS);
    const int tid = otid(), lane = tid & 63, wid = tid >> 6;
    for (int row = bid * 8 + wid; row < PM + SM; row += G * 8) { const float rs = row < PM ? rs_from16(ssp + (size_t)row * 16) : rs_from32(ssps + (row - PM) * 32);
        float* o = row < PM ? out + O_YP + (size_t)row * DM : out + O_YS + (size_t)(row - PM) * DM; const float* x = XR + (size_t)row * DM;
#pragma unroll
        for (int i = 0; i < 4; ++i) { const int c = 256 * i + 4 * lane; *(f32x4*)(o + c) = *(const f32x4*)(x + c) * rs * *(const f32x4*)(in[25] + c); } }
}
}
#define XB_TMO      128
#define XB_XCNT(j)  (256  + 64 * (j))
#define XB_XSUB(j)  (1280 + 64 * (j))
#define XB_XGEN(j)  (2304 + 64 * (j))
#define XB_TOP      3328
#define XB_TOPGEN   3392
#define XCD_BAR_WORDS 3456
#define XB_SPIN_CAP (1u << 22)
__device__ __forceinline__ unsigned xb_ld(unsigned* p)              { return __hip_atomic_load(p, __ATOMIC_RELAXED, __HIP_MEMORY_SCOPE_AGENT); }
__device__ __forceinline__ unsigned xb_add(unsigned* p, unsigned v) { return __hip_atomic_fetch_add(p, v, __ATOMIC_RELAXED, __HIP_MEMORY_SCOPE_AGENT); }
__device__ __forceinline__ unsigned xb_xcc_id() { return (unsigned)__builtin_amdgcn_s_getreg((3 << 11) | 20) & 0xFu; }
#define XB_SPIN(cond, bar) do { unsigned _sp = 0; while (cond) { __builtin_amdgcn_s_sleep(1); \
    if ((++_sp & 255u) == 0u) { if (xb_ld(&(bar)[XB_TMO])) break; if (_sp > XB_SPIN_CAP) { atomicAdd(&(bar)[XB_TMO], 1u); break; } } } } while (0)
struct XcdBarrier { unsigned* bar; unsigned x; volatile LAS unsigned* st; };
__device__ __forceinline__ XcdBarrier xcd_barrier_post(unsigned* bar, volatile LAS unsigned* st) {
    XcdBarrier b; b.bar = bar; b.x = xb_xcc_id(); b.st = st;
    if (threadIdx.x == 0) (void)xb_add(&bar[XB_XCNT(b.x)], 1u);
    return b;
}
__device__ __forceinline__ void xcd_barrier_complete(unsigned* bar, unsigned x, unsigned& nloc, unsigned& nx) {
    const unsigned G = gridDim.x * gridDim.y * gridDim.z;
    unsigned sum, cnt, mine, sp = 0u;
    for (;;) {
        sum = 0u; cnt = 0u; mine = 0u;
#pragma unroll
        for (unsigned j = 0; j < 16; ++j) { const unsigned c = xb_ld(&bar[XB_XCNT(j)]); sum += c; cnt += (c > 0u) ? 1u : 0u; mine = (j == x) ? c : mine; }
        if (sum == G) break;
        __builtin_amdgcn_s_sleep(1);
        if ((++sp & 255u) == 0u) { if (xb_ld(&bar[XB_TMO])) break; if (sp > XB_SPIN_CAP) { atomicAdd(&bar[XB_TMO], 1u); break; } }
    }
    nloc = mine > 0u ? mine : 1u; nx = cnt > 0u ? cnt : 1u;
}
__device__ __forceinline__ void xcd_barrier(const XcdBarrier& b) {
    asm volatile("s_waitcnt vmcnt(0)" ::: "memory");
    __syncthreads();
    if (threadIdx.x == 0) {
        unsigned* bar = b.bar;
        __builtin_amdgcn_s_waitcnt(0);
        unsigned nloc = b.st[0], nx = b.st[1];
        if (nloc == 0u) { xcd_barrier_complete(bar, b.x, nloc, nx); b.st[0] = nloc; b.st[1] = nx; }
        const unsigned old = xb_add(&bar[XB_XSUB(b.x)], 1u);
        const unsigned gen = old / nloc;
        if (old + 1u == (gen + 1u) * nloc) {
            __builtin_amdgcn_fence(__ATOMIC_RELEASE, "agent");
            asm volatile("s_waitcnt vmcnt(0)" ::: "memory");
            const unsigned og = xb_add(&bar[XB_TOP], 1u);
            const unsigned tg = og / nx;
            if (og + 1u == (tg + 1u) * nx) xb_add(&bar[XB_TOPGEN], 1u);
            else XB_SPIN(xb_ld(&bar[XB_TOPGEN]) == tg, bar);
            __builtin_amdgcn_fence(__ATOMIC_ACQUIRE, "agent");
            xb_add(&bar[XB_XGEN(b.x)], 1u);
            asm volatile("s_waitcnt vmcnt(0)" ::: "memory");
        } else {
            XB_SPIN(xb_ld(&bar[XB_XGEN(b.x)]) == gen, bar);
            __builtin_amdgcn_fence(__ATOMIC_ACQUIRE, "agent");
            asm volatile("s_waitcnt vmcnt(0)" ::: "memory");
        }
    }
    __syncthreads();
}

constexpr int LDS_BYTES = 144 * 1024, MISC_OFF = 136 * 1024;
static_assert(pg8::STAGE_BYTES <= MISC_OFF && att::LDS_BYTES <= MISC_OFF && dec::LDS_BYTES <= MISC_OFF && sg::LDS_BYTES <= MISC_OFF && dec::SMEM_LDS <= MISC_OFF, "LDS budget");
constexpr int NPHASE = 24;
struct Params { const float* in[26]; float* out; uchar* ws; int ph_lo, ph_hi; };

template <class T> __device__ __forceinline__ T* launder(T* p) { asm volatile("" : "+s"(p)); return p; }
#define PHASE_PTRS \
    uchar* const ws = launder(P.ws); float* const out = launder(P.out); const float* const* in = P.in; (void)in; (void)out; \
    bf16_t* const XB = (bf16_t*)(ws + WS_XB); float* const XR = (float*)(ws + WS_XRES); bf16_t* const Z = (bf16_t*)(ws + WS_Z); bf16_t* const MX = (bf16_t*)(ws + WS_MIXED); \
    bf16_t* const PO = (bf16_t*)(ws + WS_POOLED); bf16_t* const QB = (bf16_t*)(ws + WS_Q); float* const ssp = (float*)(ws + WS_SSP); float* const ssps = (float*)(ws + WS_SSPS); \
    float* const ssq = (float*)(ws + WS_SSQ); float* const KVRAW = (float*)(ws + WS_KVRAW); bf16_t* const MEMB = (bf16_t*)(ws + WS_MEMB); \
    (void)XB; (void)XR; (void)Z; (void)MX; (void)PO; (void)QB; (void)ssp; (void)ssps; (void)ssq; (void)KVRAW; (void)MEMB;

__global__ void __launch_bounds__(512, 2) yoco_fwd(Params P) {
    extern __shared__ __attribute__((aligned(16))) uchar lds_raw[];
    LAS uchar* lds = (LAS uchar*)lds_raw;
    const int tid = threadIdx.x, G = gridDim.x, bid = blockIdx.x;
    volatile LAS unsigned* misc = (volatile LAS unsigned*)(lds + MISC_OFF);
    if (tid < 4) misc[tid] = 0u;
    __syncthreads();
    const int lo = P.ph_lo, hi = P.ph_hi; const bool multi = (hi - lo) > 1;
    XcdBarrier bar; bar.bar = (unsigned*)(P.ws + WS_CTL); bar.x = 0; bar.st = misc;
    if (multi) bar = xcd_barrier_post((unsigned*)(P.ws + WS_CTL), misc);
#ifndef EN_MASK
#define EN_MASK 0xffff
#endif
#define EN(t) ((EN_MASK >> (t)) & 1)
#define IN(k) (lo <= (k) && (k) < hi)
#define SEAM(k) do { if (IN(k) && IN((k) + 1)) xcd_barrier(bar); } while (0)
#define SUNITS(u, n) for (int u = G - 1 - bid; u < (n); u += G)

    if (EN(0) && IN(0)) { PHASE_PTRS ew::prologue(in, out, ws, lds, G, bid); }
    SEAM(0);

#pragma unroll 1
    for (int l = 0; l < 2; ++l) {
        const int pb = 1 + 4 * l;
        if (EN(1) && IN(pb)) {
            PHASE_PTRS
            { pg8::Gemm g{XB, (const bf16_t*)(ws + WS_WINA) + (size_t)l * INA * DM, DM, DM, DM, 0}; pg8::StaticOrder S; S.init(PM / 256, INA / 256, G, bid);
              pg8::EpiZ E{Z, ssp, nullptr, nullptr}; pg8::gemm_phase(lds, g, S, E); }
            if (l == 0) { pg8::Gemm g{(const bf16_t*)(ws + WS_MHAT), (const bf16_t*)(ws + WS_WMEM), DM, DM, DM, 0}; pg8::StaticOrder S; S.init(2048 / 256, 4096 / 256, G, bid);
              pg8::EpiMem E{out + O_MEMK, MEMB}; pg8::gemm_phase(lds, g, S, E); }
            SUNITS(u, INA / 64) { sg::EpiZ E{Z, ssps, nullptr, nullptr}; sg::sgemm_unit(lds, XB + (size_t)PM * DM, DM, (const bf16_t*)(ws + WS_WINA) + (size_t)l * INA * DM, DM, DM, u * 64, E); }
        }
        SEAM(pb);
        if (EN(2) && IN(pb + 1)) {
            PHASE_PTRS
            ew::pooling(l, in, out, ws, G, bid);
            for (int u = bid; u < PB * MEMH * 8; u += G) { const int b = u >> 5, h = (u >> 3) & 3, x = u & 7; const size_t r0 = (size_t)b * PT + 256 * x;
                const bf16_t* Kh = MEMB + (size_t)b * 256 * 4096 + l * 1024 + h * 128;
                att::attn_body<128, false, 1, LDZ, 4096>(Z + r0 * LDZ + ZA_QM + h * 128, Kh, Kh + 512, nullptr, nullptr, Z + r0 * LDZ + ZA_GM + h * 128, MX + r0 * OUTW + 1024 + h * 128, 4, 0, lds);
                __syncthreads(); }
            SUNITS(u, SB * MEMH) { const int b = u >> 2, h = u & 3; const size_t r0 = (size_t)PM + b * 4; const size_t ko = (((size_t)l * SB + b) * MEMT * MEMH + h) * 128;
                dec::smem_unit(Z + r0 * LDZ + ZA_QM + h * 128, Z + r0 * LDZ + ZA_GM + h * 128, in[5] + ko, in[6] + ko, MX + r0 * OUTW + 1024 + h * 128, lds); }
        }
        SEAM(pb + 1);
        if (EN(3) && IN(pb + 2)) {
            PHASE_PTRS
            { pg8::Gemm g{PO, (const bf16_t*)(ws + WS_WGRP) + (size_t)l * 4 * 65536, DM, 256, 256, 256}; pg8::StaticOrder S; S.init(PM / 256, 4, G, bid);
              pg8::EpiGrp E{Z, MX}; pg8::gemm_phase(lds, g, S, E); }
            SUNITS(u, 16) { const int g = u >> 2; sg::EpiGrp E{Z, MX, g * 256};
                sg::sgemm_unit(lds, PO + (size_t)PM * DM + g * 256, DM, (const bf16_t*)(ws + WS_WGRP) + ((size_t)l * 4 + g) * 65536, 256, 256, (u & 3) * 64, E); }
        }
        SEAM(pb + 2);
        if (EN(4) && IN(pb + 3)) {
            PHASE_PTRS
            const float* baseP = l == 0 ? in[0] : XR; const float* baseS = l == 0 ? in[1] : XR + (size_t)PM * DM;
            { pg8::Gemm g{MX, (const bf16_t*)(ws + WS_WOUT) + (size_t)l * DM * OUTW, OUTW, OUTW, OUTW, 0}; pg8::StaticOrder S; S.init(PM / 256, DM / 256, G, bid);
              pg8::EpiOut E{baseP, XR, XB, ssp}; pg8::gemm_phase(lds, g, S, E); }
            SUNITS(u, DM / 64) { sg::EpiOut E{baseS, XR, XB, ssps};
                sg::sgemm_unit(lds, MX + (size_t)PM * OUTW, OUTW, (const bf16_t*)(ws + WS_WOUT) + (size_t)l * DM * OUTW, OUTW, OUTW, u * 64, E); }
        }
        SEAM(pb + 3);
    }

#pragma unroll 1
    for (int j = 0; j < 2; ++j) {
        const int l = 2 + j, pb = 9 + 7 * j; const int NB = j == 0 ? NB2 : NB3;
        if (EN(5) && IN(pb)) {
            PHASE_PTRS
            const bf16_t* WB = (const bf16_t*)(ws + WS_WINB) + (size_t)j * NB2 * DM; float* kvr = j == 0 ? KVRAW : nullptr;
            { pg8::Gemm g{XB, WB, DM, DM, DM, 0}; pg8::StaticOrder S; S.init(PM / 256, NB / 256, G, bid);
              pg8::EpiZ E{Z, ssp, ssq, kvr}; pg8::gemm_phase(lds, g, S, E); }
            SUNITS(u, NB / 64) { sg::EpiZ E{Z, ssps, ssq, kvr}; sg::sgemm_unit(lds, XB + (size_t)PM * DM, DM, WB, DM, DM, u * 64, E); }
        }
        SEAM(pb);
        if (EN(6) && IN(pb + 1)) {
            PHASE_PTRS
            if (j == 0) ew::kvpost(in, out, ws, G, bid);
            { pg8::Gemm g{Z + ZB_CQ, (const bf16_t*)(ws + WS_WQUP) + (size_t)j * QW * QRANK, LDZ, QRANK, QRANK, 0}; pg8::StaticOrder S; S.init(PM / 256, QW / 256, G, bid);
              pg8::EpiQ E{QB, ssq}; pg8::gemm_phase(lds, g, S, E); }
            for (int u = bid; u < PB * MEMH * 8; u += G) { const int b = u >> 5, h = (u >> 3) & 3, x = u & 7; const size_t r0 = (size_t)b * PT + 256 * x;
                const bf16_t* Kh = MEMB + (size_t)b * 256 * 4096 + l * 1024 + h * 128;
                att::attn_body<128, false, 1, LDZ, 4096>(Z + r0 * LDZ + ZB_QM + h * 128, Kh, Kh + 512, nullptr, nullptr, Z + r0 * LDZ + ZB_GM + h * 128, MX + r0 * OUTW + 1024 + h * 128, 4, 0, lds);
                __syncthreads(); }
            SUNITS(u, QW / 64) { sg::EpiQ E{QB, ssq}; sg::sgemm_unit(lds, Z + (size_t)PM * LDZ + ZB_CQ, LDZ, (const bf16_t*)(ws + WS_WQUP) + (size_t)j * QW * QRANK, QRANK, QRANK, u * 64, E); }
            SUNITS(u, SB * MEMH) { const int b = u >> 2, h = u & 3; const size_t r0 = (size_t)PM + b * 4; const size_t ko = (((size_t)l * SB + b) * MEMT * MEMH + h) * 128;
                dec::smem_unit(Z + r0 * LDZ + ZB_QM + h * 128, Z + r0 * LDZ + ZB_GM + h * 128, in[5] + ko, in[6] + ko, MX + r0 * OUTW + 1024 + h * 128, lds); }
        }
        SEAM(pb + 1);
        if (EN(7) && IN(pb + 2)) {
            PHASE_PTRS
            if (j == 0) { pg8::Gemm g{(const bf16_t*)(ws + WS_CKVB), (const bf16_t*)(ws + WS_WKV), KVR, KVR, KVR, 0}; pg8::StaticOrder S; S.init(PM / 256, 2048 / 256, G, bid);
              pg8::EpiKV E{(bf16_t*)(ws + WS_KN)}; pg8::gemm_phase(lds, g, S, E); }
            SUNITS(u, MLAH * 4) { const int h = u >> 2; sg::EpiAbsorb E{(bf16_t*)(ws + WS_QDEC), h};
                sg::sgemm_unit(lds, QB + (size_t)PM * QW + h * QHD, QW, (const bf16_t*)(ws + WS_WKUPN) + h * 128, 1024, 128, (u & 3) * 64, E); }
            ew::sq_rope(ws, G, bid);
        }
        SEAM(pb + 2);
        if (EN(8) && IN(pb + 3)) {
            PHASE_PTRS
            for (int u = bid; u < PB * MLAH * 4; u += G) { const int b = u >> 5, h = (u >> 2) & 7, xp = u & 3;
#pragma unroll 1
                for (int s = 0; s < 2; ++s) { const int x = s == 0 ? 7 - xp : xp; const size_t b0 = (size_t)b * PT, r0 = b0 + 256 * x;
                    att::attn_body<192, true, 1, QW, 1024>(QB + r0 * QW + h * QHD, (const bf16_t*)(ws + WS_KN) + b0 * 1024 + h * 128, (const bf16_t*)(ws + WS_VV) + b0 * 1024 + h * 128,
                        (const bf16_t*)(ws + WS_KROPEB) + b0 * ROPE, (const f32x2*)(ws + WS_ROPE) + (size_t)(256 * x) * 32, Z + r0 * LDZ + ZB_GT + h * 128, MX + r0 * OUTW + h * 128, 4 * (x + 1), 4 * x, lds);
                    __syncthreads(); } }
            for (int u = bid; u < SB * 8; u += G) { const int b = u >> 3, ch = u & 7;
                dec::decode_unit((const bf16_t*)(ws + WS_QDEC) + (size_t)b * 32 * 320, in[3], in[4], (const int*)in[7] + b * NPAGES + ch * 16,
                                 (float*)(ws + WS_OPART) + ((size_t)b * 8 + ch) * 32 * 256, (float*)(ws + WS_ML) + ((size_t)b * 8 + ch) * 32 * 2, lds);
                __syncthreads(); }
        }
        SEAM(pb + 3);
        if (EN(9) && IN(pb + 4)) {
            PHASE_PTRS
            const int ct = ew::otid();
            for (int w = bid * 8 + (ct >> 6); w < SB * 32; w += G * 8)
                dec::combine_row(w >> 5, w & 31, ct & 63, (const bf16_t*)(ws + WS_QDEC), (const float*)(ws + WS_OPART), (const float*)(ws + WS_ML), out + O_CKVS, out + O_KRS, (bf16_t*)(ws + WS_OLAT));
        }
        SEAM(pb + 4);
        if (EN(10) && IN(pb + 5)) {
            PHASE_PTRS
            SUNITS(u, MLAH * 2) { const int h = u >> 1; sg::EpiVup E{Z, MX, h};
                sg::sgemm_unit(lds, (const bf16_t*)(ws + WS_OLAT) + h * 256, 2048, (const bf16_t*)(ws + WS_WKV) + ((size_t)1024 + h * 128) * 256, 256, 256, (u & 1) * 64, E); }
        }
        SEAM(pb + 5);
        if (EN(11) && IN(pb + 6)) {
            PHASE_PTRS
            { pg8::Gemm g{MX, (const bf16_t*)(ws + WS_WOUT) + (size_t)l * DM * OUTW, OUTW, OUTW, OUTW, 0}; pg8::StaticOrder S; S.init(PM / 256, DM / 256, G, bid);
              pg8::EpiOut E{XR, XR, XB, ssp}; pg8::gemm_phase(lds, g, S, E); }
            SUNITS(u, DM / 64) { sg::EpiOut E{XR + (size_t)PM * DM, XR, XB, ssps};
                sg::sgemm_unit(lds, MX + (size_t)PM * OUTW, OUTW, (const bf16_t*)(ws + WS_WOUT) + (size_t)l * DM * OUTW, OUTW, OUTW, u * 64, E); }
        }
        SEAM(pb + 6);
    }
    if (EN(12) && IN(23)) { PHASE_PTRS ew::final_norm(in, out, ws, G, bid); }
#undef IN
#undef SEAM
#undef SUNITS
}

#ifndef MK_LAUNCHES
#define MK_LAUNCHES 1
#endif
extern "C" void kernel_launch(void* const* d_in, const int* in_sizes, int n_in, void* d_out, int out_size, void* d_ws, size_t ws_size, hipStream_t stream) {
    static int grid = 0;
    if (grid == 0) {
        if (n_in != 26 || (size_t)out_size != O_END || ws_size < WS_END) { fprintf(stderr, "kernel_launch: unexpected shapes: n_in %d out %d ws %zu (need out %zu ws %zu)\n", n_in, out_size, ws_size, (size_t)O_END, (size_t)WS_END); grid = -1; return; }
        int dev = 0, cus = 0, per_cu = 0;
        if (hipGetDevice(&dev) != hipSuccess || hipDeviceGetAttribute(&cus, hipDeviceAttributeMultiprocessorCount, dev) != hipSuccess) { grid = -1; return; }
        if (hipFuncSetAttribute((const void*)yoco_fwd, hipFuncAttributeMaxDynamicSharedMemorySize, LDS_BYTES) != hipSuccess) { fprintf(stderr, "kernel_launch: hipFuncSetAttribute failed\n"); grid = -1; return; }
        if (hipOccupancyMaxActiveBlocksPerMultiprocessor(&per_cu, (const void*)yoco_fwd, 512, LDS_BYTES) != hipSuccess || per_cu < 1) { fprintf(stderr, "kernel_launch: occupancy query says %d blocks per CU\n", per_cu); (void)hipGetLastError(); grid = -1; return; }
        grid = cus;
    }
    if (grid < 0) return;
    (void)hipMemsetAsync((char*)d_ws + WS_CTL, 0, CTL_BYTES, stream);
    Params p{};
    for (int i = 0; i < 26; ++i) p.in[i] = (const float*)d_in[i];
    p.out = (float*)d_out; p.ws = (uchar*)d_ws;
    if (MK_LAUNCHES == 1) { p.ph_lo = 0; p.ph_hi = NPHASE; hipLaunchKernelGGL(yoco_fwd, dim3(grid), dim3(512), LDS_BYTES, stream, p); }
    else for (int k = 0; k < NPHASE; ++k) { p.ph_lo = k; p.ph_hi = k + 1; hipLaunchKernelGGL(yoco_fwd, dim3(grid), dim3(512), LDS_BYTES, stream, p); }
    const hipError_t le = hipPeekAtLastError();
    if (le != hipSuccess) fprintf(stderr, "kernel_launch: launch failed: %s\n", hipGetErrorName(le));
}
```

```cpp
#include <hip/hip_runtime.h>
#include <cstdio>
#include <cstdint>

#define LAS __attribute__((address_space(3)))
typedef unsigned char uchar;
typedef unsigned short bf16_t;
typedef short bf16x8 __attribute__((ext_vector_type(8)));
typedef short s16x4 __attribute__((ext_vector_type(4)));
typedef float f32x2 __attribute__((ext_vector_type(2)));
typedef float f32x4 __attribute__((ext_vector_type(4)));
typedef float f32x16 __attribute__((ext_vector_type(16)));
typedef unsigned u32x2 __attribute__((ext_vector_type(2)));
typedef unsigned u32x4 __attribute__((ext_vector_type(4)));

constexpr int DM = 1024, PB = 8, PT = 2048, PM = PB * PT, SB = 32, ST = 4, SM = SB * ST, RP = 16640;
constexpr int KVR = 256, ROPE = 64, NOPE = 128, QRANK = 384, MLAH = 8, QHD = 192, QW = MLAH * QHD;
constexpr int MEMT = 256, MEMH = 4, MEMW = 512;
constexpr int INA = 3072, INB = 2432, OUTW = 1536, LDZ = 3072, NB2 = 2816, NB3 = 2560;
constexpr int NPAGES = 128, PAGE = 128, PAST = 16384, POOLBUF = 15;
constexpr float EPS = 1e-6f;
constexpr int ZA_U = 0, ZA_GT = 1024, ZA_QM = 2048, ZA_GM = 2560;
constexpr int ZB_CQ = 0, ZB_KR = 384, ZB_GT = 512, ZB_QM = 1536, ZB_GM = 2048, ZB_KV = 2560;

constexpr size_t O_YP = 0, O_YS = O_YP + (size_t)PM * DM, O_PSP = O_YS + (size_t)SM * DM, O_PSS = O_PSP + (size_t)2 * PB * 15 * DM, O_CKVP = O_PSS + (size_t)2 * SB * 15 * DM,
                 O_KRP = O_CKVP + (size_t)PM * KVR, O_CKVS = O_KRP + (size_t)PM * ROPE, O_KRS = O_CKVS + (size_t)SM * KVR, O_MEMK = O_KRS + (size_t)SM * ROPE,
                 O_MEMV = O_MEMK + (size_t)4 * PB * MEMT * MEMW, O_END = O_MEMV + (size_t)4 * PB * MEMT * MEMW;

constexpr size_t al256(size_t x) { return (x + 255) / 256 * 256; }
constexpr size_t WS_CTL = 0, CTL_BYTES = 65536;
constexpr size_t WS_ROPE = WS_CTL + CTL_BYTES;
constexpr size_t WS_WINA = al256(WS_ROPE + (size_t)2052 * 32 * 8);
constexpr size_t WS_WGRP = al256(WS_WINA + (size_t)2 * INA * DM * 2);
constexpr size_t WS_WINB = al256(WS_WGRP + (size_t)2 * 4 * 256 * 256 * 2);
constexpr size_t WS_WQUP = al256(WS_WINB + (size_t)2 * NB2 * DM * 2);
constexpr size_t WS_WKV  = al256(WS_WQUP + (size_t)2 * QW * QRANK * 2);
constexpr size_t WS_WKUPN = al256(WS_WKV + (size_t)2048 * 256 * 2);
constexpr size_t WS_WMEM = al256(WS_WKUPN + (size_t)256 * 1024 * 2);
constexpr size_t WS_WOUT = al256(WS_WMEM + (size_t)4096 * 1024 * 2);
constexpr size_t WS_MHAT = al256(WS_WOUT + (size_t)4 * DM * OUTW * 2);
constexpr size_t WS_MEMB = al256(WS_MHAT + (size_t)2048 * 1024 * 2);
constexpr size_t WS_XRES = al256(WS_MEMB + (size_t)2048 * 4096 * 2);
constexpr size_t WS_XB   = al256(WS_XRES + (size_t)RP * DM * 4);
constexpr size_t WS_SSP  = al256(WS_XB + (size_t)RP * DM * 2);
constexpr size_t WS_SSPS = al256(WS_SSP + (size_t)PM * 16 * 4);
constexpr size_t WS_SSQ  = al256(WS_SSPS + (size_t)SM * 32 * 4);
constexpr size_t WS_Z    = al256(WS_SSQ + (size_t)RP * 12 * 4);
constexpr size_t WS_POOLED = al256(WS_Z + (size_t)RP * LDZ * 2);
constexpr size_t WS_MIXED = al256(WS_POOLED + (size_t)RP * DM * 2);
constexpr size_t WS_Q    = al256(WS_MIXED + (size_t)RP * OUTW * 2);
constexpr size_t WS_KVRAW = al256(WS_Q + (size_t)RP * QW * 2);
constexpr size_t WS_CKVB = al256(WS_KVRAW + (size_t)RP * 320 * 4);
constexpr size_t WS_KROPEB = al256(WS_CKVB + (size_t)RP * 256 * 2);
constexpr size_t WS_KN   = al256(WS_KROPEB + (size_t)RP * 64 * 2);
constexpr size_t WS_VV   = al256(WS_KN + (size_t)PM * 1024 * 2);
constexpr size_t WS_QDEC = al256(WS_VV + (size_t)PM * 1024 * 2);
constexpr size_t WS_OPART = al256(WS_QDEC + (size_t)SB * 32 * 320 * 2);
constexpr size_t WS_ML   = al256(WS_OPART + (size_t)SB * 8 * 32 * 256 * 4);
constexpr size_t WS_OLAT = al256(WS_ML + (size_t)SB * 8 * 32 * 2 * 4);
constexpr size_t WS_END  = al256(WS_OLAT + (size_t)SM * 2048 * 2);

__device__ __forceinline__ unsigned cvt_pk_bf16(float lo, float hi) { unsigned r; asm volatile("v_cvt_pk_bf16_f32 %0, %1, %2" : "=v"(r) : "v"(lo), "v"(hi)); return r; }
__device__ __forceinline__ float bf_lo(unsigned w) { return __uint_as_float(w << 16); }
__device__ __forceinline__ float bf_hi(unsigned w) { return __uint_as_float(w & 0xffff0000u); }
__device__ __forceinline__ float bf2f(bf16_t b) { return __uint_as_float(((unsigned)b) << 16); }
__device__ __forceinline__ float silu(float x) { return x * __builtin_amdgcn_rcpf(1.0f + __expf(-x)); }
__device__ __forceinline__ void unpack8(const u32x4 w, float (&f)[8]) {
    f[0] = bf_lo(w.x); f[1] = bf_hi(w.x); f[2] = bf_lo(w.y); f[3] = bf_hi(w.y); f[4] = bf_lo(w.z); f[5] = bf_hi(w.z); f[6] = bf_lo(w.w); f[7] = bf_hi(w.w); }
__device__ __forceinline__ u32x4 pack8(const float (&f)[8]) { u32x4 w; w.x = cvt_pk_bf16(f[0], f[1]); w.y = cvt_pk_bf16(f[2], f[3]); w.z = cvt_pk_bf16(f[4], f[5]); w.w = cvt_pk_bf16(f[6], f[7]); return w; }
__device__ __forceinline__ float sum4(const f32x4 a) { return (a[0] + a[1]) + (a[2] + a[3]); }
__device__ __forceinline__ float rs_from16(const float* p) {
    const f32x4 a = *(const f32x4*)p, b = *(const f32x4*)(p + 4), c = *(const f32x4*)(p + 8), d = *(const f32x4*)(p + 12);
    return rsqrtf(((sum4(a) + sum4(b)) + (sum4(c) + sum4(d))) * (1.0f / 1024.0f) + EPS); }
__device__ __forceinline__ float rs_from32(const float* p) { float s = 0.f;
#pragma unroll
    for (int i = 0; i < 8; ++i) s += sum4(*(const f32x4*)(p + 4 * i));
    return rsqrtf(s * (1.0f / 1024.0f) + EPS); }
__device__ __forceinline__ float rsq_from12(const float* p) {
    const f32x4 a = *(const f32x4*)p, b = *(const f32x4*)(p + 4), c = *(const f32x4*)(p + 8);
    return rsqrtf((sum4(a) + sum4(b) + sum4(c)) * (1.0f / 384.0f) + EPS); }
__device__ __forceinline__ int crow(int r, int hi) { return (r & 3) + 8 * (r >> 2) + 4 * hi; }
static_assert(WS_VV == WS_KN + (size_t)PM * 1024 * 2, "VV must follow KN");
namespace pg8 {
constexpr int BM = 256, BK = 64, HALF = 128, HTB = HALF * BK * 2, STAGE_BYTES = 8 * HTB, NXCD = 8, WGM = 8;
__device__ __forceinline__ int lds_byte(int r, int c) { const int st = (r >> 4) * 2 + (c >> 5), rr = r & 15, cc = c & 31, ob = rr * 64 + cc * 2; return st * 1024 + (ob ^ (((ob >> 9) & 1) << 5)); }
__device__ __forceinline__ void stage_rc(int b, int& R, int& C) { const int st = b / 1024, sb = b % 1024, swz = sb ^ (((sb >> 9) & 1) << 5); R = (st >> 1) * 16 + swz / 64; C = (st & 1) * 32 + (swz % 64) / 2; }
__device__ __forceinline__ int perm32(int rho) { const int n = rho >> 4, i = rho & 15; return 8 * (i >> 2) + 4 * n + (i & 3); }

struct Unit { int pm, pn; };
struct Gemm { const bf16_t* A; const bf16_t* Bt; int lda, ldb, K, a_pn; };

struct StaticOrder {
    int nM, nN, nwg, G, c;
    __device__ void init(int nM_, int nN_, int G_, int c_) { nM = nM_; nN = nN_; nwg = nM * nN; G = G_; c = c_; }
    __device__ bool next(int i, Unit& u) const {
        const long L = (long)i * G + c; if (L >= nwg) return false;
        int wgid = (int)L; { const int q = nwg / NXCD, r = nwg % NXCD, xcd = wgid % NXCD, off = wgid / NXCD; wgid = (xcd < r ? xcd * (q + 1) : r * (q + 1) + (xcd - r) * q) + off; }
        const int nig = WGM * nN, gid = wgid / nig, fm = gid * WGM, gsz = (nM - fm) < WGM ? (nM - fm) : WGM;
        u.pm = fm + ((wgid % nig) % gsz); u.pn = (wgid % nig) / gsz; return true;
    }
};

template <class Epi>
__device__ __forceinline__ void gemm_phase(LAS uchar* lds, const Gemm g, const StaticOrder& S, const Epi& E) {
    int tid_ = threadIdx.x; asm volatile("" : "+v"(tid_));
    const int tid = tid_, wid = __builtin_amdgcn_readfirstlane(tid >> 6), lane = tid & 63, wr = wid >> 2, wc = wid & 3, fr = lane & 15, fq = lane >> 4;
    int K_ = g.K; asm volatile("" : "+s"(K_));
    const int K = K_, nt = K / BK;
    unsigned voffA[2], voffB[2];
#pragma unroll
    for (int i = 0; i < 2; ++i) { int R, C; stage_rc(tid * 16 + i * 8192, R, C); const int Rb = Epi::PERM ? ((R & ~31) + perm32(R & 31)) : R;
        voffA[i] = (unsigned)(R * g.lda + C) * 2u; voffB[i] = (unsigned)(Rb * g.ldb + C) * 2u; }
    const size_t kstep = (size_t)(BK * 2);
    const size_t hstepA = (size_t)HALF * g.lda * 2, hstepB = (size_t)HALF * g.ldb * 2;
    const size_t tstepA = 2 * hstepA, tstepB = 2 * hstepB;
    const unsigned ldsw = (unsigned)wid * 1024u;
    const int aoff = lds_byte(wr * 64 + fr, fq * 8), boff = lds_byte(wc * 32 + fr, fq * 8);
#define PG8_SA(b, h) (((b) * 2 + (h)) * HTB)
#define PG8_SB(b, h) ((4 + (b) * 2 + (h)) * HTB)
#define PG8_STAGE(bufoff, gbase, voff) do { _Pragma("unroll") for (int _i = 0; _i < 2; ++_i) \
        __builtin_amdgcn_global_load_lds((const unsigned*)((const char*)(gbase) + (voff)[_i]), (LAS unsigned*)(lds + (bufoff) + ldsw + _i * 8192), 16, 0, 0); } while (0)
#define PG8_LDA(dst, b, h) do { _Pragma("unroll") for (int m = 0; m < 4; ++m) _Pragma("unroll") for (int k = 0; k < 2; ++k) dst[m][k] = *(const LAS bf16x8*)(lds + PG8_SA(b, h) + aoff + m * 2048 + k * 1024); } while (0)
#define PG8_LDB(dst, b, h) do { _Pragma("unroll") for (int n = 0; n < 2; ++n) _Pragma("unroll") for (int k = 0; k < 2; ++k) dst[n][k] = *(const LAS bf16x8*)(lds + PG8_SB(b, h) + boff + n * 2048 + k * 1024); } while (0)
#define PG8_MMA(ai, bj, At, Bt) do { __builtin_amdgcn_s_setprio(1); _Pragma("unroll") for (int m = 0; m < 4; ++m) _Pragma("unroll") for (int n = 0; n < 2; ++n) _Pragma("unroll") for (int k = 0; k < 2; ++k) \
        acc[ai][bj][m][n] = __builtin_amdgcn_mfma_f32_16x16x32_bf16(Bt[n][k], At[m][k], acc[ai][bj][m][n], 0, 0, 0); __builtin_amdgcn_s_setprio(0); } while (0)
#define PG8_WAIT_V(n) asm volatile("s_waitcnt vmcnt(" #n ")" ::: "memory")
#define PG8_WAIT_L(n) asm volatile("s_waitcnt lgkmcnt(" #n ")" ::: "memory")
#define PG8_BAR __builtin_amdgcn_s_barrier()
#define PG8_SCHED __builtin_amdgcn_sched_barrier(0)
    Unit cur, nxt; int ui = 0;
    if (!S.next(0, cur)) return;
    f32x4 acc[2][2][4][2];
#pragma unroll
    for (int a = 0; a < 2; ++a)
#pragma unroll
        for (int b = 0; b < 2; ++b)
#pragma unroll
            for (int m = 0; m < 4; ++m)
#pragma unroll
                for (int n = 0; n < 2; ++n) acc[a][b][m][n] = (f32x4){0.f, 0.f, 0.f, 0.f};
    bf16x8 At[4][2], B0[2][2], B1[2][2];
    const char* cA = (const char*)g.A + (size_t)cur.pm * tstepA + (size_t)cur.pn * g.a_pn * 2; const char* cB = (const char*)g.Bt + (size_t)cur.pn * tstepB;
    PG8_STAGE(PG8_SB(0, 0), cB, voffB); PG8_STAGE(PG8_SA(0, 0), cA, voffA); PG8_STAGE(PG8_SB(0, 1), cB + hstepB, voffB); PG8_STAGE(PG8_SA(0, 1), cA + hstepA, voffA);
    if (wr == 1) PG8_BAR;
    PG8_WAIT_V(4); PG8_BAR;
    PG8_STAGE(PG8_SB(1, 0), cB + kstep, voffB); PG8_STAGE(PG8_SA(1, 0), cA + kstep, voffA); PG8_STAGE(PG8_SB(1, 1), cB + hstepB + kstep, voffB);
    PG8_WAIT_V(6); PG8_BAR;
    for (;;) {
        const bool has_next = S.next(ui + 1, nxt);
        const char* nA = has_next ? (const char*)g.A + (size_t)nxt.pm * tstepA + (size_t)nxt.pn * g.a_pn * 2 : cA; const char* nB = has_next ? (const char*)g.Bt + (size_t)nxt.pn * tstepB : cB;
        for (int t = 0; t < nt; t += 2) {
            const bool last = (t == nt - 2);
            const char* a1 = cA + (size_t)(t + 1) * kstep;
            const char* a2 = last ? nA : cA + (size_t)(t + 2) * kstep; const char* b2 = last ? nB : cB + (size_t)(t + 2) * kstep;
            const char* a3 = a2 + kstep; const char* b3 = b2 + kstep;
            PG8_LDB(B0, 0, 0); PG8_SCHED; PG8_LDA(At, 0, 0); PG8_STAGE(PG8_SA(1, 1), a1 + hstepA, voffA);
            PG8_WAIT_L(8); PG8_BAR; PG8_WAIT_L(0); PG8_MMA(0, 0, At, B0); PG8_BAR; PG8_SCHED;
            PG8_LDB(B1, 0, 1); PG8_STAGE(PG8_SB(0, 0), b2, voffB);
            PG8_BAR; PG8_WAIT_L(0); PG8_MMA(0, 1, At, B1); PG8_BAR;
            PG8_LDA(At, 0, 1); PG8_STAGE(PG8_SA(0, 0), a2, voffA);
            PG8_BAR; PG8_WAIT_L(0); PG8_MMA(1, 0, At, B0); PG8_BAR; PG8_SCHED;
            PG8_STAGE(PG8_SB(0, 1), b2 + hstepB, voffB);
            PG8_WAIT_V(6); PG8_BAR; PG8_MMA(1, 1, At, B1); PG8_BAR;
            PG8_LDB(B0, 1, 0); PG8_SCHED; PG8_LDA(At, 1, 0); PG8_STAGE(PG8_SA(0, 1), a2 + hstepA, voffA);
            PG8_WAIT_L(8); PG8_BAR; PG8_WAIT_L(0); PG8_MMA(0, 0, At, B0); PG8_BAR; PG8_SCHED;
            PG8_LDB(B1, 1, 1); PG8_STAGE(PG8_SB(1, 0), b3, voffB);
            PG8_BAR; PG8_WAIT_L(0); PG8_MMA(0, 1, At, B1); PG8_BAR;
            PG8_LDA(At, 1, 1); PG8_STAGE(PG8_SA(1, 0), a3, voffA);
            PG8_BAR; PG8_WAIT_L(0); PG8_MMA(1, 0, At, B0); PG8_BAR; PG8_SCHED;
            PG8_STAGE(PG8_SB(1, 1), b3 + hstepB, voffB);
            PG8_WAIT_V(6); PG8_BAR; PG8_MMA(1, 1, At, B1); PG8_BAR;
        }
        E(acc, cur, wr, wc, fr, fq);
        if (!has_next) break;
#pragma unroll
        for (int a = 0; a < 2; ++a)
#pragma unroll
            for (int b = 0; b < 2; ++b)
#pragma unroll
                for (int m = 0; m < 4; ++m)
#pragma unroll
                    for (int n = 0; n < 2; ++n) acc[a][b][m][n] = (f32x4){0.f, 0.f, 0.f, 0.f};
        cur = nxt; cA = nA; cB = nB; ++ui;
    }
    PG8_WAIT_V(0);
    if (wr == 0) PG8_BAR;
    PG8_BAR;
#undef PG8_SA
#undef PG8_SB
#undef PG8_STAGE
#undef PG8_LDA
#undef PG8_LDB
#undef PG8_MMA
#undef PG8_WAIT_V
#undef PG8_WAIT_L
#undef PG8_BAR
#undef PG8_SCHED
}

typedef f32x4 Acc[2][2][4][2];
struct EpiZ { static constexpr bool PERM = true;
    bf16_t* Z; const float* ssp; float* ssq; float* kvraw;
    __device__ __forceinline__ void operator()(const Acc& acc, const Unit& u, int wr, int wc, int fr, int fq) const {
        const int rbase = u.pm * BM + wr * 64 + fr, col0 = u.pn * BM + wc * 32 + 8 * fq;
        const bool kvt = (kvraw != nullptr) && u.pn == 10, wantq = (ssq != nullptr) && u.pn <= 1;
#pragma unroll
        for (int ai = 0; ai < 2; ++ai)
#pragma unroll
            for (int m = 0; m < 4; ++m) { const int row = rbase + ai * HALF + m * 16; const float rs = rs_from16(ssp + (size_t)row * 16);
#pragma unroll
                for (int bj = 0; bj < 2; ++bj) { const f32x4 v0 = acc[ai][bj][m][0] * rs, v1 = acc[ai][bj][m][1] * rs; const int c = col0 + bj * HALF;
                    if (!kvt) { u32x4 w; w.x = cvt_pk_bf16(v0[0], v0[1]); w.y = cvt_pk_bf16(v0[2], v0[3]); w.z = cvt_pk_bf16(v1[0], v1[1]); w.w = cvt_pk_bf16(v1[2], v1[3]);
                        *(u32x4*)(Z + (size_t)row * LDZ + c) = w; }
                    else { float* p = kvraw + (size_t)row * 320 + (c - ZB_KV); *(f32x4*)p = v0; *(f32x4*)(p + 4) = v1; }
                    if (kvraw != nullptr && u.pn == 1 && bj == 1 && wc < 2) { float* p = kvraw + (size_t)row * 320 + 256 + (c - ZB_KR); *(f32x4*)p = v0; *(f32x4*)(p + 4) = v1; }
                    if (wantq && (u.pn == 0 || bj == 0)) { float s = sum4(v0 * v0) + sum4(v1 * v1); s += __shfl_xor(s, 16); s += __shfl_xor(s, 32);
                        if (fq == 0) ssq[(size_t)row * 12 + (u.pn == 0 ? bj * 4 + wc : 8 + wc)] = s; } } }
    }
};
struct EpiGrp { static constexpr bool PERM = true;
    const bf16_t* Z; bf16_t* MX;
    __device__ __forceinline__ void operator()(const Acc& acc, const Unit& u, int wr, int wc, int fr, int fq) const {
        const int rbase = u.pm * BM + wr * 64 + fr, col0 = u.pn * BM + wc * 32 + 8 * fq;
#pragma unroll
        for (int ai = 0; ai < 2; ++ai)
#pragma unroll
            for (int m = 0; m < 4; ++m) { const int row = rbase + ai * HALF + m * 16;
                const u32x4 g0 = *(const u32x4*)(Z + (size_t)row * LDZ + ZA_GT + col0), g1 = *(const u32x4*)(Z + (size_t)row * LDZ + ZA_GT + col0 + HALF);
#pragma unroll
                for (int bj = 0; bj < 2; ++bj) { const int c = col0 + bj * HALF; float gt[8]; unpack8(bj ? g1 : g0, gt);
                    const f32x4 v0 = acc[ai][bj][m][0], v1 = acc[ai][bj][m][1]; float o[8];
#pragma unroll
                    for (int j = 0; j < 4; ++j) { o[j] = v0[j] * silu(gt[j]); o[4 + j] = v1[j] * silu(gt[4 + j]); }
                    *(u32x4*)(MX + (size_t)row * OUTW + c) = pack8(o); }
                asm volatile("" ::: "memory"); }
    }
};
struct EpiQ { static constexpr bool PERM = true;
    bf16_t* Q; const float* ssq;
    __device__ __forceinline__ void operator()(const Acc& acc, const Unit& u, int wr, int wc, int fr, int fq) const {
        const int rbase = u.pm * BM + wr * 64 + fr, col0 = u.pn * BM + wc * 32 + 8 * fq;
#pragma unroll
        for (int ai = 0; ai < 2; ++ai)
#pragma unroll
            for (int m = 0; m < 4; ++m) { const int row = rbase + ai * HALF + m * 16; const float rs = rsq_from12(ssq + (size_t)row * 12);
#pragma unroll
                for (int bj = 0; bj < 2; ++bj) { const f32x4 v0 = acc[ai][bj][m][0] * rs, v1 = acc[ai][bj][m][1] * rs;
                    u32x4 w; w.x = cvt_pk_bf16(v0[0], v0[1]); w.y = cvt_pk_bf16(v0[2], v0[3]); w.z = cvt_pk_bf16(v1[0], v1[1]); w.w = cvt_pk_bf16(v1[2], v1[3]);
                    *(u32x4*)(Q + (size_t)row * QW + col0 + bj * HALF) = w; } }
    }
};
struct EpiKV { static constexpr bool PERM = true;
    bf16_t* KN;
    __device__ __forceinline__ void operator()(const Acc& acc, const Unit& u, int wr, int wc, int fr, int fq) const {
        const int rbase = u.pm * BM + wr * 64 + fr, col0 = (u.pn & 3) * BM + wc * 32 + 8 * fq; bf16_t* O = KN + (size_t)(u.pn >> 2) * ((size_t)PM * 1024);
#pragma unroll
        for (int ai = 0; ai < 2; ++ai)
#pragma unroll
            for (int m = 0; m < 4; ++m) { const int row = rbase + ai * HALF + m * 16;
#pragma unroll
                for (int bj = 0; bj < 2; ++bj) { const f32x4 v0 = acc[ai][bj][m][0], v1 = acc[ai][bj][m][1];
                    u32x4 w; w.x = cvt_pk_bf16(v0[0], v0[1]); w.y = cvt_pk_bf16(v0[2], v0[3]); w.z = cvt_pk_bf16(v1[0], v1[1]); w.w = cvt_pk_bf16(v1[2], v1[3]);
                    *(u32x4*)(O + (size_t)row * 1024 + col0 + bj * HALF) = w; } }
    }
};
struct EpiMem { static constexpr bool PERM = false;
    float* OK; bf16_t* MB;
    __device__ __forceinline__ void operator()(const Acc& acc, const Unit& u, int wr, int wc, int fr, int fq) const {
        const int rbase = u.pm * BM + wr * 64 + fr, col0 = u.pn * BM + wc * 32 + 4 * fq;
#pragma unroll
        for (int ai = 0; ai < 2; ++ai)
#pragma unroll
            for (int m = 0; m < 4; ++m) { const int row = rbase + ai * HALF + m * 16;
#pragma unroll
                for (int bj = 0; bj < 2; ++bj)
#pragma unroll
                    for (int n = 0; n < 2; ++n) { const int c = col0 + bj * HALF + n * 16; const int l = c >> 10, kv = (c >> 9) & 1, cc = c & 511; const f32x4 v = acc[ai][bj][m][n];
                        *(f32x4*)(OK + (size_t)kv * (O_MEMV - O_MEMK) + ((size_t)l * 2048 + row) * 512 + cc) = v;
                        u32x2 w; w.x = cvt_pk_bf16(v[0], v[1]); w.y = cvt_pk_bf16(v[2], v[3]); *(u32x2*)(MB + (size_t)row * 4096 + c) = w; } }
    }
};
struct EpiOut { static constexpr bool PERM = false;
    const float* base; float* XR; bf16_t* XB; float* ssp;
    __device__ __forceinline__ void operator()(const Acc& acc, const Unit& u, int wr, int wc, int fr, int fq) const {
        const int rbase = u.pm * BM + wr * 64 + fr, col0 = u.pn * BM + wc * 32 + 4 * fq;
#pragma unroll
        for (int ai = 0; ai < 2; ++ai)
#pragma unroll
            for (int m = 0; m < 4; ++m) { const int row = rbase + ai * HALF + m * 16; float s = 0.f;
#pragma unroll
                for (int bj = 0; bj < 2; ++bj)
#pragma unroll
                    for (int n = 0; n < 2; ++n) { const size_t o = (size_t)row * DM + col0 + bj * HALF + n * 16; const f32x4 v = *(const f32x4*)(base + o) + acc[ai][bj][m][n];
                        *(f32x4*)(XR + o) = v; u32x2 w; w.x = cvt_pk_bf16(v[0], v[1]); w.y = cvt_pk_bf16(v[2], v[3]); *(u32x2*)(XB + o) = w; s += sum4(v * v); }
                s += __shfl_xor(s, 16); s += __shfl_xor(s, 32);
                if (fq == 0) ssp[(size_t)row * 16 + u.pn * 4 + wc] = s; }
    }
};
}
namespace sg {
constexpr int BUF = 24576, LDS_BYTES = 2 * BUF;
template <class Epi>
__device__ __forceinline__ void sgemm_unit(LAS uchar* lds, const bf16_t* A, int lda, const bf16_t* Bt, int ldb, int K, int n0, const Epi& E) {
    int tid_ = threadIdx.x; asm volatile("" : "+v"(tid_));
    const int tid = tid_, wid = tid >> 6, lane = tid & 63, r32 = lane & 31, hi = lane >> 5, rb = wid & 3, cb = wid >> 2;
    const int srow = tid >> 3, sch = tid & 7;
    const bf16_t* ap0 = A + (size_t)srow * lda + sch * 8; const bf16_t* ap1 = ap0 + (size_t)64 * lda; const bf16_t* bp = Bt + (size_t)(n0 + srow) * ldb + sch * 8;
    const int aw0 = srow * 128 + ((sch ^ (srow & 7)) << 4), aw1 = aw0 + 64 * 128, bw = 16384 + aw0;
    const int arow = rb * 32 + r32, brow = cb * 32 + r32;
    const int ard = arow * 128, brd = 16384 + brow * 128, asw = arow & 7, bsw = brow & 7;
    u32x4 ra0[2], ra1[2], rbv[2];
    f32x16 acc = {};
    const int nk = K / 64;
#define SG_LOAD(s, kt) do { ra0[s] = *(const u32x4*)(ap0 + (size_t)(kt) * 64); ra1[s] = *(const u32x4*)(ap1 + (size_t)(kt) * 64); rbv[s] = *(const u32x4*)(bp + (size_t)(kt) * 64); } while (0)
#define SG_WRITE(s, b) do { *(LAS u32x4*)(lds + (b) * BUF + aw0) = ra0[s]; *(LAS u32x4*)(lds + (b) * BUF + aw1) = ra1[s]; *(LAS u32x4*)(lds + (b) * BUF + bw) = rbv[s]; } while (0)
#define SG_COMPUTE(b) do { _Pragma("unroll") for (int kk = 0; kk < 4; ++kk) { \
        const bf16x8 af = *(const LAS bf16x8*)(lds + (b) * BUF + ard + (((2 * kk + hi) ^ asw) << 4)); \
        const bf16x8 bf = *(const LAS bf16x8*)(lds + (b) * BUF + brd + (((2 * kk + hi) ^ bsw) << 4)); \
        acc = __builtin_amdgcn_mfma_f32_32x32x16_bf16(bf, af, acc, 0, 0, 0); } } while (0)
    SG_LOAD(0, 0); SG_LOAD(1, 1);
    for (int kt = 0; kt < nk; kt += 2) {
        SG_WRITE(0, 0); __syncthreads(); if (kt + 2 < nk) SG_LOAD(0, kt + 2);
        SG_COMPUTE(0);
        SG_WRITE(1, 1); __syncthreads(); if (kt + 3 < nk) SG_LOAD(1, kt + 3);
        SG_COMPUTE(1);
    }
#undef SG_LOAD
#undef SG_WRITE
#undef SG_COMPUTE
    E(acc, rb * 32 + r32, n0 + cb * 32, hi);
}

struct EpiZ { bf16_t* Z; const float* ssps; float* ssq; float* kvraw;
    __device__ __forceinline__ void operator()(const f32x16& acc, int row, int cbase, int hi) const {
        const float rs = rs_from32(ssps + row * 32); const size_t grow = (size_t)PM + row; float s = 0.f;
#pragma unroll
        for (int g = 0; g < 4; ++g) { const f32x4 v = (f32x4){acc[4 * g], acc[4 * g + 1], acc[4 * g + 2], acc[4 * g + 3]} * rs; const int c = cbase + 8 * g + 4 * hi;
            if (kvraw != nullptr && cbase >= ZB_KV) *(f32x4*)(kvraw + grow * 320 + (c - ZB_KV)) = v;
            else { u32x2 w; w.x = cvt_pk_bf16(v[0], v[1]); w.y = cvt_pk_bf16(v[2], v[3]); *(u32x2*)(Z + grow * LDZ + c) = w; }
            if (kvraw != nullptr && cbase >= ZB_KR && cbase < ZB_KR + 64) *(f32x4*)(kvraw + grow * 320 + 256 + (c - ZB_KR)) = v;
            s += sum4(v * v); }
        if (ssq != nullptr && cbase < QRANK) { s += __shfl_xor(s, 32); if (hi == 0) ssq[grow * 12 + (cbase >> 5)] = s; }
    }
};
struct EpiGrp { const bf16_t* Z; bf16_t* MX; int cofs;
    __device__ __forceinline__ void operator()(const f32x16& acc, int row, int cbase, int hi) const {
        const size_t grow = (size_t)PM + row;
#pragma unroll
        for (int g = 0; g < 4; ++g) { const int c = cofs + cbase + 8 * g + 4 * hi; const u32x2 gw = *(const u32x2*)(Z + grow * LDZ + ZA_GT + c);
            const float o0 = acc[4 * g] * silu(bf_lo(gw.x)), o1 = acc[4 * g + 1] * silu(bf_hi(gw.x)), o2 = acc[4 * g + 2] * silu(bf_lo(gw.y)), o3 = acc[4 * g + 3] * silu(bf_hi(gw.y));
            u32x2 w; w.x = cvt_pk_bf16(o0, o1); w.y = cvt_pk_bf16(o2, o3); *(u32x2*)(MX + grow * OUTW + c) = w; }
    }
};
struct EpiOut { const float* base; float* XR; bf16_t* XB; float* ssps;
    __device__ __forceinline__ void operator()(const f32x16& acc, int row, int cbase, int hi) const {
        const size_t grow = (size_t)PM + row; float s = 0.f;
#pragma unroll
        for (int g = 0; g < 4; ++g) { const int c = cbase + 8 * g + 4 * hi; const f32x4 v = *(const f32x4*)(base + (size_t)row * DM + c) + (f32x4){acc[4 * g], acc[4 * g + 1], acc[4 * g + 2], acc[4 * g + 3]};
            *(f32x4*)(XR + grow * DM + c) = v; u32x2 w; w.x = cvt_pk_bf16(v[0], v[1]); w.y = cvt_pk_bf16(v[2], v[3]); *(u32x2*)(XB + grow * DM + c) = w; s += sum4(v * v); }
        s += __shfl_xor(s, 32); if (hi == 0) ssps[row * 32 + (cbase >> 5)] = s;
    }
};
struct EpiQ { bf16_t* Q; const float* ssq;
    __device__ __forceinline__ void operator()(const f32x16& acc, int row, int cbase, int hi) const {
        const size_t grow = (size_t)PM + row; const float rs = rsq_from12(ssq + grow * 12);
#pragma unroll
        for (int g = 0; g < 4; ++g) { const int c = cbase + 8 * g + 4 * hi; u32x2 w; w.x = cvt_pk_bf16(acc[4 * g] * rs, acc[4 * g + 1] * rs); w.y = cvt_pk_bf16(acc[4 * g + 2] * rs, acc[4 * g + 3] * rs);
            *(u32x2*)(Q + grow * QW + c) = w; }
    }
};
struct EpiAbsorb { bf16_t* QD; int h;
    __device__ __forceinline__ void operator()(const f32x16& acc, int row, int cbase, int hi) const {
        const int b = row >> 2, t = row & 3; bf16_t* o = QD + ((size_t)b * 32 + t * 8 + h) * 320;
#pragma unroll
        for (int g = 0; g < 4; ++g) { const int c = cbase + 8 * g + 4 * hi; u32x2 w; w.x = cvt_pk_bf16(acc[4 * g], acc[4 * g + 1]); w.y = cvt_pk_bf16(acc[4 * g + 2], acc[4 * g + 3]); *(u32x2*)(o + c) = w; }
    }
};
struct EpiVup { const bf16_t* Z; bf16_t* MX; int h;
    __device__ __forceinline__ void operator()(const f32x16& acc, int row, int cbase, int hi) const {
        const size_t grow = (size_t)PM + row;
#pragma unroll
        for (int g = 0; g < 4; ++g) { const int c = h * 128 + cbase + 8 * g + 4 * hi; const u32x2 gw = *(const u32x2*)(Z + grow * LDZ + ZB_GT + c);
            const float o0 = acc[4 * g] * silu(bf_lo(gw.x)), o1 = acc[4 * g + 1] * silu(bf_hi(gw.x)), o2 = acc[4 * g + 2] * silu(bf_lo(gw.y)), o3 = acc[4 * g + 3] * silu(bf_hi(gw.y));
            u32x2 w; w.x = cvt_pk_bf16(o0, o1); w.y = cvt_pk_bf16(o2, o3); *(u32x2*)(MX + grow * OUTW + c) = w; }
    }
};
}
namespace att {
constexpr int NW = 8, QBLK = 32, KVBLK = 64;
constexpr int SHM_V = KVBLK * 128 * 2, SHM_K = KVBLK * 128 * 2, SHM_KR = KVBLK * 64 * 2;
constexpr int OFF_V = 0, OFF_K = 2 * SHM_V, OFF_KR = OFF_K + 2 * SHM_K, OFF_WS = OFF_KR + 2 * SHM_KR, OFF_QR = OFF_WS + NW * 64 * 4, LDS_BYTES = OFF_QR + NW * 4096;
constexpr float THR = 8.f;
#define KSWZ(row, colB) ((row) * 256 + ((colB) ^ (((row) & 7) << 4)))
#define KRSWZ(row, colB) ((row) * 128 + ((colB) ^ (((row) & 7) << 4)))
#define SBAR() __builtin_amdgcn_sched_barrier(0)
template <int DQK> struct Cst { static constexpr float SCALE = (DQK == 128) ? 0.08838834764831845f : 0.07216878364870322f; };

template <int DQK>
__device__ __forceinline__ void partialSM(f32x16& p0, f32x16& p1, float& m_reg, float& mn, float& alpha) {
    constexpr float SCALE = Cst<DQK>::SCALE, C = SCALE * 1.4426950408889634f;
    float pmax = p0[0];
#pragma unroll
    for (int r = 1; r < 16; ++r) pmax = fmaxf(pmax, p0[r]);
#pragma unroll
    for (int r = 0; r < 16; ++r) pmax = fmaxf(pmax, p1[r]);
    { auto rr = __builtin_amdgcn_permlane32_swap(__float_as_uint(pmax), __float_as_uint(pmax), false, false);
      pmax = fmaxf(__uint_as_float(rr[0]), __uint_as_float(rr[1])); }
    if (__builtin_expect(__all(pmax - m_reg <= THR / SCALE), 1)) { mn = m_reg; alpha = 1.f; }
    else { mn = fmaxf(m_reg, pmax); alpha = __builtin_amdgcn_exp2f((m_reg - mn) * C); m_reg = mn; }
    const float mnC = -mn * C;
#pragma unroll
    for (int r = 0; r < 16; ++r) p0[r] = fmaf(p0[r], C, mnC);
#pragma unroll
    for (int r = 0; r < 16; ++r) p1[r] = fmaf(p1[r], C, mnC);
#pragma unroll
    for (int r = 0; r < 16; ++r) p0[r] = __builtin_amdgcn_exp2f(p0[r]);
}
__device__ __forceinline__ void finishSM(f32x16& p0, f32x16& p1, float alpha, float& l_reg, bf16x8& pa0, bf16x8& pa1, bf16x8& pa2, bf16x8& pa3) {
#pragma unroll
    for (int r = 0; r < 16; ++r) p1[r] = __builtin_amdgcn_exp2f(p1[r]);
    float ps = 0;
#pragma unroll
    for (int r = 0; r < 16; ++r) ps += p0[r];
#pragma unroll
    for (int r = 0; r < 16; ++r) ps += p1[r];
    { auto rr = __builtin_amdgcn_permlane32_swap(__float_as_uint(ps), __float_as_uint(ps), false, false);
      ps = __uint_as_float(rr[0]) + __uint_as_float(rr[1]); }
    l_reg = l_reg * alpha + ps;
#define PK4(P, BASE, OUT) do { unsigned a0 = cvt_pk_bf16(P[BASE + 0], P[BASE + 1]), a1 = cvt_pk_bf16(P[BASE + 2], P[BASE + 3]);   \
    unsigned b0 = cvt_pk_bf16(P[BASE + 4], P[BASE + 5]), b1 = cvt_pk_bf16(P[BASE + 6], P[BASE + 7]);                              \
    auto r0 = __builtin_amdgcn_permlane32_swap(a0, b0, false, false); auto r1 = __builtin_amdgcn_permlane32_swap(a1, b1, false, false); \
    u32x4 w = {r0[0], r1[0], r0[1], r1[1]}; OUT = *reinterpret_cast<bf16x8*>(&w); } while (0)
    PK4(p0, 0, pa0); PK4(p0, 8, pa1); PK4(p1, 0, pa2); PK4(p1, 8, pa3);
#undef PK4
}
template <int DQK>
__device__ __forceinline__ void qkt(f32x16& p0, f32x16& p1, const LAS uchar* Ks, const LAS uchar* Krs, const bf16x8* qr, const LAS uchar* qrl  , int r32, int hi) {
    p0 = f32x16{}; p1 = f32x16{};
#pragma unroll
    for (int d0 = 0; d0 < 8; ++d0) { const int cb = (d0 * 16 + hi * 8) * 2;
        const bf16x8 b0 = *(const LAS bf16x8*)(Ks + KSWZ(r32, cb));
        const bf16x8 b1 = *(const LAS bf16x8*)(Ks + KSWZ(32 + r32, cb));
        p0 = __builtin_amdgcn_mfma_f32_32x32x16_bf16(b0, qr[d0], p0, 0, 0, 0);
        p1 = __builtin_amdgcn_mfma_f32_32x32x16_bf16(b1, qr[d0], p1, 0, 0, 0); }
    if constexpr (DQK == 192) {
#pragma unroll
        for (int d0 = 0; d0 < 4; ++d0) { const int cb = (d0 * 16 + hi * 8) * 2;
            const bf16x8 b0 = *(const LAS bf16x8*)(Krs + KRSWZ(r32, cb));
            const bf16x8 b1 = *(const LAS bf16x8*)(Krs + KRSWZ(32 + r32, cb));
            const bf16x8 qf = *(const LAS bf16x8*)(qrl + d0 * 1024);
            p0 = __builtin_amdgcn_mfma_f32_32x32x16_bf16(b0, qf, p0, 0, 0, 0);
            p1 = __builtin_amdgcn_mfma_f32_32x32x16_bf16(b1, qf, p1, 0, 0, 0); }
    }
}
__device__ __forceinline__ int v_st(int k, int c) { const int kk = (k & ~0xC) | ((k & 4) << 1) | ((k & 8) >> 1); return ((kk >> 3) * 4 + (c >> 5)) * 512 + ((kk & 7) * 32 + (c & 31)) * 2; }
__device__ __forceinline__ int v_rd_base(int lane) { return ((lane & 3) << 3) | (((lane >> 2) & 3) << 6) | (((lane >> 4) & 1) << 5) | (((lane >> 5) & 1) << 8); }
constexpr int v_rd_off(int d0, int ks, int half) { return d0 * 512 + ks * 4096 + half * 2048; }
template <int OFF> __device__ __forceinline__ s16x4 tr_read(int vb) {
    s16x4 r; asm volatile("ds_read_b64_tr_b16 %0, %1 offset:%2" : "=&v"(r) : "v"(vb), "i"(OFF) : "memory"); return r;
}
template <int D0> __device__ __forceinline__ void pv_one(f32x16& od, int vb, bf16x8 pa0, bf16x8 pa1, bf16x8 pa2, bf16x8 pa3) {
    const s16x4 l0 = tr_read<v_rd_off(D0, 0, 0)>(vb), h0 = tr_read<v_rd_off(D0, 0, 1)>(vb), l1 = tr_read<v_rd_off(D0, 1, 0)>(vb), h1 = tr_read<v_rd_off(D0, 1, 1)>(vb);
    const s16x4 l2 = tr_read<v_rd_off(D0, 2, 0)>(vb), h2 = tr_read<v_rd_off(D0, 2, 1)>(vb), l3 = tr_read<v_rd_off(D0, 3, 0)>(vb), h3 = tr_read<v_rd_off(D0, 3, 1)>(vb);
    asm volatile("s_waitcnt lgkmcnt(0)" ::: "memory"); SBAR();
#define PK(L, H) (bf16x8){L[0], L[1], L[2], L[3], H[0], H[1], H[2], H[3]}
    od = __builtin_amdgcn_mfma_f32_32x32x16_bf16(pa0, PK(l0, h0), od, 0, 0, 0);
    od = __builtin_amdgcn_mfma_f32_32x32x16_bf16(pa1, PK(l1, h1), od, 0, 0, 0);
    od = __builtin_amdgcn_mfma_f32_32x32x16_bf16(pa2, PK(l2, h2), od, 0, 0, 0);
    od = __builtin_amdgcn_mfma_f32_32x32x16_bf16(pa3, PK(l3, h3), od, 0, 0, 0);
#undef PK
}
__device__ __forceinline__ void pv_d0(f32x16* o, int vb, bf16x8 pa0, bf16x8 pa1, bf16x8 pa2, bf16x8 pa3) {
    pv_one<0>(o[0], vb, pa0, pa1, pa2, pa3); pv_one<1>(o[1], vb, pa0, pa1, pa2, pa3); pv_one<2>(o[2], vb, pa0, pa1, pa2, pa3); pv_one<3>(o[3], vb, pa0, pa1, pa2, pa3);
}
__device__ __forceinline__ void causal_mask(f32x16& p0, f32x16& p1, int jj, int rowrel, int hi) {
#pragma unroll
    for (int r = 0; r < 16; ++r) { const int k0 = 64 * jj + crow(r, hi); if (k0 > rowrel) p0[r] = -1e30f; if (k0 + 32 > rowrel) p1[r] = -1e30f; }
}

template <int DQK, bool CAUSAL, int SD, int LDQ, int LDK>
__device__ __forceinline__ void attn_body(const bf16_t* __restrict__ Qb, const bf16_t* __restrict__ Kh, const bf16_t* __restrict__ Vh, const bf16_t* __restrict__ Krp,
                                          const f32x2* __restrict__ ropeq, const bf16_t* __restrict__ gate, bf16_t* __restrict__ outp, int NT, int diag0, LAS uchar* lds) {
    constexpr int NQ = 8;
    int tid_ = threadIdx.x; asm volatile("" : "+v"(tid_));
    const int tid = tid_, wid = tid >> 6, lane = tid & 63, r32 = lane & 31, hi = lane >> 5;
    LAS uchar* V_lds = lds + OFF_V; LAS uchar* K_lds = lds + OFF_K; LAS uchar* Kr_lds = lds + OFF_KR;
    LAS float* ws = (LAS float*)(lds + OFF_WS) + wid * 64; LAS float* li_l = ws; LAS float* al_l = ws + 32; LAS uchar* qrl = lds + OFF_QR + wid * 4096 + lane * 16;
    float m_reg = -1e30f, l_reg = 0; f32x16 o[4] = {}; bf16x8 qr[NQ];
    const bf16_t* Qw = Qb + (size_t)(wid * QBLK + r32) * LDQ + hi * 8;
#pragma unroll
    for (int d0 = 0; d0 < 8; ++d0) qr[d0] = *(const bf16x8*)(Qw + d0 * 16);
    if constexpr (DQK == 192) {
#pragma unroll
        for (int a = 0; a < 2; ++a) {
            const u32x4 w1 = *(const u32x4*)(Qw + 128 + 16 * a), w2 = *(const u32x4*)(Qw + 160 + 16 * a); float x1[8], x2[8], o1[8], o2[8]; unpack8(w1, x1); unpack8(w2, x2);
            const f32x2* tb = ropeq + (size_t)(wid * QBLK + r32) * 32 + 16 * a + 8 * hi;
#pragma unroll
            for (int j = 0; j < 8; ++j) { const f32x2 cs = tb[j]; o1[j] = x1[j] * cs.x - x2[j] * cs.y; o2[j] = x1[j] * cs.y + x2[j] * cs.x; }
            *(LAS u32x4*)(qrl + a * 1024) = pack8(o1); *(LAS u32x4*)(qrl + (2 + a) * 1024) = pack8(o2);
        }
    }
    const int sr = tid >> 4, sc = (tid & 15) * 8, vst0 = v_st(sr, sc), vst1 = v_st(32 + sr, sc);
    const int krow = tid >> 3, kcc = (tid & 7) * 8;
    const int vb0 = (int)(unsigned)(uintptr_t)V_lds + v_rd_base(lane);
    struct { bf16x8 vs0, vs1, ks0, ks1, kr; } sr_[SD];
#define SLOAD(i, k0) do { sr_[i].vs0 = *(const bf16x8*)(Vh + (size_t)((k0) + sr) * LDK + sc); sr_[i].vs1 = *(const bf16x8*)(Vh + (size_t)((k0) + 32 + sr) * LDK + sc); \
    sr_[i].ks0 = *(const bf16x8*)(Kh + (size_t)((k0) + sr) * LDK + sc); sr_[i].ks1 = *(const bf16x8*)(Kh + (size_t)((k0) + 32 + sr) * LDK + sc); \
    if constexpr (DQK == 192) sr_[i].kr = *(const bf16x8*)(Krp + (size_t)((k0) + krow) * 64 + kcc); } while (0)
#define SWRITE(b, i) do { *(LAS bf16x8*)(V_lds + (b) * SHM_V + vst0) = sr_[i].vs0; *(LAS bf16x8*)(V_lds + (b) * SHM_V + vst1) = sr_[i].vs1; const int kc = sc * 2; \
    *(LAS bf16x8*)(K_lds + (b) * SHM_K + KSWZ(sr, kc)) = sr_[i].ks0; *(LAS bf16x8*)(K_lds + (b) * SHM_K + KSWZ(32 + sr, kc)) = sr_[i].ks1; \
    if constexpr (DQK == 192) *(LAS bf16x8*)(Kr_lds + (b) * SHM_KR + KRSWZ(krow, kcc * 2)) = sr_[i].kr; } while (0)
#define SWAIT() do { if constexpr (SD == 2) { if constexpr (DQK == 192) asm volatile("s_waitcnt vmcnt(5)" ::: "memory"); else asm volatile("s_waitcnt vmcnt(4)" ::: "memory"); } \
    else asm volatile("s_waitcnt vmcnt(0)" ::: "memory"); } while (0)
#define RESC(a) do { if (__any((a) < 1.f)) { if (hi == 0) al_l[r32] = (a); asm volatile("s_waitcnt lgkmcnt(0)" ::: "memory"); \
    _Pragma("unroll") for (int d = 0; d < 4; ++d) _Pragma("unroll") for (int r = 0; r < 16; ++r) o[d][r] *= al_l[crow(r, hi)]; } } while (0)
#define MASK(P0, P1, tile) do { if constexpr (CAUSAL) { if ((tile) >= diag0) causal_mask(P0, P1, (tile) - diag0, wid * QBLK + r32, hi); } } while (0)
    f32x16 pA0, pA1, pB0, pB1; float mnA, mnB, alA, alB; bf16x8 pa0, pa1, pa2, pa3;
    constexpr int SE = 0, SO = SD - 1;
    SLOAD(SE, 0); asm volatile("s_waitcnt vmcnt(0)" ::: "memory"); SWRITE(0, SE); __syncthreads();
    qkt<DQK>(pA0, pA1, K_lds, Kr_lds, qr, qrl, r32, hi); MASK(pA0, pA1, 0); partialSM<DQK>(pA0, pA1, m_reg, mnA, alA);
    SLOAD(SO, KVBLK); if constexpr (SD == 2) { if (2 < NT) SLOAD(SE, 2 * KVBLK); }
    SWAIT(); SWRITE(1, SO); __syncthreads();
    for (int j = 1; j + 1 < NT; j += 2) {
        SBAR(); qkt<DQK>(pB0, pB1, K_lds + SHM_K, Kr_lds + SHM_KR, qr, qrl, r32, hi); MASK(pB0, pB1, j);
        finishSM(pA0, pA1, alA, l_reg, pa0, pa1, pa2, pa3); SBAR();
        SLOAD(SO, (j + SD) * KVBLK); SBAR();
        pv_d0(o, vb0, pa0, pa1, pa2, pa3); partialSM<DQK>(pB0, pB1, m_reg, mnB, alB);
        __syncthreads(); SWAIT(); SWRITE(0, SE);
        RESC(alB); __syncthreads();
        SBAR(); qkt<DQK>(pA0, pA1, K_lds, Kr_lds, qr, qrl, r32, hi); MASK(pA0, pA1, j + 1);
        finishSM(pB0, pB1, alB, l_reg, pa0, pa1, pa2, pa3); SBAR();
        if (SD == 1 || j + 3 < NT) SLOAD(SE, (j + 1 + SD) * KVBLK); SBAR();
        pv_d0(o, vb0 + SHM_V, pa0, pa1, pa2, pa3); partialSM<DQK>(pA0, pA1, m_reg, mnA, alA);
        __syncthreads(); SWAIT(); SWRITE(1, SO);
        RESC(alA); __syncthreads();
    }
    SBAR(); qkt<DQK>(pB0, pB1, K_lds + SHM_K, Kr_lds + SHM_KR, qr, qrl, r32, hi); MASK(pB0, pB1, NT - 1);
    finishSM(pA0, pA1, alA, l_reg, pa0, pa1, pa2, pa3); SBAR();
    pv_d0(o, vb0, pa0, pa1, pa2, pa3); partialSM<DQK>(pB0, pB1, m_reg, mnB, alB);
    __syncthreads(); RESC(alB);
    finishSM(pB0, pB1, alB, l_reg, pa0, pa1, pa2, pa3); SBAR();
    pv_d0(o, vb0 + SHM_V, pa0, pa1, pa2, pa3);
    if (hi == 0) li_l[r32] = l_reg; asm volatile("s_waitcnt lgkmcnt(0)" ::: "memory");
    float rli[16];
#pragma unroll
    for (int r = 0; r < 16; ++r) rli[r] = __builtin_amdgcn_rcpf(li_l[crow(r, hi)]);
#pragma unroll
    for (int r = 0; r < 16; ++r) { const size_t orow = (size_t)(wid * QBLK + crow(r, hi));
#pragma unroll
        for (int d0 = 0; d0 < 4; ++d0) { const int col = d0 * 32 + r32; const float g = bf2f(gate[orow * LDZ + col]);
            outp[orow * OUTW + col] = (bf16_t)(cvt_pk_bf16(o[d0][r] * rli[r] * silu(g), 0.f) & 0xffffu); } }
#undef SLOAD
#undef SWRITE
#undef SWAIT
#undef RESC
#undef MASK
}
}
namespace dec {
constexpr int BUFB = 40960, OFF_KR = 32768, OFF_WS = 2 * BUFB, LDS_BYTES = OFF_WS + 8 * 64 * 4;
__device__ __forceinline__ unsigned off_b(unsigned row, unsigned ch) { return 256u * row + 16u * (ch ^ (((row & 3) << 2) | ((row >> 2) & 3))); }
__device__ __forceinline__ unsigned row_read_addr(unsigned lane, unsigned s) { return off_b(lane & 31, 2 * s + (lane >> 5)); }
__device__ __forceinline__ unsigned tr_read_addr(unsigned lane, unsigned c, unsigned ks, unsigned t) {
    const unsigned h = lane >> 5, blk = (lane >> 4) & 1, q = (lane & 15) >> 2, p = lane & 3;
    return off_b(16 * ks + 8 * h + 4 * t + q, 4 * c + 2 * blk + (p >> 1)) + 8 * (p & 1);
}
__device__ __forceinline__ s16x4 tr_rd(unsigned addr) { s16x4 r; asm volatile("ds_read_b64_tr_b16 %0, %1" : "=&v"(r) : "v"(addr) : "memory"); return r; }

__device__ __forceinline__ void decode_unit(const bf16_t* __restrict__ Qd, const float* __restrict__ cckv, const float* __restrict__ ckr, const int* __restrict__ pt,
                                            float* __restrict__ Opart, float* __restrict__ ML, LAS uchar* lds) {
    int tid_ = threadIdx.x; asm volatile("" : "+v"(tid_));
    const int tid = tid_, wid = tid >> 6, lane = tid & 63, r32 = lane & 31, hi = lane >> 5;
    LAS float* al_l = (LAS float*)(lds + OFF_WS) + wid * 64;
    bf16x8 qr[20];
#pragma unroll
    for (int s = 0; s < 20; ++s) qr[s] = *(const bf16x8*)(Qd + (size_t)r32 * 320 + s * 16 + hi * 8);
    float m_reg = -1e30f, l_reg = 0.f; f32x16 o = {};
    f32x4 sv[10];
    const int kc = lane & 15, kq = lane >> 4;
    const unsigned wck = (unsigned)((lane >> 5) * 2 * 8192) + ((lane & 1) << 3);
    const unsigned ldsb = (unsigned)(uintptr_t)lds;
    const int pw = wid >> 2, cw = wid & 3;
#define DLOAD(j) do { const int page = pt[(j) >> 1]; const size_t krow = (size_t)page * 128 + ((j) & 1) * 64 + wid * 8; \
    const float* s0 = cckv + krow * 256 + 4 * lane; const float* s1 = ckr + (krow + kq) * 64 + 4 * kc; \
    _Pragma("unroll") for (int i = 0; i < 8; ++i) sv[i] = __builtin_nontemporal_load((const f32x4*)(s0 + i * 256)); \
    sv[8] = __builtin_nontemporal_load((const f32x4*)s1); sv[9] = __builtin_nontemporal_load((const f32x4*)(s1 + 4 * 64)); } while (0)
#define DWRITE(b) do { _Pragma("unroll") for (int i = 0; i < 8; ++i) { const int key = wid * 8 + i; u32x2 w; w.x = cvt_pk_bf16(sv[i][0], sv[i][1]); w.y = cvt_pk_bf16(sv[i][2], sv[i][3]); \
        *(LAS u32x2*)(lds + (b) * BUFB + wck + (key >> 5) * 8192 + off_b(key & 31, (lane & 31) >> 1)) = w; } \
    _Pragma("unroll") for (int i = 0; i < 2; ++i) { const int key = wid * 8 + kq + 4 * i; u32x2 w; w.x = cvt_pk_bf16(sv[8 + i][0], sv[8 + i][1]); w.y = cvt_pk_bf16(sv[8 + i][2], sv[8 + i][3]); \
        *(LAS u32x2*)(lds + (b) * BUFB + OFF_KR + key * 128 + (((kc >> 1) ^ (key & 7)) << 4) + ((kc & 1) << 3)) = w; } } while (0)
    constexpr int NT = 32;
    DLOAD(0); DWRITE(0); __syncthreads();
    for (int j = 0; j < NT; ++j) {
        const int b = j & 1;
        if (j + 1 < NT) DLOAD(j + 1);
        const LAS uchar* B = lds + b * BUFB;
        f32x16 p0 = {}, p1 = {};
#pragma unroll
        for (int s = 0; s < 16; ++s) { const unsigned ra = row_read_addr(lane, s & 7);
            const bf16x8 k0 = *(const LAS bf16x8*)(B + ((s >> 3) * 2 + 0) * 8192 + ra), k1 = *(const LAS bf16x8*)(B + ((s >> 3) * 2 + 1) * 8192 + ra);
            p0 = __builtin_amdgcn_mfma_f32_32x32x16_bf16(k0, qr[s], p0, 0, 0, 0); p1 = __builtin_amdgcn_mfma_f32_32x32x16_bf16(k1, qr[s], p1, 0, 0, 0); }
#pragma unroll
        for (int s = 0; s < 4; ++s) { const int chk = 2 * s + hi;
            const bf16x8 k0 = *(const LAS bf16x8*)(B + OFF_KR + r32 * 128 + ((chk ^ (r32 & 7)) << 4)), k1 = *(const LAS bf16x8*)(B + OFF_KR + (32 + r32) * 128 + ((chk ^ (r32 & 7)) << 4));
            p0 = __builtin_amdgcn_mfma_f32_32x32x16_bf16(k0, qr[16 + s], p0, 0, 0, 0); p1 = __builtin_amdgcn_mfma_f32_32x32x16_bf16(k1, qr[16 + s], p1, 0, 0, 0); }
        float mn, alpha; att::partialSM<192>(p0, p1, m_reg, mn, alpha);
        if (__any(alpha < 1.f)) { if (hi == 0) al_l[r32] = alpha; asm volatile("s_waitcnt lgkmcnt(0)" ::: "memory");
#pragma unroll
            for (int r = 0; r < 16; ++r) o[r] *= al_l[crow(r, hi)]; }
        bf16x8 pa[4]; att::finishSM(p0, p1, alpha, l_reg, pa[0], pa[1], pa[2], pa[3]);
        s16x4 vl[4], vh[4];
#pragma unroll
        for (int ks = 0; ks < 4; ++ks) { const unsigned vb = ldsb + b * BUFB + (pw * 2 + (ks >> 1)) * 8192;
            vl[ks] = tr_rd(vb + tr_read_addr(lane, cw, ks & 1, 0)); vh[ks] = tr_rd(vb + tr_read_addr(lane, cw, ks & 1, 1)); }
        asm volatile("s_waitcnt lgkmcnt(0)" ::: "memory"); __builtin_amdgcn_sched_barrier(0);
#pragma unroll
        for (int ks = 0; ks < 4; ++ks) o = __builtin_amdgcn_mfma_f32_32x32x16_bf16(pa[ks], ((bf16x8){vl[ks][0], vl[ks][1], vl[ks][2], vl[ks][3], vh[ks][0], vh[ks][1], vh[ks][2], vh[ks][3]}), o, 0, 0, 0);
        if (j + 1 < NT) DWRITE(b ^ 1);
        __syncthreads();
    }
#undef DLOAD
#undef DWRITE
    if (wid == 0 && hi == 0) { ML[r32 * 2] = m_reg; ML[r32 * 2 + 1] = l_reg; }
#pragma unroll
    for (int r = 0; r < 16; ++r) Opart[(size_t)crow(r, hi) * 256 + 32 * wid + r32] = o[r];
}

__device__ __forceinline__ void combine_row(int b, int row32, int lane, const bf16_t* __restrict__ Qdec, const float* __restrict__ Opart, const float* __restrict__ ML,
                                            const float* __restrict__ ckvn, const float* __restrict__ krn, bf16_t* __restrict__ olat) {
    constexpr float C = 0.07216878364870322f * 1.4426950408889634f;
    const int t = row32 >> 3, h = row32 & 7;
    const bf16_t* q = Qdec + ((size_t)b * 32 + row32) * 320;
    const u32x2 qw = *(const u32x2*)(q + 4 * lane); const float q0 = bf_lo(qw.x), q1 = bf_hi(qw.x), q2 = bf_lo(qw.y), q3 = bf_hi(qw.y); const float qrp = bf2f(q[256 + lane]);
    float sj[4]; f32x4 cn[4];
#pragma unroll
    for (int j = 0; j < 4; ++j) { cn[j] = *(const f32x4*)(ckvn + ((size_t)b * 4 + j) * 256 + 4 * lane); float s = q0 * cn[j][0] + q1 * cn[j][1] + q2 * cn[j][2] + q3 * cn[j][3] + qrp * krn[((size_t)b * 4 + j) * 64 + lane];
#pragma unroll
        for (int o = 32; o >= 1; o >>= 1) s += __shfl_xor(s, o);
        sj[j] = (j <= t) ? s : -1e30f; }
    float mc[8], lc[8], M = fmaxf(fmaxf(sj[0], sj[1]), fmaxf(sj[2], sj[3]));
#pragma unroll
    for (int c = 0; c < 8; ++c) { const f32x2 ml = *(const f32x2*)(ML + (((size_t)b * 8 + c) * 32 + row32) * 2); mc[c] = ml.x; lc[c] = ml.y; M = fmaxf(M, mc[c]); }
    float L = 0.f; f32x4 acc = {0.f, 0.f, 0.f, 0.f};
#pragma unroll
    for (int c = 0; c < 8; ++c) { const float w = __builtin_amdgcn_exp2f((mc[c] - M) * C); L += lc[c] * w; acc += *(const f32x4*)(Opart + (((size_t)b * 8 + c) * 32 + row32) * 256 + 4 * lane) * w; }
#pragma unroll
    for (int j = 0; j < 4; ++j) { const float e = (j <= t) ? __builtin_amdgcn_exp2f((sj[j] - M) * C) : 0.f; L += e; acc += cn[j] * e; }
    const float rl = 1.0f / L; u32x2 w; w.x = cvt_pk_bf16(acc[0] * rl, acc[1] * rl); w.y = cvt_pk_bf16(acc[2] * rl, acc[3] * rl);
    *(u32x2*)(olat + ((size_t)b * 4 + t) * 2048 + h * 256 + 4 * lane) = w;
}

constexpr int SMEM_LDS = 4096 + 32768;
__device__ __forceinline__ void smem_unit(const bf16_t* __restrict__ Zq  , const bf16_t* __restrict__ Zg  , const float* __restrict__ Kc, const float* __restrict__ Vc  ,
                                          bf16_t* __restrict__ outp  , LAS uchar* lds) {
    int tid_ = threadIdx.x; asm volatile("" : "+v"(tid_));
    const int tid = tid_, wid = tid >> 6, lane = tid & 63, l32 = lane & 31, hi = lane >> 5;
    LAS float* sc = (LAS float*)lds; LAS float* red = (LAS float*)(lds + 4096);
    float qv[4][4];
#pragma unroll
    for (int t = 0; t < 4; ++t) { const u32x2 w = *(const u32x2*)(Zq + (size_t)t * LDZ + 4 * l32); qv[t][0] = bf_lo(w.x); qv[t][1] = bf_hi(w.x); qv[t][2] = bf_lo(w.y); qv[t][3] = bf_hi(w.y); }
#pragma unroll 4
    for (int i = 0; i < 16; ++i) { const int m = wid * 32 + 2 * i + hi; const f32x4 kv = *(const f32x4*)(Kc + (size_t)m * 512 + 4 * l32); float p[4];
#pragma unroll
        for (int t = 0; t < 4; ++t) { p[t] = kv[0] * qv[t][0] + kv[1] * qv[t][1] + kv[2] * qv[t][2] + kv[3] * qv[t][3];
#pragma unroll
            for (int o = 16; o >= 1; o >>= 1) p[t] += __shfl_xor(p[t], o); }
        if (l32 == 0) {
#pragma unroll
            for (int t = 0; t < 4; ++t) sc[t * 256 + m] = p[t] * 0.08838834764831845f; } }
    __syncthreads();
    if (wid < 4) { float v[4], mx = -1e30f;
#pragma unroll
        for (int i = 0; i < 4; ++i) { v[i] = sc[wid * 256 + lane + 64 * i]; mx = fmaxf(mx, v[i]); }
#pragma unroll
        for (int o = 32; o >= 1; o >>= 1) mx = fmaxf(mx, __shfl_xor(mx, o));
        float s = 0.f;
#pragma unroll
        for (int i = 0; i < 4; ++i) { v[i] = __expf(v[i] - mx); s += v[i]; }
#pragma unroll
        for (int o = 32; o >= 1; o >>= 1) s += __shfl_xor(s, o);
        const float rs = 1.0f / s;
#pragma unroll
        for (int i = 0; i < 4; ++i) sc[wid * 256 + lane + 64 * i] = v[i] * rs; }
    __syncthreads();
    { const int d4 = (tid & 31) * 4, mg = tid >> 5; f32x4 a[4] = {};
#pragma unroll 4
      for (int mm = 0; mm < 16; ++mm) { const int m = mg * 16 + mm; const f32x4 vv = *(const f32x4*)(Vc + (size_t)m * 512 + d4);
#pragma unroll
          for (int t = 0; t < 4; ++t) a[t] += vv * sc[t * 256 + m]; }
#pragma unroll
      for (int t = 0; t < 4; ++t) *(LAS f32x4*)(red + (mg * 4 + t) * 128 + d4) = a[t]; }
    __syncthreads();
    { const int t = tid >> 7, d = tid & 127; float s = 0.f;
#pragma unroll
      for (int mg = 0; mg < 16; ++mg) s += red[(mg * 4 + t) * 128 + d];
      const float g = bf2f(Zg[(size_t)t * LDZ + d]);
      outp[(size_t)t * OUTW + d] = (bf16_t)(cvt_pk_bf16(s * silu(g), 0.f) & 0xffffu); }
    __syncthreads();
}
}
namespace ew {
__device__ __forceinline__ int otid() { int t = threadIdx.x; asm volatile("" : "+v"(t)); return t; }
struct TJ { const float* src; int sld, K, ncols; const float* gain; const float* cscale; bf16_t* dst; int dld; };
constexpr int NTJ = 32;
__device__ __forceinline__ TJ get_tj(int j, const float* const* in, uchar* ws) {
    TJ t; t.gain = nullptr; t.cscale = nullptr;
    bf16_t* WINA = (bf16_t*)(ws + WS_WINA); bf16_t* WGRP = (bf16_t*)(ws + WS_WGRP); bf16_t* WINB = (bf16_t*)(ws + WS_WINB); bf16_t* WQUP = (bf16_t*)(ws + WS_WQUP);
    bf16_t* WKV = (bf16_t*)(ws + WS_WKV); bf16_t* WMEM = (bf16_t*)(ws + WS_WMEM); bf16_t* WOUT = (bf16_t*)(ws + WS_WOUT);
    if (j < 2) { t.src = in[10] + (size_t)j * DM * INA; t.sld = INA; t.K = DM; t.ncols = INA; t.gain = in[9] + j * DM; t.dst = WINA + (size_t)j * INA * DM; t.dld = DM; }
    else if (j < 10) { const int i = j - 2; t.src = in[11] + (size_t)i * 65536; t.sld = 256; t.K = 256; t.ncols = 256; t.cscale = in[12] + i * 256; t.dst = WGRP + (size_t)i * 65536; t.dld = 256; }
    else if (j < 12) { const int i = j - 10; t.src = in[13] + (size_t)i * DM * INB; t.sld = INB; t.K = DM; t.ncols = QRANK; t.gain = in[9] + (2 + i) * DM; t.dst = WINB + (size_t)i * NB2 * DM; t.dld = DM; }
    else if (j < 14) { const int i = j - 12; t.src = in[13] + (size_t)i * DM * INB + QRANK; t.sld = INB; t.K = DM; t.ncols = INB - QRANK; t.gain = in[9] + (2 + i) * DM; t.dst = WINB + ((size_t)i * NB2 + ZB_GT) * DM; t.dld = DM; }
    else if (j == 14) { t.src = in[17] + KVR; t.sld = 320; t.K = DM; t.ncols = ROPE; t.gain = in[16]; t.dst = WINB + (size_t)ZB_KR * DM; t.dld = DM; }
    else if (j == 15) { t.src = in[17]; t.sld = 320; t.K = DM; t.ncols = KVR; t.gain = in[16]; t.dst = WINB + (size_t)ZB_KV * DM; t.dld = DM; }
    else if (j < 18) { const int i = j - 16; t.src = in[15] + (size_t)i * QRANK * QW; t.sld = QW; t.K = QRANK; t.ncols = QW; t.gain = in[14] + i * QRANK; t.dst = WQUP + (size_t)i * QW * QRANK; t.dld = QRANK; }
    else if (j == 18) { t.src = in[19]; t.sld = 1024; t.K = 256; t.ncols = 1024; t.dst = WKV; t.dld = 256; }
    else if (j == 19) { t.src = in[20]; t.sld = 1024; t.K = 256; t.ncols = 1024; t.dst = WKV + (size_t)1024 * 256; t.dld = 256; }
    else if (j < 28) { const int i = j - 20, l = i >> 1, kv = i & 1; t.src = (kv ? in[23] : in[22]) + (size_t)l * DM * MEMW; t.sld = MEMW; t.K = DM; t.ncols = MEMW; t.gain = in[21] + l * DM; t.dst = WMEM + (size_t)(l * 2 + kv) * MEMW * DM; t.dld = DM; }
    else { const int l = j - 28; t.src = in[24] + (size_t)l * OUTW * DM; t.sld = DM; t.K = OUTW; t.ncols = DM; t.dst = WOUT + (size_t)l * DM * OUTW; t.dld = OUTW; }
    return t;
}
__device__ __forceinline__ int tj_tiles(int j) {
    if (j < 2) return 16 * 48; if (j < 10) return 16; if (j < 12) return 16 * 6; if (j < 14) return 16 * 32; if (j == 14) return 16; if (j == 15) return 64;
    if (j < 18) return 6 * 24; if (j < 20) return 4 * 16; if (j < 28) return 16 * 8; return 24 * 16;
}
constexpr int TJ_TOTAL = 2 * 768 + 8 * 16 + 2 * 96 + 2 * 512 + 16 + 64 + 2 * 144 + 2 * 64 + 8 * 128 + 4 * 384;
__device__ __forceinline__ void transpose_tile(const TJ& t, int tile, LAS float* tl, int tid) {
    const int nkt = t.K / 64, kt = tile % nkt, nt = tile / nkt, k0 = kt * 64, n0 = nt * 64;
    { const int k = tid >> 3, n8 = (tid & 7) * 8; const float* s = t.src + (size_t)(k0 + k) * t.sld + n0 + n8; const float g = t.gain ? t.gain[k0 + k] : 1.0f;
      const f32x4 a = *(const f32x4*)s * g, b = *(const f32x4*)(s + 4) * g;
#pragma unroll
      for (int j = 0; j < 4; ++j) { tl[k * 65 + n8 + j] = a[j]; tl[k * 65 + n8 + 4 + j] = b[j]; } }
    __syncthreads();
    { const int n = tid >> 3, k8 = (tid & 7) * 8; const float cs = t.cscale ? t.cscale[n0 + n] : 1.0f; float v[8];
#pragma unroll
      for (int j = 0; j < 8; ++j) v[j] = tl[(k8 + j) * 65 + n] * cs;
      *(u32x4*)(t.dst + (size_t)(n0 + n) * t.dld + k0 + k8) = pack8(v); }
    __syncthreads();
}
__device__ __forceinline__ void sincos_d(float angf, float& c, float& s) {
    const double x = (double)angf; const double kd = rint(x * 0.63661977236758134308); const int q = (int)((long long)kd & 3);
    double r = fma(-kd, 1.57079632679489655800e+00, x); r = fma(-kd, 6.12323399573676603587e-17, r);
    const double r2 = r * r;
    double sp = -7.6471637318198164759e-13; sp = fma(sp, r2, 1.6059043836821614599e-10); sp = fma(sp, r2, -2.5052108385441718775e-08); sp = fma(sp, r2, 2.7557319223985890653e-06);
    sp = fma(sp, r2, -1.9841269841269841270e-04); sp = fma(sp, r2, 8.3333333333333333333e-03); sp = fma(sp, r2, -1.6666666666666666667e-01); const double sn = fma(sp * r2, r, r);
    double cp = 4.7794773323873852974e-14; cp = fma(cp, r2, -1.1470745597729724714e-11); cp = fma(cp, r2, 2.0876756987868098979e-09); cp = fma(cp, r2, -2.7557319223985890653e-07);
    cp = fma(cp, r2, 2.4801587301587301587e-05); cp = fma(cp, r2, -1.3888888888888888889e-03); cp = fma(cp, r2, 4.1666666666666666667e-02); cp = fma(cp, r2, -0.5); const double cn = fma(cp, r2, 1.0);
    const double ss = (q == 0) ? sn : (q == 1) ? cn : (q == 2) ? -sn : -cn, cc = (q == 0) ? cn : (q == 1) ? -sn : (q == 2) ? -cn : sn;
    c = (float)cc; s = (float)ss;
}

__device__ __forceinline__ void prologue(const float* const* in, float* out, uchar* ws, LAS uchar* lds, int G, int bid) {
    const int tid = otid(), lane = tid & 63, wid = tid >> 6;
    for (int gt = bid; gt < TJ_TOTAL; gt += G) { int j = 0, r = gt; for (; j < NTJ; ++j) { const int n = tj_tiles(j); if (r < n) break; r -= n; }
        const TJ t = get_tj(j, in, ws); transpose_tile(t, r, (LAS float*)lds, tid); }
    const size_t gtid = (size_t)bid * 512 + tid, gstride = (size_t)G * 512;
    { bf16_t* WINB = (bf16_t*)(ws + WS_WINB);
      for (size_t i = gtid; i < (size_t)(64 + 128) * DM / 8; i += gstride) { const size_t e = i * 8; bf16_t* p = (e < (size_t)64 * DM) ? WINB + (size_t)448 * DM + e : WINB + ((size_t)NB2 + 384) * DM + (e - (size_t)64 * DM);
          *(u32x4*)p = (u32x4){0u, 0u, 0u, 0u}; }
      bf16_t* WKUPN = (bf16_t*)(ws + WS_WKUPN);
      for (size_t i = gtid; i < (size_t)256 * 1024 / 8; i += gstride) { const float* s = in[19] + i * 8; const f32x4 a = *(const f32x4*)s, b = *(const f32x4*)(s + 4);
          const float v[8] = {a[0], a[1], a[2], a[3], b[0], b[1], b[2], b[3]}; *(u32x4*)(WKUPN + i * 8) = pack8(v); } }
    { bf16_t* XB = (bf16_t*)(ws + WS_XB); bf16_t* MH = (bf16_t*)(ws + WS_MHAT); float* ssp = (float*)(ws + WS_SSP); float* ssps = (float*)(ws + WS_SSPS);
      const int nrows = PM + SM + 2048;
      for (int row = bid * 8 + wid; row < nrows; row += G * 8) {
          const float* src = row < PM ? in[0] + (size_t)row * DM : row < PM + SM ? in[1] + (size_t)(row - PM) * DM : in[8] + (size_t)(row - PM - SM) * DM;
          f32x4 v[4]; float s = 0.f;
#pragma unroll
          for (int i = 0; i < 4; ++i) { v[i] = *(const f32x4*)(src + 256 * i + 4 * lane); s += sum4(v[i] * v[i]); }
#pragma unroll
          for (int o = 32; o >= 1; o >>= 1) s += __shfl_xor(s, o);
          float sc = 1.0f; bf16_t* dst;
          if (row < PM + SM) { dst = XB + (size_t)row * DM; if (row < PM) { if (lane < 16) ssp[(size_t)row * 16 + lane] = lane == 0 ? s : 0.f; } else { if (lane < 32) ssps[(row - PM) * 32 + lane] = lane == 0 ? s : 0.f; } }
          else { dst = MH + (size_t)(row - PM - SM) * DM; sc = rsqrtf(s * (1.0f / 1024.0f) + EPS); }
#pragma unroll
          for (int i = 0; i < 4; ++i) { u32x2 w; w.x = cvt_pk_bf16(v[i][0] * sc, v[i][1] * sc); w.y = cvt_pk_bf16(v[i][2] * sc, v[i][3] * sc); *(u32x2*)(dst + 256 * i + 4 * lane) = w; } } }
    { f32x2* tab = (f32x2*)(ws + WS_ROPE);
      for (size_t e = gtid; e < (size_t)2052 * 32; e += gstride) { const int p = (int)(e >> 5), i = (int)(e & 31); const int pos = p < 2048 ? p : PAST + (p - 2048);
          const float inv = (float)exp2(-(double)i * (13.287712379549449 / 32.0)); const float ang = (float)pos * inv; float c, s; sincos_d(ang, c, s); tab[e] = (f32x2){c, s}; } }
    { for (size_t e = gtid; e < (size_t)2 * SB * 11 * DM / 4; e += gstride) { const size_t f = e * 4; const int c = (int)(f % DM); const size_t rr = f / DM; const int i = (int)(rr % 11); const size_t lb = rr / 11;
          *(f32x4*)(out + O_PSS + (lb * 15 + i) * DM + c) = *(const f32x4*)(in[2] + (lb * 15 + 4 + i) * DM + c); } }
}

__device__ __forceinline__ void pooling(int l, const float* const* in, float* out, uchar* ws, int G, int bid) {
    const bf16_t* Z = (const bf16_t*)(ws + WS_Z); bf16_t* PO = (bf16_t*)(ws + WS_POOLED);
    const size_t gtid = (size_t)bid * 512 + otid(), gstride = (size_t)G * 512;
    for (size_t idx = gtid; idx < (size_t)PM * 128; idx += gstride) { const int row = (int)(idx >> 7), cv = (int)(idx & 127), g = cv >> 5, w = 2 << g, t = row & (PT - 1), n = (t + 1 < w) ? t + 1 : w;
        const bf16_t* p = Z + (size_t)row * LDZ + cv * 8; float ut[8], s[8]; unpack8(*(const u32x4*)p, ut);
#pragma unroll
        for (int j = 0; j < 8; ++j) s[j] = ut[j];
        for (int i = 1; i < n; ++i) { float x[8]; unpack8(*(const u32x4*)(p - (size_t)i * LDZ), x);
#pragma unroll
            for (int j = 0; j < 8; ++j) s[j] += x[j]; }
        const float rn = 1.0f / (float)n; float o[8];
#pragma unroll
        for (int j = 0; j < 8; ++j) o[j] = s[j] * rn - ut[j];
        *(u32x4*)(PO + (size_t)row * DM + cv * 8) = pack8(o);
        if (t >= PT - POOLBUF) { float* q = out + O_PSP + (((size_t)l * PB + (row >> 11)) * 15 + (t - (PT - POOLBUF))) * DM + cv * 8; *(f32x4*)q = (f32x4){ut[0], ut[1], ut[2], ut[3]}; *(f32x4*)(q + 4) = (f32x4){ut[4], ut[5], ut[6], ut[7]}; } }
    for (size_t idx = gtid; idx < (size_t)SM * 128; idx += gstride) { const int r = (int)(idx >> 7), cv = (int)(idx & 127), g = cv >> 5, w = 2 << g, b = r >> 2, t = r & 3;
        const float* prev = in[2] + ((size_t)l * SB + b) * 15 * DM + cv * 8; const bf16_t* us = Z + ((size_t)PM + b * 4) * LDZ + cv * 8; float ut[8], s[8];
        unpack8(*(const u32x4*)(us + (size_t)t * LDZ), ut);
#pragma unroll
        for (int j = 0; j < 8; ++j) s[j] = ut[j];
        for (int i = 1; i < w; ++i) { const int e = 15 + t - i; float x[8];
            if (e >= 15) unpack8(*(const u32x4*)(us + (size_t)(e - 15) * LDZ), x);
            else { const f32x4 a = *(const f32x4*)(prev + (size_t)e * DM), bb = *(const f32x4*)(prev + (size_t)e * DM + 4); x[0] = a[0]; x[1] = a[1]; x[2] = a[2]; x[3] = a[3]; x[4] = bb[0]; x[5] = bb[1]; x[6] = bb[2]; x[7] = bb[3]; }
#pragma unroll
            for (int j = 0; j < 8; ++j) s[j] += x[j]; }
        const float rn = 1.0f / (float)w; float o[8];
#pragma unroll
        for (int j = 0; j < 8; ++j) o[j] = s[j] * rn - ut[j];
        *(u32x4*)(PO + ((size_t)PM + r) * DM + cv * 8) = pack8(o);
        float* q = out + O_PSS + (((size_t)l * SB + b) * 15 + 11 + t) * DM + cv * 8; *(f32x4*)q = (f32x4){ut[0], ut[1], ut[2], ut[3]}; *(f32x4*)(q + 4) = (f32x4){ut[4], ut[5], ut[6], ut[7]}; }
}

__device__ __forceinline__ void kvpost(const float* const* in, float* out, uchar* ws, int G, int bid) {
    const float* KV = (const float*)(ws + WS_KVRAW); bf16_t* CB = (bf16_t*)(ws + WS_CKVB); bf16_t* KB = (bf16_t*)(ws + WS_KROPEB); const f32x2* tab = (const f32x2*)(ws + WS_ROPE);
    const int tid = otid(), lane = tid & 63, wid = tid >> 6; const f32x4 gl = *(const f32x4*)(in[18] + 4 * lane);
    for (int row = bid * 8 + wid; row < PM + SM; row += G * 8) { const float* p = KV + (size_t)row * 320; const f32x4 v = *(const f32x4*)(p + 4 * lane); float s = sum4(v * v);
#pragma unroll
        for (int o = 32; o >= 1; o >>= 1) s += __shfl_xor(s, o);
        const float rs = rsqrtf(s * (1.0f / 256.0f) + EPS); const f32x4 c = v * rs * gl;
        float* oc = row < PM ? out + O_CKVP + (size_t)row * KVR : out + O_CKVS + (size_t)(row - PM) * KVR; float* ok = row < PM ? out + O_KRP + (size_t)row * ROPE : out + O_KRS + (size_t)(row - PM) * ROPE;
        *(f32x4*)(oc + 4 * lane) = c; u32x2 w; w.x = cvt_pk_bf16(c[0], c[1]); w.y = cvt_pk_bf16(c[2], c[3]); *(u32x2*)(CB + (size_t)row * KVR + 4 * lane) = w;
        if (lane < 32) { const int ti = row < PM ? (row & (PT - 1)) : 2048 + ((row - PM) & 3); const f32x2 cs = tab[(size_t)ti * 32 + lane]; const float x1 = p[256 + lane], x2 = p[288 + lane];
            const float o1 = x1 * cs.x - x2 * cs.y, o2 = x1 * cs.y + x2 * cs.x; ok[lane] = o1; ok[32 + lane] = o2;
            KB[(size_t)row * ROPE + lane] = (bf16_t)(cvt_pk_bf16(o1, 0.f) & 0xffffu); KB[(size_t)row * ROPE + 32 + lane] = (bf16_t)(cvt_pk_bf16(o2, 0.f) & 0xffffu); } }
}
__device__ __forceinline__ void sq_rope(uchar* ws, int G, int bid) {
    const bf16_t* Q = (const bf16_t*)(ws + WS_Q); bf16_t* QD = (bf16_t*)(ws + WS_QDEC); const f32x2* tab = (const f32x2*)(ws + WS_ROPE);
    for (size_t e = (size_t)bid * 512 + otid(); e < (size_t)SM * MLAH * 32; e += (size_t)G * 512) { const int i = (int)(e & 31), h = (int)((e >> 5) & 7), r = (int)(e >> 8), b = r >> 2, t = r & 3;
        const bf16_t* q = Q + ((size_t)PM + r) * QW + h * QHD + NOPE; const float x1 = bf2f(q[i]), x2 = bf2f(q[32 + i]); const f32x2 cs = tab[(size_t)(2048 + t) * 32 + i];
        bf16_t* o = QD + ((size_t)b * 32 + t * 8 + h) * 320 + 256; o[i] = (bf16_t)(cvt_pk_bf16(x1 * cs.x - x2 * cs.y, 0.f) & 0xffffu); o[32 + i] = (bf16_t)(cvt_pk_bf16(x1 * cs.y + x2 * cs.x, 0.f) & 0xffffu); }
}
__device__ __forceinline__ void final_norm(const float* const* in, float* out, uchar* ws, int G, int bid) {
    const float* XR = (const float*)(ws + WS_XRES); const float* ssp = (const float*)(ws + WS_SSP); const float* ssps = (const float*)(ws + WS_SSPS);
    const int tid = otid(), lane = tid & 63, wid = tid >> 6;
    for (int row = bid * 8 + wid; row < PM + SM; row += G * 8) { const float rs = row < PM ? rs_from16(ssp + (size_t)row * 16) : rs_from32(ssps + (row - PM) * 32);
        float* o = row < PM ? out + O_YP + (size_t)row * DM : out + O_YS + (size_t)(row - PM) * DM; const float* x = XR + (size_t)row * DM;
#pragma unroll
        for (int i = 0; i < 4; ++i) { const int c = 256 * i + 4 * lane; *(f32x4*)(o + c) = *(const f32x4*)(x + c) * rs * *(const f32x4*)(in[25] + c); } }
}
}
#define XB_TMO      128
#define XB_XCNT(j)  (256  + 64 * (j))
#define XB_XSUB(j)  (1280 + 64 * (j))
#define XB_XGEN(j)  (2304 + 64 * (j))
#define XB_TOP      3328
#define XB_TOPGEN   3392
#define XCD_BAR_WORDS 3456
#define XB_SPIN_CAP (1u << 22)
__device__ __forceinline__ unsigned xb_ld(unsigned* p)              { return __hip_atomic_load(p, __ATOMIC_RELAXED, __HIP_MEMORY_SCOPE_AGENT); }
__device__ __forceinline__ unsigned xb_add(unsigned* p, unsigned v) { return __hip_atomic_fetch_add(p, v, __ATOMIC_RELAXED, __HIP_MEMORY_SCOPE_AGENT); }
__device__ __forceinline__ unsigned xb_xcc_id() { return (unsigned)__builtin_amdgcn_s_getreg((3 << 11) | 20) & 0xFu; }
#define XB_SPIN(cond, bar) do { unsigned _sp = 0; while (cond) { __builtin_amdgcn_s_sleep(1); \
    if ((++_sp & 255u) == 0u) { if (xb_ld(&(bar)[XB_TMO])) break; if (_sp > XB_SPIN_CAP) { atomicAdd(&(bar)[XB_TMO], 1u); break; } } } } while (0)
struct XcdBarrier { unsigned* bar; unsigned x; volatile LAS unsigned* st; };
__device__ __forceinline__ XcdBarrier xcd_barrier_post(unsigned* bar, volatile LAS unsigned* st) {
    XcdBarrier b; b.bar = bar; b.x = xb_xcc_id(); b.st = st;
    if (threadIdx.x == 0) (void)xb_add(&bar[XB_XCNT(b.x)], 1u);
    return b;
}
__device__ __forceinline__ void xcd_barrier_complete(unsigned* bar, unsigned x, unsigned& nloc, unsigned& nx) {
    const unsigned G = gridDim.x * gridDim.y * gridDim.z;
    unsigned sum, cnt, mine, sp = 0u;
    for (;;) {
        sum = 0u; cnt = 0u; mine = 0u;
#pragma unroll
        for (unsigned j = 0; j < 16; ++j) { const unsigned c = xb_ld(&bar[XB_XCNT(j)]); sum += c; cnt += (c > 0u) ? 1u : 0u; mine = (j == x) ? c : mine; }
        if (sum == G) break;
        __builtin_amdgcn_s_sleep(1);
        if ((++sp & 255u) == 0u) { if (xb_ld(&bar[XB_TMO])) break; if (sp > XB_SPIN_CAP) { atomicAdd(&bar[XB_TMO], 1u); break; } }
    }
    nloc = mine > 0u ? mine : 1u; nx = cnt > 0u ? cnt : 1u;
}
__device__ __forceinline__ void xcd_barrier(const XcdBarrier& b) {
    asm volatile("s_waitcnt vmcnt(0)" ::: "memory");
    __syncthreads();
    if (threadIdx.x == 0) {
        unsigned* bar = b.bar;
        __builtin_amdgcn_s_waitcnt(0);
        unsigned nloc = b.st[0], nx = b.st[1];
        if (nloc == 0u) { xcd_barrier_complete(bar, b.x, nloc, nx); b.st[0] = nloc; b.st[1] = nx; }
        const unsigned old = xb_add(&bar[XB_XSUB(b.x)], 1u);
        const unsigned gen = old / nloc;
        if (old + 1u == (gen + 1u) * nloc) {
            __builtin_amdgcn_fence(__ATOMIC_RELEASE, "agent");
            asm volatile("s_waitcnt vmcnt(0)" ::: "memory");
            const unsigned og = xb_add(&bar[XB_TOP], 1u);
            const unsigned tg = og / nx;
            if (og + 1u == (tg + 1u) * nx) xb_add(&bar[XB_TOPGEN], 1u);
            else XB_SPIN(xb_ld(&bar[XB_TOPGEN]) == tg, bar);
            __builtin_amdgcn_fence(__ATOMIC_ACQUIRE, "agent");
            xb_add(&bar[XB_XGEN(b.x)], 1u);
            asm volatile("s_waitcnt vmcnt(0)" ::: "memory");
        } else {
            XB_SPIN(xb_ld(&bar[XB_XGEN(b.x)]) == gen, bar);
            __builtin_amdgcn_fence(__ATOMIC_ACQUIRE, "agent");
            asm volatile("s_waitcnt vmcnt(0)" ::: "memory");
        }
    }
    __syncthreads();
}

constexpr int LDS_BYTES = 144 * 1024, MISC_OFF = 136 * 1024;
static_assert(pg8::STAGE_BYTES <= MISC_OFF && att::LDS_BYTES <= MISC_OFF && dec::LDS_BYTES <= MISC_OFF && sg::LDS_BYTES <= MISC_OFF && dec::SMEM_LDS <= MISC_OFF, "LDS budget");
constexpr int NPHASE = 24;
struct Params { const float* in[26]; float* out; uchar* ws; int ph_lo, ph_hi; };

template <class T> __device__ __forceinline__ T* launder(T* p) { asm volatile("" : "+s"(p)); return p; }
#define PHASE_PTRS \
    uchar* const ws = launder(P.ws); float* const out = launder(P.out); const float* const* in = P.in; (void)in; (void)out; \
    bf16_t* const XB = (bf16_t*)(ws + WS_XB); float* const XR = (float*)(ws + WS_XRES); bf16_t* const Z = (bf16_t*)(ws + WS_Z); bf16_t* const MX = (bf16_t*)(ws + WS_MIXED); \
    bf16_t* const PO = (bf16_t*)(ws + WS_POOLED); bf16_t* const QB = (bf16_t*)(ws + WS_Q); float* const ssp = (float*)(ws + WS_SSP); float* const ssps = (float*)(ws + WS_SSPS); \
    float* const ssq = (float*)(ws + WS_SSQ); float* const KVRAW = (float*)(ws + WS_KVRAW); bf16_t* const MEMB = (bf16_t*)(ws + WS_MEMB); \
    (void)XB; (void)XR; (void)Z; (void)MX; (void)PO; (void)QB; (void)ssp; (void)ssps; (void)ssq; (void)KVRAW; (void)MEMB;

__global__ void __launch_bounds__(512, 2) yoco_fwd(Params P) {
    extern __shared__ __attribute__((aligned(16))) uchar lds_raw[];
    LAS uchar* lds = (LAS uchar*)lds_raw;
    const int tid = threadIdx.x, G = gridDim.x, bid = blockIdx.x;
    volatile LAS unsigned* misc = (volatile LAS unsigned*)(lds + MISC_OFF);
    if (tid < 4) misc[tid] = 0u;
    __syncthreads();
    const int lo = P.ph_lo, hi = P.ph_hi; const bool multi = (hi - lo) > 1;
    XcdBarrier bar; bar.bar = (unsigned*)(P.ws + WS_CTL); bar.x = 0; bar.st = misc;
    if (multi) bar = xcd_barrier_post((unsigned*)(P.ws + WS_CTL), misc);
#ifndef EN_MASK
#define EN_MASK 0xffff
#endif
#define EN(t) ((EN_MASK >> (t)) & 1)
#ifndef REP_MASK
#define REP_MASK 0
#endif
#define NREP(t, first) ((((REP_MASK >> (t)) & 1) && (first)) ? 2 : 1)
#define IN(k) (lo <= (k) && (k) < hi)
#define SEAM(k) do { if (IN(k) && IN((k) + 1)) xcd_barrier(bar); } while (0)
#define SUNITS(u, n) for (int u = G - 1 - bid; u < (n); u += G)

    if (EN(0) && IN(0)) for (int rep = 0; rep < NREP(0, true); ++rep) { if (rep) xcd_barrier(bar); PHASE_PTRS ew::prologue(in, out, ws, lds, G, bid); }
    SEAM(0);

#pragma unroll 1
    for (int l = 0; l < 2; ++l) {
        const int pb = 1 + 4 * l;
        if (EN(1) && IN(pb)) for (int rep = 0; rep < NREP(1, l == 0); ++rep) { if (rep) xcd_barrier(bar);
            PHASE_PTRS
            { pg8::Gemm g{XB, (const bf16_t*)(ws + WS_WINA) + (size_t)l * INA * DM, DM, DM, DM, 0}; pg8::StaticOrder S; S.init(PM / 256, INA / 256, G, bid);
              pg8::EpiZ E{Z, ssp, nullptr, nullptr}; pg8::gemm_phase(lds, g, S, E); }
            if (l == 0) { pg8::Gemm g{(const bf16_t*)(ws + WS_MHAT), (const bf16_t*)(ws + WS_WMEM), DM, DM, DM, 0}; pg8::StaticOrder S; S.init(2048 / 256, 4096 / 256, G, bid);
              pg8::EpiMem E{out + O_MEMK, MEMB}; pg8::gemm_phase(lds, g, S, E); }
            SUNITS(u, INA / 64) { sg::EpiZ E{Z, ssps, nullptr, nullptr}; sg::sgemm_unit(lds, XB + (size_t)PM * DM, DM, (const bf16_t*)(ws + WS_WINA) + (size_t)l * INA * DM, DM, DM, u * 64, E); }
        }
        SEAM(pb);
        if (EN(2) && IN(pb + 1)) for (int rep = 0; rep < NREP(2, l == 0); ++rep) { if (rep) xcd_barrier(bar);
            PHASE_PTRS
            ew::pooling(l, in, out, ws, G, bid);
            for (int u = bid; u < PB * MEMH * 8; u += G) { const int b = u >> 5, h = (u >> 3) & 3, x = u & 7; const size_t r0 = (size_t)b * PT + 256 * x;
                const bf16_t* Kh = MEMB + (size_t)b * 256 * 4096 + l * 1024 + h * 128;
                att::attn_body<128, false, 1, LDZ, 4096>(Z + r0 * LDZ + ZA_QM + h * 128, Kh, Kh + 512, nullptr, nullptr, Z + r0 * LDZ + ZA_GM + h * 128, MX + r0 * OUTW + 1024 + h * 128, 4, 0, lds);
                __syncthreads(); }
            SUNITS(u, SB * MEMH) { const int b = u >> 2, h = u & 3; const size_t r0 = (size_t)PM + b * 4; const size_t ko = (((size_t)l * SB + b) * MEMT * MEMH + h) * 128;
                dec::smem_unit(Z + r0 * LDZ + ZA_QM + h * 128, Z + r0 * LDZ + ZA_GM + h * 128, in[5] + ko, in[6] + ko, MX + r0 * OUTW + 1024 + h * 128, lds); }
        }
        SEAM(pb + 1);
        if (EN(3) && IN(pb + 2)) for (int rep = 0; rep < NREP(3, l == 0); ++rep) { if (rep) xcd_barrier(bar);
            PHASE_PTRS
            { pg8::Gemm g{PO, (const bf16_t*)(ws + WS_WGRP) + (size_t)l * 4 * 65536, DM, 256, 256, 256}; pg8::StaticOrder S; S.init(PM / 256, 4, G, bid);
              pg8::EpiGrp E{Z, MX}; pg8::gemm_phase(lds, g, S, E); }
            SUNITS(u, 16) { const int g = u >> 2; sg::EpiGrp E{Z, MX, g * 256};
                sg::sgemm_unit(lds, PO + (size_t)PM * DM + g * 256, DM, (const bf16_t*)(ws + WS_WGRP) + ((size_t)l * 4 + g) * 65536, 256, 256, (u & 3) * 64, E); }
        }
        SEAM(pb + 2);
        if (EN(4) && IN(pb + 3)) for (int rep = 0; rep < NREP(4, l == 0); ++rep) { if (rep) xcd_barrier(bar);
            PHASE_PTRS
            const float* baseP = l == 0 ? in[0] : XR; const float* baseS = l == 0 ? in[1] : XR + (size_t)PM * DM;
            { pg8::Gemm g{MX, (const bf16_t*)(ws + WS_WOUT) + (size_t)l * DM * OUTW, OUTW, OUTW, OUTW, 0}; pg8::StaticOrder S; S.init(PM / 256, DM / 256, G, bid);
              pg8::EpiOut E{baseP, XR, XB, ssp}; pg8::gemm_phase(lds, g, S, E); }
            SUNITS(u, DM / 64) { sg::EpiOut E{baseS, XR, XB, ssps};
                sg::sgemm_unit(lds, MX + (size_t)PM * OUTW, OUTW, (const bf16_t*)(ws + WS_WOUT) + (size_t)l * DM * OUTW, OUTW, OUTW, u * 64, E); }
        }
        SEAM(pb + 3);
    }

#pragma unroll 1
    for (int j = 0; j < 2; ++j) {
        const int l = 2 + j, pb = 9 + 7 * j; const int NB = j == 0 ? NB2 : NB3;
        if (EN(5) && IN(pb)) for (int rep = 0; rep < NREP(5, j == 0); ++rep) { if (rep) xcd_barrier(bar);
            PHASE_PTRS
            const bf16_t* WB = (const bf16_t*)(ws + WS_WINB) + (size_t)j * NB2 * DM; float* kvr = j == 0 ? KVRAW : nullptr;
            { pg8::Gemm g{XB, WB, DM, DM, DM, 0}; pg8::StaticOrder S; S.init(PM / 256, NB / 256, G, bid);
              pg8::EpiZ E{Z, ssp, ssq, kvr}; pg8::gemm_phase(lds, g, S, E); }
            SUNITS(u, NB / 64) { sg::EpiZ E{Z, ssps, ssq, kvr}; sg::sgemm_unit(lds, XB + (size_t)PM * DM, DM, WB, DM, DM, u * 64, E); }
        }
        SEAM(pb);
        if (EN(6) && IN(pb + 1)) for (int rep = 0; rep < NREP(6, j == 0); ++rep) { if (rep) xcd_barrier(bar);
            PHASE_PTRS
            if (j == 0) ew::kvpost(in, out, ws, G, bid);
            { pg8::Gemm g{Z + ZB_CQ, (const bf16_t*)(ws + WS_WQUP) + (size_t)j * QW * QRANK, LDZ, QRANK, QRANK, 0}; pg8::StaticOrder S; S.init(PM / 256, QW / 256, G, bid);
              pg8::EpiQ E{QB, ssq}; pg8::gemm_phase(lds, g, S, E); }
            for (int u = bid; u < PB * MEMH * 8; u += G) { const int b = u >> 5, h = (u >> 3) & 3, x = u & 7; const size_t r0 = (size_t)b * PT + 256 * x;
                const bf16_t* Kh = MEMB + (size_t)b * 256 * 4096 + l * 1024 + h * 128;
                att::attn_body<128, false, 1, LDZ, 4096>(Z + r0 * LDZ + ZB_QM + h * 128, Kh, Kh + 512, nullptr, nullptr, Z + r0 * LDZ + ZB_GM + h * 128, MX + r0 * OUTW + 1024 + h * 128, 4, 0, lds);
                __syncthreads(); }
            SUNITS(u, QW / 64) { sg::EpiQ E{QB, ssq}; sg::sgemm_unit(lds, Z + (size_t)PM * LDZ + ZB_CQ, LDZ, (const bf16_t*)(ws + WS_WQUP) + (size_t)j * QW * QRANK, QRANK, QRANK, u * 64, E); }
            SUNITS(u, SB * MEMH) { const int b = u >> 2, h = u & 3; const size_t r0 = (size_t)PM + b * 4; const size_t ko = (((size_t)l * SB + b) * MEMT * MEMH + h) * 128;
                dec::smem_unit(Z + r0 * LDZ + ZB_QM + h * 128, Z + r0 * LDZ + ZB_GM + h * 128, in[5] + ko, in[6] + ko, MX + r0 * OUTW + 1024 + h * 128, lds); }
        }
        SEAM(pb + 1);
        if (EN(7) && IN(pb + 2)) for (int rep = 0; rep < NREP(7, j == 0); ++rep) { if (rep) xcd_barrier(bar);
            PHASE_PTRS
            if (j == 0) { pg8::Gemm g{(const bf16_t*)(ws + WS_CKVB), (const bf16_t*)(ws + WS_WKV), KVR, KVR, KVR, 0}; pg8::StaticOrder S; S.init(PM / 256, 2048 / 256, G, bid);
              pg8::EpiKV E{(bf16_t*)(ws + WS_KN)}; pg8::gemm_phase(lds, g, S, E); }
            SUNITS(u, MLAH * 4) { const int h = u >> 2; sg::EpiAbsorb E{(bf16_t*)(ws + WS_QDEC), h};
                sg::sgemm_unit(lds, QB + (size_t)PM * QW + h * QHD, QW, (const bf16_t*)(ws + WS_WKUPN) + h * 128, 1024, 128, (u & 3) * 64, E); }
            ew::sq_rope(ws, G, bid);
        }
        SEAM(pb + 2);
        if (EN(8) && IN(pb + 3)) for (int rep = 0; rep < NREP(8, j == 0); ++rep) { if (rep) xcd_barrier(bar);
            PHASE_PTRS
            for (int rep2 = 0; rep2 < NREP(13, j == 0); ++rep2)
            for (int u = bid; u < PB * MLAH * 4; u += G) { const int b = u >> 5, h = (u >> 2) & 7, xp = u & 3;
#pragma unroll 1
                for (int s = 0; s < 2; ++s) { const int x = s == 0 ? 7 - xp : xp; const size_t b0 = (size_t)b * PT, r0 = b0 + 256 * x;
                    att::attn_body<192, true, 1, QW, 1024>(QB + r0 * QW + h * QHD, (const bf16_t*)(ws + WS_KN) + b0 * 1024 + h * 128, (const bf16_t*)(ws + WS_VV) + b0 * 1024 + h * 128,
                        (const bf16_t*)(ws + WS_KROPEB) + b0 * ROPE, (const f32x2*)(ws + WS_ROPE) + (size_t)(256 * x) * 32, Z + r0 * LDZ + ZB_GT + h * 128, MX + r0 * OUTW + h * 128, 4 * (x + 1), 4 * x, lds);
                    __syncthreads(); } }
            for (int rep3 = 0; rep3 < NREP(14, j == 0); ++rep3)
            for (int u = bid; u < SB * 8; u += G) { const int b = u >> 3, ch = u & 7;
                dec::decode_unit((const bf16_t*)(ws + WS_QDEC) + (size_t)b * 32 * 320, in[3], in[4], (const int*)in[7] + b * NPAGES + ch * 16,
                                 (float*)(ws + WS_OPART) + ((size_t)b * 8 + ch) * 32 * 256, (float*)(ws + WS_ML) + ((size_t)b * 8 + ch) * 32 * 2, lds);
                __syncthreads(); }
        }
        SEAM(pb + 3);
        if (EN(9) && IN(pb + 4)) for (int rep = 0; rep < NREP(9, j == 0); ++rep) { if (rep) xcd_barrier(bar);
            PHASE_PTRS
            const int ct = ew::otid();
            for (int w = bid * 8 + (ct >> 6); w < SB * 32; w += G * 8)
                dec::combine_row(w >> 5, w & 31, ct & 63, (const bf16_t*)(ws + WS_QDEC), (const float*)(ws + WS_OPART), (const float*)(ws + WS_ML), out + O_CKVS, out + O_KRS, (bf16_t*)(ws + WS_OLAT));
        }
        SEAM(pb + 4);
        if (EN(10) && IN(pb + 5)) for (int rep = 0; rep < NREP(10, j == 0); ++rep) { if (rep) xcd_barrier(bar);
            PHASE_PTRS
            SUNITS(u, MLAH * 2) { const int h = u >> 1; sg::EpiVup E{Z, MX, h};
                sg::sgemm_unit(lds, (const bf16_t*)(ws + WS_OLAT) + h * 256, 2048, (const bf16_t*)(ws + WS_WKV) + ((size_t)1024 + h * 128) * 256, 256, 256, (u & 1) * 64, E); }
        }
        SEAM(pb + 5);
        if (EN(11) && IN(pb + 6)) {
            PHASE_PTRS
            { pg8::Gemm g{MX, (const bf16_t*)(ws + WS_WOUT) + (size_t)l * DM * OUTW, OUTW, OUTW, OUTW, 0}; pg8::StaticOrder S; S.init(PM / 256, DM / 256, G, bid);
              pg8::EpiOut E{XR, XR, XB, ssp}; pg8::gemm_phase(lds, g, S, E); }
            SUNITS(u, DM / 64) { sg::EpiOut E{XR + (size_t)PM * DM, XR, XB, ssps};
                sg::sgemm_unit(lds, MX + (size_t)PM * OUTW, OUTW, (const bf16_t*)(ws + WS_WOUT) + (size_t)l * DM * OUTW, OUTW, OUTW, u * 64, E); }
        }
        SEAM(pb + 6);
    }
    if (EN(12) && IN(23)) for (int rep = 0; rep < NREP(12, true); ++rep) { if (rep) xcd_barrier(bar); PHASE_PTRS ew::final_norm(in, out, ws, G, bid); }
#undef IN
#undef SEAM
#undef SUNITS
}

#ifndef MK_LAUNCHES
#define MK_LAUNCHES 1
#endif
extern "C" void kernel_launch(void* const* d_in, const int* in_sizes, int n_in, void* d_out, int out_size, void* d_ws, size_t ws_size, hipStream_t stream) {
    static int grid = 0;
    if (grid == 0) {
        if (n_in != 26 || (size_t)out_size != O_END || ws_size < WS_END) { fprintf(stderr, "kernel_launch: unexpected shapes: n_in %d out %d ws %zu (need out %zu ws %zu)\n", n_in, out_size, ws_size, (size_t)O_END, (size_t)WS_END); grid = -1; return; }
        int dev = 0, cus = 0, per_cu = 0;
        if (hipGetDevice(&dev) != hipSuccess || hipDeviceGetAttribute(&cus, hipDeviceAttributeMultiprocessorCount, dev) != hipSuccess) { grid = -1; return; }
        if (hipFuncSetAttribute((const void*)yoco_fwd, hipFuncAttributeMaxDynamicSharedMemorySize, LDS_BYTES) != hipSuccess) { fprintf(stderr, "kernel_launch: hipFuncSetAttribute failed\n"); grid = -1; return; }
        if (hipOccupancyMaxActiveBlocksPerMultiprocessor(&per_cu, (const void*)yoco_fwd, 512, LDS_BYTES) != hipSuccess || per_cu < 1) { fprintf(stderr, "kernel_launch: occupancy query says %d blocks per CU\n", per_cu); (void)hipGetLastError(); grid = -1; return; }
        grid = cus;
    }
    if (grid < 0) return;
    (void)hipMemsetAsync((char*)d_ws + WS_CTL, 0, CTL_BYTES, stream);
    Params p{};
    for (int i = 0; i < 26; ++i) p.in[i] = (const float*)d_in[i];
    p.out = (float*)d_out; p.ws = (uchar*)d_ws;
    if (MK_LAUNCHES == 1) { p.ph_lo = 0; p.ph_hi = NPHASE; hipLaunchKernelGGL(yoco_fwd, dim3(grid), dim3(512), LDS_BYTES, stream, p); }
    else for (int k = 0; k < NPHASE; ++k) { p.ph_lo = k; p.ph_hi = k + 1; hipLaunchKernelGGL(yoco_fwd, dim3(grid), dim3(512), LDS_BYTES, stream, p); }
    const hipError_t le = hipPeekAtLastError();
    if (le != hipSuccess) fprintf(stderr, "kernel_launch: launch failed: %s\n", hipGetErrorName(le));
}
```

```cpp
#include <hip/hip_runtime.h>
#include <cstdio>
#include <cstdint>

#define LAS __attribute__((address_space(3)))
typedef unsigned char uchar;
typedef unsigned short bf16_t;
typedef short bf16x8 __attribute__((ext_vector_type(8)));
typedef short s16x4 __attribute__((ext_vector_type(4)));
typedef float f32x2 __attribute__((ext_vector_type(2)));
typedef float f32x4 __attribute__((ext_vector_type(4)));
typedef float f32x16 __attribute__((ext_vector_type(16)));
typedef unsigned u32x2 __attribute__((ext_vector_type(2)));
typedef unsigned u32x4 __attribute__((ext_vector_type(4)));

constexpr int DM = 1024, PB = 8, PT = 2048, PM = PB * PT, SB = 32, ST = 4, SM = SB * ST, RP = 16640;
constexpr int KVR = 256, ROPE = 64, NOPE = 128, QRANK = 384, MLAH = 8, QHD = 192, QW = MLAH * QHD;
constexpr int MEMT = 256, MEMH = 4, MEMW = 512;
constexpr int INA = 3072, INB = 2432, OUTW = 1536, LDZ = 3072, NB2 = 2816, NB3 = 2560;
constexpr int NPAGES = 128, PAGE = 128, PAST = 16384, POOLBUF = 15;
constexpr float EPS = 1e-6f;
constexpr int ZA_U = 0, ZA_GT = 1024, ZA_QM = 2048, ZA_GM = 2560;
constexpr int ZB_CQ = 0, ZB_KR = 384, ZB_GT = 512, ZB_QM = 1536, ZB_GM = 2048, ZB_KV = 2560;

constexpr size_t O_YP = 0, O_YS = O_YP + (size_t)PM * DM, O_PSP = O_YS + (size_t)SM * DM, O_PSS = O_PSP + (size_t)2 * PB * 15 * DM, O_CKVP = O_PSS + (size_t)2 * SB * 15 * DM,
                 O_KRP = O_CKVP + (size_t)PM * KVR, O_CKVS = O_KRP + (size_t)PM * ROPE, O_KRS = O_CKVS + (size_t)SM * KVR, O_MEMK = O_KRS + (size_t)SM * ROPE,
                 O_MEMV = O_MEMK + (size_t)4 * PB * MEMT * MEMW, O_END = O_MEMV + (size_t)4 * PB * MEMT * MEMW;

constexpr size_t al256(size_t x) { return (x + 255) / 256 * 256; }
constexpr size_t WS_CTL = 0, CTL_BYTES = 65536;
constexpr size_t WS_ROPE = WS_CTL + CTL_BYTES;
constexpr size_t WS_WINA = al256(WS_ROPE + (size_t)2052 * 32 * 8);
constexpr size_t WS_WGRP = al256(WS_WINA + (size_t)2 * INA * DM * 2);
constexpr size_t WS_WINB = al256(WS_WGRP + (size_t)2 * 4 * 256 * 256 * 2);
constexpr size_t WS_WQUP = al256(WS_WINB + (size_t)2 * NB2 * DM * 2);
constexpr size_t WS_WKV  = al256(WS_WQUP + (size_t)2 * QW * QRANK * 2);
constexpr size_t WS_WKUPN = al256(WS_WKV + (size_t)2048 * 256 * 2);
constexpr size_t WS_WMEM = al256(WS_WKUPN + (size_t)256 * 1024 * 2);
constexpr size_t WS_WOUT = al256(WS_WMEM + (size_t)4096 * 1024 * 2);
constexpr size_t WS_MHAT = al256(WS_WOUT + (size_t)4 * DM * OUTW * 2);
constexpr size_t WS_MEMB = al256(WS_MHAT + (size_t)2048 * 1024 * 2);
constexpr size_t WS_XRES = al256(WS_MEMB + (size_t)2048 * 4096 * 2);
constexpr size_t WS_XB   = al256(WS_XRES + (size_t)RP * DM * 4);
constexpr size_t WS_SSP  = al256(WS_XB + (size_t)RP * DM * 2);
constexpr size_t WS_SSPS = al256(WS_SSP + (size_t)PM * 16 * 4);
constexpr size_t WS_SSQ  = al256(WS_SSPS + (size_t)SM * 32 * 4);
constexpr size_t WS_Z    = al256(WS_SSQ + (size_t)RP * 12 * 4);
constexpr size_t WS_POOLED = al256(WS_Z + (size_t)RP * LDZ * 2);
constexpr size_t WS_MIXED = al256(WS_POOLED + (size_t)RP * DM * 2);
constexpr size_t WS_Q    = al256(WS_MIXED + (size_t)RP * OUTW * 2);
constexpr size_t WS_KVRAW = al256(WS_Q + (size_t)RP * QW * 2);
constexpr size_t WS_CKVB = al256(WS_KVRAW + (size_t)RP * 320 * 4);
constexpr size_t WS_KROPEB = al256(WS_CKVB + (size_t)RP * 256 * 2);
constexpr size_t WS_KN   = al256(WS_KROPEB + (size_t)RP * 64 * 2);
constexpr size_t WS_VV   = al256(WS_KN + (size_t)PM * 1024 * 2);
constexpr size_t WS_QDEC = al256(WS_VV + (size_t)PM * 1024 * 2);
constexpr size_t WS_OPART = al256(WS_QDEC + (size_t)SB * 32 * 320 * 2);
constexpr size_t WS_ML   = al256(WS_OPART + (size_t)SB * 8 * 32 * 256 * 4);
constexpr size_t WS_OLAT = al256(WS_ML + (size_t)SB * 8 * 32 * 2 * 4);
constexpr size_t WS_END  = al256(WS_OLAT + (size_t)SM * 2048 * 2);

__device__ __forceinline__ unsigned cvt_pk_bf16(float lo, float hi) { unsigned r; asm volatile("v_cvt_pk_bf16_f32 %0, %1, %2" : "=v"(r) : "v"(lo), "v"(hi)); return r; }
__device__ __forceinline__ float bf_lo(unsigned w) { return __uint_as_float(w << 16); }
__device__ __forceinline__ float bf_hi(unsigned w) { return __uint_as_float(w & 0xffff0000u); }
__device__ __forceinline__ float bf2f(bf16_t b) { return __uint_as_float(((unsigned)b) << 16); }
__device__ __forceinline__ float silu(float x) { return x * __builtin_amdgcn_rcpf(1.0f + __expf(-x)); }
__device__ __forceinline__ void unpack8(const u32x4 w, float (&f)[8]) {
    f[0] = bf_lo(w.x); f[1] = bf_hi(w.x); f[2] = bf_lo(w.y); f[3] = bf_hi(w.y); f[4] = bf_lo(w.z); f[5] = bf_hi(w.z); f[6] = bf_lo(w.w); f[7] = bf_hi(w.w); }
__device__ __forceinline__ u32x4 pack8(const float (&f)[8]) { u32x4 w; w.x = cvt_pk_bf16(f[0], f[1]); w.y = cvt_pk_bf16(f[2], f[3]); w.z = cvt_pk_bf16(f[4], f[5]); w.w = cvt_pk_bf16(f[6], f[7]); return w; }
__device__ __forceinline__ float sum4(const f32x4 a) { return (a[0] + a[1]) + (a[2] + a[3]); }
__device__ __forceinline__ float rs_from16(const float* p) {
    const f32x4 a = *(const f32x4*)p, b = *(const f32x4*)(p + 4), c = *(const f32x4*)(p + 8), d = *(const f32x4*)(p + 12);
    return rsqrtf(((sum4(a) + sum4(b)) + (sum4(c) + sum4(d))) * (1.0f / 1024.0f) + EPS); }
__device__ __forceinline__ float rs_from32(const float* p) { float s = 0.f;
#pragma unroll
    for (int i = 0; i < 8; ++i) s += sum4(*(const f32x4*)(p + 4 * i));
    return rsqrtf(s * (1.0f / 1024.0f) + EPS); }
__device__ __forceinline__ float rsq_from12(const float* p) {
    const f32x4 a = *(const f32x4*)p, b = *(const f32x4*)(p + 4), c = *(const f32x4*)(p + 8);
    return rsqrtf((sum4(a) + sum4(b) + sum4(c)) * (1.0f / 384.0f) + EPS); }
__device__ __forceinline__ int crow(int r, int hi) { return (r & 3) + 8 * (r >> 2) + 4 * hi; }
static_assert(WS_VV == WS_KN + (size_t)PM * 1024 * 2, "VV must follow KN");
namespace pg8 {
constexpr int BM = 256, BK = 64, HALF = 128, HTB = HALF * BK * 2, STAGE_BYTES = 8 * HTB, NXCD = 8, WGM = 8;
__device__ __forceinline__ int lds_byte(int r, int c) { const int st = (r >> 4) * 2 + (c >> 5), rr = r & 15, cc = c & 31, ob = rr * 64 + cc * 2; return st * 1024 + (ob ^ (((ob >> 9) & 1) << 5)); }
__device__ __forceinline__ void stage_rc(int b, int& R, int& C) { const int st = b / 1024, sb = b % 1024, swz = sb ^ (((sb >> 9) & 1) << 5); R = (st >> 1) * 16 + swz / 64; C = (st & 1) * 32 + (swz % 64) / 2; }
__device__ __forceinline__ int perm32(int rho) { const int n = rho >> 4, i = rho & 15; return 8 * (i >> 2) + 4 * n + (i & 3); }

struct Unit { int pm, pn; };
struct Gemm { const bf16_t* A; const bf16_t* Bt; int lda, ldb, K, a_pn; };

struct StaticOrder {
    int nM, nN, nwg, G, c;
    __device__ void init(int nM_, int nN_, int G_, int c_) { nM = nM_; nN = nN_; nwg = nM * nN; G = G_; c = c_; }
    __device__ bool next(int i, Unit& u) const {
        const long L = (long)i * G + c; if (L >= nwg) return false;
        int wgid = (int)L; { const int q = nwg / NXCD, r = nwg % NXCD, xcd = wgid % NXCD, off = wgid / NXCD; wgid = (xcd < r ? xcd * (q + 1) : r * (q + 1) + (xcd - r) * q) + off; }
        const int nig = WGM * nN, gid = wgid / nig, fm = gid * WGM, gsz = (nM - fm) < WGM ? (nM - fm) : WGM;
        u.pm = fm + ((wgid % nig) % gsz); u.pn = (wgid % nig) / gsz; return true;
    }
};

template <class Epi>
__device__ __forceinline__ void gemm_phase(LAS uchar* lds, const Gemm g, const StaticOrder& S, const Epi& E) {
    int tid_ = threadIdx.x; asm volatile("" : "+v"(tid_));
    const int tid = tid_, wid = __builtin_amdgcn_readfirstlane(tid >> 6), lane = tid & 63, wr = wid >> 2, wc = wid & 3, fr = lane & 15, fq = lane >> 4;
    int K_ = g.K; asm volatile("" : "+s"(K_));
    const int K = K_, nt = K / BK;
    unsigned voffA[2], voffB[2];
#pragma unroll
    for (int i = 0; i < 2; ++i) { int R, C; stage_rc(tid * 16 + i * 8192, R, C); const int Rb = Epi::PERM ? ((R & ~31) + perm32(R & 31)) : R;
        voffA[i] = (unsigned)(R * g.lda + C) * 2u; voffB[i] = (unsigned)(Rb * g.ldb + C) * 2u; }
    const size_t kstep = (size_t)(BK * 2);
    const size_t hstepA = (size_t)HALF * g.lda * 2, hstepB = (size_t)HALF * g.ldb * 2;
    const size_t tstepA = 2 * hstepA, tstepB = 2 * hstepB;
    const unsigned ldsw = (unsigned)wid * 1024u;
    const int aoff = lds_byte(wr * 64 + fr, fq * 8), boff = lds_byte(wc * 32 + fr, fq * 8);
#define PG8_SA(b, h) (((b) * 2 + (h)) * HTB)
#define PG8_SB(b, h) ((4 + (b) * 2 + (h)) * HTB)
#define PG8_STAGE(bufoff, gbase, voff) do { _Pragma("unroll") for (int _i = 0; _i < 2; ++_i) \
        __builtin_amdgcn_global_load_lds((const unsigned*)((const char*)(gbase) + (voff)[_i]), (LAS unsigned*)(lds + (bufoff) + ldsw + _i * 8192), 16, 0, 0); } while (0)
#define PG8_LDA(dst, b, h) do { _Pragma("unroll") for (int m = 0; m < 4; ++m) _Pragma("unroll") for (int k = 0; k < 2; ++k) dst[m][k] = *(const LAS bf16x8*)(lds + PG8_SA(b, h) + aoff + m * 2048 + k * 1024); } while (0)
#define PG8_LDB(dst, b, h) do { _Pragma("unroll") for (int n = 0; n < 2; ++n) _Pragma("unroll") for (int k = 0; k < 2; ++k) dst[n][k] = *(const LAS bf16x8*)(lds + PG8_SB(b, h) + boff + n * 2048 + k * 1024); } while (0)
#define PG8_MMA(ai, bj, At, Bt) do { __builtin_amdgcn_s_setprio(1); _Pragma("unroll") for (int m = 0; m < 4; ++m) _Pragma("unroll") for (int n = 0; n < 2; ++n) _Pragma("unroll") for (int k = 0; k < 2; ++k) \
        acc[ai][bj][m][n] = __builtin_amdgcn_mfma_f32_16x16x32_bf16(Bt[n][k], At[m][k], acc[ai][bj][m][n], 0, 0, 0); __builtin_amdgcn_s_setprio(0); } while (0)
#define PG8_WAIT_V(n) asm volatile("s_waitcnt vmcnt(" #n ")" ::: "memory")
#define PG8_WAIT_L(n) asm volatile("s_waitcnt lgkmcnt(" #n ")" ::: "memory")
#define PG8_BAR __builtin_amdgcn_s_barrier()
#define PG8_SCHED __builtin_amdgcn_sched_barrier(0)
    Unit cur, nxt; int ui = 0;
    if (!S.next(0, cur)) return;
    f32x4 acc[2][2][4][2];
#pragma unroll
    for (int a = 0; a < 2; ++a)
#pragma unroll
        for (int b = 0; b < 2; ++b)
#pragma unroll
            for (int m = 0; m < 4; ++m)
#pragma unroll
                for (int n = 0; n < 2; ++n) acc[a][b][m][n] = (f32x4){0.f, 0.f, 0.f, 0.f};
    bf16x8 At[4][2], B0[2][2], B1[2][2];
    const char* cA = (const char*)g.A + (size_t)cur.pm * tstepA + (size_t)cur.pn * g.a_pn * 2; const char* cB = (const char*)g.Bt + (size_t)cur.pn * tstepB;
    PG8_STAGE(PG8_SB(0, 0), cB, voffB); PG8_STAGE(PG8_SA(0, 0), cA, voffA); PG8_STAGE(PG8_SB(0, 1), cB + hstepB, voffB); PG8_STAGE(PG8_SA(0, 1), cA + hstepA, voffA);
    if (wr == 1) PG8_BAR;
    PG8_WAIT_V(4); PG8_BAR;
    PG8_STAGE(PG8_SB(1, 0), cB + kstep, voffB); PG8_STAGE(PG8_SA(1, 0), cA + kstep, voffA); PG8_STAGE(PG8_SB(1, 1), cB + hstepB + kstep, voffB);
    PG8_WAIT_V(6); PG8_BAR;
    for (;;) {
        const bool has_next = S.next(ui + 1, nxt);
        const char* nA = has_next ? (const char*)g.A + (size_t)nxt.pm * tstepA + (size_t)nxt.pn * g.a_pn * 2 : cA; const char* nB = has_next ? (const char*)g.Bt + (size_t)nxt.pn * tstepB : cB;
        for (int t = 0; t < nt; t += 2) {
            const bool last = (t == nt - 2);
            const char* a1 = cA + (size_t)(t + 1) * kstep;
            const char* a2 = last ? nA : cA + (size_t)(t + 2) * kstep; const char* b2 = last ? nB : cB + (size_t)(t + 2) * kstep;
            const char* a3 = a2 + kstep; const char* b3 = b2 + kstep;
            PG8_LDB(B0, 0, 0); PG8_SCHED; PG8_LDA(At, 0, 0); PG8_STAGE(PG8_SA(1, 1), a1 + hstepA, voffA);
            PG8_WAIT_L(8); PG8_BAR; PG8_WAIT_L(0); PG8_MMA(0, 0, At, B0); PG8_BAR; PG8_SCHED;
            PG8_LDB(B1, 0, 1); PG8_STAGE(PG8_SB(0, 0), b2, voffB);
            PG8_BAR; PG8_WAIT_L(0); PG8_MMA(0, 1, At, B1); PG8_BAR;
            PG8_LDA(At, 0, 1); PG8_STAGE(PG8_SA(0, 0), a2, voffA);
            PG8_BAR; PG8_WAIT_L(0); PG8_MMA(1, 0, At, B0); PG8_BAR; PG8_SCHED;
            PG8_STAGE(PG8_SB(0, 1), b2 + hstepB, voffB);
            PG8_WAIT_V(6); PG8_BAR; PG8_MMA(1, 1, At, B1); PG8_BAR;
            PG8_LDB(B0, 1, 0); PG8_SCHED; PG8_LDA(At, 1, 0); PG8_STAGE(PG8_SA(0, 1), a2 + hstepA, voffA);
            PG8_WAIT_L(8); PG8_BAR; PG8_WAIT_L(0); PG8_MMA(0, 0, At, B0); PG8_BAR; PG8_SCHED;
            PG8_LDB(B1, 1, 1); PG8_STAGE(PG8_SB(1, 0), b3, voffB);
            PG8_BAR; PG8_WAIT_L(0); PG8_MMA(0, 1, At, B1); PG8_BAR;
            PG8_LDA(At, 1, 1); PG8_STAGE(PG8_SA(1, 0), a3, voffA);
            PG8_BAR; PG8_WAIT_L(0); PG8_MMA(1, 0, At, B0); PG8_BAR; PG8_SCHED;
            PG8_STAGE(PG8_SB(1, 1), b3 + hstepB, voffB);
            PG8_WAIT_V(6); PG8_BAR; PG8_MMA(1, 1, At, B1); PG8_BAR;
        }
        E(acc, cur, wr, wc, fr, fq);
        if (!has_next) break;
#pragma unroll
        for (int a = 0; a < 2; ++a)
#pragma unroll
            for (int b = 0; b < 2; ++b)
#pragma unroll
                for (int m = 0; m < 4; ++m)
#pragma unroll
                    for (int n = 0; n < 2; ++n) acc[a][b][m][n] = (f32x4){0.f, 0.f, 0.f, 0.f};
        cur = nxt; cA = nA; cB = nB; ++ui;
    }
    PG8_WAIT_V(0);
    if (wr == 0) PG8_BAR;
    PG8_BAR;
#undef PG8_SA
#undef PG8_SB
#undef PG8_STAGE
#undef PG8_LDA
#undef PG8_LDB
#undef PG8_MMA
#undef PG8_WAIT_V
#undef PG8_WAIT_L
#undef PG8_BAR
#undef PG8_SCHED
}

typedef f32x4 Acc[2][2][4][2];
struct EpiZ { static constexpr bool PERM = true;
    bf16_t* Z; const float* ssp; float* ssq; float* kvraw;
    __device__ __forceinline__ void operator()(const Acc& acc, const Unit& u, int wr, int wc, int fr, int fq) const {
        const int rbase = u.pm * BM + wr * 64 + fr, col0 = u.pn * BM + wc * 32 + 8 * fq;
        const bool kvt = (kvraw != nullptr) && u.pn == 10, wantq = (ssq != nullptr) && u.pn <= 1;
#pragma unroll
        for (int ai = 0; ai < 2; ++ai)
#pragma unroll
            for (int m = 0; m < 4; ++m) { const int row = rbase + ai * HALF + m * 16; const float rs = rs_from16(ssp + (size_t)row * 16);
#pragma unroll
                for (int bj = 0; bj < 2; ++bj) { const f32x4 v0 = acc[ai][bj][m][0] * rs, v1 = acc[ai][bj][m][1] * rs; const int c = col0 + bj * HALF;
                    if (!kvt) { u32x4 w; w.x = cvt_pk_bf16(v0[0], v0[1]); w.y = cvt_pk_bf16(v0[2], v0[3]); w.z = cvt_pk_bf16(v1[0], v1[1]); w.w = cvt_pk_bf16(v1[2], v1[3]);
                        *(u32x4*)(Z + (size_t)row * LDZ + c) = w; }
                    else { float* p = kvraw + (size_t)row * 320 + (c - ZB_KV); *(f32x4*)p = v0; *(f32x4*)(p + 4) = v1; }
                    if (kvraw != nullptr && u.pn == 1 && bj == 1 && wc < 2) { float* p = kvraw + (size_t)row * 320 + 256 + (c - ZB_KR); *(f32x4*)p = v0; *(f32x4*)(p + 4) = v1; }
                    if (wantq && (u.pn == 0 || bj == 0)) { float s = sum4(v0 * v0) + sum4(v1 * v1); s += __shfl_xor(s, 16); s += __shfl_xor(s, 32);
                        if (fq == 0) ssq[(size_t)row * 12 + (u.pn == 0 ? bj * 4 + wc : 8 + wc)] = s; } } }
    }
};
struct EpiGrp { static constexpr bool PERM = true;
    const bf16_t* Z; bf16_t* MX;
    __device__ __forceinline__ void operator()(const Acc& acc, const Unit& u, int wr, int wc, int fr, int fq) const {
        const int rbase = u.pm * BM + wr * 64 + fr, col0 = u.pn * BM + wc * 32 + 8 * fq;
#pragma unroll
        for (int ai = 0; ai < 2; ++ai)
#pragma unroll
            for (int m = 0; m < 4; ++m) { const int row = rbase + ai * HALF + m * 16;
                const u32x4 g0 = *(const u32x4*)(Z + (size_t)row * LDZ + ZA_GT + col0), g1 = *(const u32x4*)(Z + (size_t)row * LDZ + ZA_GT + col0 + HALF);
#pragma unroll
                for (int bj = 0; bj < 2; ++bj) { const int c = col0 + bj * HALF; float gt[8]; unpack8(bj ? g1 : g0, gt);
                    const f32x4 v0 = acc[ai][bj][m][0], v1 = acc[ai][bj][m][1]; float o[8];
#pragma unroll
                    for (int j = 0; j < 4; ++j) { o[j] = v0[j] * silu(gt[j]); o[4 + j] = v1[j] * silu(gt[4 + j]); }
                    *(u32x4*)(MX + (size_t)row * OUTW + c) = pack8(o); }
                asm volatile("" ::: "memory"); }
    }
};
struct EpiQ { static constexpr bool PERM = true;
    bf16_t* Q; const float* ssq;
    __device__ __forceinline__ void operator()(const Acc& acc, const Unit& u, int wr, int wc, int fr, int fq) const {
        const int rbase = u.pm * BM + wr * 64 + fr, col0 = u.pn * BM + wc * 32 + 8 * fq;
#pragma unroll
        for (int ai = 0; ai < 2; ++ai)
#pragma unroll
            for (int m = 0; m < 4; ++m) { const int row = rbase + ai * HALF + m * 16; const float rs = rsq_from12(ssq + (size_t)row * 12);
#pragma unroll
                for (int bj = 0; bj < 2; ++bj) { const f32x4 v0 = acc[ai][bj][m][0] * rs, v1 = acc[ai][bj][m][1] * rs;
                    u32x4 w; w.x = cvt_pk_bf16(v0[0], v0[1]); w.y = cvt_pk_bf16(v0[2], v0[3]); w.z = cvt_pk_bf16(v1[0], v1[1]); w.w = cvt_pk_bf16(v1[2], v1[3]);
                    *(u32x4*)(Q + (size_t)row * QW + col0 + bj * HALF) = w; } }
    }
};
struct EpiKV { static constexpr bool PERM = true;
    bf16_t* KN;
    __device__ __forceinline__ void operator()(const Acc& acc, const Unit& u, int wr, int wc, int fr, int fq) const {
        const int rbase = u.pm * BM + wr * 64 + fr, col0 = (u.pn & 3) * BM + wc * 32 + 8 * fq; bf16_t* O = KN + (size_t)(u.pn >> 2) * ((size_t)PM * 1024);
#pragma unroll
        for (int ai = 0; ai < 2; ++ai)
#pragma unroll
            for (int m = 0; m < 4; ++m) { const int row = rbase + ai * HALF + m * 16;
#pragma unroll
                for (int bj = 0; bj < 2; ++bj) { const f32x4 v0 = acc[ai][bj][m][0], v1 = acc[ai][bj][m][1];
                    u32x4 w; w.x = cvt_pk_bf16(v0[0], v0[1]); w.y = cvt_pk_bf16(v0[2], v0[3]); w.z = cvt_pk_bf16(v1[0], v1[1]); w.w = cvt_pk_bf16(v1[2], v1[3]);
                    *(u32x4*)(O + (size_t)row * 1024 + col0 + bj * HALF) = w; } }
    }
};
struct EpiMem { static constexpr bool PERM = false;
    float* OK; bf16_t* MB;
    __device__ __forceinline__ void operator()(const Acc& acc, const Unit& u, int wr, int wc, int fr, int fq) const {
        const int rbase = u.pm * BM + wr * 64 + fr, col0 = u.pn * BM + wc * 32 + 4 * fq;
#pragma unroll
        for (int ai = 0; ai < 2; ++ai)
#pragma unroll
            for (int m = 0; m < 4; ++m) { const int row = rbase + ai * HALF + m * 16;
#pragma unroll
                for (int bj = 0; bj < 2; ++bj)
#pragma unroll
                    for (int n = 0; n < 2; ++n) { const int c = col0 + bj * HALF + n * 16; const int l = c >> 10, kv = (c >> 9) & 1, cc = c & 511; const f32x4 v = acc[ai][bj][m][n];
                        *(f32x4*)(OK + (size_t)kv * (O_MEMV - O_MEMK) + ((size_t)l * 2048 + row) * 512 + cc) = v;
                        u32x2 w; w.x = cvt_pk_bf16(v[0], v[1]); w.y = cvt_pk_bf16(v[2], v[3]); *(u32x2*)(MB + (size_t)row * 4096 + c) = w; } }
    }
};
struct EpiOut { static constexpr bool PERM = false;
    const float* base; float* XR; bf16_t* XB; float* ssp;
    __device__ __forceinline__ void operator()(const Acc& acc, const Unit& u, int wr, int wc, int fr, int fq) const {
        const int rbase = u.pm * BM + wr * 64 + fr, col0 = u.pn * BM + wc * 32 + 4 * fq;
#pragma unroll
        for (int ai = 0; ai < 2; ++ai)
#pragma unroll
            for (int m = 0; m < 4; ++m) { const int row = rbase + ai * HALF + m * 16; float s = 0.f;
#pragma unroll
                for (int bj = 0; bj < 2; ++bj)
#pragma unroll
                    for (int n = 0; n < 2; ++n) { const size_t o = (size_t)row * DM + col0 + bj * HALF + n * 16; const f32x4 v = *(const f32x4*)(base + o) + acc[ai][bj][m][n];
                        *(f32x4*)(XR + o) = v; u32x2 w; w.x = cvt_pk_bf16(v[0], v[1]); w.y = cvt_pk_bf16(v[2], v[3]); *(u32x2*)(XB + o) = w; s += sum4(v * v); }
                s += __shfl_xor(s, 16); s += __shfl_xor(s, 32);
                if (fq == 0) ssp[(size_t)row * 16 + u.pn * 4 + wc] = s; }
    }
};
}
namespace sg {
constexpr int BUF = 24576, LDS_BYTES = 2 * BUF;
template <class Epi>
__device__ __forceinline__ void sgemm_unit(LAS uchar* lds, const bf16_t* A, int lda, const bf16_t* Bt, int ldb, int K, int n0, const Epi& E) {
    int tid_ = threadIdx.x; asm volatile("" : "+v"(tid_));
    const int tid = tid_, wid = tid >> 6, lane = tid & 63, r32 = lane & 31, hi = lane >> 5, rb = wid & 3, cb = wid >> 2;
    const int srow = tid >> 3, sch = tid & 7;
    const bf16_t* ap0 = A + (size_t)srow * lda + sch * 8; const bf16_t* ap1 = ap0 + (size_t)64 * lda; const bf16_t* bp = Bt + (size_t)(n0 + srow) * ldb + sch * 8;
    const int aw0 = srow * 128 + ((sch ^ (srow & 7)) << 4), aw1 = aw0 + 64 * 128, bw = 16384 + aw0;
    const int arow = rb * 32 + r32, brow = cb * 32 + r32;
    const int ard = arow * 128, brd = 16384 + brow * 128, asw = arow & 7, bsw = brow & 7;
    u32x4 ra0[2], ra1[2], rbv[2];
    f32x16 acc = {};
    const int nk = K / 64;
#define SG_LOAD(s, kt) do { ra0[s] = *(const u32x4*)(ap0 + (size_t)(kt) * 64); ra1[s] = *(const u32x4*)(ap1 + (size_t)(kt) * 64); rbv[s] = *(const u32x4*)(bp + (size_t)(kt) * 64); } while (0)
#define SG_WRITE(s, b) do { *(LAS u32x4*)(lds + (b) * BUF + aw0) = ra0[s]; *(LAS u32x4*)(lds + (b) * BUF + aw1) = ra1[s]; *(LAS u32x4*)(lds + (b) * BUF + bw) = rbv[s]; } while (0)
#define SG_COMPUTE(b) do { _Pragma("unroll") for (int kk = 0; kk < 4; ++kk) { \
        const bf16x8 af = *(const LAS bf16x8*)(lds + (b) * BUF + ard + (((2 * kk + hi) ^ asw) << 4)); \
        const bf16x8 bf = *(const LAS bf16x8*)(lds + (b) * BUF + brd + (((2 * kk + hi) ^ bsw) << 4)); \
        acc = __builtin_amdgcn_mfma_f32_32x32x16_bf16(bf, af, acc, 0, 0, 0); } } while (0)
    SG_LOAD(0, 0); SG_LOAD(1, 1);
    for (int kt = 0; kt < nk; kt += 2) {
        SG_WRITE(0, 0); __syncthreads(); if (kt + 2 < nk) SG_LOAD(0, kt + 2);
        SG_COMPUTE(0);
        SG_WRITE(1, 1); __syncthreads(); if (kt + 3 < nk) SG_LOAD(1, kt + 3);
        SG_COMPUTE(1);
    }
#undef SG_LOAD
#undef SG_WRITE
#undef SG_COMPUTE
    E(acc, rb * 32 + r32, n0 + cb * 32, hi);
}

struct EpiZ { bf16_t* Z; const float* ssps; float* ssq; float* kvraw;
    __device__ __forceinline__ void operator()(const f32x16& acc, int row, int cbase, int hi) const {
        const float rs = rs_from32(ssps + row * 32); const size_t grow = (size_t)PM + row; float s = 0.f;
#pragma unroll
        for (int g = 0; g < 4; ++g) { const f32x4 v = (f32x4){acc[4 * g], acc[4 * g + 1], acc[4 * g + 2], acc[4 * g + 3]} * rs; const int c = cbase + 8 * g + 4 * hi;
            if (kvraw != nullptr && cbase >= ZB_KV) *(f32x4*)(kvraw + grow * 320 + (c - ZB_KV)) = v;
            else { u32x2 w; w.x = cvt_pk_bf16(v[0], v[1]); w.y = cvt_pk_bf16(v[2], v[3]); *(u32x2*)(Z + grow * LDZ + c) = w; }
            if (kvraw != nullptr && cbase >= ZB_KR && cbase < ZB_KR + 64) *(f32x4*)(kvraw + grow * 320 + 256 + (c - ZB_KR)) = v;
            s += sum4(v * v); }
        if (ssq != nullptr && cbase < QRANK) { s += __shfl_xor(s, 32); if (hi == 0) ssq[grow * 12 + (cbase >> 5)] = s; }
    }
};
struct EpiGrp { const bf16_t* Z; bf16_t* MX; int cofs;
    __device__ __forceinline__ void operator()(const f32x16& acc, int row, int cbase, int hi) const {
        const size_t grow = (size_t)PM + row;
#pragma unroll
        for (int g = 0; g < 4; ++g) { const int c = cofs + cbase + 8 * g + 4 * hi; const u32x2 gw = *(const u32x2*)(Z + grow * LDZ + ZA_GT + c);
            const float o0 = acc[4 * g] * silu(bf_lo(gw.x)), o1 = acc[4 * g + 1] * silu(bf_hi(gw.x)), o2 = acc[4 * g + 2] * silu(bf_lo(gw.y)), o3 = acc[4 * g + 3] * silu(bf_hi(gw.y));
            u32x2 w; w.x = cvt_pk_bf16(o0, o1); w.y = cvt_pk_bf16(o2, o3); *(u32x2*)(MX + grow * OUTW + c) = w; }
    }
};
struct EpiOut { const float* base; float* XR; bf16_t* XB; float* ssps;
    __device__ __forceinline__ void operator()(const f32x16& acc, int row, int cbase, int hi) const {
        const size_t grow = (size_t)PM + row; float s = 0.f;
#pragma unroll
        for (int g = 0; g < 4; ++g) { const int c = cbase + 8 * g + 4 * hi; const f32x4 v = *(const f32x4*)(base + (size_t)row * DM + c) + (f32x4){acc[4 * g], acc[4 * g + 1], acc[4 * g + 2], acc[4 * g + 3]};
            *(f32x4*)(XR + grow * DM + c) = v; u32x2 w; w.x = cvt_pk_bf16(v[0], v[1]); w.y = cvt_pk_bf16(v[2], v[3]); *(u32x2*)(XB + grow * DM + c) = w; s += sum4(v * v); }
        s += __shfl_xor(s, 32); if (hi == 0) ssps[row * 32 + (cbase >> 5)] = s;
    }
};
struct EpiQ { bf16_t* Q; const float* ssq;
    __device__ __forceinline__ void operator()(const f32x16& acc, int row, int cbase, int hi) const {
        const size_t grow = (size_t)PM + row; const float rs = rsq_from12(ssq + grow * 12);
#pragma unroll
        for (int g = 0; g < 4; ++g) { const int c = cbase + 8 * g + 4 * hi; u32x2 w; w.x = cvt_pk_bf16(acc[4 * g] * rs, acc[4 * g + 1] * rs); w.y = cvt_pk_bf16(acc[4 * g + 2] * rs, acc[4 * g + 3] * rs);
            *(u32x2*)(Q + grow * QW + c) = w; }
    }
};
struct EpiAbsorb { bf16_t* QD; int h;
    __device__ __forceinline__ void operator()(const f32x16& acc, int row, int cbase, int hi) const {
        const int b = row >> 2, t = row & 3; bf16_t* o = QD + ((size_t)b * 32 + t * 8 + h) * 320;
#pragma unroll
        for (int g = 0; g < 4; ++g) { const int c = cbase + 8 * g + 4 * hi; u32x2 w; w.x = cvt_pk_bf16(acc[4 * g], acc[4 * g + 1]); w.y = cvt_pk_bf16(acc[4 * g + 2], acc[4 * g + 3]); *(u32x2*)(o + c) = w; }
    }
};
struct EpiVup { const bf16_t* Z; bf16_t* MX; int h;
    __device__ __forceinline__ void operator()(const f32x16& acc, int row, int cbase, int hi) const {
        const size_t grow = (size_t)PM + row;
#pragma unroll
        for (int g = 0; g < 4; ++g) { const int c = h * 128 + cbase + 8 * g + 4 * hi; const u32x2 gw = *(const u32x2*)(Z + grow * LDZ + ZB_GT + c);
            const float o0 = acc[4 * g] * silu(bf_lo(gw.x)), o1 = acc[4 * g + 1] * silu(bf_hi(gw.x)), o2 = acc[4 * g + 2] * silu(bf_lo(gw.y)), o3 = acc[4 * g + 3] * silu(bf_hi(gw.y));
            u32x2 w; w.x = cvt_pk_bf16(o0, o1); w.y = cvt_pk_bf16(o2, o3); *(u32x2*)(MX + grow * OUTW + c) = w; }
    }
};
}
namespace att {
constexpr int NW = 8, QBLK = 32, KVBLK = 64;
constexpr int SHM_V = KVBLK * 128 * 2, SHM_K = KVBLK * 128 * 2, SHM_KR = KVBLK * 64 * 2;
constexpr int OFF_V = 0, OFF_K = 2 * SHM_V, OFF_KR = OFF_K + 2 * SHM_K, OFF_WS = OFF_KR + 2 * SHM_KR, OFF_QR = OFF_WS + NW * 64 * 4, LDS_BYTES = OFF_QR + NW * 4096;
constexpr float THR = 8.f;
#define KSWZ(row, colB) ((row) * 256 + ((colB) ^ (((row) & 7) << 4)))
#define KRSWZ(row, colB) ((row) * 128 + ((colB) ^ (((row) & 7) << 4)))
#define SBAR() __builtin_amdgcn_sched_barrier(0)
template <int DQK> struct Cst { static constexpr float SCALE = (DQK == 128) ? 0.08838834764831845f : 0.07216878364870322f; };

template <int DQK>
__device__ __forceinline__ void partialSM(f32x16& p0, f32x16& p1, float& m_reg, float& mn, float& alpha) {
    constexpr float SCALE = Cst<DQK>::SCALE, C = SCALE * 1.4426950408889634f;
    float pmax = p0[0];
#pragma unroll
    for (int r = 1; r < 16; ++r) pmax = fmaxf(pmax, p0[r]);
#pragma unroll
    for (int r = 0; r < 16; ++r) pmax = fmaxf(pmax, p1[r]);
    { auto rr = __builtin_amdgcn_permlane32_swap(__float_as_uint(pmax), __float_as_uint(pmax), false, false);
      pmax = fmaxf(__uint_as_float(rr[0]), __uint_as_float(rr[1])); }
    if (__builtin_expect(__all(pmax - m_reg <= THR / SCALE), 1)) { mn = m_reg; alpha = 1.f; }
    else { mn = fmaxf(m_reg, pmax); alpha = __builtin_amdgcn_exp2f((m_reg - mn) * C); m_reg = mn; }
    const float mnC = -mn * C;
#pragma unroll
    for (int r = 0; r < 16; ++r) p0[r] = fmaf(p0[r], C, mnC);
#pragma unroll
    for (int r = 0; r < 16; ++r) p1[r] = fmaf(p1[r], C, mnC);
#pragma unroll
    for (int r = 0; r < 16; ++r) p0[r] = __builtin_amdgcn_exp2f(p0[r]);
}
__device__ __forceinline__ void finishSM(f32x16& p0, f32x16& p1, float alpha, float& l_reg, bf16x8& pa0, bf16x8& pa1, bf16x8& pa2, bf16x8& pa3) {
#pragma unroll
    for (int r = 0; r < 16; ++r) p1[r] = __builtin_amdgcn_exp2f(p1[r]);
    float ps = 0;
#pragma unroll
    for (int r = 0; r < 16; ++r) ps += p0[r];
#pragma unroll
    for (int r = 0; r < 16; ++r) ps += p1[r];
    { auto rr = __builtin_amdgcn_permlane32_swap(__float_as_uint(ps), __float_as_uint(ps), false, false);
      ps = __uint_as_float(rr[0]) + __uint_as_float(rr[1]); }
    l_reg = l_reg * alpha + ps;
#define PK4(P, BASE, OUT) do { unsigned a0 = cvt_pk_bf16(P[BASE + 0], P[BASE + 1]), a1 = cvt_pk_bf16(P[BASE + 2], P[BASE + 3]);   \
    unsigned b0 = cvt_pk_bf16(P[BASE + 4], P[BASE + 5]), b1 = cvt_pk_bf16(P[BASE + 6], P[BASE + 7]);                              \
    auto r0 = __builtin_amdgcn_permlane32_swap(a0, b0, false, false); auto r1 = __builtin_amdgcn_permlane32_swap(a1, b1, false, false); \
    u32x4 w = {r0[0], r1[0], r0[1], r1[1]}; OUT = *reinterpret_cast<bf16x8*>(&w); } while (0)
    PK4(p0, 0, pa0); PK4(p0, 8, pa1); PK4(p1, 0, pa2); PK4(p1, 8, pa3);
#undef PK4
}
template <int DQK>
__device__ __forceinline__ void qkt(f32x16& p0, f32x16& p1, const LAS uchar* Ks, const LAS uchar* Krs, const bf16x8* qr, const LAS uchar* qrl  , int r32, int hi) {
    p0 = f32x16{}; p1 = f32x16{};
#pragma unroll
    for (int d0 = 0; d0 < 8; ++d0) { const int cb = (d0 * 16 + hi * 8) * 2;
        const bf16x8 b0 = *(const LAS bf16x8*)(Ks + KSWZ(r32, cb));
        const bf16x8 b1 = *(const LAS bf16x8*)(Ks + KSWZ(32 + r32, cb));
        p0 = __builtin_amdgcn_mfma_f32_32x32x16_bf16(b0, qr[d0], p0, 0, 0, 0);
        p1 = __builtin_amdgcn_mfma_f32_32x32x16_bf16(b1, qr[d0], p1, 0, 0, 0); }
    if constexpr (DQK == 192) {
#pragma unroll
        for (int d0 = 0; d0 < 4; ++d0) { const int cb = (d0 * 16 + hi * 8) * 2;
            const bf16x8 b0 = *(const LAS bf16x8*)(Krs + KRSWZ(r32, cb));
            const bf16x8 b1 = *(const LAS bf16x8*)(Krs + KRSWZ(32 + r32, cb));
            const bf16x8 qf = *(const LAS bf16x8*)(qrl + d0 * 1024);
            p0 = __builtin_amdgcn_mfma_f32_32x32x16_bf16(b0, qf, p0, 0, 0, 0);
            p1 = __builtin_amdgcn_mfma_f32_32x32x16_bf16(b1, qf, p1, 0, 0, 0); }
    }
}
__device__ __forceinline__ int v_st(int k, int c) { const int kk = (k & ~0xC) | ((k & 4) << 1) | ((k & 8) >> 1); return ((kk >> 3) * 4 + (c >> 5)) * 512 + ((kk & 7) * 32 + (c & 31)) * 2; }
__device__ __forceinline__ int v_rd_base(int lane) { return ((lane & 3) << 3) | (((lane >> 2) & 3) << 6) | (((lane >> 4) & 1) << 5) | (((lane >> 5) & 1) << 8); }
constexpr int v_rd_off(int d0, int ks, int half) { return d0 * 512 + ks * 4096 + half * 2048; }
template <int OFF> __device__ __forceinline__ s16x4 tr_read(int vb) {
    s16x4 r; asm volatile("ds_read_b64_tr_b16 %0, %1 offset:%2" : "=&v"(r) : "v"(vb), "i"(OFF) : "memory"); return r;
}
template <int D0> __device__ __forceinline__ void pv_one(f32x16& od, int vb, bf16x8 pa0, bf16x8 pa1, bf16x8 pa2, bf16x8 pa3) {
    const s16x4 l0 = tr_read<v_rd_off(D0, 0, 0)>(vb), h0 = tr_read<v_rd_off(D0, 0, 1)>(vb), l1 = tr_read<v_rd_off(D0, 1, 0)>(vb), h1 = tr_read<v_rd_off(D0, 1, 1)>(vb);
    const s16x4 l2 = tr_read<v_rd_off(D0, 2, 0)>(vb), h2 = tr_read<v_rd_off(D0, 2, 1)>(vb), l3 = tr_read<v_rd_off(D0, 3, 0)>(vb), h3 = tr_read<v_rd_off(D0, 3, 1)>(vb);
    asm volatile("s_waitcnt lgkmcnt(0)" ::: "memory"); SBAR();
#define PK(L, H) (bf16x8){L[0], L[1], L[2], L[3], H[0], H[1], H[2], H[3]}
    od = __builtin_amdgcn_mfma_f32_32x32x16_bf16(pa0, PK(l0, h0), od, 0, 0, 0);
    od = __builtin_amdgcn_mfma_f32_32x32x16_bf16(pa1, PK(l1, h1), od, 0, 0, 0);
    od = __builtin_amdgcn_mfma_f32_32x32x16_bf16(pa2, PK(l2, h2), od, 0, 0, 0);
    od = __builtin_amdgcn_mfma_f32_32x32x16_bf16(pa3, PK(l3, h3), od, 0, 0, 0);
#undef PK
}
__device__ __forceinline__ void pv_d0(f32x16* o, int vb, bf16x8 pa0, bf16x8 pa1, bf16x8 pa2, bf16x8 pa3) {
    pv_one<0>(o[0], vb, pa0, pa1, pa2, pa3); pv_one<1>(o[1], vb, pa0, pa1, pa2, pa3); pv_one<2>(o[2], vb, pa0, pa1, pa2, pa3); pv_one<3>(o[3], vb, pa0, pa1, pa2, pa3);
}
__device__ __forceinline__ void causal_mask(f32x16& p0, f32x16& p1, int jj, int rowrel, int hi) {
#pragma unroll
    for (int r = 0; r < 16; ++r) { const int k0 = 64 * jj + crow(r, hi); if (k0 > rowrel) p0[r] = -1e30f; if (k0 + 32 > rowrel) p1[r] = -1e30f; }
}

template <int DQK, bool CAUSAL, int SD, int LDQ, int LDK>
__device__ __forceinline__ void attn_body(const bf16_t* __restrict__ Qb, const bf16_t* __restrict__ Kh, const bf16_t* __restrict__ Vh, const bf16_t* __restrict__ Krp,
                                          const f32x2* __restrict__ ropeq, const bf16_t* __restrict__ gate, bf16_t* __restrict__ outp, int NT, int diag0, LAS uchar* lds) {
    constexpr int NQ = 8;
    int tid_ = threadIdx.x; asm volatile("" : "+v"(tid_));
    const int tid = tid_, wid = tid >> 6, lane = tid & 63, r32 = lane & 31, hi = lane >> 5;
    LAS uchar* V_lds = lds + OFF_V; LAS uchar* K_lds = lds + OFF_K; LAS uchar* Kr_lds = lds + OFF_KR;
    LAS float* ws = (LAS float*)(lds + OFF_WS) + wid * 64; LAS float* li_l = ws; LAS float* al_l = ws + 32; LAS uchar* qrl = lds + OFF_QR + wid * 4096 + lane * 16;
    float m_reg = -1e30f, l_reg = 0; f32x16 o[4] = {}; bf16x8 qr[NQ];
    const bf16_t* Qw = Qb + (size_t)(wid * QBLK + r32) * LDQ + hi * 8;
#pragma unroll
    for (int d0 = 0; d0 < 8; ++d0) qr[d0] = *(const bf16x8*)(Qw + d0 * 16);
    if constexpr (DQK == 192) {
#pragma unroll
        for (int a = 0; a < 2; ++a) {
            const u32x4 w1 = *(const u32x4*)(Qw + 128 + 16 * a), w2 = *(const u32x4*)(Qw + 160 + 16 * a); float x1[8], x2[8], o1[8], o2[8]; unpack8(w1, x1); unpack8(w2, x2);
            const f32x2* tb = ropeq + (size_t)(wid * QBLK + r32) * 32 + 16 * a + 8 * hi;
#pragma unroll
            for (int j = 0; j < 8; ++j) { const f32x2 cs = tb[j]; o1[j] = x1[j] * cs.x - x2[j] * cs.y; o2[j] = x1[j] * cs.y + x2[j] * cs.x; }
            *(LAS u32x4*)(qrl + a * 1024) = pack8(o1); *(LAS u32x4*)(qrl + (2 + a) * 1024) = pack8(o2);
        }
    }
    const int sr = tid >> 4, sc = (tid & 15) * 8, vst0 = v_st(sr, sc), vst1 = v_st(32 + sr, sc);
    const int krow = tid >> 3, kcc = (tid & 7) * 8;
    const int vb0 = (int)(unsigned)(uintptr_t)V_lds + v_rd_base(lane);
    struct { bf16x8 vs0, vs1, ks0, ks1, kr; } sr_[SD];
#define SLOAD(i, k0) do { sr_[i].vs0 = *(const bf16x8*)(Vh + (size_t)((k0) + sr) * LDK + sc); sr_[i].vs1 = *(const bf16x8*)(Vh + (size_t)((k0) + 32 + sr) * LDK + sc); \
    sr_[i].ks0 = *(const bf16x8*)(Kh + (size_t)((k0) + sr) * LDK + sc); sr_[i].ks1 = *(const bf16x8*)(Kh + (size_t)((k0) + 32 + sr) * LDK + sc); \
    if constexpr (DQK == 192) sr_[i].kr = *(const bf16x8*)(Krp + (size_t)((k0) + krow) * 64 + kcc); } while (0)
#define SWRITE(b, i) do { *(LAS bf16x8*)(V_lds + (b) * SHM_V + vst0) = sr_[i].vs0; *(LAS bf16x8*)(V_lds + (b) * SHM_V + vst1) = sr_[i].vs1; const int kc = sc * 2; \
    *(LAS bf16x8*)(K_lds + (b) * SHM_K + KSWZ(sr, kc)) = sr_[i].ks0; *(LAS bf16x8*)(K_lds + (b) * SHM_K + KSWZ(32 + sr, kc)) = sr_[i].ks1; \
    if constexpr (DQK == 192) *(LAS bf16x8*)(Kr_lds + (b) * SHM_KR + KRSWZ(krow, kcc * 2)) = sr_[i].kr; } while (0)
#define SWAIT() do { if constexpr (SD == 2) { if constexpr (DQK == 192) asm volatile("s_waitcnt vmcnt(5)" ::: "memory"); else asm volatile("s_waitcnt vmcnt(4)" ::: "memory"); } \
    else asm volatile("s_waitcnt vmcnt(0)" ::: "memory"); } while (0)
#define RESC(a) do { if (__any((a) < 1.f)) { if (hi == 0) al_l[r32] = (a); asm volatile("s_waitcnt lgkmcnt(0)" ::: "memory"); \
    _Pragma("unroll") for (int d = 0; d < 4; ++d) _Pragma("unroll") for (int r = 0; r < 16; ++r) o[d][r] *= al_l[crow(r, hi)]; } } while (0)
#define MASK(P0, P1, tile) do { if constexpr (CAUSAL) { if ((tile) >= diag0) causal_mask(P0, P1, (tile) - diag0, wid * QBLK + r32, hi); } } while (0)
    f32x16 pA0, pA1, pB0, pB1; float mnA, mnB, alA, alB; bf16x8 pa0, pa1, pa2, pa3;
    constexpr int SE = 0, SO = SD - 1;
    SLOAD(SE, 0); asm volatile("s_waitcnt vmcnt(0)" ::: "memory"); SWRITE(0, SE); __syncthreads();
    qkt<DQK>(pA0, pA1, K_lds, Kr_lds, qr, qrl, r32, hi); MASK(pA0, pA1, 0); partialSM<DQK>(pA0, pA1, m_reg, mnA, alA);
    SLOAD(SO, KVBLK); if constexpr (SD == 2) { if (2 < NT) SLOAD(SE, 2 * KVBLK); }
    SWAIT(); SWRITE(1, SO); __syncthreads();
    for (int j = 1; j + 1 < NT; j += 2) {
        SBAR(); qkt<DQK>(pB0, pB1, K_lds + SHM_K, Kr_lds + SHM_KR, qr, qrl, r32, hi); MASK(pB0, pB1, j);
        finishSM(pA0, pA1, alA, l_reg, pa0, pa1, pa2, pa3); SBAR();
        SLOAD(SO, (j + SD) * KVBLK); SBAR();
        pv_d0(o, vb0, pa0, pa1, pa2, pa3); partialSM<DQK>(pB0, pB1, m_reg, mnB, alB);
        __syncthreads(); SWAIT(); SWRITE(0, SE);
        RESC(alB); __syncthreads();
        SBAR(); qkt<DQK>(pA0, pA1, K_lds, Kr_lds, qr, qrl, r32, hi); MASK(pA0, pA1, j + 1);
        finishSM(pB0, pB1, alB, l_reg, pa0, pa1, pa2, pa3); SBAR();
        if (SD == 1 || j + 3 < NT) SLOAD(SE, (j + 1 + SD) * KVBLK); SBAR();
        pv_d0(o, vb0 + SHM_V, pa0, pa1, pa2, pa3); partialSM<DQK>(pA0, pA1, m_reg, mnA, alA);
        __syncthreads(); SWAIT(); SWRITE(1, SO);
        RESC(alA); __syncthreads();
    }
    SBAR(); qkt<DQK>(pB0, pB1, K_lds + SHM_K, Kr_lds + SHM_KR, qr, qrl, r32, hi); MASK(pB0, pB1, NT - 1);
    finishSM(pA0, pA1, alA, l_reg, pa0, pa1, pa2, pa3); SBAR();
    pv_d0(o, vb0, pa0, pa1, pa2, pa3); partialSM<DQK>(pB0, pB1, m_reg, mnB, alB);
    __syncthreads(); RESC(alB);
    finishSM(pB0, pB1, alB, l_reg, pa0, pa1, pa2, pa3); SBAR();
    pv_d0(o, vb0 + SHM_V, pa0, pa1, pa2, pa3);
    if (hi == 0) li_l[r32] = l_reg; asm volatile("s_waitcnt lgkmcnt(0)" ::: "memory");
    float rli[16];
#pragma unroll
    for (int r = 0; r < 16; ++r) rli[r] = __builtin_amdgcn_rcpf(li_l[crow(r, hi)]);
    { LAS uchar* ot = lds + OFF_QR + wid * 4096; const int orow = lane >> 1, ocb = (lane & 1) * 32; const size_t grow = (size_t)(wid * QBLK + orow);
#pragma unroll
      for (int hf = 0; hf < 2; ++hf) {
#pragma unroll
          for (int r = 0; r < 16; ++r)
#pragma unroll
              for (int dd = 0; dd < 2; ++dd) *(LAS bf16_t*)(ot + crow(r, hi) * 128 + (dd * 32 + r32) * 2) = (bf16_t)(cvt_pk_bf16(o[2 * hf + dd][r] * rli[r], 0.f) & 0xffffu);
          asm volatile("s_waitcnt lgkmcnt(0)" ::: "memory");
#pragma unroll
          for (int c = 0; c < 4; ++c) { const u32x4 ov = *(const LAS u32x4*)(ot + orow * 128 + ocb * 2 + c * 16); const u32x4 gv = *(const u32x4*)(gate + grow * LDZ + hf * 64 + ocb + c * 8);
              float of[8], gf[8]; unpack8(ov, of); unpack8(gv, gf);
#pragma unroll
              for (int q = 0; q < 8; ++q) of[q] *= silu(gf[q]);
              *(u32x4*)(outp + grow * OUTW + hf * 64 + ocb + c * 8) = pack8(of); }
          asm volatile("s_waitcnt lgkmcnt(0)" ::: "memory"); } }
#undef SLOAD
#undef SWRITE
#undef SWAIT
#undef RESC
#undef MASK
}
}
namespace dec {
constexpr int BUFB = 40960, OFF_KR = 32768, OFF_WS = 2 * BUFB, LDS_BYTES = OFF_WS + 8 * 64 * 4;
__device__ __forceinline__ unsigned off_b(unsigned row, unsigned ch) { return 256u * row + 16u * (ch ^ (((row & 3) << 2) | ((row >> 2) & 3))); }
__device__ __forceinline__ unsigned row_read_addr(unsigned lane, unsigned s) { return off_b(lane & 31, 2 * s + (lane >> 5)); }
__device__ __forceinline__ unsigned tr_read_addr(unsigned lane, unsigned c, unsigned ks, unsigned t) {
    const unsigned h = lane >> 5, blk = (lane >> 4) & 1, q = (lane & 15) >> 2, p = lane & 3;
    return off_b(16 * ks + 8 * h + 4 * t + q, 4 * c + 2 * blk + (p >> 1)) + 8 * (p & 1);
}
__device__ __forceinline__ s16x4 tr_rd(unsigned addr) { s16x4 r; asm volatile("ds_read_b64_tr_b16 %0, %1" : "=&v"(r) : "v"(addr) : "memory"); return r; }

__device__ __forceinline__ void decode_unit(const bf16_t* __restrict__ Qd, const float* __restrict__ cckv, const float* __restrict__ ckr, const int* __restrict__ pt,
                                            float* __restrict__ Opart, float* __restrict__ ML, LAS uchar* lds) {
    int tid_ = threadIdx.x; asm volatile("" : "+v"(tid_));
    const int tid = tid_, wid = tid >> 6, lane = tid & 63, r32 = lane & 31, hi = lane >> 5;
    LAS float* al_l = (LAS float*)(lds + OFF_WS) + wid * 64;
    bf16x8 qr[20];
#pragma unroll
    for (int s = 0; s < 20; ++s) qr[s] = *(const bf16x8*)(Qd + (size_t)r32 * 320 + s * 16 + hi * 8);
    float m_reg = -1e30f, l_reg = 0.f; f32x16 o = {};
    f32x4 sv[10];
    const int kc = lane & 15, kq = lane >> 4;
    const unsigned wck = (unsigned)((lane >> 5) * 2 * 8192) + ((lane & 1) << 3);
    const unsigned ldsb = (unsigned)(uintptr_t)lds;
    const int pw = wid >> 2, cw = wid & 3;
#define DLOAD(j) do { const int page = pt[(j) >> 1]; const size_t krow = (size_t)page * 128 + ((j) & 1) * 64 + wid * 8; \
    const float* s0 = cckv + krow * 256 + 4 * lane; const float* s1 = ckr + (krow + kq) * 64 + 4 * kc; \
    _Pragma("unroll") for (int i = 0; i < 8; ++i) sv[i] = __builtin_nontemporal_load((const f32x4*)(s0 + i * 256)); \
    sv[8] = __builtin_nontemporal_load((const f32x4*)s1); sv[9] = __builtin_nontemporal_load((const f32x4*)(s1 + 4 * 64)); } while (0)
#define DWRITE(b) do { _Pragma("unroll") for (int i = 0; i < 8; ++i) { const int key = wid * 8 + i; u32x2 w; w.x = cvt_pk_bf16(sv[i][0], sv[i][1]); w.y = cvt_pk_bf16(sv[i][2], sv[i][3]); \
        *(LAS u32x2*)(lds + (b) * BUFB + wck + (key >> 5) * 8192 + off_b(key & 31, (lane & 31) >> 1)) = w; } \
    _Pragma("unroll") for (int i = 0; i < 2; ++i) { const int key = wid * 8 + kq + 4 * i; u32x2 w; w.x = cvt_pk_bf16(sv[8 + i][0], sv[8 + i][1]); w.y = cvt_pk_bf16(sv[8 + i][2], sv[8 + i][3]); \
        *(LAS u32x2*)(lds + (b) * BUFB + OFF_KR + key * 128 + (((kc >> 1) ^ (key & 7)) << 4) + ((kc & 1) << 3)) = w; } } while (0)
    constexpr int NT = 32;
    DLOAD(0); DWRITE(0); __syncthreads();
    for (int j = 0; j < NT; ++j) {
        const int b = j & 1;
        if (j + 1 < NT) DLOAD(j + 1);
        const LAS uchar* B = lds + b * BUFB;
        f32x16 p0 = {}, p1 = {};
#pragma unroll
        for (int s = 0; s < 16; ++s) { const unsigned ra = row_read_addr(lane, s & 7);
            const bf16x8 k0 = *(const LAS bf16x8*)(B + ((s >> 3) * 2 + 0) * 8192 + ra), k1 = *(const LAS bf16x8*)(B + ((s >> 3) * 2 + 1) * 8192 + ra);
            p0 = __builtin_amdgcn_mfma_f32_32x32x16_bf16(k0, qr[s], p0, 0, 0, 0); p1 = __builtin_amdgcn_mfma_f32_32x32x16_bf16(k1, qr[s], p1, 0, 0, 0); }
#pragma unroll
        for (int s = 0; s < 4; ++s) { const int chk = 2 * s + hi;
            const bf16x8 k0 = *(const LAS bf16x8*)(B + OFF_KR + r32 * 128 + ((chk ^ (r32 & 7)) << 4)), k1 = *(const LAS bf16x8*)(B + OFF_KR + (32 + r32) * 128 + ((chk ^ (r32 & 7)) << 4));
            p0 = __builtin_amdgcn_mfma_f32_32x32x16_bf16(k0, qr[16 + s], p0, 0, 0, 0); p1 = __builtin_amdgcn_mfma_f32_32x32x16_bf16(k1, qr[16 + s], p1, 0, 0, 0); }
        float mn, alpha; att::partialSM<192>(p0, p1, m_reg, mn, alpha);
        if (__any(alpha < 1.f)) { if (hi == 0) al_l[r32] = alpha; asm volatile("s_waitcnt lgkmcnt(0)" ::: "memory");
#pragma unroll
            for (int r = 0; r < 16; ++r) o[r] *= al_l[crow(r, hi)]; }
        bf16x8 pa[4]; att::finishSM(p0, p1, alpha, l_reg, pa[0], pa[1], pa[2], pa[3]);
        s16x4 vl[4], vh[4];
#pragma unroll
        for (int ks = 0; ks < 4; ++ks) { const unsigned vb = ldsb + b * BUFB + (pw * 2 + (ks >> 1)) * 8192;
            vl[ks] = tr_rd(vb + tr_read_addr(lane, cw, ks & 1, 0)); vh[ks] = tr_rd(vb + tr_read_addr(lane, cw, ks & 1, 1)); }
        asm volatile("s_waitcnt lgkmcnt(0)" ::: "memory"); __builtin_amdgcn_sched_barrier(0);
#pragma unroll
        for (int ks = 0; ks < 4; ++ks) o = __builtin_amdgcn_mfma_f32_32x32x16_bf16(pa[ks], ((bf16x8){vl[ks][0], vl[ks][1], vl[ks][2], vl[ks][3], vh[ks][0], vh[ks][1], vh[ks][2], vh[ks][3]}), o, 0, 0, 0);
        if (j + 1 < NT) DWRITE(b ^ 1);
        __syncthreads();
    }
#undef DLOAD
#undef DWRITE
    if (wid == 0 && hi == 0) { ML[r32 * 2] = m_reg; ML[r32 * 2 + 1] = l_reg; }
#pragma unroll
    for (int r = 0; r < 16; ++r) Opart[(size_t)crow(r, hi) * 256 + 32 * wid + r32] = o[r];
}

__device__ __forceinline__ void combine_row(int b, int row32, int lane, const bf16_t* __restrict__ Qdec, const float* __restrict__ Opart, const float* __restrict__ ML,
                                            const float* __restrict__ ckvn, const float* __restrict__ krn, bf16_t* __restrict__ olat) {
    constexpr float C = 0.07216878364870322f * 1.4426950408889634f;
    const int t = row32 >> 3, h = row32 & 7;
    const bf16_t* q = Qdec + ((size_t)b * 32 + row32) * 320;
    const u32x2 qw = *(const u32x2*)(q + 4 * lane); const float q0 = bf_lo(qw.x), q1 = bf_hi(qw.x), q2 = bf_lo(qw.y), q3 = bf_hi(qw.y); const float qrp = bf2f(q[256 + lane]);
    float sj[4]; f32x4 cn[4];
#pragma unroll
    for (int j = 0; j < 4; ++j) { cn[j] = *(const f32x4*)(ckvn + ((size_t)b * 4 + j) * 256 + 4 * lane); float s = q0 * cn[j][0] + q1 * cn[j][1] + q2 * cn[j][2] + q3 * cn[j][3] + qrp * krn[((size_t)b * 4 + j) * 64 + lane];
#pragma unroll
        for (int o = 32; o >= 1; o >>= 1) s += __shfl_xor(s, o);
        sj[j] = (j <= t) ? s : -1e30f; }
    float mc[8], lc[8], M = fmaxf(fmaxf(sj[0], sj[1]), fmaxf(sj[2], sj[3]));
#pragma unroll
    for (int c = 0; c < 8; ++c) { const f32x2 ml = *(const f32x2*)(ML + (((size_t)b * 8 + c) * 32 + row32) * 2); mc[c] = ml.x; lc[c] = ml.y; M = fmaxf(M, mc[c]); }
    float L = 0.f; f32x4 acc = {0.f, 0.f, 0.f, 0.f};
#pragma unroll
    for (int c = 0; c < 8; ++c) { const float w = __builtin_amdgcn_exp2f((mc[c] - M) * C); L += lc[c] * w; acc += *(const f32x4*)(Opart + (((size_t)b * 8 + c) * 32 + row32) * 256 + 4 * lane) * w; }
#pragma unroll
    for (int j = 0; j < 4; ++j) { const float e = (j <= t) ? __builtin_amdgcn_exp2f((sj[j] - M) * C) : 0.f; L += e; acc += cn[j] * e; }
    const float rl = 1.0f / L; u32x2 w; w.x = cvt_pk_bf16(acc[0] * rl, acc[1] * rl); w.y = cvt_pk_bf16(acc[2] * rl, acc[3] * rl);
    *(u32x2*)(olat + ((size_t)b * 4 + t) * 2048 + h * 256 + 4 * lane) = w;
}

constexpr int SMEM_LDS = 4096 + 32768;
__device__ __forceinline__ void smem_unit(const bf16_t* __restrict__ Zq  , const bf16_t* __restrict__ Zg  , const float* __restrict__ Kc, const float* __restrict__ Vc  ,
                                          bf16_t* __restrict__ outp  , LAS uchar* lds) {
    int tid_ = threadIdx.x; asm volatile("" : "+v"(tid_));
    const int tid = tid_, wid = tid >> 6, lane = tid & 63, l32 = lane & 31, hi = lane >> 5;
    LAS float* sc = (LAS float*)lds; LAS float* red = (LAS float*)(lds + 4096);
    float qv[4][4];
#pragma unroll
    for (int t = 0; t < 4; ++t) { const u32x2 w = *(const u32x2*)(Zq + (size_t)t * LDZ + 4 * l32); qv[t][0] = bf_lo(w.x); qv[t][1] = bf_hi(w.x); qv[t][2] = bf_lo(w.y); qv[t][3] = bf_hi(w.y); }
#pragma unroll 4
    for (int i = 0; i < 16; ++i) { const int m = wid * 32 + 2 * i + hi; const f32x4 kv = *(const f32x4*)(Kc + (size_t)m * 512 + 4 * l32); float p[4];
#pragma unroll
        for (int t = 0; t < 4; ++t) { p[t] = kv[0] * qv[t][0] + kv[1] * qv[t][1] + kv[2] * qv[t][2] + kv[3] * qv[t][3];
#pragma unroll
            for (int o = 16; o >= 1; o >>= 1) p[t] += __shfl_xor(p[t], o); }
        if (l32 == 0) {
#pragma unroll
            for (int t = 0; t < 4; ++t) sc[t * 256 + m] = p[t] * 0.08838834764831845f; } }
    __syncthreads();
    if (wid < 4) { float v[4], mx = -1e30f;
#pragma unroll
        for (int i = 0; i < 4; ++i) { v[i] = sc[wid * 256 + lane + 64 * i]; mx = fmaxf(mx, v[i]); }
#pragma unroll
        for (int o = 32; o >= 1; o >>= 1) mx = fmaxf(mx, __shfl_xor(mx, o));
        float s = 0.f;
#pragma unroll
        for (int i = 0; i < 4; ++i) { v[i] = __expf(v[i] - mx); s += v[i]; }
#pragma unroll
        for (int o = 32; o >= 1; o >>= 1) s += __shfl_xor(s, o);
        const float rs = 1.0f / s;
#pragma unroll
        for (int i = 0; i < 4; ++i) sc[wid * 256 + lane + 64 * i] = v[i] * rs; }
    __syncthreads();
    { const int d4 = (tid & 31) * 4, mg = tid >> 5; f32x4 a[4] = {};
#pragma unroll 4
      for (int mm = 0; mm < 16; ++mm) { const int m = mg * 16 + mm; const f32x4 vv = *(const f32x4*)(Vc + (size_t)m * 512 + d4);
#pragma unroll
          for (int t = 0; t < 4; ++t) a[t] += vv * sc[t * 256 + m]; }
#pragma unroll
      for (int t = 0; t < 4; ++t) *(LAS f32x4*)(red + (mg * 4 + t) * 128 + d4) = a[t]; }
    __syncthreads();
    { const int t = tid >> 7, d = tid & 127; float s = 0.f;
#pragma unroll
      for (int mg = 0; mg < 16; ++mg) s += red[(mg * 4 + t) * 128 + d];
      const float g = bf2f(Zg[(size_t)t * LDZ + d]);
      outp[(size_t)t * OUTW + d] = (bf16_t)(cvt_pk_bf16(s * silu(g), 0.f) & 0xffffu); }
    __syncthreads();
}
}
namespace ew {
__device__ __forceinline__ int otid() { int t = threadIdx.x; asm volatile("" : "+v"(t)); return t; }
struct TJ { const float* src; int sld, K, ncols; const float* gain; const float* cscale; bf16_t* dst; int dld; };
constexpr int NTJ = 32;
__device__ __forceinline__ TJ get_tj(int j, const float* const* in, uchar* ws) {
    TJ t; t.gain = nullptr; t.cscale = nullptr;
    bf16_t* WINA = (bf16_t*)(ws + WS_WINA); bf16_t* WGRP = (bf16_t*)(ws + WS_WGRP); bf16_t* WINB = (bf16_t*)(ws + WS_WINB); bf16_t* WQUP = (bf16_t*)(ws + WS_WQUP);
    bf16_t* WKV = (bf16_t*)(ws + WS_WKV); bf16_t* WMEM = (bf16_t*)(ws + WS_WMEM); bf16_t* WOUT = (bf16_t*)(ws + WS_WOUT);
    if (j < 2) { t.src = in[10] + (size_t)j * DM * INA; t.sld = INA; t.K = DM; t.ncols = INA; t.gain = in[9] + j * DM; t.dst = WINA + (size_t)j * INA * DM; t.dld = DM; }
    else if (j < 10) { const int i = j - 2; t.src = in[11] + (size_t)i * 65536; t.sld = 256; t.K = 256; t.ncols = 256; t.cscale = in[12] + i * 256; t.dst = WGRP + (size_t)i * 65536; t.dld = 256; }
    else if (j < 12) { const int i = j - 10; t.src = in[13] + (size_t)i * DM * INB; t.sld = INB; t.K = DM; t.ncols = QRANK; t.gain = in[9] + (2 + i) * DM; t.dst = WINB + (size_t)i * NB2 * DM; t.dld = DM; }
    else if (j < 14) { const int i = j - 12; t.src = in[13] + (size_t)i * DM * INB + QRANK; t.sld = INB; t.K = DM; t.ncols = INB - QRANK; t.gain = in[9] + (2 + i) * DM; t.dst = WINB + ((size_t)i * NB2 + ZB_GT) * DM; t.dld = DM; }
    else if (j == 14) { t.src = in[17] + KVR; t.sld = 320; t.K = DM; t.ncols = ROPE; t.gain = in[16]; t.dst = WINB + (size_t)ZB_KR * DM; t.dld = DM; }
    else if (j == 15) { t.src = in[17]; t.sld = 320; t.K = DM; t.ncols = KVR; t.gain = in[16]; t.dst = WINB + (size_t)ZB_KV * DM; t.dld = DM; }
    else if (j < 18) { const int i = j - 16; t.src = in[15] + (size_t)i * QRANK * QW; t.sld = QW; t.K = QRANK; t.ncols = QW; t.gain = in[14] + i * QRANK; t.dst = WQUP + (size_t)i * QW * QRANK; t.dld = QRANK; }
    else if (j == 18) { t.src = in[19]; t.sld = 1024; t.K = 256; t.ncols = 1024; t.dst = WKV; t.dld = 256; }
    else if (j == 19) { t.src = in[20]; t.sld = 1024; t.K = 256; t.ncols = 1024; t.dst = WKV + (size_t)1024 * 256; t.dld = 256; }
    else if (j < 28) { const int i = j - 20, l = i >> 1, kv = i & 1; t.src = (kv ? in[23] : in[22]) + (size_t)l * DM * MEMW; t.sld = MEMW; t.K = DM; t.ncols = MEMW; t.gain = in[21] + l * DM; t.dst = WMEM + (size_t)(l * 2 + kv) * MEMW * DM; t.dld = DM; }
    else { const int l = j - 28; t.src = in[24] + (size_t)l * OUTW * DM; t.sld = DM; t.K = OUTW; t.ncols = DM; t.dst = WOUT + (size_t)l * DM * OUTW; t.dld = OUTW; }
    return t;
}
__device__ __forceinline__ int tj_tiles(int j) {
    if (j < 2) return 16 * 48; if (j < 10) return 16; if (j < 12) return 16 * 6; if (j < 14) return 16 * 32; if (j == 14) return 16; if (j == 15) return 64;
    if (j < 18) return 6 * 24; if (j < 20) return 4 * 16; if (j < 28) return 16 * 8; return 24 * 16;
}
constexpr int TJ_TOTAL = 2 * 768 + 8 * 16 + 2 * 96 + 2 * 512 + 16 + 64 + 2 * 144 + 2 * 64 + 8 * 128 + 4 * 384;
__device__ __forceinline__ void transpose_tile(const TJ& t, int tile, LAS float* tl, int tid) {
    const int nkt = t.K / 64, kt = tile % nkt, nt = tile / nkt, k0 = kt * 64, n0 = nt * 64;
    { const int k = tid >> 3, n8 = (tid & 7) * 8; const float* s = t.src + (size_t)(k0 + k) * t.sld + n0 + n8; const float g = t.gain ? t.gain[k0 + k] : 1.0f;
      const f32x4 a = *(const f32x4*)s * g, b = *(const f32x4*)(s + 4) * g;
#pragma unroll
      for (int j = 0; j < 4; ++j) { tl[k * 65 + n8 + j] = a[j]; tl[k * 65 + n8 + 4 + j] = b[j]; } }
    __syncthreads();
    { const int n = tid >> 3, k8 = (tid & 7) * 8; const float cs = t.cscale ? t.cscale[n0 + n] : 1.0f; float v[8];
#pragma unroll
      for (int j = 0; j < 8; ++j) v[j] = tl[(k8 + j) * 65 + n] * cs;
      *(u32x4*)(t.dst + (size_t)(n0 + n) * t.dld + k0 + k8) = pack8(v); }
    __syncthreads();
}
__device__ __forceinline__ void sincos_d(float angf, float& c, float& s) {
    const double x = (double)angf; const double kd = rint(x * 0.63661977236758134308); const int q = (int)((long long)kd & 3);
    double r = fma(-kd, 1.57079632679489655800e+00, x); r = fma(-kd, 6.12323399573676603587e-17, r);
    const double r2 = r * r;
    double sp = -7.6471637318198164759e-13; sp = fma(sp, r2, 1.6059043836821614599e-10); sp = fma(sp, r2, -2.5052108385441718775e-08); sp = fma(sp, r2, 2.7557319223985890653e-06);
    sp = fma(sp, r2, -1.9841269841269841270e-04); sp = fma(sp, r2, 8.3333333333333333333e-03); sp = fma(sp, r2, -1.6666666666666666667e-01); const double sn = fma(sp * r2, r, r);
    double cp = 4.7794773323873852974e-14; cp = fma(cp, r2, -1.1470745597729724714e-11); cp = fma(cp, r2, 2.0876756987868098979e-09); cp = fma(cp, r2, -2.7557319223985890653e-07);
    cp = fma(cp, r2, 2.4801587301587301587e-05); cp = fma(cp, r2, -1.3888888888888888889e-03); cp = fma(cp, r2, 4.1666666666666666667e-02); cp = fma(cp, r2, -0.5); const double cn = fma(cp, r2, 1.0);
    const double ss = (q == 0) ? sn : (q == 1) ? cn : (q == 2) ? -sn : -cn, cc = (q == 0) ? cn : (q == 1) ? -sn : (q == 2) ? -cn : sn;
    c = (float)cc; s = (float)ss;
}

__device__ __forceinline__ void prologue(const float* const* in, float* out, uchar* ws, LAS uchar* lds, int G, int bid) {
    const int tid = otid(), lane = tid & 63, wid = tid >> 6;
    for (int gt = bid; gt < TJ_TOTAL; gt += G) { int j = 0, r = gt; for (; j < NTJ; ++j) { const int n = tj_tiles(j); if (r < n) break; r -= n; }
        const TJ t = get_tj(j, in, ws); transpose_tile(t, r, (LAS float*)lds, tid); }
    const size_t gtid = (size_t)bid * 512 + tid, gstride = (size_t)G * 512;
    { bf16_t* WINB = (bf16_t*)(ws + WS_WINB);
      for (size_t i = gtid; i < (size_t)(64 + 128) * DM / 8; i += gstride) { const size_t e = i * 8; bf16_t* p = (e < (size_t)64 * DM) ? WINB + (size_t)448 * DM + e : WINB + ((size_t)NB2 + 384) * DM + (e - (size_t)64 * DM);
          *(u32x4*)p = (u32x4){0u, 0u, 0u, 0u}; }
      bf16_t* WKUPN = (bf16_t*)(ws + WS_WKUPN);
      for (size_t i = gtid; i < (size_t)256 * 1024 / 8; i += gstride) { const float* s = in[19] + i * 8; const f32x4 a = *(const f32x4*)s, b = *(const f32x4*)(s + 4);
          const float v[8] = {a[0], a[1], a[2], a[3], b[0], b[1], b[2], b[3]}; *(u32x4*)(WKUPN + i * 8) = pack8(v); } }
    { bf16_t* XB = (bf16_t*)(ws + WS_XB); bf16_t* MH = (bf16_t*)(ws + WS_MHAT); float* ssp = (float*)(ws + WS_SSP); float* ssps = (float*)(ws + WS_SSPS);
      const int nrows = PM + SM + 2048;
      for (int row = bid * 8 + wid; row < nrows; row += G * 8) {
          const float* src = row < PM ? in[0] + (size_t)row * DM : row < PM + SM ? in[1] + (size_t)(row - PM) * DM : in[8] + (size_t)(row - PM - SM) * DM;
          f32x4 v[4]; float s = 0.f;
#pragma unroll
          for (int i = 0; i < 4; ++i) { v[i] = *(const f32x4*)(src + 256 * i + 4 * lane); s += sum4(v[i] * v[i]); }
#pragma unroll
          for (int o = 32; o >= 1; o >>= 1) s += __shfl_xor(s, o);
          float sc = 1.0f; bf16_t* dst;
          if (row < PM + SM) { dst = XB + (size_t)row * DM; if (row < PM) { if (lane < 16) ssp[(size_t)row * 16 + lane] = lane == 0 ? s : 0.f; } else { if (lane < 32) ssps[(row - PM) * 32 + lane] = lane == 0 ? s : 0.f; } }
          else { dst = MH + (size_t)(row - PM - SM) * DM; sc = rsqrtf(s * (1.0f / 1024.0f) + EPS); }
#pragma unroll
          for (int i = 0; i < 4; ++i) { u32x2 w; w.x = cvt_pk_bf16(v[i][0] * sc, v[i][1] * sc); w.y = cvt_pk_bf16(v[i][2] * sc, v[i][3] * sc); *(u32x2*)(dst + 256 * i + 4 * lane) = w; } } }
    { f32x2* tab = (f32x2*)(ws + WS_ROPE);
      for (size_t e = gtid; e < (size_t)2052 * 32; e += gstride) { const int p = (int)(e >> 5), i = (int)(e & 31); const int pos = p < 2048 ? p : PAST + (p - 2048);
          const float inv = (float)exp2(-(double)i * (13.287712379549449 / 32.0)); const float ang = (float)pos * inv; float c, s; sincos_d(ang, c, s); tab[e] = (f32x2){c, s}; } }
    { for (size_t e = gtid; e < (size_t)2 * SB * 11 * DM / 4; e += gstride) { const size_t f = e * 4; const int c = (int)(f % DM); const size_t rr = f / DM; const int i = (int)(rr % 11); const size_t lb = rr / 11;
          *(f32x4*)(out + O_PSS + (lb * 15 + i) * DM + c) = *(const f32x4*)(in[2] + (lb * 15 + 4 + i) * DM + c); } }
}

template <int W> __device__ __forceinline__ void pool16(const bf16_t* __restrict__ zc, bf16_t* __restrict__ po, float* __restrict__ ps, bool bstart) {
    u32x2 uu[15 + W];
#pragma unroll
    for (int i = 0; i < W - 1; ++i) uu[i] = bstart ? (u32x2){0u, 0u} : *(const u32x2*)(zc - (ptrdiff_t)(W - 1 - i) * LDZ);
#pragma unroll
    for (int k = 0; k < 16; ++k) uu[W - 1 + k] = *(const u32x2*)(zc + (size_t)k * LDZ);
    float s0 = 0.f, s1 = 0.f, s2 = 0.f, s3 = 0.f;
#pragma unroll
    for (int i = 0; i < W - 1; ++i) { s0 += bf_lo(uu[i].x); s1 += bf_hi(uu[i].x); s2 += bf_lo(uu[i].y); s3 += bf_hi(uu[i].y); }
#pragma unroll
    for (int k = 0; k < 16; ++k) { const u32x2 c = uu[W - 1 + k]; const float c0 = bf_lo(c.x), c1 = bf_hi(c.x), c2 = bf_lo(c.y), c3 = bf_hi(c.y);
        s0 += c0; s1 += c1; s2 += c2; s3 += c3;
        const float rn = (bstart && k < W - 1) ? 1.0f / (float)(k + 1) : 1.0f / (float)W;
        u32x2 o; o.x = cvt_pk_bf16(s0 * rn - c0, s1 * rn - c1); o.y = cvt_pk_bf16(s2 * rn - c2, s3 * rn - c3); *(u32x2*)(po + (size_t)k * DM) = o;
        if (ps != nullptr && k >= 1) *(f32x4*)(ps + (size_t)(k - 1) * DM) = (f32x4){c0, c1, c2, c3};
        const u32x2 d = uu[k]; s0 -= bf_lo(d.x); s1 -= bf_hi(d.x); s2 -= bf_lo(d.y); s3 -= bf_hi(d.y); }
}
__device__ __forceinline__ void pooling(int l, const float* const* in, float* out, uchar* ws, int G, int bid) {
    const bf16_t* Z = (const bf16_t*)(ws + WS_Z); bf16_t* PO = (bf16_t*)(ws + WS_POOLED);
    const int tid = otid(), lane = tid & 63, wid = tid >> 6;
    for (int pr = bid * 8 + wid; pr < (PM / 16) * 4; pr += G * 8) { const int g = pr & 3, blk = pr >> 2, r0 = blk * 16, t0 = r0 & (PT - 1), c4 = g * 256 + lane * 4;
        const bf16_t* zc = Z + (size_t)r0 * LDZ + c4; bf16_t* po = PO + (size_t)r0 * DM + c4; const bool bstart = (t0 == 0);
        float* ps = (t0 == PT - 16) ? out + O_PSP + (((size_t)l * PB + (r0 >> 11)) * 15) * DM + c4 : nullptr;
        if (g == 0) pool16<2>(zc, po, ps, bstart); else if (g == 1) pool16<4>(zc, po, ps, bstart); else if (g == 2) pool16<8>(zc, po, ps, bstart); else pool16<16>(zc, po, ps, bstart); }
    const size_t gtid = (size_t)bid * 512 + tid, gstride = (size_t)G * 512;
    for (size_t idx = gtid; idx < (size_t)SM * 128; idx += gstride) { const int r = (int)(idx >> 7), cv = (int)(idx & 127), g = cv >> 5, w = 2 << g, b = r >> 2, t = r & 3;
        const float* prev = in[2] + ((size_t)l * SB + b) * 15 * DM + cv * 8; const bf16_t* us = Z + ((size_t)PM + b * 4) * LDZ + cv * 8; float ut[8], s[8];
        unpack8(*(const u32x4*)(us + (size_t)t * LDZ), ut);
#pragma unroll
        for (int j = 0; j < 8; ++j) s[j] = ut[j];
        for (int i = 1; i < w; ++i) { const int e = 15 + t - i; float x[8];
            if (e >= 15) unpack8(*(const u32x4*)(us + (size_t)(e - 15) * LDZ), x);
            else { const f32x4 a = *(const f32x4*)(prev + (size_t)e * DM), bb = *(const f32x4*)(prev + (size_t)e * DM + 4); x[0] = a[0]; x[1] = a[1]; x[2] = a[2]; x[3] = a[3]; x[4] = bb[0]; x[5] = bb[1]; x[6] = bb[2]; x[7] = bb[3]; }
#pragma unroll
            for (int j = 0; j < 8; ++j) s[j] += x[j]; }
        const float rn = 1.0f / (float)w; float o[8];
#pragma unroll
        for (int j = 0; j < 8; ++j) o[j] = s[j] * rn - ut[j];
        *(u32x4*)(PO + ((size_t)PM + r) * DM + cv * 8) = pack8(o);
        float* q = out + O_PSS + (((size_t)l * SB + b) * 15 + 11 + t) * DM + cv * 8; *(f32x4*)q = (f32x4){ut[0], ut[1], ut[2], ut[3]}; *(f32x4*)(q + 4) = (f32x4){ut[4], ut[5], ut[6], ut[7]}; }
}

__device__ __forceinline__ void kvpost(const float* const* in, float* out, uchar* ws, int G, int bid) {
    const float* KV = (const float*)(ws + WS_KVRAW); bf16_t* CB = (bf16_t*)(ws + WS_CKVB); bf16_t* KB = (bf16_t*)(ws + WS_KROPEB); const f32x2* tab = (const f32x2*)(ws + WS_ROPE);
    const int tid = otid(), lane = tid & 63, wid = tid >> 6; const f32x4 gl = *(const f32x4*)(in[18] + 4 * lane);
    for (int row = bid * 8 + wid; row < PM + SM; row += G * 8) { const float* p = KV + (size_t)row * 320; const f32x4 v = *(const f32x4*)(p + 4 * lane); float s = sum4(v * v);
#pragma unroll
        for (int o = 32; o >= 1; o >>= 1) s += __shfl_xor(s, o);
        const float rs = rsqrtf(s * (1.0f / 256.0f) + EPS); const f32x4 c = v * rs * gl;
        float* oc = row < PM ? out + O_CKVP + (size_t)row * KVR : out + O_CKVS + (size_t)(row - PM) * KVR; float* ok = row < PM ? out + O_KRP + (size_t)row * ROPE : out + O_KRS + (size_t)(row - PM) * ROPE;
        *(f32x4*)(oc + 4 * lane) = c; u32x2 w; w.x = cvt_pk_bf16(c[0], c[1]); w.y = cvt_pk_bf16(c[2], c[3]); *(u32x2*)(CB + (size_t)row * KVR + 4 * lane) = w;
        if (lane < 32) { const int ti = row < PM ? (row & (PT - 1)) : 2048 + ((row - PM) & 3); const f32x2 cs = tab[(size_t)ti * 32 + lane]; const float x1 = p[256 + lane], x2 = p[288 + lane];
            const float o1 = x1 * cs.x - x2 * cs.y, o2 = x1 * cs.y + x2 * cs.x; ok[lane] = o1; ok[32 + lane] = o2;
            KB[(size_t)row * ROPE + lane] = (bf16_t)(cvt_pk_bf16(o1, 0.f) & 0xffffu); KB[(size_t)row * ROPE + 32 + lane] = (bf16_t)(cvt_pk_bf16(o2, 0.f) & 0xffffu); } }
}
__device__ __forceinline__ void sq_rope(uchar* ws, int G, int bid) {
    const bf16_t* Q = (const bf16_t*)(ws + WS_Q); bf16_t* QD = (bf16_t*)(ws + WS_QDEC); const f32x2* tab = (const f32x2*)(ws + WS_ROPE);
    for (size_t e = (size_t)bid * 512 + otid(); e < (size_t)SM * MLAH * 32; e += (size_t)G * 512) { const int i = (int)(e & 31), h = (int)((e >> 5) & 7), r = (int)(e >> 8), b = r >> 2, t = r & 3;
        const bf16_t* q = Q + ((size_t)PM + r) * QW + h * QHD + NOPE; const float x1 = bf2f(q[i]), x2 = bf2f(q[32 + i]); const f32x2 cs = tab[(size_t)(2048 + t) * 32 + i];
        bf16_t* o = QD + ((size_t)b * 32 + t * 8 + h) * 320 + 256; o[i] = (bf16_t)(cvt_pk_bf16(x1 * cs.x - x2 * cs.y, 0.f) & 0xffffu); o[32 + i] = (bf16_t)(cvt_pk_bf16(x1 * cs.y + x2 * cs.x, 0.f) & 0xffffu); }
}
__device__ __forceinline__ void final_norm(const float* const* in, float* out, uchar* ws, int G, int bid) {
    const float* XR = (const float*)(ws + WS_XRES); const float* ssp = (const float*)(ws + WS_SSP); const float* ssps = (const float*)(ws + WS_SSPS);
    const int tid = otid(), lane = tid & 63, wid = tid >> 6;
    for (int row = bid * 8 + wid; row < PM + SM; row += G * 8) { const float rs = row < PM ? rs_from16(ssp + (size_t)row * 16) : rs_from32(ssps + (row - PM) * 32);
        float* o = row < PM ? out + O_YP + (size_t)row * DM : out + O_YS + (size_t)(row - PM) * DM; const float* x = XR + (size_t)row * DM;
#pragma unroll
        for (int i = 0; i < 4; ++i) { const int c = 256 * i + 4 * lane; *(f32x4*)(o + c) = *(const f32x4*)(x + c) * rs * *(const f32x4*)(in[25] + c); } }
}
}
#define XB_TMO      128
#define XB_XCNT(j)  (256  + 64 * (j))
#define XB_XSUB(j)  (1280 + 64 * (j))
#define XB_XGEN(j)  (2304 + 64 * (j))
#define XB_TOP      3328
#define XB_TOPGEN   3392
#define XCD_BAR_WORDS 3456
#define XB_SPIN_CAP (1u << 22)
__device__ __forceinline__ unsigned xb_ld(unsigned* p)              { return __hip_atomic_load(p, __ATOMIC_RELAXED, __HIP_MEMORY_SCOPE_AGENT); }
__device__ __forceinline__ unsigned xb_add(unsigned* p, unsigned v) { return __hip_atomic_fetch_add(p, v, __ATOMIC_RELAXED, __HIP_MEMORY_SCOPE_AGENT); }
__device__ __forceinline__ unsigned xb_xcc_id() { return (unsigned)__builtin_amdgcn_s_getreg((3 << 11) | 20) & 0xFu; }
#define XB_SPIN(cond, bar) do { unsigned _sp = 0; while (cond) { __builtin_amdgcn_s_sleep(1); \
    if ((++_sp & 255u) == 0u) { if (xb_ld(&(bar)[XB_TMO])) break; if (_sp > XB_SPIN_CAP) { atomicAdd(&(bar)[XB_TMO], 1u); break; } } } } while (0)
struct XcdBarrier { unsigned* bar; unsigned x; volatile LAS unsigned* st; };
__device__ __forceinline__ XcdBarrier xcd_barrier_post(unsigned* bar, volatile LAS unsigned* st) {
    XcdBarrier b; b.bar = bar; b.x = xb_xcc_id(); b.st = st;
    if (threadIdx.x == 0) (void)xb_add(&bar[XB_XCNT(b.x)], 1u);
    return b;
}
__device__ __forceinline__ void xcd_barrier_complete(unsigned* bar, unsigned x, unsigned& nloc, unsigned& nx) {
    const unsigned G = gridDim.x * gridDim.y * gridDim.z;
    unsigned sum, cnt, mine, sp = 0u;
    for (;;) {
        sum = 0u; cnt = 0u; mine = 0u;
#pragma unroll
        for (unsigned j = 0; j < 16; ++j) { const unsigned c = xb_ld(&bar[XB_XCNT(j)]); sum += c; cnt += (c > 0u) ? 1u : 0u; mine = (j == x) ? c : mine; }
        if (sum == G) break;
        __builtin_amdgcn_s_sleep(1);
        if ((++sp & 255u) == 0u) { if (xb_ld(&bar[XB_TMO])) break; if (sp > XB_SPIN_CAP) { atomicAdd(&bar[XB_TMO], 1u); break; } }
    }
    nloc = mine > 0u ? mine : 1u; nx = cnt > 0u ? cnt : 1u;
}
__device__ __forceinline__ void xcd_barrier(const XcdBarrier& b) {
    asm volatile("s_waitcnt vmcnt(0)" ::: "memory");
    __syncthreads();
    if (threadIdx.x == 0) {
        unsigned* bar = b.bar;
        __builtin_amdgcn_s_waitcnt(0);
        unsigned nloc = b.st[0], nx = b.st[1];
        if (nloc == 0u) { xcd_barrier_complete(bar, b.x, nloc, nx); b.st[0] = nloc; b.st[1] = nx; }
        const unsigned old = xb_add(&bar[XB_XSUB(b.x)], 1u);
        const unsigned gen = old / nloc;
        if (old + 1u == (gen + 1u) * nloc) {
            __builtin_amdgcn_fence(__ATOMIC_RELEASE, "agent");
            asm volatile("s_waitcnt vmcnt(0)" ::: "memory");
            const unsigned og = xb_add(&bar[XB_TOP], 1u);
            const unsigned tg = og / nx;
            if (og + 1u == (tg + 1u) * nx) xb_add(&bar[XB_TOPGEN], 1u);
            else XB_SPIN(xb_ld(&bar[XB_TOPGEN]) == tg, bar);
            __builtin_amdgcn_fence(__ATOMIC_ACQUIRE, "agent");
            xb_add(&bar[XB_XGEN(b.x)], 1u);
            asm volatile("s_waitcnt vmcnt(0)" ::: "memory");
        } else {
            XB_SPIN(xb_ld(&bar[XB_XGEN(b.x)]) == gen, bar);
            __builtin_amdgcn_fence(__ATOMIC_ACQUIRE, "agent");
            asm volatile("s_waitcnt vmcnt(0)" ::: "memory");
        }
    }
    __syncthreads();
}

constexpr int LDS_BYTES = 144 * 1024, MISC_OFF = 136 * 1024;
static_assert(pg8::STAGE_BYTES <= MISC_OFF && att::LDS_BYTES <= MISC_OFF && dec::LDS_BYTES <= MISC_OFF && sg::LDS_BYTES <= MISC_OFF && dec::SMEM_LDS <= MISC_OFF, "LDS budget");
constexpr int NPHASE = 24;
struct Params { const float* in[26]; float* out; uchar* ws; int ph_lo, ph_hi; };

template <class T> __device__ __forceinline__ T* launder(T* p) { asm volatile("" : "+s"(p)); return p; }
#define PHASE_PTRS \
    uchar* const ws = launder(P.ws); float* const out = launder(P.out); const float* const* in = P.in; (void)in; (void)out; \
    bf16_t* const XB = (bf16_t*)(ws + WS_XB); float* const XR = (float*)(ws + WS_XRES); bf16_t* const Z = (bf16_t*)(ws + WS_Z); bf16_t* const MX = (bf16_t*)(ws + WS_MIXED); \
    bf16_t* const PO = (bf16_t*)(ws + WS_POOLED); bf16_t* const QB = (bf16_t*)(ws + WS_Q); float* const ssp = (float*)(ws + WS_SSP); float* const ssps = (float*)(ws + WS_SSPS); \
    float* const ssq = (float*)(ws + WS_SSQ); float* const KVRAW = (float*)(ws + WS_KVRAW); bf16_t* const MEMB = (bf16_t*)(ws + WS_MEMB); \
    (void)XB; (void)XR; (void)Z; (void)MX; (void)PO; (void)QB; (void)ssp; (void)ssps; (void)ssq; (void)KVRAW; (void)MEMB;

__global__ void __launch_bounds__(512, 2) yoco_fwd(Params P) {
    extern __shared__ __attribute__((aligned(16))) uchar lds_raw[];
    LAS uchar* lds = (LAS uchar*)lds_raw;
    const int tid = threadIdx.x, G = gridDim.x, bid = blockIdx.x;
    volatile LAS unsigned* misc = (volatile LAS unsigned*)(lds + MISC_OFF);
    if (tid < 4) misc[tid] = 0u;
    __syncthreads();
    const int lo = P.ph_lo, hi = P.ph_hi; const bool multi = (hi - lo) > 1;
    XcdBarrier bar; bar.bar = (unsigned*)(P.ws + WS_CTL); bar.x = 0; bar.st = misc;
    if (multi) bar = xcd_barrier_post((unsigned*)(P.ws + WS_CTL), misc);
#ifndef EN_MASK
#define EN_MASK 0xffff
#endif
#define EN(t) ((EN_MASK >> (t)) & 1)
#ifndef REP_MASK
#define REP_MASK 0
#endif
#define NREP(t, first) ((((REP_MASK >> (t)) & 1) && (first)) ? 2 : 1)
#define IN(k) (lo <= (k) && (k) < hi)
#define SEAM(k) do { if (IN(k) && IN((k) + 1)) xcd_barrier(bar); } while (0)
#define SUNITS(u, n) for (int u = G - 1 - bid; u < (n); u += G)

    if (EN(0) && IN(0)) for (int rep = 0; rep < NREP(0, true); ++rep) { if (rep) xcd_barrier(bar); PHASE_PTRS ew::prologue(in, out, ws, lds, G, bid); }
    SEAM(0);

#pragma unroll 1
    for (int l = 0; l < 2; ++l) {
        const int pb = 1 + 4 * l;
        if (EN(1) && IN(pb)) for (int rep = 0; rep < NREP(1, l == 0); ++rep) { if (rep) xcd_barrier(bar);
            PHASE_PTRS
            { pg8::Gemm g{XB, (const bf16_t*)(ws + WS_WINA) + (size_t)l * INA * DM, DM, DM, DM, 0}; pg8::StaticOrder S; S.init(PM / 256, INA / 256, G, bid);
              pg8::EpiZ E{Z, ssp, nullptr, nullptr}; pg8::gemm_phase(lds, g, S, E); }
            if (l == 0) { pg8::Gemm g{(const bf16_t*)(ws + WS_MHAT), (const bf16_t*)(ws + WS_WMEM), DM, DM, DM, 0}; pg8::StaticOrder S; S.init(2048 / 256, 4096 / 256, G, bid);
              pg8::EpiMem E{out + O_MEMK, MEMB}; pg8::gemm_phase(lds, g, S, E); }
            SUNITS(u, INA / 64) { sg::EpiZ E{Z, ssps, nullptr, nullptr}; sg::sgemm_unit(lds, XB + (size_t)PM * DM, DM, (const bf16_t*)(ws + WS_WINA) + (size_t)l * INA * DM, DM, DM, u * 64, E); }
        }
        SEAM(pb);
        if (EN(2) && IN(pb + 1)) for (int rep = 0; rep < NREP(2, l == 0); ++rep) { if (rep) xcd_barrier(bar);
            PHASE_PTRS
            for (int rep2 = 0; rep2 < NREP(15, l == 0); ++rep2) ew::pooling(l, in, out, ws, G, bid);
            for (int rep3 = 0; rep3 < NREP(16, l == 0); ++rep3)
            for (int u = bid; u < PB * MEMH * 8; u += G) { const int b = u >> 5, h = (u >> 3) & 3, x = u & 7; const size_t r0 = (size_t)b * PT + 256 * x;
                const bf16_t* Kh = MEMB + (size_t)b * 256 * 4096 + l * 1024 + h * 128;
                att::attn_body<128, false, 1, LDZ, 4096>(Z + r0 * LDZ + ZA_QM + h * 128, Kh, Kh + 512, nullptr, nullptr, Z + r0 * LDZ + ZA_GM + h * 128, MX + r0 * OUTW + 1024 + h * 128, 4, 0, lds);
                __syncthreads(); }
            SUNITS(u, SB * MEMH) { const int b = u >> 2, h = u & 3; const size_t r0 = (size_t)PM + b * 4; const size_t ko = (((size_t)l * SB + b) * MEMT * MEMH + h) * 128;
                dec::smem_unit(Z + r0 * LDZ + ZA_QM + h * 128, Z + r0 * LDZ + ZA_GM + h * 128, in[5] + ko, in[6] + ko, MX + r0 * OUTW + 1024 + h * 128, lds); }
        }
        SEAM(pb + 1);
        if (EN(3) && IN(pb + 2)) for (int rep = 0; rep < NREP(3, l == 0); ++rep) { if (rep) xcd_barrier(bar);
            PHASE_PTRS
            { pg8::Gemm g{PO, (const bf16_t*)(ws + WS_WGRP) + (size_t)l * 4 * 65536, DM, 256, 256, 256}; pg8::StaticOrder S; S.init(PM / 256, 4, G, bid);
              pg8::EpiGrp E{Z, MX}; pg8::gemm_phase(lds, g, S, E); }
            SUNITS(u, 16) { const int g = u >> 2; sg::EpiGrp E{Z, MX, g * 256};
                sg::sgemm_unit(lds, PO + (size_t)PM * DM + g * 256, DM, (const bf16_t*)(ws + WS_WGRP) + ((size_t)l * 4 + g) * 65536, 256, 256, (u & 3) * 64, E); }
        }
        SEAM(pb + 2);
        if (EN(4) && IN(pb + 3)) for (int rep = 0; rep < NREP(4, l == 0); ++rep) { if (rep) xcd_barrier(bar);
            PHASE_PTRS
            const float* baseP = l == 0 ? in[0] : XR; const float* baseS = l == 0 ? in[1] : XR + (size_t)PM * DM;
            { pg8::Gemm g{MX, (const bf16_t*)(ws + WS_WOUT) + (size_t)l * DM * OUTW, OUTW, OUTW, OUTW, 0}; pg8::StaticOrder S; S.init(PM / 256, DM / 256, G, bid);
              pg8::EpiOut E{baseP, XR, XB, ssp}; pg8::gemm_phase(lds, g, S, E); }
            SUNITS(u, DM / 64) { sg::EpiOut E{baseS, XR, XB, ssps};
                sg::sgemm_unit(lds, MX + (size_t)PM * OUTW, OUTW, (const bf16_t*)(ws + WS_WOUT) + (size_t)l * DM * OUTW, OUTW, OUTW, u * 64, E); }
        }
        SEAM(pb + 3);
    }

#pragma unroll 1
    for (int j = 0; j < 2; ++j) {
        const int l = 2 + j, pb = 9 + 7 * j; const int NB = j == 0 ? NB2 : NB3;
        if (EN(5) && IN(pb)) for (int rep = 0; rep < NREP(5, j == 0); ++rep) { if (rep) xcd_barrier(bar);
            PHASE_PTRS
            const bf16_t* WB = (const bf16_t*)(ws + WS_WINB) + (size_t)j * NB2 * DM; float* kvr = j == 0 ? KVRAW : nullptr;
            { pg8::Gemm g{XB, WB, DM, DM, DM, 0}; pg8::StaticOrder S; S.init(PM / 256, NB / 256, G, bid);
              pg8::EpiZ E{Z, ssp, ssq, kvr}; pg8::gemm_phase(lds, g, S, E); }
            SUNITS(u, NB / 64) { sg::EpiZ E{Z, ssps, ssq, kvr}; sg::sgemm_unit(lds, XB + (size_t)PM * DM, DM, WB, DM, DM, u * 64, E); }
        }
        SEAM(pb);
        if (EN(6) && IN(pb + 1)) for (int rep = 0; rep < NREP(6, j == 0); ++rep) { if (rep) xcd_barrier(bar);
            PHASE_PTRS
            if (j == 0) ew::kvpost(in, out, ws, G, bid);
            { pg8::Gemm g{Z + ZB_CQ, (const bf16_t*)(ws + WS_WQUP) + (size_t)j * QW * QRANK, LDZ, QRANK, QRANK, 0}; pg8::StaticOrder S; S.init(PM / 256, QW / 256, G, bid);
              pg8::EpiQ E{QB, ssq}; pg8::gemm_phase(lds, g, S, E); }
            for (int u = bid; u < PB * MEMH * 8; u += G) { const int b = u >> 5, h = (u >> 3) & 3, x = u & 7; const size_t r0 = (size_t)b * PT + 256 * x;
                const bf16_t* Kh = MEMB + (size_t)b * 256 * 4096 + l * 1024 + h * 128;
                att::attn_body<128, false, 1, LDZ, 4096>(Z + r0 * LDZ + ZB_QM + h * 128, Kh, Kh + 512, nullptr, nullptr, Z + r0 * LDZ + ZB_GM + h * 128, MX + r0 * OUTW + 1024 + h * 128, 4, 0, lds);
                __syncthreads(); }
            SUNITS(u, QW / 64) { sg::EpiQ E{QB, ssq}; sg::sgemm_unit(lds, Z + (size_t)PM * LDZ + ZB_CQ, LDZ, (const bf16_t*)(ws + WS_WQUP) + (size_t)j * QW * QRANK, QRANK, QRANK, u * 64, E); }
            SUNITS(u, SB * MEMH) { const int b = u >> 2, h = u & 3; const size_t r0 = (size_t)PM + b * 4; const size_t ko = (((size_t)l * SB + b) * MEMT * MEMH + h) * 128;
                dec::smem_unit(Z + r0 * LDZ + ZB_QM + h * 128, Z + r0 * LDZ + ZB_GM + h * 128, in[5] + ko, in[6] + ko, MX + r0 * OUTW + 1024 + h * 128, lds); }
        }
        SEAM(pb + 1);
        if (EN(7) && IN(pb + 2)) for (int rep = 0; rep < NREP(7, j == 0); ++rep) { if (rep) xcd_barrier(bar);
            PHASE_PTRS
            if (j == 0) { pg8::Gemm g{(const bf16_t*)(ws + WS_CKVB), (const bf16_t*)(ws + WS_WKV), KVR, KVR, KVR, 0}; pg8::StaticOrder S; S.init(PM / 256, 2048 / 256, G, bid);
              pg8::EpiKV E{(bf16_t*)(ws + WS_KN)}; pg8::gemm_phase(lds, g, S, E); }
            SUNITS(u, MLAH * 4) { const int h = u >> 2; sg::EpiAbsorb E{(bf16_t*)(ws + WS_QDEC), h};
                sg::sgemm_unit(lds, QB + (size_t)PM * QW + h * QHD, QW, (const bf16_t*)(ws + WS_WKUPN) + h * 128, 1024, 128, (u & 3) * 64, E); }
            ew::sq_rope(ws, G, bid);
        }
        SEAM(pb + 2);
        if (EN(8) && IN(pb + 3)) for (int rep = 0; rep < NREP(8, j == 0); ++rep) { if (rep) xcd_barrier(bar);
            PHASE_PTRS
            for (int rep2 = 0; rep2 < NREP(13, j == 0); ++rep2)
            for (int u = bid; u < PB * MLAH * 4; u += G) { const int b = u >> 5, h = (u >> 2) & 7, xp = u & 3;
#pragma unroll 1
                for (int s = 0; s < 2; ++s) { const int x = s == 0 ? 7 - xp : xp; const size_t b0 = (size_t)b * PT, r0 = b0 + 256 * x;
                    att::attn_body<192, true, 1, QW, 1024>(QB + r0 * QW + h * QHD, (const bf16_t*)(ws + WS_KN) + b0 * 1024 + h * 128, (const bf16_t*)(ws + WS_VV) + b0 * 1024 + h * 128,
                        (const bf16_t*)(ws + WS_KROPEB) + b0 * ROPE, (const f32x2*)(ws + WS_ROPE) + (size_t)(256 * x) * 32, Z + r0 * LDZ + ZB_GT + h * 128, MX + r0 * OUTW + h * 128, 4 * (x + 1), 4 * x, lds);
                    __syncthreads(); } }
            for (int rep3 = 0; rep3 < NREP(14, j == 0); ++rep3)
            for (int u = bid; u < SB * 8; u += G) { const int b = u >> 3, ch = u & 7;
                dec::decode_unit((const bf16_t*)(ws + WS_QDEC) + (size_t)b * 32 * 320, in[3], in[4], (const int*)in[7] + b * NPAGES + ch * 16,
                                 (float*)(ws + WS_OPART) + ((size_t)b * 8 + ch) * 32 * 256, (float*)(ws + WS_ML) + ((size_t)b * 8 + ch) * 32 * 2, lds);
                __syncthreads(); }
        }
        SEAM(pb + 3);
        if (EN(9) && IN(pb + 4)) for (int rep = 0; rep < NREP(9, j == 0); ++rep) { if (rep) xcd_barrier(bar);
            PHASE_PTRS
            const int ct = ew::otid();
            for (int w = bid * 8 + (ct >> 6); w < SB * 32; w += G * 8)
                dec::combine_row(w >> 5, w & 31, ct & 63, (const bf16_t*)(ws + WS_QDEC), (const float*)(ws + WS_OPART), (const float*)(ws + WS_ML), out + O_CKVS, out + O_KRS, (bf16_t*)(ws + WS_OLAT));
        }
        SEAM(pb + 4);
        if (EN(10) && IN(pb + 5)) for (int rep = 0; rep < NREP(10, j == 0); ++rep) { if (rep) xcd_barrier(bar);
            PHASE_PTRS
            SUNITS(u, MLAH * 2) { const int h = u >> 1; sg::EpiVup E{Z, MX, h};
                sg::sgemm_unit(lds, (const bf16_t*)(ws + WS_OLAT) + h * 256, 2048, (const bf16_t*)(ws + WS_WKV) + ((size_t)1024 + h * 128) * 256, 256, 256, (u & 1) * 64, E); }
        }
        SEAM(pb + 5);
        if (EN(11) && IN(pb + 6)) {
            PHASE_PTRS
            { pg8::Gemm g{MX, (const bf16_t*)(ws + WS_WOUT) + (size_t)l * DM * OUTW, OUTW, OUTW, OUTW, 0}; pg8::StaticOrder S; S.init(PM / 256, DM / 256, G, bid);
              pg8::EpiOut E{XR, XR, XB, ssp}; pg8::gemm_phase(lds, g, S, E); }
            SUNITS(u, DM / 64) { sg::EpiOut E{XR + (size_t)PM * DM, XR, XB, ssps};
                sg::sgemm_unit(lds, MX + (size_t)PM * OUTW, OUTW, (const bf16_t*)(ws + WS_WOUT) + (size_t)l * DM * OUTW, OUTW, OUTW, u * 64, E); }
        }
        SEAM(pb + 6);
    }
    if (EN(12) && IN(23)) for (int rep = 0; rep < NREP(12, true); ++rep) { if (rep) xcd_barrier(bar); PHASE_PTRS ew::final_norm(in, out, ws, G, bid); }
#undef IN
#undef SEAM
#undef SUNITS
}

#ifndef MK_LAUNCHES
#define MK_LAUNCHES 1
#endif
extern "C" void kernel_launch(void* const* d_in, const int* in_sizes, int n_in, void* d_out, int out_size, void* d_ws, size_t ws_size, hipStream_t stream) {
    static int grid = 0;
    if (grid == 0) {
        if (n_in != 26 || (size_t)out_size != O_END || ws_size < WS_END) { fprintf(stderr, "kernel_launch: unexpected shapes: n_in %d out %d ws %zu (need out %zu ws %zu)\n", n_in, out_size, ws_size, (size_t)O_END, (size_t)WS_END); grid = -1; return; }
        int dev = 0, cus = 0, per_cu = 0;
        if (hipGetDevice(&dev) != hipSuccess || hipDeviceGetAttribute(&cus, hipDeviceAttributeMultiprocessorCount, dev) != hipSuccess) { grid = -1; return; }
        if (hipFuncSetAttribute((const void*)yoco_fwd, hipFuncAttributeMaxDynamicSharedMemorySize, LDS_BYTES) != hipSuccess) { fprintf(stderr, "kernel_launch: hipFuncSetAttribute failed\n"); grid = -1; return; }
        if (hipOccupancyMaxActiveBlocksPerMultiprocessor(&per_cu, (const void*)yoco_fwd, 512, LDS_BYTES) != hipSuccess || per_cu < 1) { fprintf(stderr, "kernel_launch: occupancy query says %d blocks per CU\n", per_cu); (void)hipGetLastError(); grid = -1; return; }
        grid = cus;
    }
    if (grid < 0) return;
    (void)hipMemsetAsync((char*)d_ws + WS_CTL, 0, CTL_BYTES, stream);
    Params p{};
    for (int i = 0; i < 26; ++i) p.in[i] = (const float*)d_in[i];
    p.out = (float*)d_out; p.ws = (uchar*)d_ws;
    if (MK_LAUNCHES == 1) { p.ph_lo = 0; p.ph_hi = NPHASE; hipLaunchKernelGGL(yoco_fwd, dim3(grid), dim3(512), LDS_BYTES, stream, p); }
    else for (int k = 0; k < NPHASE; ++k) { p.ph_lo = k; p.ph_hi = k + 1; hipLaunchKernelGGL(yoco_fwd, dim3(grid), dim3(512), LDS_BYTES, stream, p); }
    const hipError_t le = hipPeekAtLastError();
    if (le != hipSuccess) fprintf(stderr, "kernel_launch: launch failed: %s\n", hipGetErrorName(le));
}
```

```cpp
#include <hip/hip_runtime.h>
#include <cstdio>
#include <cstdint>

#define LAS __attribute__((address_space(3)))
typedef unsigned char uchar;
typedef unsigned short bf16_t;
typedef short bf16x8 __attribute__((ext_vector_type(8)));
typedef short s16x4 __attribute__((ext_vector_type(4)));
typedef float f32x2 __attribute__((ext_vector_type(2)));
typedef float f32x4 __attribute__((ext_vector_type(4)));
typedef float f32x16 __attribute__((ext_vector_type(16)));
typedef unsigned u32x2 __attribute__((ext_vector_type(2)));
typedef unsigned u32x4 __attribute__((ext_vector_type(4)));

constexpr int DM = 1024, PB = 8, PT = 2048, PM = PB * PT, SB = 32, ST = 4, SM = SB * ST, RP = 16640;
constexpr int KVR = 256, ROPE = 64, NOPE = 128, QRANK = 384, MLAH = 8, QHD = 192, QW = MLAH * QHD;
constexpr int MEMT = 256, MEMH = 4, MEMW = 512;
constexpr int INA = 3072, INB = 2432, OUTW = 1536, LDZ = 3072, NB2 = 2816, NB3 = 2560;
constexpr int NPAGES = 128, PAGE = 128, PAST = 16384, POOLBUF = 15;
constexpr float EPS = 1e-6f;
constexpr int ZA_U = 0, ZA_GT = 1024, ZA_QM = 2048, ZA_GM = 2560;
constexpr int ZB_CQ = 0, ZB_KR = 384, ZB_GT = 512, ZB_QM = 1536, ZB_GM = 2048, ZB_KV = 2560;

constexpr size_t O_YP = 0, O_YS = O_YP + (size_t)PM * DM, O_PSP = O_YS + (size_t)SM * DM, O_PSS = O_PSP + (size_t)2 * PB * 15 * DM, O_CKVP = O_PSS + (size_t)2 * SB * 15 * DM,
                 O_KRP = O_CKVP + (size_t)PM * KVR, O_CKVS = O_KRP + (size_t)PM * ROPE, O_KRS = O_CKVS + (size_t)SM * KVR, O_MEMK = O_KRS + (size_t)SM * ROPE,
                 O_MEMV = O_MEMK + (size_t)4 * PB * MEMT * MEMW, O_END = O_MEMV + (size_t)4 * PB * MEMT * MEMW;

constexpr size_t al256(size_t x) { return (x + 255) / 256 * 256; }
constexpr size_t WS_CTL = 0, CTL_BYTES = 65536;
constexpr size_t WS_ROPE = WS_CTL + CTL_BYTES;
constexpr size_t WS_WINA = al256(WS_ROPE + (size_t)2052 * 32 * 8);
constexpr size_t WS_WGRP = al256(WS_WINA + (size_t)2 * INA * DM * 2);
constexpr size_t WS_WINB = al256(WS_WGRP + (size_t)2 * 4 * 256 * 256 * 2);
constexpr size_t WS_WQUP = al256(WS_WINB + (size_t)2 * NB2 * DM * 2);
constexpr size_t WS_WKV  = al256(WS_WQUP + (size_t)2 * QW * QRANK * 2);
constexpr size_t WS_WKUPN = al256(WS_WKV + (size_t)2048 * 256 * 2);
constexpr size_t WS_WMEM = al256(WS_WKUPN + (size_t)256 * 1024 * 2);
constexpr size_t WS_WOUT = al256(WS_WMEM + (size_t)4096 * 1024 * 2);
constexpr size_t WS_MHAT = al256(WS_WOUT + (size_t)4 * DM * OUTW * 2);
constexpr size_t WS_MEMB = al256(WS_MHAT + (size_t)2048 * 1024 * 2);
constexpr size_t WS_XRES = al256(WS_MEMB + (size_t)2048 * 4096 * 2);
constexpr size_t WS_XB   = al256(WS_XRES + (size_t)RP * DM * 4);
constexpr size_t WS_SSP  = al256(WS_XB + (size_t)RP * DM * 2);
constexpr size_t WS_SSPS = al256(WS_SSP + (size_t)PM * 16 * 4);
constexpr size_t WS_SSQ  = al256(WS_SSPS + (size_t)SM * 32 * 4);
constexpr size_t WS_Z    = al256(WS_SSQ + (size_t)RP * 12 * 4);
constexpr size_t WS_POOLED = al256(WS_Z + (size_t)RP * LDZ * 2);
constexpr size_t WS_MIXED = al256(WS_POOLED + (size_t)RP * DM * 2);
constexpr size_t WS_Q    = al256(WS_MIXED + (size_t)RP * OUTW * 2);
constexpr size_t WS_KVRAW = al256(WS_Q + (size_t)RP * QW * 2);
constexpr size_t WS_CKVB = al256(WS_KVRAW + (size_t)RP * 320 * 4);
constexpr size_t WS_KROPEB = al256(WS_CKVB + (size_t)RP * 256 * 2);
constexpr size_t WS_KN   = al256(WS_KROPEB + (size_t)RP * 64 * 2);
constexpr size_t WS_VV   = al256(WS_KN + (size_t)PM * 1024 * 2);
constexpr size_t WS_QDEC = al256(WS_VV + (size_t)PM * 1024 * 2);
constexpr size_t WS_OPART = al256(WS_QDEC + (size_t)SB * 32 * 320 * 2);
constexpr size_t WS_ML   = al256(WS_OPART + (size_t)SB * 8 * 32 * 256 * 4);
constexpr size_t WS_OLAT = al256(WS_ML + (size_t)SB * 8 * 32 * 2 * 4);
constexpr size_t WS_END  = al256(WS_OLAT + (size_t)SM * 2048 * 2);

__device__ __forceinline__ unsigned cvt_pk_bf16(float lo, float hi) { unsigned r; asm volatile("v_cvt_pk_bf16_f32 %0, %1, %2" : "=v"(r) : "v"(lo), "v"(hi)); return r; }
__device__ __forceinline__ float bf_lo(unsigned w) { return __uint_as_float(w << 16); }
__device__ __forceinline__ float bf_hi(unsigned w) { return __uint_as_float(w & 0xffff0000u); }
__device__ __forceinline__ float bf2f(bf16_t b) { return __uint_as_float(((unsigned)b) << 16); }
__device__ __forceinline__ float silu(float x) { return x * __builtin_amdgcn_rcpf(1.0f + __expf(-x)); }
__device__ __forceinline__ void unpack8(const u32x4 w, float (&f)[8]) {
    f[0] = bf_lo(w.x); f[1] = bf_hi(w.x); f[2] = bf_lo(w.y); f[3] = bf_hi(w.y); f[4] = bf_lo(w.z); f[5] = bf_hi(w.z); f[6] = bf_lo(w.w); f[7] = bf_hi(w.w); }
__device__ __forceinline__ u32x4 pack8(const float (&f)[8]) { u32x4 w; w.x = cvt_pk_bf16(f[0], f[1]); w.y = cvt_pk_bf16(f[2], f[3]); w.z = cvt_pk_bf16(f[4], f[5]); w.w = cvt_pk_bf16(f[6], f[7]); return w; }
__device__ __forceinline__ float sum4(const f32x4 a) { return (a[0] + a[1]) + (a[2] + a[3]); }
__device__ __forceinline__ float rs_from16(const float* p) {
    const f32x4 a = *(const f32x4*)p, b = *(const f32x4*)(p + 4), c = *(const f32x4*)(p + 8), d = *(const f32x4*)(p + 12);
    return rsqrtf(((sum4(a) + sum4(b)) + (sum4(c) + sum4(d))) * (1.0f / 1024.0f) + EPS); }
__device__ __forceinline__ float rs_from32(const float* p) { float s = 0.f;
#pragma unroll
    for (int i = 0; i < 8; ++i) s += sum4(*(const f32x4*)(p + 4 * i));
    return rsqrtf(s * (1.0f / 1024.0f) + EPS); }
__device__ __forceinline__ float rsq_from12(const float* p) {
    const f32x4 a = *(const f32x4*)p, b = *(const f32x4*)(p + 4), c = *(const f32x4*)(p + 8);
    return rsqrtf((sum4(a) + sum4(b) + sum4(c)) * (1.0f / 384.0f) + EPS); }
__device__ __forceinline__ int crow(int r, int hi) { return (r & 3) + 8 * (r >> 2) + 4 * hi; }
static_assert(WS_VV == WS_KN + (size_t)PM * 1024 * 2, "VV must follow KN");
namespace pg8 {
constexpr int BM = 256, BK = 64, HALF = 128, HTB = HALF * BK * 2, STAGE_BYTES = 8 * HTB, NXCD = 8, WGM = 8;
__device__ __forceinline__ int lds_byte(int r, int c) { const int st = (r >> 4) * 2 + (c >> 5), rr = r & 15, cc = c & 31, ob = rr * 64 + cc * 2; return st * 1024 + (ob ^ (((ob >> 9) & 1) << 5)); }
__device__ __forceinline__ void stage_rc(int b, int& R, int& C) { const int st = b / 1024, sb = b % 1024, swz = sb ^ (((sb >> 9) & 1) << 5); R = (st >> 1) * 16 + swz / 64; C = (st & 1) * 32 + (swz % 64) / 2; }
__device__ __forceinline__ int perm32(int rho) { const int n = rho >> 4, i = rho & 15; return 8 * (i >> 2) + 4 * n + (i & 3); }

struct Unit { int pm, pn; };
struct Gemm { const bf16_t* A; const bf16_t* Bt; int lda, ldb, K, a_pn; };

struct StaticOrder {
    int nM, nN, nwg, G, c;
    __device__ void init(int nM_, int nN_, int G_, int c_) { nM = nM_; nN = nN_; nwg = nM * nN; G = G_; c = c_; }
    __device__ bool next(int i, Unit& u) const {
        const long L = (long)i * G + c; if (L >= nwg) return false;
        int wgid = (int)L; { const int q = nwg / NXCD, r = nwg % NXCD, xcd = wgid % NXCD, off = wgid / NXCD; wgid = (xcd < r ? xcd * (q + 1) : r * (q + 1) + (xcd - r) * q) + off; }
        const int nig = WGM * nN, gid = wgid / nig, fm = gid * WGM, gsz = (nM - fm) < WGM ? (nM - fm) : WGM;
        u.pm = fm + ((wgid % nig) % gsz); u.pn = (wgid % nig) / gsz; return true;
    }
};

template <class Epi>
__device__ __forceinline__ void gemm_phase(LAS uchar* lds, const Gemm g, const StaticOrder& S, const Epi& E) {
    int tid_ = threadIdx.x; asm volatile("" : "+v"(tid_));
    const int tid = tid_, wid = __builtin_amdgcn_readfirstlane(tid >> 6), lane = tid & 63, wr = wid >> 2, wc = wid & 3, fr = lane & 15, fq = lane >> 4;
    int K_ = g.K; asm volatile("" : "+s"(K_));
    const int K = K_, nt = K / BK;
    unsigned voffA[2], voffB[2];
#pragma unroll
    for (int i = 0; i < 2; ++i) { int R, C; stage_rc(tid * 16 + i * 8192, R, C); const int Rb = Epi::PERM ? ((R & ~31) + perm32(R & 31)) : R;
        voffA[i] = (unsigned)(R * g.lda + C) * 2u; voffB[i] = (unsigned)(Rb * g.ldb + C) * 2u; }
    const size_t kstep = (size_t)(BK * 2);
    const size_t hstepA = (size_t)HALF * g.lda * 2, hstepB = (size_t)HALF * g.ldb * 2;
    const size_t tstepA = 2 * hstepA, tstepB = 2 * hstepB;
    const unsigned ldsw = (unsigned)wid * 1024u;
    const int aoff = lds_byte(wr * 64 + fr, fq * 8), boff = lds_byte(wc * 32 + fr, fq * 8);
#define PG8_SA(b, h) (((b) * 2 + (h)) * HTB)
#define PG8_SB(b, h) ((4 + (b) * 2 + (h)) * HTB)
#define PG8_STAGE(bufoff, gbase, voff) do { _Pragma("unroll") for (int _i = 0; _i < 2; ++_i) \
        __builtin_amdgcn_global_load_lds((const unsigned*)((const char*)(gbase) + (voff)[_i]), (LAS unsigned*)(lds + (bufoff) + ldsw + _i * 8192), 16, 0, 0); } while (0)
#define PG8_LDA(dst, b, h) do { _Pragma("unroll") for (int m = 0; m < 4; ++m) _Pragma("unroll") for (int k = 0; k < 2; ++k) dst[m][k] = *(const LAS bf16x8*)(lds + PG8_SA(b, h) + aoff + m * 2048 + k * 1024); } while (0)
#define PG8_LDB(dst, b, h) do { _Pragma("unroll") for (int n = 0; n < 2; ++n) _Pragma("unroll") for (int k = 0; k < 2; ++k) dst[n][k] = *(const LAS bf16x8*)(lds + PG8_SB(b, h) + boff + n * 2048 + k * 1024); } while (0)
#define PG8_MMA(ai, bj, At, Bt) do { __builtin_amdgcn_s_setprio(1); _Pragma("unroll") for (int m = 0; m < 4; ++m) _Pragma("unroll") for (int n = 0; n < 2; ++n) _Pragma("unroll") for (int k = 0; k < 2; ++k) \
        acc[ai][bj][m][n] = __builtin_amdgcn_mfma_f32_16x16x32_bf16(Bt[n][k], At[m][k], acc[ai][bj][m][n], 0, 0, 0); __builtin_amdgcn_s_setprio(0); } while (0)
#define PG8_WAIT_V(n) asm volatile("s_waitcnt vmcnt(" #n ")" ::: "memory")
#define PG8_WAIT_L(n) asm volatile("s_waitcnt lgkmcnt(" #n ")" ::: "memory")
#define PG8_BAR __builtin_amdgcn_s_barrier()
#define PG8_SCHED __builtin_amdgcn_sched_barrier(0)
    Unit cur, nxt; int ui = 0;
    if (!S.next(0, cur)) return;
    f32x4 acc[2][2][4][2];
#pragma unroll
    for (int a = 0; a < 2; ++a)
#pragma unroll
        for (int b = 0; b < 2; ++b)
#pragma unroll
            for (int m = 0; m < 4; ++m)
#pragma unroll
                for (int n = 0; n < 2; ++n) acc[a][b][m][n] = (f32x4){0.f, 0.f, 0.f, 0.f};
    bf16x8 At[4][2], B0[2][2], B1[2][2];
    const char* cA = (const char*)g.A + (size_t)cur.pm * tstepA + (size_t)cur.pn * g.a_pn * 2; const char* cB = (const char*)g.Bt + (size_t)cur.pn * tstepB;
    PG8_STAGE(PG8_SB(0, 0), cB, voffB); PG8_STAGE(PG8_SA(0, 0), cA, voffA); PG8_STAGE(PG8_SB(0, 1), cB + hstepB, voffB); PG8_STAGE(PG8_SA(0, 1), cA + hstepA, voffA);
    if (wr == 1) PG8_BAR;
    PG8_WAIT_V(4); PG8_BAR;
    PG8_STAGE(PG8_SB(1, 0), cB + kstep, voffB); PG8_STAGE(PG8_SA(1, 0), cA + kstep, voffA); PG8_STAGE(PG8_SB(1, 1), cB + hstepB + kstep, voffB);
    PG8_WAIT_V(6); PG8_BAR;
    for (;;) {
        const bool has_next = S.next(ui + 1, nxt);
        const char* nA = has_next ? (const char*)g.A + (size_t)nxt.pm * tstepA + (size_t)nxt.pn * g.a_pn * 2 : cA; const char* nB = has_next ? (const char*)g.Bt + (size_t)nxt.pn * tstepB : cB;
        for (int t = 0; t < nt; t += 2) {
            const bool last = (t == nt - 2);
            const char* a1 = cA + (size_t)(t + 1) * kstep;
            const char* a2 = last ? nA : cA + (size_t)(t + 2) * kstep; const char* b2 = last ? nB : cB + (size_t)(t + 2) * kstep;
            const char* a3 = a2 + kstep; const char* b3 = b2 + kstep;
            PG8_LDB(B0, 0, 0); PG8_SCHED; PG8_LDA(At, 0, 0); PG8_STAGE(PG8_SA(1, 1), a1 + hstepA, voffA);
            PG8_WAIT_L(8); PG8_BAR; PG8_WAIT_L(0); PG8_MMA(0, 0, At, B0); PG8_BAR; PG8_SCHED;
            PG8_LDB(B1, 0, 1); PG8_STAGE(PG8_SB(0, 0), b2, voffB);
            PG8_BAR; PG8_WAIT_L(0); PG8_MMA(0, 1, At, B1); PG8_BAR;
            PG8_LDA(At, 0, 1); PG8_STAGE(PG8_SA(0, 0), a2, voffA);
            PG8_BAR; PG8_WAIT_L(0); PG8_MMA(1, 0, At, B0); PG8_BAR; PG8_SCHED;
            PG8_STAGE(PG8_SB(0, 1), b2 + hstepB, voffB);
            PG8_WAIT_V(6); PG8_BAR; PG8_MMA(1, 1, At, B1); PG8_BAR;
            PG8_LDB(B0, 1, 0); PG8_SCHED; PG8_LDA(At, 1, 0); PG8_STAGE(PG8_SA(0, 1), a2 + hstepA, voffA);
            PG8_WAIT_L(8); PG8_BAR; PG8_WAIT_L(0); PG8_MMA(0, 0, At, B0); PG8_BAR; PG8_SCHED;
            PG8_LDB(B1, 1, 1); PG8_STAGE(PG8_SB(1, 0), b3, voffB);
            PG8_BAR; PG8_WAIT_L(0); PG8_MMA(0, 1, At, B1); PG8_BAR;
            PG8_LDA(At, 1, 1); PG8_STAGE(PG8_SA(1, 0), a3, voffA);
            PG8_BAR; PG8_WAIT_L(0); PG8_MMA(1, 0, At, B0); PG8_BAR; PG8_SCHED;
            PG8_STAGE(PG8_SB(1, 1), b3 + hstepB, voffB);
            PG8_WAIT_V(6); PG8_BAR; PG8_MMA(1, 1, At, B1); PG8_BAR;
        }
        E(acc, cur, wr, wc, fr, fq);
        if (!has_next) break;
#pragma unroll
        for (int a = 0; a < 2; ++a)
#pragma unroll
            for (int b = 0; b < 2; ++b)
#pragma unroll
                for (int m = 0; m < 4; ++m)
#pragma unroll
                    for (int n = 0; n < 2; ++n) acc[a][b][m][n] = (f32x4){0.f, 0.f, 0.f, 0.f};
        cur = nxt; cA = nA; cB = nB; ++ui;
    }
    PG8_WAIT_V(0);
    if (wr == 0) PG8_BAR;
    PG8_BAR;
#undef PG8_SA
#undef PG8_SB
#undef PG8_STAGE
#undef PG8_LDA
#undef PG8_LDB
#undef PG8_MMA
#undef PG8_WAIT_V
#undef PG8_WAIT_L
#undef PG8_BAR
#undef PG8_SCHED
}

typedef f32x4 Acc[2][2][4][2];
struct EpiZ { static constexpr bool PERM = true;
    bf16_t* Z; const float* ssp; float* ssq; float* kvraw;
    __device__ __forceinline__ void operator()(const Acc& acc, const Unit& u, int wr, int wc, int fr, int fq) const {
        const int rbase = u.pm * BM + wr * 64 + fr, col0 = u.pn * BM + wc * 32 + 8 * fq;
        const bool kvt = (kvraw != nullptr) && u.pn == 10, wantq = (ssq != nullptr) && u.pn <= 1;
#pragma unroll
        for (int ai = 0; ai < 2; ++ai)
#pragma unroll
            for (int m = 0; m < 4; ++m) { const int row = rbase + ai * HALF + m * 16; const float rs = rs_from16(ssp + (size_t)row * 16);
#pragma unroll
                for (int bj = 0; bj < 2; ++bj) { const f32x4 v0 = acc[ai][bj][m][0] * rs, v1 = acc[ai][bj][m][1] * rs; const int c = col0 + bj * HALF;
                    if (!kvt) { u32x4 w; w.x = cvt_pk_bf16(v0[0], v0[1]); w.y = cvt_pk_bf16(v0[2], v0[3]); w.z = cvt_pk_bf16(v1[0], v1[1]); w.w = cvt_pk_bf16(v1[2], v1[3]);
                        *(u32x4*)(Z + (size_t)row * LDZ + c) = w; }
                    else { float* p = kvraw + (size_t)row * 320 + (c - ZB_KV); *(f32x4*)p = v0; *(f32x4*)(p + 4) = v1; }
                    if (kvraw != nullptr && u.pn == 1 && bj == 1 && wc < 2) { float* p = kvraw + (size_t)row * 320 + 256 + (c - ZB_KR); *(f32x4*)p = v0; *(f32x4*)(p + 4) = v1; }
                    if (wantq && (u.pn == 0 || bj == 0)) { float s = sum4(v0 * v0) + sum4(v1 * v1); s += __shfl_xor(s, 16); s += __shfl_xor(s, 32);
                        if (fq == 0) ssq[(size_t)row * 12 + (u.pn == 0 ? bj * 4 + wc : 8 + wc)] = s; } } }
    }
};
struct EpiGrp { static constexpr bool PERM = true;
    const bf16_t* Z; bf16_t* MX;
    __device__ __forceinline__ void operator()(const Acc& acc, const Unit& u, int wr, int wc, int fr, int fq) const {
        const int rbase = u.pm * BM + wr * 64 + fr, col0 = u.pn * BM + wc * 32 + 8 * fq;
#pragma unroll
        for (int ai = 0; ai < 2; ++ai)
#pragma unroll
            for (int m = 0; m < 4; ++m) { const int row = rbase + ai * HALF + m * 16;
                const u32x4 g0 = *(const u32x4*)(Z + (size_t)row * LDZ + ZA_GT + col0), g1 = *(const u32x4*)(Z + (size_t)row * LDZ + ZA_GT + col0 + HALF);
#pragma unroll
                for (int bj = 0; bj < 2; ++bj) { const int c = col0 + bj * HALF; float gt[8]; unpack8(bj ? g1 : g0, gt);
                    const f32x4 v0 = acc[ai][bj][m][0], v1 = acc[ai][bj][m][1]; float o[8];
#pragma unroll
                    for (int j = 0; j < 4; ++j) { o[j] = v0[j] * silu(gt[j]); o[4 + j] = v1[j] * silu(gt[4 + j]); }
                    *(u32x4*)(MX + (size_t)row * OUTW + c) = pack8(o); }
                asm volatile("" ::: "memory"); }
    }
};
struct EpiQ { static constexpr bool PERM = true;
    bf16_t* Q; const float* ssq;
    __device__ __forceinline__ void operator()(const Acc& acc, const Unit& u, int wr, int wc, int fr, int fq) const {
        const int rbase = u.pm * BM + wr * 64 + fr, col0 = u.pn * BM + wc * 32 + 8 * fq;
#pragma unroll
        for (int ai = 0; ai < 2; ++ai)
#pragma unroll
            for (int m = 0; m < 4; ++m) { const int row = rbase + ai * HALF + m * 16; const float rs = rsq_from12(ssq + (size_t)row * 12);
#pragma unroll
                for (int bj = 0; bj < 2; ++bj) { const f32x4 v0 = acc[ai][bj][m][0] * rs, v1 = acc[ai][bj][m][1] * rs;
                    u32x4 w; w.x = cvt_pk_bf16(v0[0], v0[1]); w.y = cvt_pk_bf16(v0[2], v0[3]); w.z = cvt_pk_bf16(v1[0], v1[1]); w.w = cvt_pk_bf16(v1[2], v1[3]);
                    *(u32x4*)(Q + (size_t)row * QW + col0 + bj * HALF) = w; } }
    }
};
struct EpiKV { static constexpr bool PERM = true;
    bf16_t* KN;
    __device__ __forceinline__ void operator()(const Acc& acc, const Unit& u, int wr, int wc, int fr, int fq) const {
        const int rbase = u.pm * BM + wr * 64 + fr, col0 = (u.pn & 3) * BM + wc * 32 + 8 * fq; bf16_t* O = KN + (size_t)(u.pn >> 2) * ((size_t)PM * 1024);
#pragma unroll
        for (int ai = 0; ai < 2; ++ai)
#pragma unroll
            for (int m = 0; m < 4; ++m) { const int row = rbase + ai * HALF + m * 16;
#pragma unroll
                for (int bj = 0; bj < 2; ++bj) { const f32x4 v0 = acc[ai][bj][m][0], v1 = acc[ai][bj][m][1];
                    u32x4 w; w.x = cvt_pk_bf16(v0[0], v0[1]); w.y = cvt_pk_bf16(v0[2], v0[3]); w.z = cvt_pk_bf16(v1[0], v1[1]); w.w = cvt_pk_bf16(v1[2], v1[3]);
                    *(u32x4*)(O + (size_t)row * 1024 + col0 + bj * HALF) = w; } }
    }
};
struct EpiMem { static constexpr bool PERM = false;
    float* OK; bf16_t* MB;
    __device__ __forceinline__ void operator()(const Acc& acc, const Unit& u, int wr, int wc, int fr, int fq) const {
        const int rbase = u.pm * BM + wr * 64 + fr, col0 = u.pn * BM + wc * 32 + 4 * fq;
#pragma unroll
        for (int ai = 0; ai < 2; ++ai)
#pragma unroll
            for (int m = 0; m < 4; ++m) { const int row = rbase + ai * HALF + m * 16;
#pragma unroll
                for (int bj = 0; bj < 2; ++bj)
#pragma unroll
                    for (int n = 0; n < 2; ++n) { const int c = col0 + bj * HALF + n * 16; const int l = c >> 10, kv = (c >> 9) & 1, cc = c & 511; const f32x4 v = acc[ai][bj][m][n];
                        *(f32x4*)(OK + (size_t)kv * (O_MEMV - O_MEMK) + ((size_t)l * 2048 + row) * 512 + cc) = v;
                        u32x2 w; w.x = cvt_pk_bf16(v[0], v[1]); w.y = cvt_pk_bf16(v[2], v[3]); *(u32x2*)(MB + (size_t)row * 4096 + c) = w; } }
    }
};
struct EpiOut { static constexpr bool PERM = false;
    bf16_t* XB; float* ssp;
    __device__ __forceinline__ void operator()(const Acc& acc, const Unit& u, int wr, int wc, int fr, int fq) const {
        const int rbase = u.pm * BM + wr * 64 + fr, col0 = u.pn * BM + wc * 32 + 4 * fq;
        u32x2 bw[2][4][2][2];
#pragma unroll
        for (int ai = 0; ai < 2; ++ai)
#pragma unroll
            for (int m = 0; m < 4; ++m)
#pragma unroll
                for (int bj = 0; bj < 2; ++bj)
#pragma unroll
                    for (int n = 0; n < 2; ++n) bw[ai][m][bj][n] = *(const u32x2*)(XB + (size_t)(rbase + ai * HALF + m * 16) * DM + col0 + bj * HALF + n * 16);
#pragma unroll
        for (int ai = 0; ai < 2; ++ai)
#pragma unroll
            for (int m = 0; m < 4; ++m) { const int row = rbase + ai * HALF + m * 16; float s = 0.f;
#pragma unroll
                for (int bj = 0; bj < 2; ++bj)
#pragma unroll
                    for (int n = 0; n < 2; ++n) { const size_t o = (size_t)row * DM + col0 + bj * HALF + n * 16; const u32x2 b = bw[ai][m][bj][n];
                        const f32x4 v = (f32x4){bf_lo(b.x), bf_hi(b.x), bf_lo(b.y), bf_hi(b.y)} + acc[ai][bj][m][n];
                        u32x2 w; w.x = cvt_pk_bf16(v[0], v[1]); w.y = cvt_pk_bf16(v[2], v[3]); *(u32x2*)(XB + o) = w; s += sum4(v * v); }
                s += __shfl_xor(s, 16); s += __shfl_xor(s, 32);
                if (fq == 0) ssp[(size_t)row * 16 + u.pn * 4 + wc] = s; }
    }
};
}
namespace sg {
constexpr int BUF = 24576, LDS_BYTES = 2 * BUF;
template <class Epi>
__device__ __forceinline__ void sgemm_unit(LAS uchar* lds, const bf16_t* A, int lda, const bf16_t* Bt, int ldb, int K, int n0, const Epi& E) {
    int tid_ = threadIdx.x; asm volatile("" : "+v"(tid_));
    const int tid = tid_, wid = tid >> 6, lane = tid & 63, r32 = lane & 31, hi = lane >> 5, rb = wid & 3, cb = wid >> 2;
    const int srow = tid >> 3, sch = tid & 7;
    const bf16_t* ap0 = A + (size_t)srow * lda + sch * 8; const bf16_t* ap1 = ap0 + (size_t)64 * lda; const bf16_t* bp = Bt + (size_t)(n0 + srow) * ldb + sch * 8;
    const int aw0 = srow * 128 + ((sch ^ (srow & 7)) << 4), aw1 = aw0 + 64 * 128, bw = 16384 + aw0;
    const int arow = rb * 32 + r32, brow = cb * 32 + r32;
    const int ard = arow * 128, brd = 16384 + brow * 128, asw = arow & 7, bsw = brow & 7;
    u32x4 ra0[2], ra1[2], rbv[2];
    f32x16 acc = {};
    const int nk = K / 64;
#define SG_LOAD(s, kt) do { ra0[s] = *(const u32x4*)(ap0 + (size_t)(kt) * 64); ra1[s] = *(const u32x4*)(ap1 + (size_t)(kt) * 64); rbv[s] = *(const u32x4*)(bp + (size_t)(kt) * 64); } while (0)
#define SG_WRITE(s, b) do { *(LAS u32x4*)(lds + (b) * BUF + aw0) = ra0[s]; *(LAS u32x4*)(lds + (b) * BUF + aw1) = ra1[s]; *(LAS u32x4*)(lds + (b) * BUF + bw) = rbv[s]; } while (0)
#define SG_COMPUTE(b) do { _Pragma("unroll") for (int kk = 0; kk < 4; ++kk) { \
        const bf16x8 af = *(const LAS bf16x8*)(lds + (b) * BUF + ard + (((2 * kk + hi) ^ asw) << 4)); \
        const bf16x8 bf = *(const LAS bf16x8*)(lds + (b) * BUF + brd + (((2 * kk + hi) ^ bsw) << 4)); \
        acc = __builtin_amdgcn_mfma_f32_32x32x16_bf16(bf, af, acc, 0, 0, 0); } } while (0)
    SG_LOAD(0, 0); SG_LOAD(1, 1);
    for (int kt = 0; kt < nk; kt += 2) {
        SG_WRITE(0, 0); __syncthreads(); if (kt + 2 < nk) SG_LOAD(0, kt + 2);
        SG_COMPUTE(0);
        SG_WRITE(1, 1); __syncthreads(); if (kt + 3 < nk) SG_LOAD(1, kt + 3);
        SG_COMPUTE(1);
    }
#undef SG_LOAD
#undef SG_WRITE
#undef SG_COMPUTE
    E(acc, rb * 32 + r32, n0 + cb * 32, hi);
}

struct EpiZ { bf16_t* Z; const float* ssps; float* ssq; float* kvraw;
    __device__ __forceinline__ void operator()(const f32x16& acc, int row, int cbase, int hi) const {
        const float rs = rs_from32(ssps + row * 32); const size_t grow = (size_t)PM + row; float s = 0.f;
#pragma unroll
        for (int g = 0; g < 4; ++g) { const f32x4 v = (f32x4){acc[4 * g], acc[4 * g + 1], acc[4 * g + 2], acc[4 * g + 3]} * rs; const int c = cbase + 8 * g + 4 * hi;
            if (kvraw != nullptr && cbase >= ZB_KV) *(f32x4*)(kvraw + grow * 320 + (c - ZB_KV)) = v;
            else { u32x2 w; w.x = cvt_pk_bf16(v[0], v[1]); w.y = cvt_pk_bf16(v[2], v[3]); *(u32x2*)(Z + grow * LDZ + c) = w; }
            if (kvraw != nullptr && cbase >= ZB_KR && cbase < ZB_KR + 64) *(f32x4*)(kvraw + grow * 320 + 256 + (c - ZB_KR)) = v;
            s += sum4(v * v); }
        if (ssq != nullptr && cbase < QRANK) { s += __shfl_xor(s, 32); if (hi == 0) ssq[grow * 12 + (cbase >> 5)] = s; }
    }
};
struct EpiGrp { const bf16_t* Z; bf16_t* MX; int cofs;
    __device__ __forceinline__ void operator()(const f32x16& acc, int row, int cbase, int hi) const {
        const size_t grow = (size_t)PM + row;
#pragma unroll
        for (int g = 0; g < 4; ++g) { const int c = cofs + cbase + 8 * g + 4 * hi; const u32x2 gw = *(const u32x2*)(Z + grow * LDZ + ZA_GT + c);
            const float o0 = acc[4 * g] * silu(bf_lo(gw.x)), o1 = acc[4 * g + 1] * silu(bf_hi(gw.x)), o2 = acc[4 * g + 2] * silu(bf_lo(gw.y)), o3 = acc[4 * g + 3] * silu(bf_hi(gw.y));
            u32x2 w; w.x = cvt_pk_bf16(o0, o1); w.y = cvt_pk_bf16(o2, o3); *(u32x2*)(MX + grow * OUTW + c) = w; }
    }
};
struct EpiOut { bf16_t* XB; float* ssps;
    __device__ __forceinline__ void operator()(const f32x16& acc, int row, int cbase, int hi) const {
        const size_t grow = (size_t)PM + row; float s = 0.f;
#pragma unroll
        for (int g = 0; g < 4; ++g) { const int c = cbase + 8 * g + 4 * hi; const u32x2 b = *(const u32x2*)(XB + grow * DM + c);
            const f32x4 v = (f32x4){bf_lo(b.x), bf_hi(b.x), bf_lo(b.y), bf_hi(b.y)} + (f32x4){acc[4 * g], acc[4 * g + 1], acc[4 * g + 2], acc[4 * g + 3]};
            u32x2 w; w.x = cvt_pk_bf16(v[0], v[1]); w.y = cvt_pk_bf16(v[2], v[3]); *(u32x2*)(XB + grow * DM + c) = w; s += sum4(v * v); }
        s += __shfl_xor(s, 32); if (hi == 0) ssps[row * 32 + (cbase >> 5)] = s;
    }
};
struct EpiQ { bf16_t* Q; const float* ssq;
    __device__ __forceinline__ void operator()(const f32x16& acc, int row, int cbase, int hi) const {
        const size_t grow = (size_t)PM + row; const float rs = rsq_from12(ssq + grow * 12);
#pragma unroll
        for (int g = 0; g < 4; ++g) { const int c = cbase + 8 * g + 4 * hi; u32x2 w; w.x = cvt_pk_bf16(acc[4 * g] * rs, acc[4 * g + 1] * rs); w.y = cvt_pk_bf16(acc[4 * g + 2] * rs, acc[4 * g + 3] * rs);
            *(u32x2*)(Q + grow * QW + c) = w; }
    }
};
struct EpiAbsorb { bf16_t* QD; int h;
    __device__ __forceinline__ void operator()(const f32x16& acc, int row, int cbase, int hi) const {
        const int b = row >> 2, t = row & 3; bf16_t* o = QD + ((size_t)b * 32 + t * 8 + h) * 320;
#pragma unroll
        for (int g = 0; g < 4; ++g) { const int c = cbase + 8 * g + 4 * hi; u32x2 w; w.x = cvt_pk_bf16(acc[4 * g], acc[4 * g + 1]); w.y = cvt_pk_bf16(acc[4 * g + 2], acc[4 * g + 3]); *(u32x2*)(o + c) = w; }
    }
};
struct EpiVup { const bf16_t* Z; bf16_t* MX; int h;
    __device__ __forceinline__ void operator()(const f32x16& acc, int row, int cbase, int hi) const {
        const size_t grow = (size_t)PM + row;
#pragma unroll
        for (int g = 0; g < 4; ++g) { const int c = h * 128 + cbase + 8 * g + 4 * hi; const u32x2 gw = *(const u32x2*)(Z + grow * LDZ + ZB_GT + c);
            const float o0 = acc[4 * g] * silu(bf_lo(gw.x)), o1 = acc[4 * g + 1] * silu(bf_hi(gw.x)), o2 = acc[4 * g + 2] * silu(bf_lo(gw.y)), o3 = acc[4 * g + 3] * silu(bf_hi(gw.y));
            u32x2 w; w.x = cvt_pk_bf16(o0, o1); w.y = cvt_pk_bf16(o2, o3); *(u32x2*)(MX + grow * OUTW + c) = w; }
    }
};
}
namespace att {
constexpr int NW = 8, QBLK = 32, KVBLK = 64;
constexpr int SHM_V = KVBLK * 128 * 2, SHM_K = KVBLK * 128 * 2, SHM_KR = KVBLK * 64 * 2;
constexpr int OFF_V = 0, OFF_K = 2 * SHM_V, OFF_KR = OFF_K + 2 * SHM_K, OFF_WS = OFF_KR + 2 * SHM_KR, OFF_QR = OFF_WS + NW * 64 * 4, LDS_BYTES = OFF_QR + NW * 4096;
constexpr float THR = 8.f;
#define KSWZ(row, colB) ((row) * 256 + ((colB) ^ (((row) & 7) << 4)))
#define KRSWZ(row, colB) ((row) * 128 + ((colB) ^ (((row) & 7) << 4)))
#define SBAR() __builtin_amdgcn_sched_barrier(0)
template <int DQK> struct Cst { static constexpr float SCALE = (DQK == 128) ? 0.08838834764831845f : 0.07216878364870322f; };

template <int DQK>
__device__ __forceinline__ void partialSM(f32x16& p0, f32x16& p1, float& m_reg, float& mn, float& alpha) {
    constexpr float SCALE = Cst<DQK>::SCALE, C = SCALE * 1.4426950408889634f;
    float pmax = p0[0];
#pragma unroll
    for (int r = 1; r < 16; ++r) pmax = fmaxf(pmax, p0[r]);
#pragma unroll
    for (int r = 0; r < 16; ++r) pmax = fmaxf(pmax, p1[r]);
    { auto rr = __builtin_amdgcn_permlane32_swap(__float_as_uint(pmax), __float_as_uint(pmax), false, false);
      pmax = fmaxf(__uint_as_float(rr[0]), __uint_as_float(rr[1])); }
    if (__builtin_expect(__all(pmax - m_reg <= THR / SCALE), 1)) { mn = m_reg; alpha = 1.f; }
    else { mn = fmaxf(m_reg, pmax); alpha = __builtin_amdgcn_exp2f((m_reg - mn) * C); m_reg = mn; }
    const float mnC = -mn * C;
#pragma unroll
    for (int r = 0; r < 16; ++r) p0[r] = fmaf(p0[r], C, mnC);
#pragma unroll
    for (int r = 0; r < 16; ++r) p1[r] = fmaf(p1[r], C, mnC);
#pragma unroll
    for (int r = 0; r < 16; ++r) p0[r] = __builtin_amdgcn_exp2f(p0[r]);
}
__device__ __forceinline__ void finishSM(f32x16& p0, f32x16& p1, float alpha, float& l_reg, bf16x8& pa0, bf16x8& pa1, bf16x8& pa2, bf16x8& pa3) {
#pragma unroll
    for (int r = 0; r < 16; ++r) p1[r] = __builtin_amdgcn_exp2f(p1[r]);
    float ps = 0;
#pragma unroll
    for (int r = 0; r < 16; ++r) ps += p0[r];
#pragma unroll
    for (int r = 0; r < 16; ++r) ps += p1[r];
    { auto rr = __builtin_amdgcn_permlane32_swap(__float_as_uint(ps), __float_as_uint(ps), false, false);
      ps = __uint_as_float(rr[0]) + __uint_as_float(rr[1]); }
    l_reg = l_reg * alpha + ps;
#define PK4(P, BASE, OUT) do { unsigned a0 = cvt_pk_bf16(P[BASE + 0], P[BASE + 1]), a1 = cvt_pk_bf16(P[BASE + 2], P[BASE + 3]);   \
    unsigned b0 = cvt_pk_bf16(P[BASE + 4], P[BASE + 5]), b1 = cvt_pk_bf16(P[BASE + 6], P[BASE + 7]);                              \
    auto r0 = __builtin_amdgcn_permlane32_swap(a0, b0, false, false); auto r1 = __builtin_amdgcn_permlane32_swap(a1, b1, false, false); \
    u32x4 w = {r0[0], r1[0], r0[1], r1[1]}; OUT = *reinterpret_cast<bf16x8*>(&w); } while (0)
    PK4(p0, 0, pa0); PK4(p0, 8, pa1); PK4(p1, 0, pa2); PK4(p1, 8, pa3);
#undef PK4
}
template <int DQK>
__device__ __forceinline__ void qkt(f32x16& p0, f32x16& p1, const LAS uchar* Ks, const LAS uchar* Krs, const bf16x8* qr, const LAS uchar* qrl  , int r32, int hi) {
    p0 = f32x16{}; p1 = f32x16{};
#pragma unroll
    for (int d0 = 0; d0 < 8; ++d0) { const int cb = (d0 * 16 + hi * 8) * 2;
        const bf16x8 b0 = *(const LAS bf16x8*)(Ks + KSWZ(r32, cb));
        const bf16x8 b1 = *(const LAS bf16x8*)(Ks + KSWZ(32 + r32, cb));
        p0 = __builtin_amdgcn_mfma_f32_32x32x16_bf16(b0, qr[d0], p0, 0, 0, 0);
        p1 = __builtin_amdgcn_mfma_f32_32x32x16_bf16(b1, qr[d0], p1, 0, 0, 0); }
    if constexpr (DQK == 192) {
#pragma unroll
        for (int d0 = 0; d0 < 4; ++d0) { const int cb = (d0 * 16 + hi * 8) * 2;
            const bf16x8 b0 = *(const LAS bf16x8*)(Krs + KRSWZ(r32, cb));
            const bf16x8 b1 = *(const LAS bf16x8*)(Krs + KRSWZ(32 + r32, cb));
            const bf16x8 qf = *(const LAS bf16x8*)(qrl + d0 * 1024);
            p0 = __builtin_amdgcn_mfma_f32_32x32x16_bf16(b0, qf, p0, 0, 0, 0);
            p1 = __builtin_amdgcn_mfma_f32_32x32x16_bf16(b1, qf, p1, 0, 0, 0); }
    }
}
__device__ __forceinline__ int v_st(int k, int c) { const int kk = (k & ~0xC) | ((k & 4) << 1) | ((k & 8) >> 1); return ((kk >> 3) * 4 + (c >> 5)) * 512 + ((kk & 7) * 32 + (c & 31)) * 2; }
__device__ __forceinline__ int v_rd_base(int lane) { return ((lane & 3) << 3) | (((lane >> 2) & 3) << 6) | (((lane >> 4) & 1) << 5) | (((lane >> 5) & 1) << 8); }
constexpr int v_rd_off(int d0, int ks, int half) { return d0 * 512 + ks * 4096 + half * 2048; }
template <int OFF> __device__ __forceinline__ s16x4 tr_read(int vb) {
    s16x4 r; asm volatile("ds_read_b64_tr_b16 %0, %1 offset:%2" : "=&v"(r) : "v"(vb), "i"(OFF) : "memory"); return r;
}
template <int D0> __device__ __forceinline__ void pv_one(f32x16& od, int vb, bf16x8 pa0, bf16x8 pa1, bf16x8 pa2, bf16x8 pa3) {
    const s16x4 l0 = tr_read<v_rd_off(D0, 0, 0)>(vb), h0 = tr_read<v_rd_off(D0, 0, 1)>(vb), l1 = tr_read<v_rd_off(D0, 1, 0)>(vb), h1 = tr_read<v_rd_off(D0, 1, 1)>(vb);
    const s16x4 l2 = tr_read<v_rd_off(D0, 2, 0)>(vb), h2 = tr_read<v_rd_off(D0, 2, 1)>(vb), l3 = tr_read<v_rd_off(D0, 3, 0)>(vb), h3 = tr_read<v_rd_off(D0, 3, 1)>(vb);
    asm volatile("s_waitcnt lgkmcnt(0)" ::: "memory"); SBAR();
#define PK(L, H) (bf16x8){L[0], L[1], L[2], L[3], H[0], H[1], H[2], H[3]}
    od = __builtin_amdgcn_mfma_f32_32x32x16_bf16(pa0, PK(l0, h0), od, 0, 0, 0);
    od = __builtin_amdgcn_mfma_f32_32x32x16_bf16(pa1, PK(l1, h1), od, 0, 0, 0);
    od = __builtin_amdgcn_mfma_f32_32x32x16_bf16(pa2, PK(l2, h2), od, 0, 0, 0);
    od = __builtin_amdgcn_mfma_f32_32x32x16_bf16(pa3, PK(l3, h3), od, 0, 0, 0);
#undef PK
}
__device__ __forceinline__ void pv_d0(f32x16* o, int vb, bf16x8 pa0, bf16x8 pa1, bf16x8 pa2, bf16x8 pa3) {
    pv_one<0>(o[0], vb, pa0, pa1, pa2, pa3); pv_one<1>(o[1], vb, pa0, pa1, pa2, pa3); pv_one<2>(o[2], vb, pa0, pa1, pa2, pa3); pv_one<3>(o[3], vb, pa0, pa1, pa2, pa3);
}
__device__ __forceinline__ void causal_mask(f32x16& p0, f32x16& p1, int jj, int rowrel, int hi) {
#pragma unroll
    for (int r = 0; r < 16; ++r) { const int k0 = 64 * jj + crow(r, hi); if (k0 > rowrel) p0[r] = -1e30f; if (k0 + 32 > rowrel) p1[r] = -1e30f; }
}

template <int DQK, bool CAUSAL, int SD, int LDQ, int LDK>
__device__ __forceinline__ void attn_body(const bf16_t* __restrict__ Qb, const bf16_t* __restrict__ Kh, const bf16_t* __restrict__ Vh, const bf16_t* __restrict__ Krp,
                                          const f32x2* __restrict__ ropeq, const bf16_t* __restrict__ gate, bf16_t* __restrict__ outp, int NT, int diag0, LAS uchar* lds) {
    constexpr int NQ = 8;
    int tid_ = threadIdx.x; asm volatile("" : "+v"(tid_));
    const int tid = tid_, wid = tid >> 6, lane = tid & 63, r32 = lane & 31, hi = lane >> 5;
    LAS uchar* V_lds = lds + OFF_V; LAS uchar* K_lds = lds + OFF_K; LAS uchar* Kr_lds = lds + OFF_KR;
    LAS float* ws = (LAS float*)(lds + OFF_WS) + wid * 64; LAS float* li_l = ws; LAS float* al_l = ws + 32; LAS uchar* qrl = lds + OFF_QR + wid * 4096 + lane * 16;
    float m_reg = -1e30f, l_reg = 0; f32x16 o[4] = {}; bf16x8 qr[NQ];
    const bf16_t* Qw = Qb + (size_t)(wid * QBLK + r32) * LDQ + hi * 8;
#pragma unroll
    for (int d0 = 0; d0 < 8; ++d0) qr[d0] = *(const bf16x8*)(Qw + d0 * 16);
    if constexpr (DQK == 192) {
#pragma unroll
        for (int a = 0; a < 2; ++a) {
            const u32x4 w1 = *(const u32x4*)(Qw + 128 + 16 * a), w2 = *(const u32x4*)(Qw + 160 + 16 * a); float x1[8], x2[8], o1[8], o2[8]; unpack8(w1, x1); unpack8(w2, x2);
            const f32x2* tb = ropeq + (size_t)(wid * QBLK + r32) * 32 + 16 * a + 8 * hi;
#pragma unroll
            for (int j = 0; j < 8; ++j) { const f32x2 cs = tb[j]; o1[j] = x1[j] * cs.x - x2[j] * cs.y; o2[j] = x1[j] * cs.y + x2[j] * cs.x; }
            *(LAS u32x4*)(qrl + a * 1024) = pack8(o1); *(LAS u32x4*)(qrl + (2 + a) * 1024) = pack8(o2);
        }
    }
    const int sr = tid >> 4, sc = (tid & 15) * 8, vst0 = v_st(sr, sc), vst1 = v_st(32 + sr, sc);
    const int krow = tid >> 3, kcc = (tid & 7) * 8;
    const int vb0 = (int)(unsigned)(uintptr_t)V_lds + v_rd_base(lane);
    struct { bf16x8 vs0, vs1, ks0, ks1, kr; } sr_[SD];
#define SLOAD(i, k0) do { sr_[i].vs0 = *(const bf16x8*)(Vh + (size_t)((k0) + sr) * LDK + sc); sr_[i].vs1 = *(const bf16x8*)(Vh + (size_t)((k0) + 32 + sr) * LDK + sc); \
    sr_[i].ks0 = *(const bf16x8*)(Kh + (size_t)((k0) + sr) * LDK + sc); sr_[i].ks1 = *(const bf16x8*)(Kh + (size_t)((k0) + 32 + sr) * LDK + sc); \
    if constexpr (DQK == 192) sr_[i].kr = *(const bf16x8*)(Krp + (size_t)((k0) + krow) * 64 + kcc); } while (0)
#define SWRITE(b, i) do { *(LAS bf16x8*)(V_lds + (b) * SHM_V + vst0) = sr_[i].vs0; *(LAS bf16x8*)(V_lds + (b) * SHM_V + vst1) = sr_[i].vs1; const int kc = sc * 2; \
    *(LAS bf16x8*)(K_lds + (b) * SHM_K + KSWZ(sr, kc)) = sr_[i].ks0; *(LAS bf16x8*)(K_lds + (b) * SHM_K + KSWZ(32 + sr, kc)) = sr_[i].ks1; \
    if constexpr (DQK == 192) *(LAS bf16x8*)(Kr_lds + (b) * SHM_KR + KRSWZ(krow, kcc * 2)) = sr_[i].kr; } while (0)
#define SWAIT() do { if constexpr (SD == 2) { if constexpr (DQK == 192) asm volatile("s_waitcnt vmcnt(5)" ::: "memory"); else asm volatile("s_waitcnt vmcnt(4)" ::: "memory"); } \
    else asm volatile("s_waitcnt vmcnt(0)" ::: "memory"); } while (0)
#define RESC(a) do { if (__any((a) < 1.f)) { if (hi == 0) al_l[r32] = (a); asm volatile("s_waitcnt lgkmcnt(0)" ::: "memory"); \
    _Pragma("unroll") for (int d = 0; d < 4; ++d) _Pragma("unroll") for (int r = 0; r < 16; ++r) o[d][r] *= al_l[crow(r, hi)]; } } while (0)
#define MASK(P0, P1, tile) do { if constexpr (CAUSAL) { if ((tile) >= diag0) causal_mask(P0, P1, (tile) - diag0, wid * QBLK + r32, hi); } } while (0)
    f32x16 pA0, pA1, pB0, pB1; float mnA, mnB, alA, alB; bf16x8 pa0, pa1, pa2, pa3;
    constexpr int SE = 0, SO = SD - 1;
    SLOAD(SE, 0); asm volatile("s_waitcnt vmcnt(0)" ::: "memory"); SWRITE(0, SE); __syncthreads();
    qkt<DQK>(pA0, pA1, K_lds, Kr_lds, qr, qrl, r32, hi); MASK(pA0, pA1, 0); partialSM<DQK>(pA0, pA1, m_reg, mnA, alA);
    SLOAD(SO, KVBLK); if constexpr (SD == 2) { if (2 < NT) SLOAD(SE, 2 * KVBLK); }
    SWAIT(); SWRITE(1, SO); __syncthreads();
    for (int j = 1; j + 1 < NT; j += 2) {
        SBAR(); qkt<DQK>(pB0, pB1, K_lds + SHM_K, Kr_lds + SHM_KR, qr, qrl, r32, hi); MASK(pB0, pB1, j);
        finishSM(pA0, pA1, alA, l_reg, pa0, pa1, pa2, pa3); SBAR();
        SLOAD(SO, (j + SD) * KVBLK); SBAR();
        pv_d0(o, vb0, pa0, pa1, pa2, pa3); partialSM<DQK>(pB0, pB1, m_reg, mnB, alB);
        __syncthreads(); SWAIT(); SWRITE(0, SE);
        RESC(alB); __syncthreads();
        SBAR(); qkt<DQK>(pA0, pA1, K_lds, Kr_lds, qr, qrl, r32, hi); MASK(pA0, pA1, j + 1);
        finishSM(pB0, pB1, alB, l_reg, pa0, pa1, pa2, pa3); SBAR();
        if (SD == 1 || j + 3 < NT) SLOAD(SE, (j + 1 + SD) * KVBLK); SBAR();
        pv_d0(o, vb0 + SHM_V, pa0, pa1, pa2, pa3); partialSM<DQK>(pA0, pA1, m_reg, mnA, alA);
        __syncthreads(); SWAIT(); SWRITE(1, SO);
        RESC(alA); __syncthreads();
    }
    SBAR(); qkt<DQK>(pB0, pB1, K_lds + SHM_K, Kr_lds + SHM_KR, qr, qrl, r32, hi); MASK(pB0, pB1, NT - 1);
    finishSM(pA0, pA1, alA, l_reg, pa0, pa1, pa2, pa3); SBAR();
    pv_d0(o, vb0, pa0, pa1, pa2, pa3); partialSM<DQK>(pB0, pB1, m_reg, mnB, alB);
    __syncthreads(); RESC(alB);
    finishSM(pB0, pB1, alB, l_reg, pa0, pa1, pa2, pa3); SBAR();
    pv_d0(o, vb0 + SHM_V, pa0, pa1, pa2, pa3);
    if (hi == 0) li_l[r32] = l_reg; asm volatile("s_waitcnt lgkmcnt(0)" ::: "memory");
    float rli[16];
#pragma unroll
    for (int r = 0; r < 16; ++r) rli[r] = __builtin_amdgcn_rcpf(li_l[crow(r, hi)]);
    { LAS uchar* ot = lds + OFF_QR + wid * 4096; const int orow = lane >> 1, ocb = (lane & 1) * 32; const size_t grow = (size_t)(wid * QBLK + orow);
#pragma unroll
      for (int hf = 0; hf < 2; ++hf) {
#pragma unroll
          for (int r = 0; r < 16; ++r)
#pragma unroll
              for (int dd = 0; dd < 2; ++dd) *(LAS bf16_t*)(ot + crow(r, hi) * 128 + (dd * 32 + r32) * 2) = (bf16_t)(cvt_pk_bf16(o[2 * hf + dd][r] * rli[r], 0.f) & 0xffffu);
          asm volatile("s_waitcnt lgkmcnt(0)" ::: "memory");
#pragma unroll
          for (int c = 0; c < 4; ++c) { const u32x4 ov = *(const LAS u32x4*)(ot + orow * 128 + ocb * 2 + c * 16); const u32x4 gv = *(const u32x4*)(gate + grow * LDZ + hf * 64 + ocb + c * 8);
              float of[8], gf[8]; unpack8(ov, of); unpack8(gv, gf);
#pragma unroll
              for (int q = 0; q < 8; ++q) of[q] *= silu(gf[q]);
              *(u32x4*)(outp + grow * OUTW + hf * 64 + ocb + c * 8) = pack8(of); }
          asm volatile("s_waitcnt lgkmcnt(0)" ::: "memory"); } }
#undef SLOAD
#undef SWRITE
#undef SWAIT
#undef RESC
#undef MASK
}
}
namespace dec {
constexpr int BUFB = 40960, OFF_KR = 32768, OFF_WS = 2 * BUFB, LDS_BYTES = OFF_WS + 8 * 64 * 4;
__device__ __forceinline__ unsigned off_b(unsigned row, unsigned ch) { return 256u * row + 16u * (ch ^ (((row & 3) << 2) | ((row >> 2) & 3))); }
__device__ __forceinline__ unsigned row_read_addr(unsigned lane, unsigned s) { return off_b(lane & 31, 2 * s + (lane >> 5)); }
__device__ __forceinline__ unsigned tr_read_addr(unsigned lane, unsigned c, unsigned ks, unsigned t) {
    const unsigned h = lane >> 5, blk = (lane >> 4) & 1, q = (lane & 15) >> 2, p = lane & 3;
    return off_b(16 * ks + 8 * h + 4 * t + q, 4 * c + 2 * blk + (p >> 1)) + 8 * (p & 1);
}
__device__ __forceinline__ s16x4 tr_rd(unsigned addr) { s16x4 r; asm volatile("ds_read_b64_tr_b16 %0, %1" : "=&v"(r) : "v"(addr) : "memory"); return r; }

__device__ __forceinline__ void decode_unit(const bf16_t* __restrict__ Qd, const float* __restrict__ cckv, const float* __restrict__ ckr, const int* __restrict__ pt,
                                            float* __restrict__ Opart, float* __restrict__ ML, LAS uchar* lds) {
    int tid_ = threadIdx.x; asm volatile("" : "+v"(tid_));
    const int tid = tid_, wid = tid >> 6, lane = tid & 63, r32 = lane & 31, hi = lane >> 5;
    LAS float* al_l = (LAS float*)(lds + OFF_WS) + wid * 64;
    bf16x8 qr[20];
#pragma unroll
    for (int s = 0; s < 20; ++s) qr[s] = *(const bf16x8*)(Qd + (size_t)r32 * 320 + s * 16 + hi * 8);
    float m_reg = -1e30f, l_reg = 0.f; f32x16 o = {};
    f32x4 sv[10];
    const int kc = lane & 15, kq = lane >> 4;
    const unsigned wck = (unsigned)((lane >> 5) * 2 * 8192) + ((lane & 1) << 3);
    const unsigned ldsb = (unsigned)(uintptr_t)lds;
    const int pw = wid >> 2, cw = wid & 3;
#define DLOAD(j) do { const int page = pt[(j) >> 1]; const size_t krow = (size_t)page * 128 + ((j) & 1) * 64 + wid * 8; \
    const float* s0 = cckv + krow * 256 + 4 * lane; const float* s1 = ckr + (krow + kq) * 64 + 4 * kc; \
    _Pragma("unroll") for (int i = 0; i < 8; ++i) sv[i] = __builtin_nontemporal_load((const f32x4*)(s0 + i * 256)); \
    sv[8] = __builtin_nontemporal_load((const f32x4*)s1); sv[9] = __builtin_nontemporal_load((const f32x4*)(s1 + 4 * 64)); } while (0)
#define DWRITE(b) do { _Pragma("unroll") for (int i = 0; i < 8; ++i) { const int key = wid * 8 + i; u32x2 w; w.x = cvt_pk_bf16(sv[i][0], sv[i][1]); w.y = cvt_pk_bf16(sv[i][2], sv[i][3]); \
        *(LAS u32x2*)(lds + (b) * BUFB + wck + (key >> 5) * 8192 + off_b(key & 31, (lane & 31) >> 1)) = w; } \
    _Pragma("unroll") for (int i = 0; i < 2; ++i) { const int key = wid * 8 + kq + 4 * i; u32x2 w; w.x = cvt_pk_bf16(sv[8 + i][0], sv[8 + i][1]); w.y = cvt_pk_bf16(sv[8 + i][2], sv[8 + i][3]); \
        *(LAS u32x2*)(lds + (b) * BUFB + OFF_KR + key * 128 + (((kc >> 1) ^ (key & 7)) << 4) + ((kc & 1) << 3)) = w; } } while (0)
    constexpr int NT = 32;
    DLOAD(0); DWRITE(0); __syncthreads();
    for (int j = 0; j < NT; ++j) {
        const int b = j & 1;
        if (j + 1 < NT) DLOAD(j + 1);
        const LAS uchar* B = lds + b * BUFB;
        f32x16 p0 = {}, p1 = {};
#pragma unroll
        for (int s = 0; s < 16; ++s) { const unsigned ra = row_read_addr(lane, s & 7);
            const bf16x8 k0 = *(const LAS bf16x8*)(B + ((s >> 3) * 2 + 0) * 8192 + ra), k1 = *(const LAS bf16x8*)(B + ((s >> 3) * 2 + 1) * 8192 + ra);
            p0 = __builtin_amdgcn_mfma_f32_32x32x16_bf16(k0, qr[s], p0, 0, 0, 0); p1 = __builtin_amdgcn_mfma_f32_32x32x16_bf16(k1, qr[s], p1, 0, 0, 0); }
#pragma unroll
        for (int s = 0; s < 4; ++s) { const int chk = 2 * s + hi;
            const bf16x8 k0 = *(const LAS bf16x8*)(B + OFF_KR + r32 * 128 + ((chk ^ (r32 & 7)) << 4)), k1 = *(const LAS bf16x8*)(B + OFF_KR + (32 + r32) * 128 + ((chk ^ (r32 & 7)) << 4));
            p0 = __builtin_amdgcn_mfma_f32_32x32x16_bf16(k0, qr[16 + s], p0, 0, 0, 0); p1 = __builtin_amdgcn_mfma_f32_32x32x16_bf16(k1, qr[16 + s], p1, 0, 0, 0); }
        float mn, alpha; att::partialSM<192>(p0, p1, m_reg, mn, alpha);
        if (__any(alpha < 1.f)) { if (hi == 0) al_l[r32] = alpha; asm volatile("s_waitcnt lgkmcnt(0)" ::: "memory");
#pragma unroll
            for (int r = 0; r < 16; ++r) o[r] *= al_l[crow(r, hi)]; }
        bf16x8 pa[4]; att::finishSM(p0, p1, alpha, l_reg, pa[0], pa[1], pa[2], pa[3]);
        s16x4 vl[4], vh[4];
#pragma unroll
        for (int ks = 0; ks < 4; ++ks) { const unsigned vb = ldsb + b * BUFB + (pw * 2 + (ks >> 1)) * 8192;
            vl[ks] = tr_rd(vb + tr_read_addr(lane, cw, ks & 1, 0)); vh[ks] = tr_rd(vb + tr_read_addr(lane, cw, ks & 1, 1)); }
        asm volatile("s_waitcnt lgkmcnt(0)" ::: "memory"); __builtin_amdgcn_sched_barrier(0);
#pragma unroll
        for (int ks = 0; ks < 4; ++ks) o = __builtin_amdgcn_mfma_f32_32x32x16_bf16(pa[ks], ((bf16x8){vl[ks][0], vl[ks][1], vl[ks][2], vl[ks][3], vh[ks][0], vh[ks][1], vh[ks][2], vh[ks][3]}), o, 0, 0, 0);
        if (j + 1 < NT) DWRITE(b ^ 1);
        __syncthreads();
    }
#undef DLOAD
#undef DWRITE
    if (wid == 0 && hi == 0) { ML[r32 * 2] = m_reg; ML[r32 * 2 + 1] = l_reg; }
#pragma unroll
    for (int r = 0; r < 16; ++r) Opart[(size_t)crow(r, hi) * 256 + 32 * wid + r32] = o[r];
}

__device__ __forceinline__ void combine_row(int b, int row32, int lane, const bf16_t* __restrict__ Qdec, const float* __restrict__ Opart, const float* __restrict__ ML,
                                            const float* __restrict__ ckvn, const float* __restrict__ krn, bf16_t* __restrict__ olat) {
    constexpr float C = 0.07216878364870322f * 1.4426950408889634f;
    const int t = row32 >> 3, h = row32 & 7;
    const bf16_t* q = Qdec + ((size_t)b * 32 + row32) * 320;
    const u32x2 qw = *(const u32x2*)(q + 4 * lane); const float q0 = bf_lo(qw.x), q1 = bf_hi(qw.x), q2 = bf_lo(qw.y), q3 = bf_hi(qw.y); const float qrp = bf2f(q[256 + lane]);
    float sj[4]; f32x4 cn[4];
#pragma unroll
    for (int j = 0; j < 4; ++j) { cn[j] = *(const f32x4*)(ckvn + ((size_t)b * 4 + j) * 256 + 4 * lane); float s = q0 * cn[j][0] + q1 * cn[j][1] + q2 * cn[j][2] + q3 * cn[j][3] + qrp * krn[((size_t)b * 4 + j) * 64 + lane];
#pragma unroll
        for (int o = 32; o >= 1; o >>= 1) s += __shfl_xor(s, o);
        sj[j] = (j <= t) ? s : -1e30f; }
    float mc[8], lc[8], M = fmaxf(fmaxf(sj[0], sj[1]), fmaxf(sj[2], sj[3]));
#pragma unroll
    for (int c = 0; c < 8; ++c) { const f32x2 ml = *(const f32x2*)(ML + (((size_t)b * 8 + c) * 32 + row32) * 2); mc[c] = ml.x; lc[c] = ml.y; M = fmaxf(M, mc[c]); }
    float L = 0.f; f32x4 acc = {0.f, 0.f, 0.f, 0.f};
#pragma unroll
    for (int c = 0; c < 8; ++c) { const float w = __builtin_amdgcn_exp2f((mc[c] - M) * C); L += lc[c] * w; acc += *(const f32x4*)(Opart + (((size_t)b * 8 + c) * 32 + row32) * 256 + 4 * lane) * w; }
#pragma unroll
    for (int j = 0; j < 4; ++j) { const float e = (j <= t) ? __builtin_amdgcn_exp2f((sj[j] - M) * C) : 0.f; L += e; acc += cn[j] * e; }
    const float rl = 1.0f / L; u32x2 w; w.x = cvt_pk_bf16(acc[0] * rl, acc[1] * rl); w.y = cvt_pk_bf16(acc[2] * rl, acc[3] * rl);
    *(u32x2*)(olat + ((size_t)b * 4 + t) * 2048 + h * 256 + 4 * lane) = w;
}

constexpr int SMEM_LDS = 4096 + 32768;
__device__ __forceinline__ void smem_unit(const bf16_t* __restrict__ Zq  , const bf16_t* __restrict__ Zg  , const float* __restrict__ Kc, const float* __restrict__ Vc  ,
                                          bf16_t* __restrict__ outp  , LAS uchar* lds) {
    int tid_ = threadIdx.x; asm volatile("" : "+v"(tid_));
    const int tid = tid_, wid = tid >> 6, lane = tid & 63, l32 = lane & 31, hi = lane >> 5;
    LAS float* sc = (LAS float*)lds; LAS float* red = (LAS float*)(lds + 4096);
    float qv[4][4];
#pragma unroll
    for (int t = 0; t < 4; ++t) { const u32x2 w = *(const u32x2*)(Zq + (size_t)t * LDZ + 4 * l32); qv[t][0] = bf_lo(w.x); qv[t][1] = bf_hi(w.x); qv[t][2] = bf_lo(w.y); qv[t][3] = bf_hi(w.y); }
#pragma unroll 4
    for (int i = 0; i < 16; ++i) { const int m = wid * 32 + 2 * i + hi; const f32x4 kv = *(const f32x4*)(Kc + (size_t)m * 512 + 4 * l32); float p[4];
#pragma unroll
        for (int t = 0; t < 4; ++t) { p[t] = kv[0] * qv[t][0] + kv[1] * qv[t][1] + kv[2] * qv[t][2] + kv[3] * qv[t][3];
#pragma unroll
            for (int o = 16; o >= 1; o >>= 1) p[t] += __shfl_xor(p[t], o); }
        if (l32 == 0) {
#pragma unroll
            for (int t = 0; t < 4; ++t) sc[t * 256 + m] = p[t] * 0.08838834764831845f; } }
    __syncthreads();
    if (wid < 4) { float v[4], mx = -1e30f;
#pragma unroll
        for (int i = 0; i < 4; ++i) { v[i] = sc[wid * 256 + lane + 64 * i]; mx = fmaxf(mx, v[i]); }
#pragma unroll
        for (int o = 32; o >= 1; o >>= 1) mx = fmaxf(mx, __shfl_xor(mx, o));
        float s = 0.f;
#pragma unroll
        for (int i = 0; i < 4; ++i) { v[i] = __expf(v[i] - mx); s += v[i]; }
#pragma unroll
        for (int o = 32; o >= 1; o >>= 1) s += __shfl_xor(s, o);
        const float rs = 1.0f / s;
#pragma unroll
        for (int i = 0; i < 4; ++i) sc[wid * 256 + lane + 64 * i] = v[i] * rs; }
    __syncthreads();
    { const int d4 = (tid & 31) * 4, mg = tid >> 5; f32x4 a[4] = {};
#pragma unroll 4
      for (int mm = 0; mm < 16; ++mm) { const int m = mg * 16 + mm; const f32x4 vv = *(const f32x4*)(Vc + (size_t)m * 512 + d4);
#pragma unroll
          for (int t = 0; t < 4; ++t) a[t] += vv * sc[t * 256 + m]; }
#pragma unroll
      for (int t = 0; t < 4; ++t) *(LAS f32x4*)(red + (mg * 4 + t) * 128 + d4) = a[t]; }
    __syncthreads();
    { const int t = tid >> 7, d = tid & 127; float s = 0.f;
#pragma unroll
      for (int mg = 0; mg < 16; ++mg) s += red[(mg * 4 + t) * 128 + d];
      const float g = bf2f(Zg[(size_t)t * LDZ + d]);
      outp[(size_t)t * OUTW + d] = (bf16_t)(cvt_pk_bf16(s * silu(g), 0.f) & 0xffffu); }
    __syncthreads();
}
}
namespace ew {
__device__ __forceinline__ int otid() { int t = threadIdx.x; asm volatile("" : "+v"(t)); return t; }
struct TJ { const float* src; int sld, K, ncols; const float* gain; const float* cscale; bf16_t* dst; int dld; };
constexpr int NTJ = 32;
__device__ __forceinline__ TJ get_tj(int j, const float* const* in, uchar* ws) {
    TJ t; t.gain = nullptr; t.cscale = nullptr;
    bf16_t* WINA = (bf16_t*)(ws + WS_WINA); bf16_t* WGRP = (bf16_t*)(ws + WS_WGRP); bf16_t* WINB = (bf16_t*)(ws + WS_WINB); bf16_t* WQUP = (bf16_t*)(ws + WS_WQUP);
    bf16_t* WKV = (bf16_t*)(ws + WS_WKV); bf16_t* WMEM = (bf16_t*)(ws + WS_WMEM); bf16_t* WOUT = (bf16_t*)(ws + WS_WOUT);
    if (j < 2) { t.src = in[10] + (size_t)j * DM * INA; t.sld = INA; t.K = DM; t.ncols = INA; t.gain = in[9] + j * DM; t.dst = WINA + (size_t)j * INA * DM; t.dld = DM; }
    else if (j < 10) { const int i = j - 2; t.src = in[11] + (size_t)i * 65536; t.sld = 256; t.K = 256; t.ncols = 256; t.cscale = in[12] + i * 256; t.dst = WGRP + (size_t)i * 65536; t.dld = 256; }
    else if (j < 12) { const int i = j - 10; t.src = in[13] + (size_t)i * DM * INB; t.sld = INB; t.K = DM; t.ncols = QRANK; t.gain = in[9] + (2 + i) * DM; t.dst = WINB + (size_t)i * NB2 * DM; t.dld = DM; }
    else if (j < 14) { const int i = j - 12; t.src = in[13] + (size_t)i * DM * INB + QRANK; t.sld = INB; t.K = DM; t.ncols = INB - QRANK; t.gain = in[9] + (2 + i) * DM; t.dst = WINB + ((size_t)i * NB2 + ZB_GT) * DM; t.dld = DM; }
    else if (j == 14) { t.src = in[17] + KVR; t.sld = 320; t.K = DM; t.ncols = ROPE; t.gain = in[16]; t.dst = WINB + (size_t)ZB_KR * DM; t.dld = DM; }
    else if (j == 15) { t.src = in[17]; t.sld = 320; t.K = DM; t.ncols = KVR; t.gain = in[16]; t.dst = WINB + (size_t)ZB_KV * DM; t.dld = DM; }
    else if (j < 18) { const int i = j - 16; t.src = in[15] + (size_t)i * QRANK * QW; t.sld = QW; t.K = QRANK; t.ncols = QW; t.gain = in[14] + i * QRANK; t.dst = WQUP + (size_t)i * QW * QRANK; t.dld = QRANK; }
    else if (j == 18) { t.src = in[19]; t.sld = 1024; t.K = 256; t.ncols = 1024; t.dst = WKV; t.dld = 256; }
    else if (j == 19) { t.src = in[20]; t.sld = 1024; t.K = 256; t.ncols = 1024; t.dst = WKV + (size_t)1024 * 256; t.dld = 256; }
    else if (j < 28) { const int i = j - 20, l = i >> 1, kv = i & 1; t.src = (kv ? in[23] : in[22]) + (size_t)l * DM * MEMW; t.sld = MEMW; t.K = DM; t.ncols = MEMW; t.gain = in[21] + l * DM; t.dst = WMEM + (size_t)(l * 2 + kv) * MEMW * DM; t.dld = DM; }
    else { const int l = j - 28; t.src = in[24] + (size_t)l * OUTW * DM; t.sld = DM; t.K = OUTW; t.ncols = DM; t.dst = WOUT + (size_t)l * DM * OUTW; t.dld = OUTW; }
    return t;
}
__device__ __forceinline__ int tj_tiles(int j) {
    if (j < 2) return 16 * 48; if (j < 10) return 16; if (j < 12) return 16 * 6; if (j < 14) return 16 * 32; if (j == 14) return 16; if (j == 15) return 64;
    if (j < 18) return 6 * 24; if (j < 20) return 4 * 16; if (j < 28) return 16 * 8; return 24 * 16;
}
constexpr int TJ_TOTAL = 2 * 768 + 8 * 16 + 2 * 96 + 2 * 512 + 16 + 64 + 2 * 144 + 2 * 64 + 8 * 128 + 4 * 384;
__device__ __forceinline__ void transpose_tile(const TJ& t, int tile, LAS float* tl, int tid) {
    const int nkt = t.K / 64, kt = tile % nkt, nt = tile / nkt, k0 = kt * 64, n0 = nt * 64;
    { const int k = tid >> 3, n8 = (tid & 7) * 8; const float* s = t.src + (size_t)(k0 + k) * t.sld + n0 + n8; const float g = t.gain ? t.gain[k0 + k] : 1.0f;
      const f32x4 a = *(const f32x4*)s * g, b = *(const f32x4*)(s + 4) * g;
#pragma unroll
      for (int j = 0; j < 4; ++j) { tl[k * 65 + n8 + j] = a[j]; tl[k * 65 + n8 + 4 + j] = b[j]; } }
    __syncthreads();
    { const int n = tid >> 3, k8 = (tid & 7) * 8; const float cs = t.cscale ? t.cscale[n0 + n] : 1.0f; float v[8];
#pragma unroll
      for (int j = 0; j < 8; ++j) v[j] = tl[(k8 + j) * 65 + n] * cs;
      *(u32x4*)(t.dst + (size_t)(n0 + n) * t.dld + k0 + k8) = pack8(v); }
    __syncthreads();
}
__device__ __forceinline__ void sincos_d(float angf, float& c, float& s) {
    const double x = (double)angf; const double kd = rint(x * 0.63661977236758134308); const int q = (int)((long long)kd & 3);
    double r = fma(-kd, 1.57079632679489655800e+00, x); r = fma(-kd, 6.12323399573676603587e-17, r);
    const double r2 = r * r;
    double sp = -7.6471637318198164759e-13; sp = fma(sp, r2, 1.6059043836821614599e-10); sp = fma(sp, r2, -2.5052108385441718775e-08); sp = fma(sp, r2, 2.7557319223985890653e-06);
    sp = fma(sp, r2, -1.9841269841269841270e-04); sp = fma(sp, r2, 8.3333333333333333333e-03); sp = fma(sp, r2, -1.6666666666666666667e-01); const double sn = fma(sp * r2, r, r);
    double cp = 4.7794773323873852974e-14; cp = fma(cp, r2, -1.1470745597729724714e-11); cp = fma(cp, r2, 2.0876756987868098979e-09); cp = fma(cp, r2, -2.7557319223985890653e-07);
    cp = fma(cp, r2, 2.4801587301587301587e-05); cp = fma(cp, r2, -1.3888888888888888889e-03); cp = fma(cp, r2, 4.1666666666666666667e-02); cp = fma(cp, r2, -0.5); const double cn = fma(cp, r2, 1.0);
    const double ss = (q == 0) ? sn : (q == 1) ? cn : (q == 2) ? -sn : -cn, cc = (q == 0) ? cn : (q == 1) ? -sn : (q == 2) ? -cn : sn;
    c = (float)cc; s = (float)ss;
}

__device__ __forceinline__ void prologue(const float* const* in, float* out, uchar* ws, LAS uchar* lds, int G, int bid) {
    const int tid = otid(), lane = tid & 63, wid = tid >> 6;
    for (int gt = bid; gt < TJ_TOTAL; gt += G) { int j = 0, r = gt; for (; j < NTJ; ++j) { const int n = tj_tiles(j); if (r < n) break; r -= n; }
        const TJ t = get_tj(j, in, ws); transpose_tile(t, r, (LAS float*)lds, tid); }
    const size_t gtid = (size_t)bid * 512 + tid, gstride = (size_t)G * 512;
    { bf16_t* WINB = (bf16_t*)(ws + WS_WINB);
      for (size_t i = gtid; i < (size_t)(64 + 128) * DM / 8; i += gstride) { const size_t e = i * 8; bf16_t* p = (e < (size_t)64 * DM) ? WINB + (size_t)448 * DM + e : WINB + ((size_t)NB2 + 384) * DM + (e - (size_t)64 * DM);
          *(u32x4*)p = (u32x4){0u, 0u, 0u, 0u}; }
      bf16_t* WKUPN = (bf16_t*)(ws + WS_WKUPN);
      for (size_t i = gtid; i < (size_t)256 * 1024 / 8; i += gstride) { const float* s = in[19] + i * 8; const f32x4 a = *(const f32x4*)s, b = *(const f32x4*)(s + 4);
          const float v[8] = {a[0], a[1], a[2], a[3], b[0], b[1], b[2], b[3]}; *(u32x4*)(WKUPN + i * 8) = pack8(v); } }
    { bf16_t* XB = (bf16_t*)(ws + WS_XB); bf16_t* MH = (bf16_t*)(ws + WS_MHAT); float* ssp = (float*)(ws + WS_SSP); float* ssps = (float*)(ws + WS_SSPS);
      const int nrows = PM + SM + 2048;
      for (int row = bid * 8 + wid; row < nrows; row += G * 8) {
          const float* src = row < PM ? in[0] + (size_t)row * DM : row < PM + SM ? in[1] + (size_t)(row - PM) * DM : in[8] + (size_t)(row - PM - SM) * DM;
          f32x4 v[4]; float s = 0.f;
#pragma unroll
          for (int i = 0; i < 4; ++i) { v[i] = *(const f32x4*)(src + 256 * i + 4 * lane); s += sum4(v[i] * v[i]); }
#pragma unroll
          for (int o = 32; o >= 1; o >>= 1) s += __shfl_xor(s, o);
          float sc = 1.0f; bf16_t* dst;
          if (row < PM + SM) { dst = XB + (size_t)row * DM; if (row < PM) { if (lane < 16) ssp[(size_t)row * 16 + lane] = lane == 0 ? s : 0.f; } else { if (lane < 32) ssps[(row - PM) * 32 + lane] = lane == 0 ? s : 0.f; } }
          else { dst = MH + (size_t)(row - PM - SM) * DM; sc = rsqrtf(s * (1.0f / 1024.0f) + EPS); }
#pragma unroll
          for (int i = 0; i < 4; ++i) { u32x2 w; w.x = cvt_pk_bf16(v[i][0] * sc, v[i][1] * sc); w.y = cvt_pk_bf16(v[i][2] * sc, v[i][3] * sc); *(u32x2*)(dst + 256 * i + 4 * lane) = w; } } }
    { f32x2* tab = (f32x2*)(ws + WS_ROPE);
      for (size_t e = gtid; e < (size_t)2052 * 32; e += gstride) { const int p = (int)(e >> 5), i = (int)(e & 31); const int pos = p < 2048 ? p : PAST + (p - 2048);
          const float inv = (float)exp2(-(double)i * (13.287712379549449 / 32.0)); const float ang = (float)pos * inv; float c, s; sincos_d(ang, c, s); tab[e] = (f32x2){c, s}; } }
    { for (size_t e = gtid; e < (size_t)2 * SB * 11 * DM / 4; e += gstride) { const size_t f = e * 4; const int c = (int)(f % DM); const size_t rr = f / DM; const int i = (int)(rr % 11); const size_t lb = rr / 11;
          *(f32x4*)(out + O_PSS + (lb * 15 + i) * DM + c) = *(const f32x4*)(in[2] + (lb * 15 + 4 + i) * DM + c); } }
}

template <int W> __device__ __forceinline__ void pool16(const bf16_t* __restrict__ zc, bf16_t* __restrict__ po, float* __restrict__ ps, bool bstart) {
    u32x2 uu[15 + W];
#pragma unroll
    for (int i = 0; i < W - 1; ++i) uu[i] = bstart ? (u32x2){0u, 0u} : *(const u32x2*)(zc - (ptrdiff_t)(W - 1 - i) * LDZ);
#pragma unroll
    for (int k = 0; k < 16; ++k) uu[W - 1 + k] = *(const u32x2*)(zc + (size_t)k * LDZ);
    float s0 = 0.f, s1 = 0.f, s2 = 0.f, s3 = 0.f;
#pragma unroll
    for (int i = 0; i < W - 1; ++i) { s0 += bf_lo(uu[i].x); s1 += bf_hi(uu[i].x); s2 += bf_lo(uu[i].y); s3 += bf_hi(uu[i].y); }
#pragma unroll
    for (int k = 0; k < 16; ++k) { const u32x2 c = uu[W - 1 + k]; const float c0 = bf_lo(c.x), c1 = bf_hi(c.x), c2 = bf_lo(c.y), c3 = bf_hi(c.y);
        s0 += c0; s1 += c1; s2 += c2; s3 += c3;
        const float rn = (bstart && k < W - 1) ? 1.0f / (float)(k + 1) : 1.0f / (float)W;
        u32x2 o; o.x = cvt_pk_bf16(s0 * rn - c0, s1 * rn - c1); o.y = cvt_pk_bf16(s2 * rn - c2, s3 * rn - c3); *(u32x2*)(po + (size_t)k * DM) = o;
        if (ps != nullptr && k >= 1) *(f32x4*)(ps + (size_t)(k - 1) * DM) = (f32x4){c0, c1, c2, c3};
        const u32x2 d = uu[k]; s0 -= bf_lo(d.x); s1 -= bf_hi(d.x); s2 -= bf_lo(d.y); s3 -= bf_hi(d.y); }
}
__device__ __forceinline__ void pooling(int l, const float* const* in, float* out, uchar* ws, int G, int bid) {
    const bf16_t* Z = (const bf16_t*)(ws + WS_Z); bf16_t* PO = (bf16_t*)(ws + WS_POOLED);
    const int tid = otid(), lane = tid & 63, wid = tid >> 6;
    for (int pr = bid * 8 + wid; pr < (PM / 16) * 4; pr += G * 8) { const int g = pr & 3, blk = pr >> 2, r0 = blk * 16, t0 = r0 & (PT - 1), c4 = g * 256 + lane * 4;
        const bf16_t* zc = Z + (size_t)r0 * LDZ + c4; bf16_t* po = PO + (size_t)r0 * DM + c4; const bool bstart = (t0 == 0);
        float* ps = (t0 == PT - 16) ? out + O_PSP + (((size_t)l * PB + (r0 >> 11)) * 15) * DM + c4 : nullptr;
        if (g == 0) pool16<2>(zc, po, ps, bstart); else if (g == 1) pool16<4>(zc, po, ps, bstart); else if (g == 2) pool16<8>(zc, po, ps, bstart); else pool16<16>(zc, po, ps, bstart); }
    const size_t gtid = (size_t)bid * 512 + tid, gstride = (size_t)G * 512;
    for (size_t idx = gtid; idx < (size_t)SM * 128; idx += gstride) { const int r = (int)(idx >> 7), cv = (int)(idx & 127), g = cv >> 5, w = 2 << g, b = r >> 2, t = r & 3;
        const float* prev = in[2] + ((size_t)l * SB + b) * 15 * DM + cv * 8; const bf16_t* us = Z + ((size_t)PM + b * 4) * LDZ + cv * 8; float ut[8], s[8];
        unpack8(*(const u32x4*)(us + (size_t)t * LDZ), ut);
#pragma unroll
        for (int j = 0; j < 8; ++j) s[j] = ut[j];
        for (int i = 1; i < w; ++i) { const int e = 15 + t - i; float x[8];
            if (e >= 15) unpack8(*(const u32x4*)(us + (size_t)(e - 15) * LDZ), x);
            else { const f32x4 a = *(const f32x4*)(prev + (size_t)e * DM), bb = *(const f32x4*)(prev + (size_t)e * DM + 4); x[0] = a[0]; x[1] = a[1]; x[2] = a[2]; x[3] = a[3]; x[4] = bb[0]; x[5] = bb[1]; x[6] = bb[2]; x[7] = bb[3]; }
#pragma unroll
            for (int j = 0; j < 8; ++j) s[j] += x[j]; }
        const float rn = 1.0f / (float)w; float o[8];
#pragma unroll
        for (int j = 0; j < 8; ++j) o[j] = s[j] * rn - ut[j];
        *(u32x4*)(PO + ((size_t)PM + r) * DM + cv * 8) = pack8(o);
        float* q = out + O_PSS + (((size_t)l * SB + b) * 15 + 11 + t) * DM + cv * 8; *(f32x4*)q = (f32x4){ut[0], ut[1], ut[2], ut[3]}; *(f32x4*)(q + 4) = (f32x4){ut[4], ut[5], ut[6], ut[7]}; }
}

__device__ __forceinline__ void kvpost(const float* const* in, float* out, uchar* ws, int G, int bid) {
    const float* KV = (const float*)(ws + WS_KVRAW); bf16_t* CB = (bf16_t*)(ws + WS_CKVB); bf16_t* KB = (bf16_t*)(ws + WS_KROPEB); const f32x2* tab = (const f32x2*)(ws + WS_ROPE);
    const int tid = otid(), lane = tid & 63, wid = tid >> 6; const f32x4 gl = *(const f32x4*)(in[18] + 4 * lane);
    for (int row = bid * 8 + wid; row < PM + SM; row += G * 8) { const float* p = KV + (size_t)row * 320; const f32x4 v = *(const f32x4*)(p + 4 * lane); float s = sum4(v * v);
#pragma unroll
        for (int o = 32; o >= 1; o >>= 1) s += __shfl_xor(s, o);
        const float rs = rsqrtf(s * (1.0f / 256.0f) + EPS); const f32x4 c = v * rs * gl;
        float* oc = row < PM ? out + O_CKVP + (size_t)row * KVR : out + O_CKVS + (size_t)(row - PM) * KVR; float* ok = row < PM ? out + O_KRP + (size_t)row * ROPE : out + O_KRS + (size_t)(row - PM) * ROPE;
        *(f32x4*)(oc + 4 * lane) = c; u32x2 w; w.x = cvt_pk_bf16(c[0], c[1]); w.y = cvt_pk_bf16(c[2], c[3]); *(u32x2*)(CB + (size_t)row * KVR + 4 * lane) = w;
        if (lane < 32) { const int ti = row < PM ? (row & (PT - 1)) : 2048 + ((row - PM) & 3); const f32x2 cs = tab[(size_t)ti * 32 + lane]; const float x1 = p[256 + lane], x2 = p[288 + lane];
            const float o1 = x1 * cs.x - x2 * cs.y, o2 = x1 * cs.y + x2 * cs.x; ok[lane] = o1; ok[32 + lane] = o2;
            KB[(size_t)row * ROPE + lane] = (bf16_t)(cvt_pk_bf16(o1, 0.f) & 0xffffu); KB[(size_t)row * ROPE + 32 + lane] = (bf16_t)(cvt_pk_bf16(o2, 0.f) & 0xffffu); } }
}
__device__ __forceinline__ void sq_rope(uchar* ws, int G, int bid) {
    const bf16_t* Q = (const bf16_t*)(ws + WS_Q); bf16_t* QD = (bf16_t*)(ws + WS_QDEC); const f32x2* tab = (const f32x2*)(ws + WS_ROPE);
    for (size_t e = (size_t)bid * 512 + otid(); e < (size_t)SM * MLAH * 32; e += (size_t)G * 512) { const int i = (int)(e & 31), h = (int)((e >> 5) & 7), r = (int)(e >> 8), b = r >> 2, t = r & 3;
        const bf16_t* q = Q + ((size_t)PM + r) * QW + h * QHD + NOPE; const float x1 = bf2f(q[i]), x2 = bf2f(q[32 + i]); const f32x2 cs = tab[(size_t)(2048 + t) * 32 + i];
        bf16_t* o = QD + ((size_t)b * 32 + t * 8 + h) * 320 + 256; o[i] = (bf16_t)(cvt_pk_bf16(x1 * cs.x - x2 * cs.y, 0.f) & 0xffffu); o[32 + i] = (bf16_t)(cvt_pk_bf16(x1 * cs.y + x2 * cs.x, 0.f) & 0xffffu); }
}
__device__ __forceinline__ void final_norm(const float* const* in, float* out, uchar* ws, int G, int bid) {
    const bf16_t* XB = (const bf16_t*)(ws + WS_XB); const float* ssp = (const float*)(ws + WS_SSP); const float* ssps = (const float*)(ws + WS_SSPS);
    const int tid = otid(), lane = tid & 63, wid = tid >> 6;
    for (int row = bid * 8 + wid; row < PM + SM; row += G * 8) { const float rs = row < PM ? rs_from16(ssp + (size_t)row * 16) : rs_from32(ssps + (row - PM) * 32);
        float* o = row < PM ? out + O_YP + (size_t)row * DM : out + O_YS + (size_t)(row - PM) * DM; const bf16_t* x = XB + (size_t)row * DM;
#pragma unroll
        for (int i = 0; i < 4; ++i) { const int c = 256 * i + 4 * lane; const u32x2 b = *(const u32x2*)(x + c);
            *(f32x4*)(o + c) = (f32x4){bf_lo(b.x), bf_hi(b.x), bf_lo(b.y), bf_hi(b.y)} * rs * *(const f32x4*)(in[25] + c); } }
}
}
#define XB_TMO      128
#define XB_XCNT(j)  (256  + 64 * (j))
#define XB_XSUB(j)  (1280 + 64 * (j))
#define XB_XGEN(j)  (2304 + 64 * (j))
#define XB_TOP      3328
#define XB_TOPGEN   3392
#define XCD_BAR_WORDS 3456
#define XB_SPIN_CAP (1u << 22)
__device__ __forceinline__ unsigned xb_ld(unsigned* p)              { return __hip_atomic_load(p, __ATOMIC_RELAXED, __HIP_MEMORY_SCOPE_AGENT); }
__device__ __forceinline__ unsigned xb_add(unsigned* p, unsigned v) { return __hip_atomic_fetch_add(p, v, __ATOMIC_RELAXED, __HIP_MEMORY_SCOPE_AGENT); }
__device__ __forceinline__ unsigned xb_xcc_id() { return (unsigned)__builtin_amdgcn_s_getreg((3 << 11) | 20) & 0xFu; }
#define XB_SPIN(cond, bar) do { unsigned _sp = 0; while (cond) { __builtin_amdgcn_s_sleep(1); \
    if ((++_sp & 255u) == 0u) { if (xb_ld(&(bar)[XB_TMO])) break; if (_sp > XB_SPIN_CAP) { atomicAdd(&(bar)[XB_TMO], 1u); break; } } } } while (0)
struct XcdBarrier { unsigned* bar; unsigned x; volatile LAS unsigned* st; };
__device__ __forceinline__ XcdBarrier xcd_barrier_post(unsigned* bar, volatile LAS unsigned* st) {
    XcdBarrier b; b.bar = bar; b.x = xb_xcc_id(); b.st = st;
    if (threadIdx.x == 0) (void)xb_add(&bar[XB_XCNT(b.x)], 1u);
    return b;
}
__device__ __forceinline__ void xcd_barrier_complete(unsigned* bar, unsigned x, unsigned& nloc, unsigned& nx) {
    const unsigned G = gridDim.x * gridDim.y * gridDim.z;
    unsigned sum, cnt, mine, sp = 0u;
    for (;;) {
        sum = 0u; cnt = 0u; mine = 0u;
#pragma unroll
        for (unsigned j = 0; j < 16; ++j) { const unsigned c = xb_ld(&bar[XB_XCNT(j)]); sum += c; cnt += (c > 0u) ? 1u : 0u; mine = (j == x) ? c : mine; }
        if (sum == G) break;
        __builtin_amdgcn_s_sleep(1);
        if ((++sp & 255u) == 0u) { if (xb_ld(&bar[XB_TMO])) break; if (sp > XB_SPIN_CAP) { atomicAdd(&bar[XB_TMO], 1u); break; } }
    }
    nloc = mine > 0u ? mine : 1u; nx = cnt > 0u ? cnt : 1u;
}
__device__ __forceinline__ void xcd_barrier(const XcdBarrier& b) {
    asm volatile("s_waitcnt vmcnt(0)" ::: "memory");
    __syncthreads();
    if (threadIdx.x == 0) {
        unsigned* bar = b.bar;
        __builtin_amdgcn_s_waitcnt(0);
        unsigned nloc = b.st[0], nx = b.st[1];
        if (nloc == 0u) { xcd_barrier_complete(bar, b.x, nloc, nx); b.st[0] = nloc; b.st[1] = nx; }
        const unsigned old = xb_add(&bar[XB_XSUB(b.x)], 1u);
        const unsigned gen = old / nloc;
        if (old + 1u == (gen + 1u) * nloc) {
            __builtin_amdgcn_fence(__ATOMIC_RELEASE, "agent");
            asm volatile("s_waitcnt vmcnt(0)" ::: "memory");
            const unsigned og = xb_add(&bar[XB_TOP], 1u);
            const unsigned tg = og / nx;
            if (og + 1u == (tg + 1u) * nx) xb_add(&bar[XB_TOPGEN], 1u);
            else XB_SPIN(xb_ld(&bar[XB_TOPGEN]) == tg, bar);
            __builtin_amdgcn_fence(__ATOMIC_ACQUIRE, "agent");
            xb_add(&bar[XB_XGEN(b.x)], 1u);
            asm volatile("s_waitcnt vmcnt(0)" ::: "memory");
        } else {
            XB_SPIN(xb_ld(&bar[XB_XGEN(b.x)]) == gen, bar);
            __builtin_amdgcn_fence(__ATOMIC_ACQUIRE, "agent");
            asm volatile("s_waitcnt vmcnt(0)" ::: "memory");
        }
    }
    __syncthreads();
}

constexpr int LDS_BYTES = 144 * 1024, MISC_OFF = 136 * 1024;
static_assert(pg8::STAGE_BYTES <= MISC_OFF && att::LDS_BYTES <= MISC_OFF && dec::LDS_BYTES <= MISC_OFF && sg::LDS_BYTES <= MISC_OFF && dec::SMEM_LDS <= MISC_OFF, "LDS budget");
constexpr int NPHASE = 24;
struct Params { const float* in[26]; float* out; uchar* ws; int ph_lo, ph_hi; };

template <class T> __device__ __forceinline__ T* launder(T* p) { asm volatile("" : "+s"(p)); return p; }
#define PHASE_PTRS \
    uchar* const ws = launder(P.ws); float* const out = launder(P.out); const float* const* in = P.in; (void)in; (void)out; \
    bf16_t* const XB = (bf16_t*)(ws + WS_XB); float* const XR = (float*)(ws + WS_XRES); bf16_t* const Z = (bf16_t*)(ws + WS_Z); bf16_t* const MX = (bf16_t*)(ws + WS_MIXED); \
    bf16_t* const PO = (bf16_t*)(ws + WS_POOLED); bf16_t* const QB = (bf16_t*)(ws + WS_Q); float* const ssp = (float*)(ws + WS_SSP); float* const ssps = (float*)(ws + WS_SSPS); \
    float* const ssq = (float*)(ws + WS_SSQ); float* const KVRAW = (float*)(ws + WS_KVRAW); bf16_t* const MEMB = (bf16_t*)(ws + WS_MEMB); \
    (void)XB; (void)XR; (void)Z; (void)MX; (void)PO; (void)QB; (void)ssp; (void)ssps; (void)ssq; (void)KVRAW; (void)MEMB;

__global__ void __launch_bounds__(512, 2) yoco_fwd(Params P) {
    extern __shared__ __attribute__((aligned(16))) uchar lds_raw[];
    LAS uchar* lds = (LAS uchar*)lds_raw;
    const int tid = threadIdx.x, G = gridDim.x, bid = blockIdx.x;
    volatile LAS unsigned* misc = (volatile LAS unsigned*)(lds + MISC_OFF);
    if (tid < 4) misc[tid] = 0u;
    __syncthreads();
    const int lo = P.ph_lo, hi = P.ph_hi; const bool multi = (hi - lo) > 1;
    XcdBarrier bar; bar.bar = (unsigned*)(P.ws + WS_CTL); bar.x = 0; bar.st = misc;
    if (multi) bar = xcd_barrier_post((unsigned*)(P.ws + WS_CTL), misc);
#ifndef EN_MASK
#define EN_MASK 0xffff
#endif
#define EN(t) ((EN_MASK >> (t)) & 1)
#ifndef REP_MASK
#define REP_MASK 0
#endif
#define NREP(t, first) ((((REP_MASK >> (t)) & 1) && (first)) ? 2 : 1)
#define IN(k) (lo <= (k) && (k) < hi)
#define SEAM(k) do { if (IN(k) && IN((k) + 1)) xcd_barrier(bar); } while (0)
#define SUNITS(u, n) for (int u = G - 1 - bid; u < (n); u += G)

    if (EN(0) && IN(0)) for (int rep = 0; rep < NREP(0, true); ++rep) { if (rep) xcd_barrier(bar); PHASE_PTRS ew::prologue(in, out, ws, lds, G, bid); }
    SEAM(0);

#pragma unroll 1
    for (int l = 0; l < 2; ++l) {
        const int pb = 1 + 4 * l;
        if (EN(1) && IN(pb)) for (int rep = 0; rep < NREP(1, l == 0); ++rep) { if (rep) xcd_barrier(bar);
            PHASE_PTRS
            { pg8::Gemm g{XB, (const bf16_t*)(ws + WS_WINA) + (size_t)l * INA * DM, DM, DM, DM, 0}; pg8::StaticOrder S; S.init(PM / 256, INA / 256, G, bid);
              pg8::EpiZ E{Z, ssp, nullptr, nullptr}; pg8::gemm_phase(lds, g, S, E); }
            if (l == 0) { pg8::Gemm g{(const bf16_t*)(ws + WS_MHAT), (const bf16_t*)(ws + WS_WMEM), DM, DM, DM, 0}; pg8::StaticOrder S; S.init(2048 / 256, 4096 / 256, G, bid);
              pg8::EpiMem E{out + O_MEMK, MEMB}; pg8::gemm_phase(lds, g, S, E); }
            SUNITS(u, INA / 64) { sg::EpiZ E{Z, ssps, nullptr, nullptr}; sg::sgemm_unit(lds, XB + (size_t)PM * DM, DM, (const bf16_t*)(ws + WS_WINA) + (size_t)l * INA * DM, DM, DM, u * 64, E); }
        }
        SEAM(pb);
        if (EN(2) && IN(pb + 1)) for (int rep = 0; rep < NREP(2, l == 0); ++rep) { if (rep) xcd_barrier(bar);
            PHASE_PTRS
            for (int rep2 = 0; rep2 < NREP(15, l == 0); ++rep2) ew::pooling(l, in, out, ws, G, bid);
            for (int rep3 = 0; rep3 < NREP(16, l == 0); ++rep3)
            for (int u = bid; u < PB * MEMH * 8; u += G) { const int b = u >> 5, h = (u >> 3) & 3, x = u & 7; const size_t r0 = (size_t)b * PT + 256 * x;
                const bf16_t* Kh = MEMB + (size_t)b * 256 * 4096 + l * 1024 + h * 128;
                att::attn_body<128, false, 1, LDZ, 4096>(Z + r0 * LDZ + ZA_QM + h * 128, Kh, Kh + 512, nullptr, nullptr, Z + r0 * LDZ + ZA_GM + h * 128, MX + r0 * OUTW + 1024 + h * 128, 4, 0, lds);
                __syncthreads(); }
            SUNITS(u, SB * MEMH) { const int b = u >> 2, h = u & 3; const size_t r0 = (size_t)PM + b * 4; const size_t ko = (((size_t)l * SB + b) * MEMT * MEMH + h) * 128;
                dec::smem_unit(Z + r0 * LDZ + ZA_QM + h * 128, Z + r0 * LDZ + ZA_GM + h * 128, in[5] + ko, in[6] + ko, MX + r0 * OUTW + 1024 + h * 128, lds); }
        }
        SEAM(pb + 1);
        if (EN(3) && IN(pb + 2)) for (int rep = 0; rep < NREP(3, l == 0); ++rep) { if (rep) xcd_barrier(bar);
            PHASE_PTRS
            { pg8::Gemm g{PO, (const bf16_t*)(ws + WS_WGRP) + (size_t)l * 4 * 65536, DM, 256, 256, 256}; pg8::StaticOrder S; S.init(PM / 256, 4, G, bid);
              pg8::EpiGrp E{Z, MX}; pg8::gemm_phase(lds, g, S, E); }
            SUNITS(u, 16) { const int g = u >> 2; sg::EpiGrp E{Z, MX, g * 256};
                sg::sgemm_unit(lds, PO + (size_t)PM * DM + g * 256, DM, (const bf16_t*)(ws + WS_WGRP) + ((size_t)l * 4 + g) * 65536, 256, 256, (u & 3) * 64, E); }
        }
        SEAM(pb + 2);
        if (EN(4) && IN(pb + 3)) for (int rep = 0; rep < NREP(4, l == 0); ++rep) { if (rep) xcd_barrier(bar);
            PHASE_PTRS
            for (int rep2 = 0; rep2 < NREP(17, l == 0); ++rep2)
            { pg8::Gemm g{MX, (const bf16_t*)(ws + WS_WOUT) + (size_t)l * DM * OUTW, OUTW, OUTW, OUTW, 0}; pg8::StaticOrder S; S.init(PM / 256, DM / 256, G, bid);
              pg8::EpiOut E{XB, ssp}; pg8::gemm_phase(lds, g, S, E); }
            for (int rep3 = 0; rep3 < NREP(18, l == 0); ++rep3)
            SUNITS(u, DM / 64) { sg::EpiOut E{XB, ssps};
                sg::sgemm_unit(lds, MX + (size_t)PM * OUTW, OUTW, (const bf16_t*)(ws + WS_WOUT) + (size_t)l * DM * OUTW, OUTW, OUTW, u * 64, E); }
        }
        SEAM(pb + 3);
    }

#pragma unroll 1
    for (int j = 0; j < 2; ++j) {
        const int l = 2 + j, pb = 9 + 7 * j; const int NB = j == 0 ? NB2 : NB3;
        if (EN(5) && IN(pb)) for (int rep = 0; rep < NREP(5, j == 0); ++rep) { if (rep) xcd_barrier(bar);
            PHASE_PTRS
            const bf16_t* WB = (const bf16_t*)(ws + WS_WINB) + (size_t)j * NB2 * DM; float* kvr = j == 0 ? KVRAW : nullptr;
            { pg8::Gemm g{XB, WB, DM, DM, DM, 0}; pg8::StaticOrder S; S.init(PM / 256, NB / 256, G, bid);
              pg8::EpiZ E{Z, ssp, ssq, kvr}; pg8::gemm_phase(lds, g, S, E); }
            SUNITS(u, NB / 64) { sg::EpiZ E{Z, ssps, ssq, kvr}; sg::sgemm_unit(lds, XB + (size_t)PM * DM, DM, WB, DM, DM, u * 64, E); }
        }
        SEAM(pb);
        if (EN(6) && IN(pb + 1)) for (int rep = 0; rep < NREP(6, j == 0); ++rep) { if (rep) xcd_barrier(bar);
            PHASE_PTRS
            if (j == 0) ew::kvpost(in, out, ws, G, bid);
            { pg8::Gemm g{Z + ZB_CQ, (const bf16_t*)(ws + WS_WQUP) + (size_t)j * QW * QRANK, LDZ, QRANK, QRANK, 0}; pg8::StaticOrder S; S.init(PM / 256, QW / 256, G, bid);
              pg8::EpiQ E{QB, ssq}; pg8::gemm_phase(lds, g, S, E); }
            for (int u = bid; u < PB * MEMH * 8; u += G) { const int b = u >> 5, h = (u >> 3) & 3, x = u & 7; const size_t r0 = (size_t)b * PT + 256 * x;
                const bf16_t* Kh = MEMB + (size_t)b * 256 * 4096 + l * 1024 + h * 128;
                att::attn_body<128, false, 1, LDZ, 4096>(Z + r0 * LDZ + ZB_QM + h * 128, Kh, Kh + 512, nullptr, nullptr, Z + r0 * LDZ + ZB_GM + h * 128, MX + r0 * OUTW + 1024 + h * 128, 4, 0, lds);
                __syncthreads(); }
            SUNITS(u, QW / 64) { sg::EpiQ E{QB, ssq}; sg::sgemm_unit(lds, Z + (size_t)PM * LDZ + ZB_CQ, LDZ, (const bf16_t*)(ws + WS_WQUP) + (size_t)j * QW * QRANK, QRANK, QRANK, u * 64, E); }
            SUNITS(u, SB * MEMH) { const int b = u >> 2, h = u & 3; const size_t r0 = (size_t)PM + b * 4; const size_t ko = (((size_t)l * SB + b) * MEMT * MEMH + h) * 128;
                dec::smem_unit(Z + r0 * LDZ + ZB_QM + h * 128, Z + r0 * LDZ + ZB_GM + h * 128, in[5] + ko, in[6] + ko, MX + r0 * OUTW + 1024 + h * 128, lds); }
        }
        SEAM(pb + 1);
        if (EN(7) && IN(pb + 2)) for (int rep = 0; rep < NREP(7, j == 0); ++rep) { if (rep) xcd_barrier(bar);
            PHASE_PTRS
            if (j == 0) { pg8::Gemm g{(const bf16_t*)(ws + WS_CKVB), (const bf16_t*)(ws + WS_WKV), KVR, KVR, KVR, 0}; pg8::StaticOrder S; S.init(PM / 256, 2048 / 256, G, bid);
              pg8::EpiKV E{(bf16_t*)(ws + WS_KN)}; pg8::gemm_phase(lds, g, S, E); }
            SUNITS(u, MLAH * 4) { const int h = u >> 2; sg::EpiAbsorb E{(bf16_t*)(ws + WS_QDEC), h};
                sg::sgemm_unit(lds, QB + (size_t)PM * QW + h * QHD, QW, (const bf16_t*)(ws + WS_WKUPN) + h * 128, 1024, 128, (u & 3) * 64, E); }
            ew::sq_rope(ws, G, bid);
        }
        SEAM(pb + 2);
        if (EN(8) && IN(pb + 3)) for (int rep = 0; rep < NREP(8, j == 0); ++rep) { if (rep) xcd_barrier(bar);
            PHASE_PTRS
#pragma unroll 1
            for (int half = 0; half < 2; ++half) {
            if ((half ^ (bid & 1)) == 0) {
            for (int rep2 = 0; rep2 < NREP(13, j == 0); ++rep2)
            for (int u = bid; u < PB * MLAH * 4; u += G) { const int b = u >> 5, h = (u >> 2) & 7, xp = u & 3;
#pragma unroll 1
                for (int s = 0; s < 2; ++s) { const int x = s == 0 ? 7 - xp : xp; const size_t b0 = (size_t)b * PT, r0 = b0 + 256 * x;
                    att::attn_body<192, true, 1, QW, 1024>(QB + r0 * QW + h * QHD, (const bf16_t*)(ws + WS_KN) + b0 * 1024 + h * 128, (const bf16_t*)(ws + WS_VV) + b0 * 1024 + h * 128,
                        (const bf16_t*)(ws + WS_KROPEB) + b0 * ROPE, (const f32x2*)(ws + WS_ROPE) + (size_t)(256 * x) * 32, Z + r0 * LDZ + ZB_GT + h * 128, MX + r0 * OUTW + h * 128, 4 * (x + 1), 4 * x, lds);
                    __syncthreads(); } }
            } else {
            for (int rep3 = 0; rep3 < NREP(14, j == 0); ++rep3)
            for (int u = bid; u < SB * 8; u += G) { const int b = u >> 3, ch = u & 7;
                dec::decode_unit((const bf16_t*)(ws + WS_QDEC) + (size_t)b * 32 * 320, in[3], in[4], (const int*)in[7] + b * NPAGES + ch * 16,
                                 (float*)(ws + WS_OPART) + ((size_t)b * 8 + ch) * 32 * 256, (float*)(ws + WS_ML) + ((size_t)b * 8 + ch) * 32 * 2, lds);
                __syncthreads(); }
            } }
        }
        SEAM(pb + 3);
        if (EN(9) && IN(pb + 4)) for (int rep = 0; rep < NREP(9, j == 0); ++rep) { if (rep) xcd_barrier(bar);
            PHASE_PTRS
            const int ct = ew::otid();
            for (int w = bid * 8 + (ct >> 6); w < SB * 32; w += G * 8)
                dec::combine_row(w >> 5, w & 31, ct & 63, (const bf16_t*)(ws + WS_QDEC), (const float*)(ws + WS_OPART), (const float*)(ws + WS_ML), out + O_CKVS, out + O_KRS, (bf16_t*)(ws + WS_OLAT));
        }
        SEAM(pb + 4);
        if (EN(10) && IN(pb + 5)) for (int rep = 0; rep < NREP(10, j == 0); ++rep) { if (rep) xcd_barrier(bar);
            PHASE_PTRS
            SUNITS(u, MLAH * 2) { const int h = u >> 1; sg::EpiVup E{Z, MX, h};
                sg::sgemm_unit(lds, (const bf16_t*)(ws + WS_OLAT) + h * 256, 2048, (const bf16_t*)(ws + WS_WKV) + ((size_t)1024 + h * 128) * 256, 256, 256, (u & 1) * 64, E); }
        }
        SEAM(pb + 5);
        if (EN(11) && IN(pb + 6)) {
            PHASE_PTRS
            { pg8::Gemm g{MX, (const bf16_t*)(ws + WS_WOUT) + (size_t)l * DM * OUTW, OUTW, OUTW, OUTW, 0}; pg8::StaticOrder S; S.init(PM / 256, DM / 256, G, bid);
              pg8::EpiOut E{XB, ssp}; pg8::gemm_phase(lds, g, S, E); }
            SUNITS(u, DM / 64) { sg::EpiOut E{XB, ssps};
                sg::sgemm_unit(lds, MX + (size_t)PM * OUTW, OUTW, (const bf16_t*)(ws + WS_WOUT) + (size_t)l * DM * OUTW, OUTW, OUTW, u * 64, E); }
        }
        SEAM(pb + 6);
    }
    if (EN(12) && IN(23)) for (int rep = 0; rep < NREP(12, true); ++rep) { if (rep) xcd_barrier(bar); PHASE_PTRS ew::final_norm(in, out, ws, G, bid); }
#undef IN
#undef SEAM
#undef SUNITS
}

#ifndef MK_LAUNCHES
#define MK_LAUNCHES 1
#endif
extern "C" void kernel_launch(void* const* d_in, const int* in_sizes, int n_in, void* d_out, int out_size, void* d_ws, size_t ws_size, hipStream_t stream) {
    static int grid = 0;
    if (grid == 0) {
        if (n_in != 26 || (size_t)out_size != O_END || ws_size < WS_END) { fprintf(stderr, "kernel_launch: unexpected shapes: n_in %d out %d ws %zu (need out %zu ws %zu)\n", n_in, out_size, ws_size, (size_t)O_END, (size_t)WS_END); grid = -1; return; }
        int dev = 0, cus = 0, per_cu = 0;
        if (hipGetDevice(&dev) != hipSuccess || hipDeviceGetAttribute(&cus, hipDeviceAttributeMultiprocessorCount, dev) != hipSuccess) { grid = -1; return; }
        if (hipFuncSetAttribute((const void*)yoco_fwd, hipFuncAttributeMaxDynamicSharedMemorySize, LDS_BYTES) != hipSuccess) { fprintf(stderr, "kernel_launch: hipFuncSetAttribute failed\n"); grid = -1; return; }
        if (hipOccupancyMaxActiveBlocksPerMultiprocessor(&per_cu, (const void*)yoco_fwd, 512, LDS_BYTES) != hipSuccess || per_cu < 1) { fprintf(stderr, "kernel_launch: occupancy query says %d blocks per CU\n", per_cu); (void)hipGetLastError(); grid = -1; return; }
        grid = cus;
    }
    if (grid < 0) return;
    (void)hipMemsetAsync((char*)d_ws + WS_CTL, 0, CTL_BYTES, stream);
    Params p{};
    for (int i = 0; i < 26; ++i) p.in[i] = (const float*)d_in[i];
    p.out = (float*)d_out; p.ws = (uchar*)d_ws;
    if (MK_LAUNCHES == 1) { p.ph_lo = 0; p.ph_hi = NPHASE; hipLaunchKernelGGL(yoco_fwd, dim3(grid), dim3(512), LDS_BYTES, stream, p); }
    else for (int k = 0; k < NPHASE; ++k) { p.ph_lo = k; p.ph_hi = k + 1; hipLaunchKernelGGL(yoco_fwd, dim3(grid), dim3(512), LDS_BYTES, stream, p); }
    const hipError_t le = hipPeekAtLastError();
    if (le != hipSuccess) fprintf(stderr, "kernel_launch: launch failed: %s\n", hipGetErrorName(le));
}
```

```cpp
#include <hip/hip_runtime.h>
#include <cstdio>
#include <cstdint>

#define LAS __attribute__((address_space(3)))
typedef unsigned char uchar;
typedef unsigned short bf16_t;
typedef short bf16x8 __attribute__((ext_vector_type(8)));
typedef short s16x4 __attribute__((ext_vector_type(4)));
typedef float f32x2 __attribute__((ext_vector_type(2)));
typedef float f32x4 __attribute__((ext_vector_type(4)));
typedef float f32x16 __attribute__((ext_vector_type(16)));
typedef unsigned u32x2 __attribute__((ext_vector_type(2)));
typedef unsigned u32x4 __attribute__((ext_vector_type(4)));

constexpr int DM = 1024, PB = 8, PT = 2048, PM = PB * PT, SB = 32, ST = 4, SM = SB * ST, RP = 16640;
constexpr int KVR = 256, ROPE = 64, NOPE = 128, QRANK = 384, MLAH = 8, QHD = 192, QW = MLAH * QHD;
constexpr int MEMT = 256, MEMH = 4, MEMW = 512;
constexpr int INA = 3072, INB = 2432, OUTW = 1536, LDZ = 3072, NB2 = 2816, NB3 = 2560;
constexpr int NPAGES = 128, PAGE = 128, PAST = 16384, POOLBUF = 15;
constexpr float EPS = 1e-6f;
constexpr int ZA_U = 0, ZA_GT = 1024, ZA_QM = 2048, ZA_GM = 2560;
constexpr int ZB_CQ = 0, ZB_KR = 384, ZB_GT = 512, ZB_QM = 1536, ZB_GM = 2048, ZB_KV = 2560;

constexpr size_t O_YP = 0, O_YS = O_YP + (size_t)PM * DM, O_PSP = O_YS + (size_t)SM * DM, O_PSS = O_PSP + (size_t)2 * PB * 15 * DM, O_CKVP = O_PSS + (size_t)2 * SB * 15 * DM,
                 O_KRP = O_CKVP + (size_t)PM * KVR, O_CKVS = O_KRP + (size_t)PM * ROPE, O_KRS = O_CKVS + (size_t)SM * KVR, O_MEMK = O_KRS + (size_t)SM * ROPE,
                 O_MEMV = O_MEMK + (size_t)4 * PB * MEMT * MEMW, O_END = O_MEMV + (size_t)4 * PB * MEMT * MEMW;

constexpr size_t al256(size_t x) { return (x + 255) / 256 * 256; }
constexpr size_t WS_CTL = 0, CTL_BYTES = 65536;
constexpr size_t WS_ROPE = WS_CTL + CTL_BYTES;
constexpr size_t WS_WINA = al256(WS_ROPE + (size_t)2052 * 32 * 8);
constexpr size_t WS_WGRP = al256(WS_WINA + (size_t)2 * INA * DM * 2);
constexpr size_t WS_WINB = al256(WS_WGRP + (size_t)2 * 4 * 256 * 256 * 2);
constexpr size_t WS_WQUP = al256(WS_WINB + (size_t)2 * NB2 * DM * 2);
constexpr size_t WS_WKV  = al256(WS_WQUP + (size_t)2 * QW * QRANK * 2);
constexpr size_t WS_WKUPN = al256(WS_WKV + (size_t)2048 * 256 * 2);
constexpr size_t WS_WMEM = al256(WS_WKUPN + (size_t)256 * 1024 * 2);
constexpr size_t WS_WOUT = al256(WS_WMEM + (size_t)4096 * 1024 * 2);
constexpr size_t WS_MHAT = al256(WS_WOUT + (size_t)4 * DM * OUTW * 2);
constexpr size_t WS_MEMB = al256(WS_MHAT + (size_t)2048 * 1024 * 2);
constexpr size_t WS_XRES = al256(WS_MEMB + (size_t)2048 * 4096 * 2);
constexpr size_t WS_XB   = al256(WS_XRES + (size_t)RP * DM * 4);
constexpr size_t WS_SSP  = al256(WS_XB + (size_t)RP * DM * 2);
constexpr size_t WS_SSPS = al256(WS_SSP + (size_t)PM * 16 * 4);
constexpr size_t WS_SSQ  = al256(WS_SSPS + (size_t)SM * 32 * 4);
constexpr size_t WS_Z    = al256(WS_SSQ + (size_t)RP * 12 * 4);
constexpr size_t WS_POOLED = al256(WS_Z + (size_t)RP * LDZ * 2);
constexpr size_t WS_MIXED = al256(WS_POOLED + (size_t)RP * DM * 2);
constexpr size_t WS_Q    = al256(WS_MIXED + (size_t)RP * OUTW * 2);
constexpr size_t WS_KVRAW = al256(WS_Q + (size_t)RP * QW * 2);
constexpr size_t WS_CKVB = al256(WS_KVRAW + (size_t)RP * 320 * 4);
constexpr size_t WS_KROPEB = al256(WS_CKVB + (size_t)RP * 256 * 2);
constexpr size_t WS_KN   = al256(WS_KROPEB + (size_t)RP * 64 * 2);
constexpr size_t WS_VV   = al256(WS_KN + (size_t)PM * 1024 * 2);
constexpr size_t WS_QDEC = al256(WS_VV + (size_t)PM * 1024 * 2);
constexpr size_t WS_OPART = al256(WS_QDEC + (size_t)SB * 32 * 320 * 2);
constexpr size_t WS_ML   = al256(WS_OPART + (size_t)SB * 8 * 32 * 256 * 4);
constexpr size_t WS_OLAT = al256(WS_ML + (size_t)SB * 8 * 32 * 2 * 4);
constexpr size_t WS_END  = al256(WS_OLAT + (size_t)SM * 2048 * 2);

__device__ __forceinline__ unsigned cvt_pk_bf16(float lo, float hi) { unsigned r; asm volatile("v_cvt_pk_bf16_f32 %0, %1, %2" : "=v"(r) : "v"(lo), "v"(hi)); return r; }
__device__ __forceinline__ float bf_lo(unsigned w) { return __uint_as_float(w << 16); }
__device__ __forceinline__ float bf_hi(unsigned w) { return __uint_as_float(w & 0xffff0000u); }
__device__ __forceinline__ float bf2f(bf16_t b) { return __uint_as_float(((unsigned)b) << 16); }
__device__ __forceinline__ float silu(float x) { return x * __builtin_amdgcn_rcpf(1.0f + __expf(-x)); }
__device__ __forceinline__ void unpack8(const u32x4 w, float (&f)[8]) {
    f[0] = bf_lo(w.x); f[1] = bf_hi(w.x); f[2] = bf_lo(w.y); f[3] = bf_hi(w.y); f[4] = bf_lo(w.z); f[5] = bf_hi(w.z); f[6] = bf_lo(w.w); f[7] = bf_hi(w.w); }
__device__ __forceinline__ u32x4 pack8(const float (&f)[8]) { u32x4 w; w.x = cvt_pk_bf16(f[0], f[1]); w.y = cvt_pk_bf16(f[2], f[3]); w.z = cvt_pk_bf16(f[4], f[5]); w.w = cvt_pk_bf16(f[6], f[7]); return w; }
__device__ __forceinline__ float sum4(const f32x4 a) { return (a[0] + a[1]) + (a[2] + a[3]); }
__device__ __forceinline__ float rs_from16(const float* p) {
    const f32x4 a = *(const f32x4*)p, b = *(const f32x4*)(p + 4), c = *(const f32x4*)(p + 8), d = *(const f32x4*)(p + 12);
    return rsqrtf(((sum4(a) + sum4(b)) + (sum4(c) + sum4(d))) * (1.0f / 1024.0f) + EPS); }
__device__ __forceinline__ float rs_from32(const float* p) { float s = 0.f;
#pragma unroll
    for (int i = 0; i < 8; ++i) s += sum4(*(const f32x4*)(p + 4 * i));
    return rsqrtf(s * (1.0f / 1024.0f) + EPS); }
__device__ __forceinline__ float rsq_from12(const float* p) {
    const f32x4 a = *(const f32x4*)p, b = *(const f32x4*)(p + 4), c = *(const f32x4*)(p + 8);
    return rsqrtf((sum4(a) + sum4(b) + sum4(c)) * (1.0f / 384.0f) + EPS); }
__device__ __forceinline__ int crow(int r, int hi) { return (r & 3) + 8 * (r >> 2) + 4 * hi; }
static_assert(WS_VV == WS_KN + (size_t)PM * 1024 * 2, "VV must follow KN");
namespace pg8 {
constexpr int BM = 256, BK = 64, HALF = 128, HTB = HALF * BK * 2, STAGE_BYTES = 8 * HTB, NXCD = 8, WGM = 8;
__device__ __forceinline__ int lds_byte(int r, int c) { const int st = (r >> 4) * 2 + (c >> 5), rr = r & 15, cc = c & 31, ob = rr * 64 + cc * 2; return st * 1024 + (ob ^ (((ob >> 9) & 1) << 5)); }
__device__ __forceinline__ void stage_rc(int b, int& R, int& C) { const int st = b / 1024, sb = b % 1024, swz = sb ^ (((sb >> 9) & 1) << 5); R = (st >> 1) * 16 + swz / 64; C = (st & 1) * 32 + (swz % 64) / 2; }
__device__ __forceinline__ int perm32(int rho) { const int n = rho >> 4, i = rho & 15; return 8 * (i >> 2) + 4 * n + (i & 3); }

struct Unit { int pm, pn; };
struct Gemm { const bf16_t* A; const bf16_t* Bt; int lda, ldb, K, a_pn; };

struct StaticOrder {
    int nM, nN, nwg, G, c;
    __device__ __forceinline__ void init(int nM_, int nN_, int G_, int c_) { nM = nM_; nN = nN_; nwg = nM * nN; G = G_; c = c_; }
    __device__ __forceinline__ bool next(int i, Unit& u) const {
        const long L = (long)i * G + c; if (L >= nwg) return false;
        int wgid = (int)L; { const int q = nwg / NXCD, r = nwg % NXCD, xcd = wgid % NXCD, off = wgid / NXCD; wgid = (xcd < r ? xcd * (q + 1) : r * (q + 1) + (xcd - r) * q) + off; }
        const int nig = WGM * nN, gid = wgid / nig, fm = gid * WGM, gsz = (nM - fm) < WGM ? (nM - fm) : WGM;
        u.pm = fm + ((wgid % nig) % gsz); u.pn = (wgid % nig) / gsz; return true;
    }
};

template <class Epi>
__device__ __forceinline__ void gemm_phase(LAS uchar* lds, const Gemm g, const StaticOrder& S, const Epi& E) {
    int tid_ = threadIdx.x; asm volatile("" : "+v"(tid_));
    const int tid = tid_, wid = __builtin_amdgcn_readfirstlane(tid >> 6), lane = tid & 63, wr = wid >> 2, wc = wid & 3, fr = lane & 15, fq = lane >> 4;
    int K_ = g.K; asm volatile("" : "+s"(K_));
    const int K = K_, nt = K / BK;
    unsigned voffA[2], voffB[2];
#pragma unroll
    for (int i = 0; i < 2; ++i) { int R, C; stage_rc(tid * 16 + i * 8192, R, C); const int Rb = Epi::PERM ? ((R & ~31) + perm32(R & 31)) : R;
        voffA[i] = (unsigned)(R * g.lda + C) * 2u; voffB[i] = (unsigned)(Rb * g.ldb + C) * 2u; }
    const size_t kstep = (size_t)(BK * 2);
    const size_t hstepA = (size_t)HALF * g.lda * 2, hstepB = (size_t)HALF * g.ldb * 2;
    const size_t tstepA = 2 * hstepA, tstepB = 2 * hstepB;
    const unsigned ldsw = (unsigned)wid * 1024u;
    const int aoff = lds_byte(wr * 64 + fr, fq * 8), boff = lds_byte(wc * 32 + fr, fq * 8);
#define PG8_SA(b, h) (((b) * 2 + (h)) * HTB)
#define PG8_SB(b, h) ((4 + (b) * 2 + (h)) * HTB)
#define PG8_STAGE(bufoff, gbase, voff) do { _Pragma("unroll") for (int _i = 0; _i < 2; ++_i) \
        __builtin_amdgcn_global_load_lds((const unsigned*)((const char*)(gbase) + (voff)[_i]), (LAS unsigned*)(lds + (bufoff) + ldsw + _i * 8192), 16, 0, 0); } while (0)
#define PG8_LDA(dst, b, h) do { _Pragma("unroll") for (int m = 0; m < 4; ++m) _Pragma("unroll") for (int k = 0; k < 2; ++k) dst[m][k] = *(const LAS bf16x8*)(lds + PG8_SA(b, h) + aoff + m * 2048 + k * 1024); } while (0)
#define PG8_LDB(dst, b, h) do { _Pragma("unroll") for (int n = 0; n < 2; ++n) _Pragma("unroll") for (int k = 0; k < 2; ++k) dst[n][k] = *(const LAS bf16x8*)(lds + PG8_SB(b, h) + boff + n * 2048 + k * 1024); } while (0)
#define PG8_MMA(ai, bj, At, Bt) do { __builtin_amdgcn_s_setprio(1); _Pragma("unroll") for (int m = 0; m < 4; ++m) _Pragma("unroll") for (int n = 0; n < 2; ++n) _Pragma("unroll") for (int k = 0; k < 2; ++k) \
        acc[ai][bj][m][n] = __builtin_amdgcn_mfma_f32_16x16x32_bf16(Bt[n][k], At[m][k], acc[ai][bj][m][n], 0, 0, 0); __builtin_amdgcn_s_setprio(0); } while (0)
#define PG8_WAIT_V(n) asm volatile("s_waitcnt vmcnt(" #n ")" ::: "memory")
#define PG8_WAIT_L(n) asm volatile("s_waitcnt lgkmcnt(" #n ")" ::: "memory")
#define PG8_BAR __builtin_amdgcn_s_barrier()
#define PG8_SCHED __builtin_amdgcn_sched_barrier(0)
    Unit cur, nxt; int ui = 0;
    if (!S.next(0, cur)) return;
    f32x4 acc[2][2][4][2];
#pragma unroll
    for (int a = 0; a < 2; ++a)
#pragma unroll
        for (int b = 0; b < 2; ++b)
#pragma unroll
            for (int m = 0; m < 4; ++m)
#pragma unroll
                for (int n = 0; n < 2; ++n) acc[a][b][m][n] = (f32x4){0.f, 0.f, 0.f, 0.f};
    bf16x8 At[4][2], B0[2][2], B1[2][2];
    const char* cA = (const char*)g.A + (size_t)cur.pm * tstepA + (size_t)cur.pn * g.a_pn * 2; const char* cB = (const char*)g.Bt + (size_t)cur.pn * tstepB;
    PG8_STAGE(PG8_SB(0, 0), cB, voffB); PG8_STAGE(PG8_SA(0, 0), cA, voffA); PG8_STAGE(PG8_SB(0, 1), cB + hstepB, voffB); PG8_STAGE(PG8_SA(0, 1), cA + hstepA, voffA);
    if (wr == 1) PG8_BAR;
    PG8_WAIT_V(4); PG8_BAR;
    PG8_STAGE(PG8_SB(1, 0), cB + kstep, voffB); PG8_STAGE(PG8_SA(1, 0), cA + kstep, voffA); PG8_STAGE(PG8_SB(1, 1), cB + hstepB + kstep, voffB);
    PG8_WAIT_V(6); PG8_BAR;
    for (;;) {
        const bool has_next = S.next(ui + 1, nxt);
        const char* nA = has_next ? (const char*)g.A + (size_t)nxt.pm * tstepA + (size_t)nxt.pn * g.a_pn * 2 : cA; const char* nB = has_next ? (const char*)g.Bt + (size_t)nxt.pn * tstepB : cB;
        for (int t = 0; t < nt; t += 2) {
            const bool last = (t == nt - 2);
            const char* a1 = cA + (size_t)(t + 1) * kstep;
            const char* a2 = last ? nA : cA + (size_t)(t + 2) * kstep; const char* b2 = last ? nB : cB + (size_t)(t + 2) * kstep;
            const char* a3 = a2 + kstep; const char* b3 = b2 + kstep;
            PG8_LDB(B0, 0, 0); PG8_SCHED; PG8_LDA(At, 0, 0); PG8_STAGE(PG8_SA(1, 1), a1 + hstepA, voffA);
            PG8_WAIT_L(8); PG8_BAR; PG8_WAIT_L(0); PG8_MMA(0, 0, At, B0); PG8_BAR; PG8_SCHED;
            PG8_LDB(B1, 0, 1); PG8_STAGE(PG8_SB(0, 0), b2, voffB);
            PG8_BAR; PG8_WAIT_L(0); PG8_MMA(0, 1, At, B1); PG8_BAR;
            PG8_LDA(At, 0, 1); PG8_STAGE(PG8_SA(0, 0), a2, voffA);
            PG8_BAR; PG8_WAIT_L(0); PG8_MMA(1, 0, At, B0); PG8_BAR; PG8_SCHED;
            PG8_STAGE(PG8_SB(0, 1), b2 + hstepB, voffB);
            PG8_WAIT_V(6); PG8_BAR; PG8_MMA(1, 1, At, B1); PG8_BAR;
            PG8_LDB(B0, 1, 0); PG8_SCHED; PG8_LDA(At, 1, 0); PG8_STAGE(PG8_SA(0, 1), a2 + hstepA, voffA);
            PG8_WAIT_L(8); PG8_BAR; PG8_WAIT_L(0); PG8_MMA(0, 0, At, B0); PG8_BAR; PG8_SCHED;
            PG8_LDB(B1, 1, 1); PG8_STAGE(PG8_SB(1, 0), b3, voffB);
            PG8_BAR; PG8_WAIT_L(0); PG8_MMA(0, 1, At, B1); PG8_BAR;
            PG8_LDA(At, 1, 1); PG8_STAGE(PG8_SA(1, 0), a3, voffA);
            PG8_BAR; PG8_WAIT_L(0); PG8_MMA(1, 0, At, B0); PG8_BAR; PG8_SCHED;
            PG8_STAGE(PG8_SB(1, 1), b3 + hstepB, voffB);
            PG8_WAIT_V(6); PG8_BAR; PG8_MMA(1, 1, At, B1); PG8_BAR;
        }
        E(acc, cur, wr, wc, fr, fq);
        if (!has_next) break;
#pragma unroll
        for (int a = 0; a < 2; ++a)
#pragma unroll
            for (int b = 0; b < 2; ++b)
#pragma unroll
                for (int m = 0; m < 4; ++m)
#pragma unroll
                    for (int n = 0; n < 2; ++n) acc[a][b][m][n] = (f32x4){0.f, 0.f, 0.f, 0.f};
        cur = nxt; cA = nA; cB = nB; ++ui;
    }
    PG8_WAIT_V(0);
    if (wr == 0) PG8_BAR;
    PG8_BAR;
#undef PG8_SA
#undef PG8_SB
#undef PG8_STAGE
#undef PG8_LDA
#undef PG8_LDB
#undef PG8_MMA
#undef PG8_WAIT_V
#undef PG8_WAIT_L
#undef PG8_BAR
#undef PG8_SCHED
}

typedef f32x4 Acc[2][2][4][2];
struct EpiZ { static constexpr bool PERM = true;
    bf16_t* Z; const float* ssp; float* ssq; float* kvraw;
    __device__ __forceinline__ void operator()(const Acc& acc, const Unit& u, int wr, int wc, int fr, int fq) const {
        const int rbase = u.pm * BM + wr * 64 + fr, col0 = u.pn * BM + wc * 32 + 8 * fq;
        const bool kvt = (kvraw != nullptr) && u.pn == 10, wantq = (ssq != nullptr) && u.pn <= 1;
#pragma unroll
        for (int ai = 0; ai < 2; ++ai)
#pragma unroll
            for (int m = 0; m < 4; ++m) { const int row = rbase + ai * HALF + m * 16; const float rs = rs_from16(ssp + (size_t)row * 16);
#pragma unroll
                for (int bj = 0; bj < 2; ++bj) { const f32x4 v0 = acc[ai][bj][m][0] * rs, v1 = acc[ai][bj][m][1] * rs; const int c = col0 + bj * HALF;
                    if (!kvt) { u32x4 w; w.x = cvt_pk_bf16(v0[0], v0[1]); w.y = cvt_pk_bf16(v0[2], v0[3]); w.z = cvt_pk_bf16(v1[0], v1[1]); w.w = cvt_pk_bf16(v1[2], v1[3]);
                        *(u32x4*)(Z + (size_t)row * LDZ + c) = w; }
                    else { float* p = kvraw + (size_t)row * 320 + (c - ZB_KV); *(f32x4*)p = v0; *(f32x4*)(p + 4) = v1; }
                    if (kvraw != nullptr && u.pn == 1 && bj == 1 && wc < 2) { float* p = kvraw + (size_t)row * 320 + 256 + (c - ZB_KR); *(f32x4*)p = v0; *(f32x4*)(p + 4) = v1; }
                    if (wantq && (u.pn == 0 || bj == 0)) { float s = sum4(v0 * v0) + sum4(v1 * v1); s += __shfl_xor(s, 16); s += __shfl_xor(s, 32);
                        if (fq == 0) ssq[(size_t)row * 12 + (u.pn == 0 ? bj * 4 + wc : 8 + wc)] = s; } } }
    }
};
struct EpiGrp { static constexpr bool PERM = true;
    const bf16_t* Z; bf16_t* MX;
    __device__ __forceinline__ void operator()(const Acc& acc, const Unit& u, int wr, int wc, int fr, int fq) const {
        const int rbase = u.pm * BM + wr * 64 + fr, col0 = u.pn * BM + wc * 32 + 8 * fq;
#pragma unroll
        for (int ai = 0; ai < 2; ++ai)
#pragma unroll
            for (int m = 0; m < 4; ++m) { const int row = rbase + ai * HALF + m * 16;
                const u32x4 g0 = *(const u32x4*)(Z + (size_t)row * LDZ + ZA_GT + col0), g1 = *(const u32x4*)(Z + (size_t)row * LDZ + ZA_GT + col0 + HALF);
#pragma unroll
                for (int bj = 0; bj < 2; ++bj) { const int c = col0 + bj * HALF; float gt[8]; unpack8(bj ? g1 : g0, gt);
                    const f32x4 v0 = acc[ai][bj][m][0], v1 = acc[ai][bj][m][1]; float o[8];
#pragma unroll
                    for (int j = 0; j < 4; ++j) { o[j] = v0[j] * silu(gt[j]); o[4 + j] = v1[j] * silu(gt[4 + j]); }
                    *(u32x4*)(MX + (size_t)row * OUTW + c) = pack8(o); }
                asm volatile("" ::: "memory"); }
    }
};
struct EpiQ { static constexpr bool PERM = true;
    bf16_t* Q; const float* ssq;
    __device__ __forceinline__ void operator()(const Acc& acc, const Unit& u, int wr, int wc, int fr, int fq) const {
        const int rbase = u.pm * BM + wr * 64 + fr, col0 = u.pn * BM + wc * 32 + 8 * fq;
#pragma unroll
        for (int ai = 0; ai < 2; ++ai)
#pragma unroll
            for (int m = 0; m < 4; ++m) { const int row = rbase + ai * HALF + m * 16; const float rs = rsq_from12(ssq + (size_t)row * 12);
#pragma unroll
                for (int bj = 0; bj < 2; ++bj) { const f32x4 v0 = acc[ai][bj][m][0] * rs, v1 = acc[ai][bj][m][1] * rs;
                    u32x4 w; w.x = cvt_pk_bf16(v0[0], v0[1]); w.y = cvt_pk_bf16(v0[2], v0[3]); w.z = cvt_pk_bf16(v1[0], v1[1]); w.w = cvt_pk_bf16(v1[2], v1[3]);
                    *(u32x4*)(Q + (size_t)row * QW + col0 + bj * HALF) = w; } }
    }
};
struct EpiKV { static constexpr bool PERM = true;
    bf16_t* KN;
    __device__ __forceinline__ void operator()(const Acc& acc, const Unit& u, int wr, int wc, int fr, int fq) const {
        const int rbase = u.pm * BM + wr * 64 + fr, col0 = (u.pn & 3) * BM + wc * 32 + 8 * fq; bf16_t* O = KN + (size_t)(u.pn >> 2) * ((size_t)PM * 1024);
#pragma unroll
        for (int ai = 0; ai < 2; ++ai)
#pragma unroll
            for (int m = 0; m < 4; ++m) { const int row = rbase + ai * HALF + m * 16;
#pragma unroll
                for (int bj = 0; bj < 2; ++bj) { const f32x4 v0 = acc[ai][bj][m][0], v1 = acc[ai][bj][m][1];
                    u32x4 w; w.x = cvt_pk_bf16(v0[0], v0[1]); w.y = cvt_pk_bf16(v0[2], v0[3]); w.z = cvt_pk_bf16(v1[0], v1[1]); w.w = cvt_pk_bf16(v1[2], v1[3]);
                    *(u32x4*)(O + (size_t)row * 1024 + col0 + bj * HALF) = w; } }
    }
};
struct EpiMem { static constexpr bool PERM = true;
    float* OK; bf16_t* MB;
    __device__ __forceinline__ void operator()(const Acc& acc, const Unit& u, int wr, int wc, int fr, int fq) const {
        const int rbase = u.pm * BM + wr * 64 + fr, col0 = u.pn * BM + wc * 32 + 8 * fq;
#pragma unroll
        for (int ai = 0; ai < 2; ++ai)
#pragma unroll
            for (int m = 0; m < 4; ++m) { const int row = rbase + ai * HALF + m * 16;
#pragma unroll
                for (int bj = 0; bj < 2; ++bj) { const int c = col0 + bj * HALF; const int l = c >> 10, kv = (c >> 9) & 1, cc = c & 511; const f32x4 v0 = acc[ai][bj][m][0], v1 = acc[ai][bj][m][1];
                    float* o = OK + (size_t)kv * (O_MEMV - O_MEMK) + ((size_t)l * 2048 + row) * 512 + cc; *(f32x4*)o = v0; *(f32x4*)(o + 4) = v1;
                    u32x4 w; w.x = cvt_pk_bf16(v0[0], v0[1]); w.y = cvt_pk_bf16(v0[2], v0[3]); w.z = cvt_pk_bf16(v1[0], v1[1]); w.w = cvt_pk_bf16(v1[2], v1[3]);
                    *(u32x4*)(MB + (size_t)row * 4096 + c) = w; } }
    }
};
struct EpiOut { static constexpr bool PERM = false;
    bf16_t* XB; float* ssp;
    __device__ __forceinline__ void operator()(const Acc& acc, const Unit& u, int wr, int wc, int fr, int fq) const {
        const int rbase = u.pm * BM + wr * 64 + fr, col0 = u.pn * BM + wc * 32 + 4 * fq;
        u32x2 bw[2][4][2][2];
#pragma unroll
        for (int ai = 0; ai < 2; ++ai)
#pragma unroll
            for (int m = 0; m < 4; ++m)
#pragma unroll
                for (int bj = 0; bj < 2; ++bj)
#pragma unroll
                    for (int n = 0; n < 2; ++n) bw[ai][m][bj][n] = *(const u32x2*)(XB + (size_t)(rbase + ai * HALF + m * 16) * DM + col0 + bj * HALF + n * 16);
#pragma unroll
        for (int ai = 0; ai < 2; ++ai)
#pragma unroll
            for (int m = 0; m < 4; ++m) { const int row = rbase + ai * HALF + m * 16; float s = 0.f;
#pragma unroll
                for (int bj = 0; bj < 2; ++bj)
#pragma unroll
                    for (int n = 0; n < 2; ++n) { const size_t o = (size_t)row * DM + col0 + bj * HALF + n * 16; const u32x2 b = bw[ai][m][bj][n];
                        const f32x4 v = (f32x4){bf_lo(b.x), bf_hi(b.x), bf_lo(b.y), bf_hi(b.y)} + acc[ai][bj][m][n];
                        u32x2 w; w.x = cvt_pk_bf16(v[0], v[1]); w.y = cvt_pk_bf16(v[2], v[3]); *(u32x2*)(XB + o) = w; s += sum4(v * v); }
                s += __shfl_xor(s, 16); s += __shfl_xor(s, 32);
                if (fq == 0) ssp[(size_t)row * 16 + u.pn * 4 + wc] = s; }
    }
};
}
namespace sg {
constexpr int BUF = 24576, LDS_BYTES = 2 * BUF;
template <class Epi>
__device__ __forceinline__ void sgemm_unit(LAS uchar* lds, const bf16_t* A, int lda, const bf16_t* Bt, int ldb, int K, int n0, const Epi& E) {
    int tid_ = threadIdx.x; asm volatile("" : "+v"(tid_));
    const int tid = tid_, wid = tid >> 6, lane = tid & 63, r32 = lane & 31, hi = lane >> 5, rb = wid & 3, cb = wid >> 2;
    const int srow = tid >> 3, sch = tid & 7;
    const bf16_t* ap0 = A + (size_t)srow * lda + sch * 8; const bf16_t* ap1 = ap0 + (size_t)64 * lda; const bf16_t* bp = Bt + (size_t)(n0 + srow) * ldb + sch * 8;
    const int aw0 = srow * 128 + ((sch ^ (srow & 7)) << 4), aw1 = aw0 + 64 * 128, bw = 16384 + aw0;
    const int arow = rb * 32 + r32, brow = cb * 32 + r32;
    const int ard = arow * 128, brd = 16384 + brow * 128, asw = arow & 7, bsw = brow & 7;
    u32x4 ra0[4], ra1[4], rbv[4];
    f32x16 acc = {};
    const int nk = K / 64;
#define SG_LOAD(s, kt) do { ra0[s] = *(const u32x4*)(ap0 + (size_t)(kt) * 64); ra1[s] = *(const u32x4*)(ap1 + (size_t)(kt) * 64); rbv[s] = *(const u32x4*)(bp + (size_t)(kt) * 64); } while (0)
#define SG_WRITE(s, b) do { *(LAS u32x4*)(lds + (b) * BUF + aw0) = ra0[s]; *(LAS u32x4*)(lds + (b) * BUF + aw1) = ra1[s]; *(LAS u32x4*)(lds + (b) * BUF + bw) = rbv[s]; } while (0)
#define SG_COMPUTE(b) do { _Pragma("unroll") for (int kk = 0; kk < 4; ++kk) { \
        const bf16x8 af = *(const LAS bf16x8*)(lds + (b) * BUF + ard + (((2 * kk + hi) ^ asw) << 4)); \
        const bf16x8 bf = *(const LAS bf16x8*)(lds + (b) * BUF + brd + (((2 * kk + hi) ^ bsw) << 4)); \
        acc = __builtin_amdgcn_mfma_f32_32x32x16_bf16(bf, af, acc, 0, 0, 0); } } while (0)
    if ((nk & 3) == 0) {
        SG_LOAD(0, 0); SG_LOAD(1, 1); SG_LOAD(2, 2); SG_LOAD(3, 3);
        for (int kt = 0; kt < nk; kt += 4) { const int l = nk - 1;
            SG_WRITE(0, 0); __syncthreads(); SG_LOAD(0, (kt + 4 < nk ? kt + 4 : l)); SG_COMPUTE(0);
            SG_WRITE(1, 1); __syncthreads(); SG_LOAD(1, (kt + 5 < nk ? kt + 5 : l)); SG_COMPUTE(1);
            SG_WRITE(2, 0); __syncthreads(); SG_LOAD(2, (kt + 6 < nk ? kt + 6 : l)); SG_COMPUTE(0);
            SG_WRITE(3, 1); __syncthreads(); SG_LOAD(3, (kt + 7 < nk ? kt + 7 : l)); SG_COMPUTE(1);
        }
    } else {
        SG_LOAD(0, 0); SG_LOAD(1, 1);
        for (int kt = 0; kt < nk; kt += 2) { const int l = nk - 1;
            SG_WRITE(0, 0); __syncthreads(); SG_LOAD(0, (kt + 2 < nk ? kt + 2 : l));
            SG_COMPUTE(0);
            SG_WRITE(1, 1); __syncthreads(); SG_LOAD(1, (kt + 3 < nk ? kt + 3 : l));
            SG_COMPUTE(1);
        }
    }
#undef SG_LOAD
#undef SG_WRITE
#undef SG_COMPUTE
    E(acc, rb * 32 + r32, n0 + cb * 32, hi);
}

struct EpiZ { bf16_t* Z; const float* ssps; float* ssq; float* kvraw;
    __device__ __forceinline__ void operator()(const f32x16& acc, int row, int cbase, int hi) const {
        const float rs = rs_from32(ssps + row * 32); const size_t grow = (size_t)PM + row; float s = 0.f;
#pragma unroll
        for (int g = 0; g < 4; ++g) { const f32x4 v = (f32x4){acc[4 * g], acc[4 * g + 1], acc[4 * g + 2], acc[4 * g + 3]} * rs; const int c = cbase + 8 * g + 4 * hi;
            if (kvraw != nullptr && cbase >= ZB_KV) *(f32x4*)(kvraw + grow * 320 + (c - ZB_KV)) = v;
            else { u32x2 w; w.x = cvt_pk_bf16(v[0], v[1]); w.y = cvt_pk_bf16(v[2], v[3]); *(u32x2*)(Z + grow * LDZ + c) = w; }
            if (kvraw != nullptr && cbase >= ZB_KR && cbase < ZB_KR + 64) *(f32x4*)(kvraw + grow * 320 + 256 + (c - ZB_KR)) = v;
            s += sum4(v * v); }
        if (ssq != nullptr && cbase < QRANK) { s += __shfl_xor(s, 32); if (hi == 0) ssq[grow * 12 + (cbase >> 5)] = s; }
    }
};
struct EpiGrp { const bf16_t* Z; bf16_t* MX; int cofs;
    __device__ __forceinline__ void operator()(const f32x16& acc, int row, int cbase, int hi) const {
        const size_t grow = (size_t)PM + row;
#pragma unroll
        for (int g = 0; g < 4; ++g) { const int c = cofs + cbase + 8 * g + 4 * hi; const u32x2 gw = *(const u32x2*)(Z + grow * LDZ + ZA_GT + c);
            const float o0 = acc[4 * g] * silu(bf_lo(gw.x)), o1 = acc[4 * g + 1] * silu(bf_hi(gw.x)), o2 = acc[4 * g + 2] * silu(bf_lo(gw.y)), o3 = acc[4 * g + 3] * silu(bf_hi(gw.y));
            u32x2 w; w.x = cvt_pk_bf16(o0, o1); w.y = cvt_pk_bf16(o2, o3); *(u32x2*)(MX + grow * OUTW + c) = w; }
    }
};
struct EpiOut { bf16_t* XB; float* ssps;
    __device__ __forceinline__ void operator()(const f32x16& acc, int row, int cbase, int hi) const {
        const size_t grow = (size_t)PM + row; float s = 0.f;
#pragma unroll
        for (int g = 0; g < 4; ++g) { const int c = cbase + 8 * g + 4 * hi; const u32x2 b = *(const u32x2*)(XB + grow * DM + c);
            const f32x4 v = (f32x4){bf_lo(b.x), bf_hi(b.x), bf_lo(b.y), bf_hi(b.y)} + (f32x4){acc[4 * g], acc[4 * g + 1], acc[4 * g + 2], acc[4 * g + 3]};
            u32x2 w; w.x = cvt_pk_bf16(v[0], v[1]); w.y = cvt_pk_bf16(v[2], v[3]); *(u32x2*)(XB + grow * DM + c) = w; s += sum4(v * v); }
        s += __shfl_xor(s, 32); if (hi == 0) ssps[row * 32 + (cbase >> 5)] = s;
    }
};
struct EpiQ { bf16_t* Q; const float* ssq;
    __device__ __forceinline__ void operator()(const f32x16& acc, int row, int cbase, int hi) const {
        const size_t grow = (size_t)PM + row; const float rs = rsq_from12(ssq + grow * 12);
#pragma unroll
        for (int g = 0; g < 4; ++g) { const int c = cbase + 8 * g + 4 * hi; u32x2 w; w.x = cvt_pk_bf16(acc[4 * g] * rs, acc[4 * g + 1] * rs); w.y = cvt_pk_bf16(acc[4 * g + 2] * rs, acc[4 * g + 3] * rs);
            *(u32x2*)(Q + grow * QW + c) = w; }
    }
};
struct EpiAbsorb { bf16_t* QD; int h;
    __device__ __forceinline__ void operator()(const f32x16& acc, int row, int cbase, int hi) const {
        const int b = row >> 2, t = row & 3; bf16_t* o = QD + ((size_t)b * 32 + t * 8 + h) * 320;
#pragma unroll
        for (int g = 0; g < 4; ++g) { const int c = cbase + 8 * g + 4 * hi; u32x2 w; w.x = cvt_pk_bf16(acc[4 * g], acc[4 * g + 1]); w.y = cvt_pk_bf16(acc[4 * g + 2], acc[4 * g + 3]); *(u32x2*)(o + c) = w; }
    }
};
struct EpiVup { const bf16_t* Z; bf16_t* MX; int h;
    __device__ __forceinline__ void operator()(const f32x16& acc, int row, int cbase, int hi) const {
        const size_t grow = (size_t)PM + row;
#pragma unroll
        for (int g = 0; g < 4; ++g) { const int c = h * 128 + cbase + 8 * g + 4 * hi; const u32x2 gw = *(const u32x2*)(Z + grow * LDZ + ZB_GT + c);
            const float o0 = acc[4 * g] * silu(bf_lo(gw.x)), o1 = acc[4 * g + 1] * silu(bf_hi(gw.x)), o2 = acc[4 * g + 2] * silu(bf_lo(gw.y)), o3 = acc[4 * g + 3] * silu(bf_hi(gw.y));
            u32x2 w; w.x = cvt_pk_bf16(o0, o1); w.y = cvt_pk_bf16(o2, o3); *(u32x2*)(MX + grow * OUTW + c) = w; }
    }
};
}
namespace att {
constexpr int NW = 8, QBLK = 32, KVBLK = 64;
constexpr int SHM_V = KVBLK * 128 * 2, SHM_K = KVBLK * 128 * 2, SHM_KR = KVBLK * 64 * 2;
constexpr int OFF_V = 0, OFF_K = 2 * SHM_V, OFF_KR = OFF_K + 2 * SHM_K, OFF_WS = OFF_KR + 2 * SHM_KR, OFF_QR = OFF_WS + NW * 64 * 4, LDS_BYTES = OFF_QR + NW * 4096;
constexpr float THR = 8.f;
#define KSWZ(row, colB) ((row) * 256 + ((colB) ^ (((row) & 7) << 4)))
#define KRSWZ(row, colB) ((row) * 128 + ((colB) ^ (((row) & 7) << 4)))
#define SBAR() __builtin_amdgcn_sched_barrier(0)
template <int DQK> struct Cst { static constexpr float SCALE = (DQK == 128) ? 0.08838834764831845f : 0.07216878364870322f; };

template <int DQK>
__device__ __forceinline__ void partialSM(f32x16& p0, f32x16& p1, float& m_reg, float& mn, float& alpha) {
    constexpr float SCALE = Cst<DQK>::SCALE, C = SCALE * 1.4426950408889634f;
    float pmax = p0[0];
#pragma unroll
    for (int r = 1; r < 16; ++r) pmax = fmaxf(pmax, p0[r]);
#pragma unroll
    for (int r = 0; r < 16; ++r) pmax = fmaxf(pmax, p1[r]);
    { auto rr = __builtin_amdgcn_permlane32_swap(__float_as_uint(pmax), __float_as_uint(pmax), false, false);
      pmax = fmaxf(__uint_as_float(rr[0]), __uint_as_float(rr[1])); }
    if (__builtin_expect(__all(pmax - m_reg <= THR / SCALE), 1)) { mn = m_reg; alpha = 1.f; }
    else { mn = fmaxf(m_reg, pmax); alpha = __builtin_amdgcn_exp2f((m_reg - mn) * C); m_reg = mn; }
    const float mnC = -mn * C;
#pragma unroll
    for (int r = 0; r < 16; ++r) p0[r] = fmaf(p0[r], C, mnC);
#pragma unroll
    for (int r = 0; r < 16; ++r) p1[r] = fmaf(p1[r], C, mnC);
#pragma unroll
    for (int r = 0; r < 16; ++r) p0[r] = __builtin_amdgcn_exp2f(p0[r]);
}
__device__ __forceinline__ void finishSM(f32x16& p0, f32x16& p1, float alpha, float& l_reg, bf16x8& pa0, bf16x8& pa1, bf16x8& pa2, bf16x8& pa3) {
#pragma unroll
    for (int r = 0; r < 16; ++r) p1[r] = __builtin_amdgcn_exp2f(p1[r]);
    float ps = 0;
#pragma unroll
    for (int r = 0; r < 16; ++r) ps += p0[r];
#pragma unroll
    for (int r = 0; r < 16; ++r) ps += p1[r];
    { auto rr = __builtin_amdgcn_permlane32_swap(__float_as_uint(ps), __float_as_uint(ps), false, false);
      ps = __uint_as_float(rr[0]) + __uint_as_float(rr[1]); }
    l_reg = l_reg * alpha + ps;
#define PK4(P, BASE, OUT) do { unsigned a0 = cvt_pk_bf16(P[BASE + 0], P[BASE + 1]), a1 = cvt_pk_bf16(P[BASE + 2], P[BASE + 3]);   \
    unsigned b0 = cvt_pk_bf16(P[BASE + 4], P[BASE + 5]), b1 = cvt_pk_bf16(P[BASE + 6], P[BASE + 7]);                              \
    auto r0 = __builtin_amdgcn_permlane32_swap(a0, b0, false, false); auto r1 = __builtin_amdgcn_permlane32_swap(a1, b1, false, false); \
    u32x4 w = {r0[0], r1[0], r0[1], r1[1]}; OUT = *reinterpret_cast<bf16x8*>(&w); } while (0)
    PK4(p0, 0, pa0); PK4(p0, 8, pa1); PK4(p1, 0, pa2); PK4(p1, 8, pa3);
#undef PK4
}
template <int DQK>
__device__ __forceinline__ void qkt(f32x16& p0, f32x16& p1, const LAS uchar* Ks, const LAS uchar* Krs, const bf16x8* qr, const LAS uchar* qrl  , int r32, int hi) {
    p0 = f32x16{}; p1 = f32x16{};
#pragma unroll
    for (int d0 = 0; d0 < 8; ++d0) { const int cb = (d0 * 16 + hi * 8) * 2;
        const bf16x8 b0 = *(const LAS bf16x8*)(Ks + KSWZ(r32, cb));
        const bf16x8 b1 = *(const LAS bf16x8*)(Ks + KSWZ(32 + r32, cb));
        p0 = __builtin_amdgcn_mfma_f32_32x32x16_bf16(b0, qr[d0], p0, 0, 0, 0);
        p1 = __builtin_amdgcn_mfma_f32_32x32x16_bf16(b1, qr[d0], p1, 0, 0, 0); }
    if constexpr (DQK == 192) {
#pragma unroll
        for (int d0 = 0; d0 < 4; ++d0) { const int cb = (d0 * 16 + hi * 8) * 2;
            const bf16x8 b0 = *(const LAS bf16x8*)(Krs + KRSWZ(r32, cb));
            const bf16x8 b1 = *(const LAS bf16x8*)(Krs + KRSWZ(32 + r32, cb));
            const bf16x8 qf = *(const LAS bf16x8*)(qrl + d0 * 1024);
            p0 = __builtin_amdgcn_mfma_f32_32x32x16_bf16(b0, qf, p0, 0, 0, 0);
            p1 = __builtin_amdgcn_mfma_f32_32x32x16_bf16(b1, qf, p1, 0, 0, 0); }
    }
}
__device__ __forceinline__ int v_st(int k, int c) { const int kk = (k & ~0xC) | ((k & 4) << 1) | ((k & 8) >> 1); return ((kk >> 3) * 4 + (c >> 5)) * 512 + ((kk & 7) * 32 + (c & 31)) * 2; }
__device__ __forceinline__ int v_rd_base(int lane) { return ((lane & 3) << 3) | (((lane >> 2) & 3) << 6) | (((lane >> 4) & 1) << 5) | (((lane >> 5) & 1) << 8); }
constexpr int v_rd_off(int d0, int ks, int half) { return d0 * 512 + ks * 4096 + half * 2048; }
template <int OFF> __device__ __forceinline__ s16x4 tr_read(int vb) {
    s16x4 r; asm volatile("ds_read_b64_tr_b16 %0, %1 offset:%2" : "=&v"(r) : "v"(vb), "i"(OFF) : "memory"); return r;
}
template <int D0> __device__ __forceinline__ void pv_one(f32x16& od, int vb, bf16x8 pa0, bf16x8 pa1, bf16x8 pa2, bf16x8 pa3) {
    const s16x4 l0 = tr_read<v_rd_off(D0, 0, 0)>(vb), h0 = tr_read<v_rd_off(D0, 0, 1)>(vb), l1 = tr_read<v_rd_off(D0, 1, 0)>(vb), h1 = tr_read<v_rd_off(D0, 1, 1)>(vb);
    const s16x4 l2 = tr_read<v_rd_off(D0, 2, 0)>(vb), h2 = tr_read<v_rd_off(D0, 2, 1)>(vb), l3 = tr_read<v_rd_off(D0, 3, 0)>(vb), h3 = tr_read<v_rd_off(D0, 3, 1)>(vb);
    asm volatile("s_waitcnt lgkmcnt(0)" ::: "memory"); SBAR();
#define PK(L, H) (bf16x8){L[0], L[1], L[2], L[3], H[0], H[1], H[2], H[3]}
    od = __builtin_amdgcn_mfma_f32_32x32x16_bf16(pa0, PK(l0, h0), od, 0, 0, 0);
    od = __builtin_amdgcn_mfma_f32_32x32x16_bf16(pa1, PK(l1, h1), od, 0, 0, 0);
    od = __builtin_amdgcn_mfma_f32_32x32x16_bf16(pa2, PK(l2, h2), od, 0, 0, 0);
    od = __builtin_amdgcn_mfma_f32_32x32x16_bf16(pa3, PK(l3, h3), od, 0, 0, 0);
#undef PK
}
__device__ __forceinline__ void pv_d0(f32x16* o, int vb, bf16x8 pa0, bf16x8 pa1, bf16x8 pa2, bf16x8 pa3) {
    pv_one<0>(o[0], vb, pa0, pa1, pa2, pa3); pv_one<1>(o[1], vb, pa0, pa1, pa2, pa3); pv_one<2>(o[2], vb, pa0, pa1, pa2, pa3); pv_one<3>(o[3], vb, pa0, pa1, pa2, pa3);
}
__device__ __forceinline__ void causal_mask(f32x16& p0, f32x16& p1, int jj, int rowrel, int hi) {
#pragma unroll
    for (int r = 0; r < 16; ++r) { const int k0 = 64 * jj + crow(r, hi); if (k0 > rowrel) p0[r] = -1e30f; if (k0 + 32 > rowrel) p1[r] = -1e30f; }
}

template <int DQK, bool CAUSAL, int SD, int LDQ, int LDK>
__device__ __forceinline__ void attn_body(const bf16_t* __restrict__ Qb, const bf16_t* __restrict__ Kh, const bf16_t* __restrict__ Vh, const bf16_t* __restrict__ Krp,
                                          const f32x2* __restrict__ ropeq, const bf16_t* __restrict__ gate, bf16_t* __restrict__ outp, int NT, int diag0, LAS uchar* lds) {
    constexpr int NQ = 8;
    int tid_ = threadIdx.x; asm volatile("" : "+v"(tid_));
    const int tid = tid_, wid = tid >> 6, lane = tid & 63, r32 = lane & 31, hi = lane >> 5;
    LAS uchar* V_lds = lds + OFF_V; LAS uchar* K_lds = lds + OFF_K; LAS uchar* Kr_lds = lds + OFF_KR;
    LAS float* ws = (LAS float*)(lds + OFF_WS) + wid * 64; LAS float* li_l = ws; LAS float* al_l = ws + 32; LAS uchar* qrl = lds + OFF_QR + wid * 4096 + lane * 16;
    float m_reg = -1e30f, l_reg = 0; f32x16 o[4] = {}; bf16x8 qr[NQ];
    const bf16_t* Qw = Qb + (size_t)(wid * QBLK + r32) * LDQ + hi * 8;
#pragma unroll
    for (int d0 = 0; d0 < 8; ++d0) qr[d0] = *(const bf16x8*)(Qw + d0 * 16);
    if constexpr (DQK == 192) {
#pragma unroll
        for (int a = 0; a < 2; ++a) {
            const u32x4 w1 = *(const u32x4*)(Qw + 128 + 16 * a), w2 = *(const u32x4*)(Qw + 160 + 16 * a); float x1[8], x2[8], o1[8], o2[8]; unpack8(w1, x1); unpack8(w2, x2);
            const f32x2* tb = ropeq + (size_t)(wid * QBLK + r32) * 32 + 16 * a + 8 * hi;
#pragma unroll
            for (int j = 0; j < 8; ++j) { const f32x2 cs = tb[j]; o1[j] = x1[j] * cs.x - x2[j] * cs.y; o2[j] = x1[j] * cs.y + x2[j] * cs.x; }
            *(LAS u32x4*)(qrl + a * 1024) = pack8(o1); *(LAS u32x4*)(qrl + (2 + a) * 1024) = pack8(o2);
        }
    }
    const int sr = tid >> 4, sc = (tid & 15) * 8, vst0 = v_st(sr, sc), vst1 = v_st(32 + sr, sc);
    const int krow = tid >> 3, kcc = (tid & 7) * 8;
    const int vb0 = (int)(unsigned)(uintptr_t)V_lds + v_rd_base(lane);
    struct { bf16x8 vs0, vs1, ks0, ks1, kr; } sr_[SD];
#define SLOAD(i, k0) do { sr_[i].vs0 = *(const bf16x8*)(Vh + (size_t)((k0) + sr) * LDK + sc); sr_[i].vs1 = *(const bf16x8*)(Vh + (size_t)((k0) + 32 + sr) * LDK + sc); \
    sr_[i].ks0 = *(const bf16x8*)(Kh + (size_t)((k0) + sr) * LDK + sc); sr_[i].ks1 = *(const bf16x8*)(Kh + (size_t)((k0) + 32 + sr) * LDK + sc); \
    if constexpr (DQK == 192) sr_[i].kr = *(const bf16x8*)(Krp + (size_t)((k0) + krow) * 64 + kcc); } while (0)
#define SWRITE(b, i) do { *(LAS bf16x8*)(V_lds + (b) * SHM_V + vst0) = sr_[i].vs0; *(LAS bf16x8*)(V_lds + (b) * SHM_V + vst1) = sr_[i].vs1; const int kc = sc * 2; \
    *(LAS bf16x8*)(K_lds + (b) * SHM_K + KSWZ(sr, kc)) = sr_[i].ks0; *(LAS bf16x8*)(K_lds + (b) * SHM_K + KSWZ(32 + sr, kc)) = sr_[i].ks1; \
    if constexpr (DQK == 192) *(LAS bf16x8*)(Kr_lds + (b) * SHM_KR + KRSWZ(krow, kcc * 2)) = sr_[i].kr; } while (0)
#define SWAIT() do { if constexpr (SD == 2) { if constexpr (DQK == 192) asm volatile("s_waitcnt vmcnt(5)" ::: "memory"); else asm volatile("s_waitcnt vmcnt(4)" ::: "memory"); } \
    else asm volatile("s_waitcnt vmcnt(0)" ::: "memory"); } while (0)
#define RESC(a) do { if (__any((a) < 1.f)) { if (hi == 0) al_l[r32] = (a); asm volatile("s_waitcnt lgkmcnt(0)" ::: "memory"); \
    _Pragma("unroll") for (int d = 0; d < 4; ++d) _Pragma("unroll") for (int r = 0; r < 16; ++r) o[d][r] *= al_l[crow(r, hi)]; } } while (0)
#define MASK(P0, P1, tile) do { if constexpr (CAUSAL) { if ((tile) >= diag0) causal_mask(P0, P1, (tile) - diag0, wid * QBLK + r32, hi); } } while (0)
    f32x16 pA0, pA1, pB0, pB1; float mnA, mnB, alA, alB; bf16x8 pa0, pa1, pa2, pa3;
    constexpr int SE = 0, SO = SD - 1;
    SLOAD(SE, 0); asm volatile("s_waitcnt vmcnt(0)" ::: "memory"); SWRITE(0, SE); __syncthreads();
    qkt<DQK>(pA0, pA1, K_lds, Kr_lds, qr, qrl, r32, hi); MASK(pA0, pA1, 0); partialSM<DQK>(pA0, pA1, m_reg, mnA, alA);
    SLOAD(SO, KVBLK); if constexpr (SD == 2) { if (2 < NT) SLOAD(SE, 2 * KVBLK); }
    SWAIT(); SWRITE(1, SO); __syncthreads();
    for (int j = 1; j + 1 < NT; j += 2) {
        SBAR(); qkt<DQK>(pB0, pB1, K_lds + SHM_K, Kr_lds + SHM_KR, qr, qrl, r32, hi); MASK(pB0, pB1, j);
        finishSM(pA0, pA1, alA, l_reg, pa0, pa1, pa2, pa3); SBAR();
        SLOAD(SO, (j + SD) * KVBLK); SBAR();
        pv_d0(o, vb0, pa0, pa1, pa2, pa3); partialSM<DQK>(pB0, pB1, m_reg, mnB, alB);
        __syncthreads(); SWAIT(); SWRITE(0, SE);
        RESC(alB); __syncthreads();
        SBAR(); qkt<DQK>(pA0, pA1, K_lds, Kr_lds, qr, qrl, r32, hi); MASK(pA0, pA1, j + 1);
        finishSM(pB0, pB1, alB, l_reg, pa0, pa1, pa2, pa3); SBAR();
        if (SD == 1 || j + 3 < NT) SLOAD(SE, (j + 1 + SD) * KVBLK); SBAR();
        pv_d0(o, vb0 + SHM_V, pa0, pa1, pa2, pa3); partialSM<DQK>(pA0, pA1, m_reg, mnA, alA);
        __syncthreads(); SWAIT(); SWRITE(1, SO);
        RESC(alA); __syncthreads();
    }
    SBAR(); qkt<DQK>(pB0, pB1, K_lds + SHM_K, Kr_lds + SHM_KR, qr, qrl, r32, hi); MASK(pB0, pB1, NT - 1);
    finishSM(pA0, pA1, alA, l_reg, pa0, pa1, pa2, pa3); SBAR();
    pv_d0(o, vb0, pa0, pa1, pa2, pa3); partialSM<DQK>(pB0, pB1, m_reg, mnB, alB);
    __syncthreads(); RESC(alB);
    finishSM(pB0, pB1, alB, l_reg, pa0, pa1, pa2, pa3); SBAR();
    pv_d0(o, vb0 + SHM_V, pa0, pa1, pa2, pa3);
    if (hi == 0) li_l[r32] = l_reg; asm volatile("s_waitcnt lgkmcnt(0)" ::: "memory");
    float rli[16];
#pragma unroll
    for (int r = 0; r < 16; ++r) rli[r] = __builtin_amdgcn_rcpf(li_l[crow(r, hi)]);
    { LAS uchar* ot = lds + OFF_QR + wid * 4096; const int orow = lane >> 1, ocb = (lane & 1) * 32; const size_t grow = (size_t)(wid * QBLK + orow);
#pragma unroll
      for (int hf = 0; hf < 2; ++hf) {
#pragma unroll
          for (int r = 0; r < 16; ++r)
#pragma unroll
              for (int dd = 0; dd < 2; ++dd) *(LAS bf16_t*)(ot + crow(r, hi) * 128 + (dd * 32 + r32) * 2) = (bf16_t)(cvt_pk_bf16(o[2 * hf + dd][r] * rli[r], 0.f) & 0xffffu);
          asm volatile("s_waitcnt lgkmcnt(0)" ::: "memory");
#pragma unroll
          for (int c = 0; c < 4; ++c) { const u32x4 ov = *(const LAS u32x4*)(ot + orow * 128 + ocb * 2 + c * 16); const u32x4 gv = *(const u32x4*)(gate + grow * LDZ + hf * 64 + ocb + c * 8);
              float of[8], gf[8]; unpack8(ov, of); unpack8(gv, gf);
#pragma unroll
              for (int q = 0; q < 8; ++q) of[q] *= silu(gf[q]);
              *(u32x4*)(outp + grow * OUTW + hf * 64 + ocb + c * 8) = pack8(of); }
          asm volatile("s_waitcnt lgkmcnt(0)" ::: "memory"); } }
#undef SLOAD
#undef SWRITE
#undef SWAIT
#undef RESC
#undef MASK
}
}
namespace dec {
constexpr int BUFB = 40960, OFF_KR = 32768, OFF_WS = 2 * BUFB, LDS_BYTES = OFF_WS + 8 * 64 * 4 + 32 * 640 + 64;
__device__ __forceinline__ unsigned off_b(unsigned row, unsigned ch) { return 256u * row + 16u * (ch ^ (((row & 3) << 2) | ((row >> 2) & 3))); }
__device__ __forceinline__ unsigned row_read_addr(unsigned lane, unsigned s) { return off_b(lane & 31, 2 * s + (lane >> 5)); }
__device__ __forceinline__ unsigned tr_read_addr(unsigned lane, unsigned c, unsigned ks, unsigned t) {
    const unsigned h = lane >> 5, blk = (lane >> 4) & 1, q = (lane & 15) >> 2, p = lane & 3;
    return off_b(16 * ks + 8 * h + 4 * t + q, 4 * c + 2 * blk + (p >> 1)) + 8 * (p & 1);
}
__device__ __forceinline__ s16x4 tr_rd(unsigned addr) { s16x4 r; asm volatile("ds_read_b64_tr_b16 %0, %1" : "=&v"(r) : "v"(addr) : "memory"); return r; }

__device__ __forceinline__ void partialSM1(f32x16& p0, float& m_reg, float& alpha) {
    constexpr float SCALE = att::Cst<192>::SCALE, C = SCALE * 1.4426950408889634f;
    float pmax = p0[0];
#pragma unroll
    for (int r = 1; r < 16; ++r) pmax = fmaxf(pmax, p0[r]);
    { auto rr = __builtin_amdgcn_permlane32_swap(__float_as_uint(pmax), __float_as_uint(pmax), false, false);
      pmax = fmaxf(__uint_as_float(rr[0]), __uint_as_float(rr[1])); }
    float mn;
    if (__builtin_expect(__all(pmax - m_reg <= att::THR / SCALE), 1)) { mn = m_reg; alpha = 1.f; }
    else { mn = fmaxf(m_reg, pmax); alpha = __builtin_amdgcn_exp2f((m_reg - mn) * C); m_reg = mn; }
    const float mnC = -mn * C;
#pragma unroll
    for (int r = 0; r < 16; ++r) p0[r] = __builtin_amdgcn_exp2f(fmaf(p0[r], C, mnC));
}
__device__ __forceinline__ void finishSM1(const f32x16& p0, float alpha, float& l_reg, bf16x8& pa0, bf16x8& pa1) {
    float ps = 0;
#pragma unroll
    for (int r = 0; r < 16; ++r) ps += p0[r];
    { auto rr = __builtin_amdgcn_permlane32_swap(__float_as_uint(ps), __float_as_uint(ps), false, false);
      ps = __uint_as_float(rr[0]) + __uint_as_float(rr[1]); }
    l_reg = l_reg * alpha + ps;
#define PK4(P, BASE, OUT) do { unsigned a0 = cvt_pk_bf16(P[BASE + 0], P[BASE + 1]), a1 = cvt_pk_bf16(P[BASE + 2], P[BASE + 3]);   \
    unsigned b0 = cvt_pk_bf16(P[BASE + 4], P[BASE + 5]), b1 = cvt_pk_bf16(P[BASE + 6], P[BASE + 7]);                              \
    auto r0 = __builtin_amdgcn_permlane32_swap(a0, b0, false, false); auto r1 = __builtin_amdgcn_permlane32_swap(a1, b1, false, false); \
    u32x4 w = {r0[0], r1[0], r0[1], r1[1]}; OUT = *reinterpret_cast<bf16x8*>(&w); } while (0)
    PK4(p0, 0, pa0); PK4(p0, 8, pa1);
#undef PK4
}

constexpr int OFF_Q = OFF_WS + 8 * 64 * 4;
__device__ __forceinline__ void decode_unit(const bf16_t* __restrict__ Qd, const float* __restrict__ cckv, const float* __restrict__ ckr, const int* __restrict__ pt,
                                            float* __restrict__ Opart, float* __restrict__ ML, LAS uchar* lds) {
    int tid_ = threadIdx.x; asm volatile("" : "+v"(tid_));
    const int tid = tid_, wid = tid >> 6, lane = tid & 63, r32 = lane & 31, hi = lane >> 5, kb = wid & 1, dq = wid >> 1;
    LAS float* al_l = (LAS float*)(lds + OFF_WS) + wid * 64;
    for (int c = tid; c < 32 * 40; c += 512) { const int r = c / 40, ch = c - r * 40; *(LAS u32x4*)(lds + OFF_Q + r * 640 + ((ch ^ (r & 7)) << 4)) = *(const u32x4*)(Qd + (size_t)r * 320 + ch * 8); }
    LAS int* pgs = (LAS int*)(lds + OFF_Q + 32 * 640);
    if (tid < 16) pgs[tid] = pt[tid];
    __syncthreads();
    const LAS uchar* qb = lds + OFF_Q + r32 * 640; const int qsw = r32 & 7;
    float m_reg = -1e30f, l_reg = 0.f; f32x16 o0 = {}, o1 = {};
    f32x4 svA[10], svB[10];
    const int kc = lane & 15, kq = lane >> 4;
    const unsigned wck = (unsigned)((lane >> 5) * 2 * 8192) + ((lane & 1) << 3);
    const unsigned ldsb = (unsigned)(uintptr_t)lds;
    const int pw = dq >> 1, cw0 = (dq & 1) * 2;
    const unsigned tra[2][2][2] = {{{tr_read_addr(lane, cw0, 0, 0), tr_read_addr(lane, cw0, 0, 1)}, {tr_read_addr(lane, cw0, 1, 0), tr_read_addr(lane, cw0, 1, 1)}},
                                   {{tr_read_addr(lane, cw0 + 1, 0, 0), tr_read_addr(lane, cw0 + 1, 0, 1)}, {tr_read_addr(lane, cw0 + 1, 1, 0), tr_read_addr(lane, cw0 + 1, 1, 1)}}};
#define DLOAD(sv, j) do { const int page = pgs[(j) >> 1]; const size_t krow = (size_t)page * 128 + ((j) & 1) * 64 + wid * 8; \
    const float* s0 = cckv + krow * 256 + 4 * lane; const float* s1 = ckr + (krow + kq) * 64 + 4 * kc; \
    _Pragma("unroll") for (int i = 0; i < 8; ++i) sv[i] = __builtin_nontemporal_load((const f32x4*)(s0 + i * 256)); \
    sv[8] = __builtin_nontemporal_load((const f32x4*)s1); sv[9] = __builtin_nontemporal_load((const f32x4*)(s1 + 4 * 64)); } while (0)
#define DWRITE(sv, b) do { _Pragma("unroll") for (int i = 0; i < 8; ++i) { const int key = wid * 8 + i; u32x2 w; w.x = cvt_pk_bf16(sv[i][0], sv[i][1]); w.y = cvt_pk_bf16(sv[i][2], sv[i][3]); \
        *(LAS u32x2*)(lds + (b) * BUFB + wck + (key >> 5) * 8192 + off_b(key & 31, (lane & 31) >> 1)) = w; } \
    _Pragma("unroll") for (int i = 0; i < 2; ++i) { const int key = wid * 8 + kq + 4 * i; u32x2 w; w.x = cvt_pk_bf16(sv[8 + i][0], sv[8 + i][1]); w.y = cvt_pk_bf16(sv[8 + i][2], sv[8 + i][3]); \
        *(LAS u32x2*)(lds + (b) * BUFB + OFF_KR + key * 128 + (((kc >> 1) ^ (key & 7)) << 4) + ((kc & 1) << 3)) = w; } } while (0)
#define DCOMPUTE(b) do { const LAS uchar* B = lds + (b) * BUFB; f32x16 p0 = {}; \
      \
    _Pragma("unroll") for (int s0 = 0; s0 < 16; s0 += 4) { bf16x8 kf[4], qf[4]; \
        _Pragma("unroll") for (int i = 0; i < 4; ++i) { const int s = s0 + i; qf[i] = *(const LAS bf16x8*)(qb + (((2 * s + hi) ^ qsw) << 4)); \
            kf[i] = *(const LAS bf16x8*)(B + ((s >> 3) * 2 + kb) * 8192 + row_read_addr(lane, s & 7)); } \
        asm volatile("" ::: "memory"); \
        _Pragma("unroll") for (int i = 0; i < 4; ++i) p0 = __builtin_amdgcn_mfma_f32_32x32x16_bf16(kf[i], qf[i], p0, 0, 0, 0); \
        asm volatile("" ::: "memory"); } \
    { bf16x8 kf[4], qf[4]; \
        _Pragma("unroll") for (int s = 0; s < 4; ++s) { const int chk = 2 * s + hi; qf[s] = *(const LAS bf16x8*)(qb + (((32 + 2 * s + hi) ^ qsw) << 4)); \
            kf[s] = *(const LAS bf16x8*)(B + OFF_KR + (kb * 32 + r32) * 128 + ((chk ^ (r32 & 7)) << 4)); } \
        asm volatile("" ::: "memory"); \
        _Pragma("unroll") for (int s = 0; s < 4; ++s) p0 = __builtin_amdgcn_mfma_f32_32x32x16_bf16(kf[s], qf[s], p0, 0, 0, 0); } \
    float alpha; partialSM1(p0, m_reg, alpha); \
    if (__any(alpha < 1.f)) { if (hi == 0) al_l[r32] = alpha; asm volatile("s_waitcnt lgkmcnt(0)" ::: "memory"); \
        _Pragma("unroll") for (int r = 0; r < 16; ++r) { const float a = al_l[crow(r, hi)]; o0[r] *= a; o1[r] *= a; } } \
    bf16x8 pa[2]; finishSM1(p0, alpha, l_reg, pa[0], pa[1]); \
    const unsigned vb = ldsb + (b) * BUFB + (pw * 2 + kb) * 8192; s16x4 vl[2][2], vh[2][2]; \
    _Pragma("unroll") for (int dd = 0; dd < 2; ++dd) _Pragma("unroll") for (int ks = 0; ks < 2; ++ks) { vl[dd][ks] = tr_rd(vb + tra[dd][ks][0]); vh[dd][ks] = tr_rd(vb + tra[dd][ks][1]); } \
    asm volatile("s_waitcnt lgkmcnt(0)" ::: "memory"); __builtin_amdgcn_sched_barrier(0); \
    _Pragma("unroll") for (int ks = 0; ks < 2; ++ks) { \
        o0 = __builtin_amdgcn_mfma_f32_32x32x16_bf16(pa[ks], ((bf16x8){vl[0][ks][0], vl[0][ks][1], vl[0][ks][2], vl[0][ks][3], vh[0][ks][0], vh[0][ks][1], vh[0][ks][2], vh[0][ks][3]}), o0, 0, 0, 0); \
        o1 = __builtin_amdgcn_mfma_f32_32x32x16_bf16(pa[ks], ((bf16x8){vl[1][ks][0], vl[1][ks][1], vl[1][ks][2], vl[1][ks][3], vh[1][ks][0], vh[1][ks][1], vh[1][ks][2], vh[1][ks][3]}), o1, 0, 0, 0); } } while (0)
    constexpr int NT = 32;
    DLOAD(svA, 0); DLOAD(svB, 1); DWRITE(svA, 0); DLOAD(svA, 2); __syncthreads();
    for (int j = 0; j < NT; j += 2) {
        DCOMPUTE(0);
        DWRITE(svB, 1);
        { const int jn = (j + 3 < NT) ? j + 3 : NT - 1; DLOAD(svB, jn); }
        __syncthreads();
        DCOMPUTE(1);
        DWRITE(svA, 0);
        { const int jn = (j + 4 < NT) ? j + 4 : NT - 1; DLOAD(svA, jn); }
        __syncthreads();
    }
#undef DLOAD
#undef DWRITE
#undef DCOMPUTE
    LAS float* mlx = (LAS float*)lds + dq * 64;
    LAS float* ox = (LAS float*)(lds + 4096) + dq * 2048;
    if (kb == 1) { if (hi == 0) { mlx[r32 * 2] = m_reg; mlx[r32 * 2 + 1] = l_reg; }
#pragma unroll
        for (int r = 0; r < 16; ++r) { ox[crow(r, hi) * 32 + r32] = o0[r]; ox[1024 + crow(r, hi) * 32 + r32] = o1[r]; } }
    __syncthreads();
    if (kb == 0) { constexpr float C = att::Cst<192>::SCALE * 1.4426950408889634f;
        const float m1 = mlx[r32 * 2], l1 = mlx[r32 * 2 + 1], M = fmaxf(m_reg, m1), w0 = __builtin_amdgcn_exp2f((m_reg - M) * C), w1 = __builtin_amdgcn_exp2f((m1 - M) * C), L = l_reg * w0 + l1 * w1;
        if (hi == 0) { al_l[r32] = w0; al_l[32 + r32] = w1; } asm volatile("s_waitcnt lgkmcnt(0)" ::: "memory");
        if (dq == 0 && hi == 0) { ML[r32 * 2] = M; ML[r32 * 2 + 1] = L; }
#pragma unroll
        for (int r = 0; r < 16; ++r) { const int row = crow(r, hi); const float a0 = al_l[row], a1 = al_l[32 + row];
            Opart[(size_t)row * 256 + dq * 64 + r32] = o0[r] * a0 + ox[row * 32 + r32] * a1; Opart[(size_t)row * 256 + dq * 64 + 32 + r32] = o1[r] * a0 + ox[1024 + row * 32 + r32] * a1; } }
}

__device__ __forceinline__ void combine_row(int b, int row32, int lane, const bf16_t* __restrict__ Qdec, const float* __restrict__ Opart, const float* __restrict__ ML,
                                            const float* __restrict__ ckvn, const float* __restrict__ krn, bf16_t* __restrict__ olat) {
    constexpr float C = 0.07216878364870322f * 1.4426950408889634f;
    const int t = row32 >> 3, h = row32 & 7;
    const bf16_t* q = Qdec + ((size_t)b * 32 + row32) * 320;
    const u32x2 qw = *(const u32x2*)(q + 4 * lane); const float q0 = bf_lo(qw.x), q1 = bf_hi(qw.x), q2 = bf_lo(qw.y), q3 = bf_hi(qw.y); const float qrp = bf2f(q[256 + lane]);
    float sj[4]; f32x4 cn[4];
#pragma unroll
    for (int j = 0; j < 4; ++j) { cn[j] = *(const f32x4*)(ckvn + ((size_t)b * 4 + j) * 256 + 4 * lane); float s = q0 * cn[j][0] + q1 * cn[j][1] + q2 * cn[j][2] + q3 * cn[j][3] + qrp * krn[((size_t)b * 4 + j) * 64 + lane];
#pragma unroll
        for (int o = 32; o >= 1; o >>= 1) s += __shfl_xor(s, o);
        sj[j] = (j <= t) ? s : -1e30f; }
    float mc[8], lc[8], M = fmaxf(fmaxf(sj[0], sj[1]), fmaxf(sj[2], sj[3]));
#pragma unroll
    for (int c = 0; c < 8; ++c) { const f32x2 ml = *(const f32x2*)(ML + (((size_t)b * 8 + c) * 32 + row32) * 2); mc[c] = ml.x; lc[c] = ml.y; M = fmaxf(M, mc[c]); }
    float L = 0.f; f32x4 acc = {0.f, 0.f, 0.f, 0.f};
#pragma unroll
    for (int c = 0; c < 8; ++c) { const float w = __builtin_amdgcn_exp2f((mc[c] - M) * C); L += lc[c] * w; acc += *(const f32x4*)(Opart + (((size_t)b * 8 + c) * 32 + row32) * 256 + 4 * lane) * w; }
#pragma unroll
    for (int j = 0; j < 4; ++j) { const float e = (j <= t) ? __builtin_amdgcn_exp2f((sj[j] - M) * C) : 0.f; L += e; acc += cn[j] * e; }
    const float rl = 1.0f / L; u32x2 w; w.x = cvt_pk_bf16(acc[0] * rl, acc[1] * rl); w.y = cvt_pk_bf16(acc[2] * rl, acc[3] * rl);
    *(u32x2*)(olat + ((size_t)b * 4 + t) * 2048 + h * 256 + 4 * lane) = w;
}

constexpr int SMEM_LDS = 4096 + 32768;
__device__ __forceinline__ void smem_unit(const bf16_t* __restrict__ Zq  , const bf16_t* __restrict__ Zg  , const float* __restrict__ Kc, const float* __restrict__ Vc  ,
                                          bf16_t* __restrict__ outp  , LAS uchar* lds) {
    int tid_ = threadIdx.x; asm volatile("" : "+v"(tid_));
    const int tid = tid_, wid = tid >> 6, lane = tid & 63, l32 = lane & 31, hi = lane >> 5;
    LAS float* sc = (LAS float*)lds; LAS float* red = (LAS float*)(lds + 4096);
    float qv[4][4];
#pragma unroll
    for (int t = 0; t < 4; ++t) { const u32x2 w = *(const u32x2*)(Zq + (size_t)t * LDZ + 4 * l32); qv[t][0] = bf_lo(w.x); qv[t][1] = bf_hi(w.x); qv[t][2] = bf_lo(w.y); qv[t][3] = bf_hi(w.y); }
    f32x4 kreg[16], vreg[16]; const int d4 = (tid & 31) * 4, mg = tid >> 5;
#pragma unroll
    for (int i = 0; i < 16; ++i) kreg[i] = *(const f32x4*)(Kc + (size_t)(wid * 32 + 2 * i + hi) * 512 + 4 * l32);
#pragma unroll
    for (int mm = 0; mm < 16; ++mm) vreg[mm] = *(const f32x4*)(Vc + (size_t)(mg * 16 + mm) * 512 + d4);
#pragma unroll
    for (int i = 0; i < 16; ++i) { const int m = wid * 32 + 2 * i + hi; const f32x4 kv = kreg[i]; float p[4];
#pragma unroll
        for (int t = 0; t < 4; ++t) { p[t] = kv[0] * qv[t][0] + kv[1] * qv[t][1] + kv[2] * qv[t][2] + kv[3] * qv[t][3];
#pragma unroll
            for (int o = 16; o >= 1; o >>= 1) p[t] += __shfl_xor(p[t], o); }
        if (l32 == 0) {
#pragma unroll
            for (int t = 0; t < 4; ++t) sc[t * 256 + m] = p[t] * 0.08838834764831845f; } }
    __syncthreads();
    if (wid < 4) { float v[4], mx = -1e30f;
#pragma unroll
        for (int i = 0; i < 4; ++i) { v[i] = sc[wid * 256 + lane + 64 * i]; mx = fmaxf(mx, v[i]); }
#pragma unroll
        for (int o = 32; o >= 1; o >>= 1) mx = fmaxf(mx, __shfl_xor(mx, o));
        float s = 0.f;
#pragma unroll
        for (int i = 0; i < 4; ++i) { v[i] = __expf(v[i] - mx); s += v[i]; }
#pragma unroll
        for (int o = 32; o >= 1; o >>= 1) s += __shfl_xor(s, o);
        const float rs = 1.0f / s;
#pragma unroll
        for (int i = 0; i < 4; ++i) sc[wid * 256 + lane + 64 * i] = v[i] * rs; }
    __syncthreads();
    { f32x4 a[4] = {};
#pragma unroll
      for (int mm = 0; mm < 16; ++mm) { const int m = mg * 16 + mm; const f32x4 vv = vreg[mm];
#pragma unroll
          for (int t = 0; t < 4; ++t) a[t] += vv * sc[t * 256 + m]; }
#pragma unroll
      for (int t = 0; t < 4; ++t) *(LAS f32x4*)(red + (mg * 4 + t) * 128 + d4) = a[t]; }
    __syncthreads();
    { const int t = tid >> 7, d = tid & 127; float s = 0.f;
#pragma unroll
      for (int mg = 0; mg < 16; ++mg) s += red[(mg * 4 + t) * 128 + d];
      const float g = bf2f(Zg[(size_t)t * LDZ + d]);
      outp[(size_t)t * OUTW + d] = (bf16_t)(cvt_pk_bf16(s * silu(g), 0.f) & 0xffffu); }
    __syncthreads();
}
}
namespace ew {
__device__ __forceinline__ int otid() { int t = threadIdx.x; asm volatile("" : "+v"(t)); return t; }
struct TJ { const float* src; int sld, K, ncols; const float* gain; const float* cscale; bf16_t* dst; int dld; };
constexpr int NTJ = 32;
__device__ __forceinline__ TJ get_tj(int j, const float* const* in, uchar* ws) {
    TJ t; t.gain = nullptr; t.cscale = nullptr;
    bf16_t* WINA = (bf16_t*)(ws + WS_WINA); bf16_t* WGRP = (bf16_t*)(ws + WS_WGRP); bf16_t* WINB = (bf16_t*)(ws + WS_WINB); bf16_t* WQUP = (bf16_t*)(ws + WS_WQUP);
    bf16_t* WKV = (bf16_t*)(ws + WS_WKV); bf16_t* WMEM = (bf16_t*)(ws + WS_WMEM); bf16_t* WOUT = (bf16_t*)(ws + WS_WOUT);
    if (j < 2) { t.src = in[10] + (size_t)j * DM * INA; t.sld = INA; t.K = DM; t.ncols = INA; t.gain = in[9] + j * DM; t.dst = WINA + (size_t)j * INA * DM; t.dld = DM; }
    else if (j < 10) { const int i = j - 2; t.src = in[11] + (size_t)i * 65536; t.sld = 256; t.K = 256; t.ncols = 256; t.cscale = in[12] + i * 256; t.dst = WGRP + (size_t)i * 65536; t.dld = 256; }
    else if (j < 12) { const int i = j - 10; t.src = in[13] + (size_t)i * DM * INB; t.sld = INB; t.K = DM; t.ncols = QRANK; t.gain = in[9] + (2 + i) * DM; t.dst = WINB + (size_t)i * NB2 * DM; t.dld = DM; }
    else if (j < 14) { const int i = j - 12; t.src = in[13] + (size_t)i * DM * INB + QRANK; t.sld = INB; t.K = DM; t.ncols = INB - QRANK; t.gain = in[9] + (2 + i) * DM; t.dst = WINB + ((size_t)i * NB2 + ZB_GT) * DM; t.dld = DM; }
    else if (j == 14) { t.src = in[17] + KVR; t.sld = 320; t.K = DM; t.ncols = ROPE; t.gain = in[16]; t.dst = WINB + (size_t)ZB_KR * DM; t.dld = DM; }
    else if (j == 15) { t.src = in[17]; t.sld = 320; t.K = DM; t.ncols = KVR; t.gain = in[16]; t.dst = WINB + (size_t)ZB_KV * DM; t.dld = DM; }
    else if (j < 18) { const int i = j - 16; t.src = in[15] + (size_t)i * QRANK * QW; t.sld = QW; t.K = QRANK; t.ncols = QW; t.gain = in[14] + i * QRANK; t.dst = WQUP + (size_t)i * QW * QRANK; t.dld = QRANK; }
    else if (j == 18) { t.src = in[19]; t.sld = 1024; t.K = 256; t.ncols = 1024; t.dst = WKV; t.dld = 256; }
    else if (j == 19) { t.src = in[20]; t.sld = 1024; t.K = 256; t.ncols = 1024; t.dst = WKV + (size_t)1024 * 256; t.dld = 256; }
    else if (j < 28) { const int i = j - 20, l = i >> 1, kv = i & 1; t.src = (kv ? in[23] : in[22]) + (size_t)l * DM * MEMW; t.sld = MEMW; t.K = DM; t.ncols = MEMW; t.gain = in[21] + l * DM; t.dst = WMEM + (size_t)(l * 2 + kv) * MEMW * DM; t.dld = DM; }
    else { const int l = j - 28; t.src = in[24] + (size_t)l * OUTW * DM; t.sld = DM; t.K = OUTW; t.ncols = DM; t.dst = WOUT + (size_t)l * DM * OUTW; t.dld = OUTW; }
    return t;
}
__device__ __forceinline__ int tj_tiles(int j) {
    if (j < 2) return 16 * 48; if (j < 10) return 16; if (j < 12) return 16 * 6; if (j < 14) return 16 * 32; if (j == 14) return 16; if (j == 15) return 64;
    if (j < 18) return 6 * 24; if (j < 20) return 4 * 16; if (j < 28) return 16 * 8; return 24 * 16;
}
constexpr int TJ_TOTAL = 2 * 768 + 8 * 16 + 2 * 96 + 2 * 512 + 16 + 64 + 2 * 144 + 2 * 64 + 8 * 128 + 4 * 384;
__device__ __forceinline__ void tt_load(const TJ& t, int tile, int tid, f32x4& a, f32x4& b) {
    const int nkt = t.K / 64, kt = tile % nkt, nt = tile / nkt, k0 = kt * 64, n0 = nt * 64;
    const int k = tid >> 3, n8 = (tid & 7) * 8; const float* s = t.src + (size_t)(k0 + k) * t.sld + n0 + n8; const float g = t.gain ? t.gain[k0 + k] : 1.0f;
    a = *(const f32x4*)s * g; b = *(const f32x4*)(s + 4) * g;
}
__device__ __forceinline__ void tt_store(const TJ& t, int tile, LAS float* tl, int tid, const f32x4 a, const f32x4 b) {
    const int nkt = t.K / 64, kt = tile % nkt, nt = tile / nkt, k0 = kt * 64, n0 = nt * 64;
    { const int k = tid >> 3, n8 = (tid & 7) * 8;
#pragma unroll
      for (int j = 0; j < 4; ++j) { tl[k * 65 + n8 + j] = a[j]; tl[k * 65 + n8 + 4 + j] = b[j]; } }
    __syncthreads();
    { const int n = tid >> 3, k8 = (tid & 7) * 8; const float cs = t.cscale ? t.cscale[n0 + n] : 1.0f; float v[8];
#pragma unroll
      for (int j = 0; j < 8; ++j) v[j] = tl[(k8 + j) * 65 + n] * cs;
      *(u32x4*)(t.dst + (size_t)(n0 + n) * t.dld + k0 + k8) = pack8(v); }
    __syncthreads();
}
__device__ __forceinline__ void tj_of(int gt, int& j, int& r) { j = 0; r = gt; for (; j < NTJ; ++j) { const int n = tj_tiles(j); if (r < n) break; r -= n; } }
__device__ __forceinline__ void sincos_d(float angf, float& c, float& s) {
    const double x = (double)angf; const double kd = rint(x * 0.63661977236758134308); const int q = (int)((long long)kd & 3);
    double r = fma(-kd, 1.57079632679489655800e+00, x); r = fma(-kd, 6.12323399573676603587e-17, r);
    const double r2 = r * r;
    double sp = -7.6471637318198164759e-13; sp = fma(sp, r2, 1.6059043836821614599e-10); sp = fma(sp, r2, -2.5052108385441718775e-08); sp = fma(sp, r2, 2.7557319223985890653e-06);
    sp = fma(sp, r2, -1.9841269841269841270e-04); sp = fma(sp, r2, 8.3333333333333333333e-03); sp = fma(sp, r2, -1.6666666666666666667e-01); const double sn = fma(sp * r2, r, r);
    double cp = 4.7794773323873852974e-14; cp = fma(cp, r2, -1.1470745597729724714e-11); cp = fma(cp, r2, 2.0876756987868098979e-09); cp = fma(cp, r2, -2.7557319223985890653e-07);
    cp = fma(cp, r2, 2.4801587301587301587e-05); cp = fma(cp, r2, -1.3888888888888888889e-03); cp = fma(cp, r2, 4.1666666666666666667e-02); cp = fma(cp, r2, -0.5); const double cn = fma(cp, r2, 1.0);
    const double ss = (q == 0) ? sn : (q == 1) ? cn : (q == 2) ? -sn : -cn, cc = (q == 0) ? cn : (q == 1) ? -sn : (q == 2) ? -cn : sn;
    c = (float)cc; s = (float)ss;
}

__device__ __forceinline__ void prologue(const float* const* in, float* out, uchar* ws, LAS uchar* lds, int G, int bid) {
    const int tid = otid(), lane = tid & 63, wid = tid >> 6;
    { const int wv = __builtin_amdgcn_readfirstlane(tid >> 6); LAS float* tl = (LAS float*)(lds + wv * (64 * 68 * 4)); const int kr = lane >> 4, c4 = (lane & 15) * 4;
      const int tq = TJ_TOTAL / G, trm = TJ_TOTAL % G, tlo = bid * tq + (bid < trm ? bid : trm), thi = tlo + tq + (bid < trm ? 1 : 0);
      int gt = tlo + wv; const int gs = 8;
      if (gt < thi) { int j, r; tj_of(gt, j, r); TJ t = get_tj(j, in, ws); f32x4 v[16];
#define TT_LOAD(T, R) do { const int nnt_ = (T).ncols / 64, n0_ = ((R) % nnt_) * 64, k0_ = ((R) / nnt_) * 64; const float* s_ = (T).src + (size_t)(k0_ + kr) * (T).sld + n0_ + c4; \
          _Pragma("unroll") for (int i = 0; i < 16; ++i) v[i] = *(const f32x4*)(s_ + (size_t)(4 * i) * (T).sld); } while (0)
          TT_LOAD(t, r);
          for (;;) {
#pragma unroll
              for (int i = 0; i < 16; ++i) { LAS float* w = tl + (4 * i + kr) * 65 + c4; w[0] = v[i][0]; w[1] = v[i][1]; w[2] = v[i][2]; w[3] = v[i][3]; }
              const int gn = gt + gs; const bool more = gn < thi; TJ tn = t; int rn = r;
              if (more) { int jn; tj_of(gn, jn, rn); tn = get_tj(jn, in, ws); TT_LOAD(tn, rn); }
              { const int nnt = t.ncols / 64, n0 = (r % nnt) * 64, k0 = (r / nnt) * 64, kc = (lane >> 3) * 8, nl = lane & 7;
                f32x4 g0 = {1.f, 1.f, 1.f, 1.f}, g1 = g0; if (t.gain) { g0 = *(const f32x4*)(t.gain + k0 + kc); g1 = *(const f32x4*)(t.gain + k0 + kc + 4); }
                asm volatile("s_waitcnt lgkmcnt(0)" ::: "memory");
#pragma unroll
                for (int i = 0; i < 8; ++i) { const int n = 8 * i + nl; const float cs = t.cscale ? t.cscale[n0 + n] : 1.0f; float o[8];
#pragma unroll
                    for (int e = 0; e < 8; ++e) o[e] = tl[(kc + e) * 65 + n] * (e < 4 ? g0[e & 3] : g1[e & 3]) * cs;
                    *(u32x4*)(t.dst + (size_t)(n0 + n) * t.dld + k0 + kc) = pack8(o); } }
              if (!more) break;
              t = tn; r = rn; gt = gn;
          }
#undef TT_LOAD
      } }
#ifdef TP_A
    if (bid == 0 && tid == 0) ((volatile LAS unsigned*)(lds + 136 * 1024))[48] = (unsigned)__builtin_amdgcn_s_memrealtime();
#endif
    const size_t gtid = (size_t)bid * 512 + tid, gstride = (size_t)G * 512;
    { bf16_t* WINB = (bf16_t*)(ws + WS_WINB);
      for (size_t i = gtid; i < (size_t)(64 + 128) * DM / 8; i += gstride) { const size_t e = i * 8; bf16_t* p = (e < (size_t)64 * DM) ? WINB + (size_t)448 * DM + e : WINB + ((size_t)NB2 + 384) * DM + (e - (size_t)64 * DM);
          *(u32x4*)p = (u32x4){0u, 0u, 0u, 0u}; }
      bf16_t* WKUPN = (bf16_t*)(ws + WS_WKUPN);
      for (size_t i = gtid; i < (size_t)256 * 1024 / 8; i += gstride) { const float* s = in[19] + i * 8; const f32x4 a = *(const f32x4*)s, b = *(const f32x4*)(s + 4);
          const float v[8] = {a[0], a[1], a[2], a[3], b[0], b[1], b[2], b[3]}; *(u32x4*)(WKUPN + i * 8) = pack8(v); } }
#ifdef TP_A
    if (bid == 0 && tid == 0) ((volatile LAS unsigned*)(lds + 136 * 1024))[49] = (unsigned)__builtin_amdgcn_s_memrealtime();
#endif
    { bf16_t* XB = (bf16_t*)(ws + WS_XB); bf16_t* MH = (bf16_t*)(ws + WS_MHAT); float* ssp = (float*)(ws + WS_SSP); float* ssps = (float*)(ws + WS_SSPS);
      const int nrows = PM + SM + 2048;
      for (int row = bid * 8 + wid; row < nrows; row += G * 8) {
          const float* src = row < PM ? in[0] + (size_t)row * DM : row < PM + SM ? in[1] + (size_t)(row - PM) * DM : in[8] + (size_t)(row - PM - SM) * DM;
          f32x4 v[4]; float s = 0.f;
#pragma unroll
          for (int i = 0; i < 4; ++i) { v[i] = *(const f32x4*)(src + 256 * i + 4 * lane); s += sum4(v[i] * v[i]); }
#pragma unroll
          for (int o = 32; o >= 1; o >>= 1) s += __shfl_xor(s, o);
          float sc = 1.0f; bf16_t* dst;
          if (row < PM + SM) { dst = XB + (size_t)row * DM; if (row < PM) { if (lane < 16) ssp[(size_t)row * 16 + lane] = lane == 0 ? s : 0.f; } else { if (lane < 32) ssps[(row - PM) * 32 + lane] = lane == 0 ? s : 0.f; } }
          else { dst = MH + (size_t)(row - PM - SM) * DM; sc = rsqrtf(s * (1.0f / 1024.0f) + EPS); }
#pragma unroll
          for (int i = 0; i < 4; ++i) { u32x2 w; w.x = cvt_pk_bf16(v[i][0] * sc, v[i][1] * sc); w.y = cvt_pk_bf16(v[i][2] * sc, v[i][3] * sc); *(u32x2*)(dst + 256 * i + 4 * lane) = w; } } }
#ifdef TP_A
    if (bid == 0 && tid == 0) ((volatile LAS unsigned*)(lds + 136 * 1024))[50] = (unsigned)__builtin_amdgcn_s_memrealtime();
#endif
    { f32x2* tab = (f32x2*)(ws + WS_ROPE);
      for (size_t e = gtid; e < (size_t)2052 * 32; e += gstride) { const int p = (int)(e >> 5), i = (int)(e & 31); const int pos = p < 2048 ? p : PAST + (p - 2048);
          const float inv = (float)exp2(-(double)i * (13.287712379549449 / 32.0)); const float ang = (float)pos * inv; float c, s; sincos_d(ang, c, s); tab[e] = (f32x2){c, s}; } }
#ifdef TP_A
    if (bid == 0 && tid == 0) ((volatile LAS unsigned*)(lds + 136 * 1024))[51] = (unsigned)__builtin_amdgcn_s_memrealtime();
#endif
    { for (size_t e = gtid; e < (size_t)2 * SB * 11 * DM / 4; e += gstride) { const size_t f = e * 4; const int c = (int)(f % DM); const size_t rr = f / DM; const int i = (int)(rr % 11); const size_t lb = rr / 11;
          *(f32x4*)(out + O_PSS + (lb * 15 + i) * DM + c) = *(const f32x4*)(in[2] + (lb * 15 + 4 + i) * DM + c); } }
#ifdef TP_A
    if (bid == 0 && tid == 0) ((volatile LAS unsigned*)(lds + 136 * 1024))[52] = (unsigned)__builtin_amdgcn_s_memrealtime();
#endif
}

template <int W> __device__ __forceinline__ void pool16(const bf16_t* __restrict__ zc, bf16_t* __restrict__ po, float* __restrict__ ps, bool bstart) {
    u32x2 uu[15 + W];
#pragma unroll
    for (int i = 0; i < W - 1; ++i) uu[i] = bstart ? (u32x2){0u, 0u} : *(const u32x2*)(zc - (ptrdiff_t)(W - 1 - i) * LDZ);
#pragma unroll
    for (int k = 0; k < 16; ++k) uu[W - 1 + k] = *(const u32x2*)(zc + (size_t)k * LDZ);
    float s0 = 0.f, s1 = 0.f, s2 = 0.f, s3 = 0.f;
#pragma unroll
    for (int i = 0; i < W - 1; ++i) { s0 += bf_lo(uu[i].x); s1 += bf_hi(uu[i].x); s2 += bf_lo(uu[i].y); s3 += bf_hi(uu[i].y); }
#pragma unroll
    for (int k = 0; k < 16; ++k) { const u32x2 c = uu[W - 1 + k]; const float c0 = bf_lo(c.x), c1 = bf_hi(c.x), c2 = bf_lo(c.y), c3 = bf_hi(c.y);
        s0 += c0; s1 += c1; s2 += c2; s3 += c3;
        const float rn = (bstart && k < W - 1) ? 1.0f / (float)(k + 1) : 1.0f / (float)W;
        u32x2 o; o.x = cvt_pk_bf16(s0 * rn - c0, s1 * rn - c1); o.y = cvt_pk_bf16(s2 * rn - c2, s3 * rn - c3); *(u32x2*)(po + (size_t)k * DM) = o;
        if (ps != nullptr && k >= 1) *(f32x4*)(ps + (size_t)(k - 1) * DM) = (f32x4){c0, c1, c2, c3};
        const u32x2 d = uu[k]; s0 -= bf_lo(d.x); s1 -= bf_hi(d.x); s2 -= bf_lo(d.y); s3 -= bf_hi(d.y); }
}
__device__ __forceinline__ void pool_tile(int l, float* out, uchar* ws, int pm, int g) {
    const bf16_t* Z = (const bf16_t*)(ws + WS_Z); bf16_t* PO = (bf16_t*)(ws + WS_POOLED);
    const int tid = otid(), lane = tid & 63, wid = tid >> 6;
#pragma unroll 1
    for (int blk = wid; blk < 16; blk += 8) { const int r0 = pm * 256 + blk * 16, t0 = r0 & (PT - 1), c4 = g * 256 + lane * 4;
        const bf16_t* zc = Z + (size_t)r0 * LDZ + c4; bf16_t* po = PO + (size_t)r0 * DM + c4; const bool bstart = (t0 == 0);
        float* ps = (t0 == PT - 16) ? out + O_PSP + (((size_t)l * PB + (r0 >> 11)) * 15) * DM + c4 : nullptr;
        if (g == 0) pool16<2>(zc, po, ps, bstart); else if (g == 1) pool16<4>(zc, po, ps, bstart); else if (g == 2) pool16<8>(zc, po, ps, bstart); else pool16<16>(zc, po, ps, bstart); }
}
__device__ __forceinline__ void pool_sample(int l, const float* const* in, float* out, uchar* ws, int G, int bid) {
    const bf16_t* Z = (const bf16_t*)(ws + WS_Z); bf16_t* PO = (bf16_t*)(ws + WS_POOLED);
    const int tid = otid();
    const size_t gtid = (size_t)bid * 512 + tid, gstride = (size_t)G * 512;
    for (size_t idx = gtid; idx < (size_t)SB * 128; idx += gstride) { const int b = (int)(idx >> 7), cv = (int)(idx & 127), g = cv >> 5, w = 2 << g;
        const float* prev = in[2] + ((size_t)l * SB + b) * 15 * DM + cv * 8; const bf16_t* us = Z + ((size_t)PM + b * 4) * LDZ + cv * 8; float x[19][8];
#pragma unroll
        for (int e = 0; e < 15; ++e) { const f32x4 a = *(const f32x4*)(prev + (size_t)e * DM), bb = *(const f32x4*)(prev + (size_t)e * DM + 4);
            x[e][0] = a[0]; x[e][1] = a[1]; x[e][2] = a[2]; x[e][3] = a[3]; x[e][4] = bb[0]; x[e][5] = bb[1]; x[e][6] = bb[2]; x[e][7] = bb[3]; }
#pragma unroll
        for (int t = 0; t < 4; ++t) unpack8(*(const u32x4*)(us + (size_t)t * LDZ), x[15 + t]);
        const float rn = 1.0f / (float)w;
#pragma unroll
        for (int t = 0; t < 4; ++t) { float sm[8] = {0.f, 0.f, 0.f, 0.f, 0.f, 0.f, 0.f, 0.f};
#pragma unroll
            for (int e = 18; e >= 0; --e) { if (e <= 15 + t) { const float m = (e > 15 + t - w) ? 1.0f : 0.0f;
#pragma unroll
                for (int jj = 0; jj < 8; ++jj) sm[jj] = fmaf(m, x[e][jj], sm[jj]); } }
            float o[8];
#pragma unroll
            for (int jj = 0; jj < 8; ++jj) o[jj] = sm[jj] * rn - x[15 + t][jj];
            *(u32x4*)(PO + ((size_t)PM + b * 4 + t) * DM + cv * 8) = pack8(o);
            float* q = out + O_PSS + (((size_t)l * SB + b) * 15 + 11 + t) * DM + cv * 8;
            *(f32x4*)q = (f32x4){x[15 + t][0], x[15 + t][1], x[15 + t][2], x[15 + t][3]}; *(f32x4*)(q + 4) = (f32x4){x[15 + t][4], x[15 + t][5], x[15 + t][6], x[15 + t][7]}; } }
}

__device__ __forceinline__ void pool_sample_grp(int l, const float* const* in, float* out, uchar* ws, int g, bool wstate) {
    const bf16_t* Z = (const bf16_t*)(ws + WS_Z); bf16_t* PO = (bf16_t*)(ws + WS_POOLED);
    const int tid = otid(); const int w = 2 << g; const float rn = 1.0f / (float)w;
#pragma unroll 1
    for (int it = tid; it < SB * 32; it += 512) { const int b = it >> 5, cv = g * 32 + (it & 31);
        const float* prev = in[2] + ((size_t)l * SB + b) * 15 * DM + cv * 8; const bf16_t* us = Z + ((size_t)PM + b * 4) * LDZ + cv * 8; float x[19][8];
#pragma unroll
        for (int e = 0; e < 15; ++e) { const f32x4 a = *(const f32x4*)(prev + (size_t)e * DM), bb = *(const f32x4*)(prev + (size_t)e * DM + 4);
            x[e][0] = a[0]; x[e][1] = a[1]; x[e][2] = a[2]; x[e][3] = a[3]; x[e][4] = bb[0]; x[e][5] = bb[1]; x[e][6] = bb[2]; x[e][7] = bb[3]; }
#pragma unroll
        for (int t = 0; t < 4; ++t) unpack8(*(const u32x4*)(us + (size_t)t * LDZ), x[15 + t]);
#pragma unroll
        for (int t = 0; t < 4; ++t) { float sm[8] = {0.f, 0.f, 0.f, 0.f, 0.f, 0.f, 0.f, 0.f};
#pragma unroll
            for (int e = 18; e >= 0; --e) { if (e <= 15 + t) { const float m = (e > 15 + t - w) ? 1.0f : 0.0f;
#pragma unroll
                for (int jj = 0; jj < 8; ++jj) sm[jj] = fmaf(m, x[e][jj], sm[jj]); } }
            float o[8];
#pragma unroll
            for (int jj = 0; jj < 8; ++jj) o[jj] = sm[jj] * rn - x[15 + t][jj];
            *(u32x4*)(PO + ((size_t)PM + b * 4 + t) * DM + cv * 8) = pack8(o);
            if (wstate) { float* q = out + O_PSS + (((size_t)l * SB + b) * 15 + 11 + t) * DM + cv * 8;
                *(f32x4*)q = (f32x4){x[15 + t][0], x[15 + t][1], x[15 + t][2], x[15 + t][3]}; *(f32x4*)(q + 4) = (f32x4){x[15 + t][4], x[15 + t][5], x[15 + t][6], x[15 + t][7]}; } } }
}

__device__ __forceinline__ void kvpost(const float* const* in, float* out, uchar* ws, int G, int bid) {
    const float* KV = (const float*)(ws + WS_KVRAW); bf16_t* CB = (bf16_t*)(ws + WS_CKVB); bf16_t* KB = (bf16_t*)(ws + WS_KROPEB); const f32x2* tab = (const f32x2*)(ws + WS_ROPE);
    const int tid = otid(), lane = tid & 63, wid = tid >> 6; const f32x4 gl = *(const f32x4*)(in[18] + 4 * lane);
    for (int row = bid * 8 + wid; row < PM + SM; row += G * 8) { const float* p = KV + (size_t)row * 320; const f32x4 v = *(const f32x4*)(p + 4 * lane); float s = sum4(v * v);
#pragma unroll
        for (int o = 32; o >= 1; o >>= 1) s += __shfl_xor(s, o);
        const float rs = rsqrtf(s * (1.0f / 256.0f) + EPS); const f32x4 c = v * rs * gl;
        float* oc = row < PM ? out + O_CKVP + (size_t)row * KVR : out + O_CKVS + (size_t)(row - PM) * KVR; float* ok = row < PM ? out + O_KRP + (size_t)row * ROPE : out + O_KRS + (size_t)(row - PM) * ROPE;
        *(f32x4*)(oc + 4 * lane) = c; u32x2 w; w.x = cvt_pk_bf16(c[0], c[1]); w.y = cvt_pk_bf16(c[2], c[3]); *(u32x2*)(CB + (size_t)row * KVR + 4 * lane) = w;
        if (lane < 32) { const int ti = row < PM ? (row & (PT - 1)) : 2048 + ((row - PM) & 3); const f32x2 cs = tab[(size_t)ti * 32 + lane]; const float x1 = p[256 + lane], x2 = p[288 + lane];
            const float o1 = x1 * cs.x - x2 * cs.y, o2 = x1 * cs.y + x2 * cs.x; ok[lane] = o1; ok[32 + lane] = o2;
            KB[(size_t)row * ROPE + lane] = (bf16_t)(cvt_pk_bf16(o1, 0.f) & 0xffffu); KB[(size_t)row * ROPE + 32 + lane] = (bf16_t)(cvt_pk_bf16(o2, 0.f) & 0xffffu); } }
}
__device__ __forceinline__ void sq_rope(uchar* ws, int G, int bid) {
    const bf16_t* Q = (const bf16_t*)(ws + WS_Q); bf16_t* QD = (bf16_t*)(ws + WS_QDEC); const f32x2* tab = (const f32x2*)(ws + WS_ROPE);
    for (size_t e = (size_t)bid * 512 + otid(); e < (size_t)SM * MLAH * 32; e += (size_t)G * 512) { const int i = (int)(e & 31), h = (int)((e >> 5) & 7), r = (int)(e >> 8), b = r >> 2, t = r & 3;
        const bf16_t* q = Q + ((size_t)PM + r) * QW + h * QHD + NOPE; const float x1 = bf2f(q[i]), x2 = bf2f(q[32 + i]); const f32x2 cs = tab[(size_t)(2048 + t) * 32 + i];
        bf16_t* o = QD + ((size_t)b * 32 + t * 8 + h) * 320 + 256; o[i] = (bf16_t)(cvt_pk_bf16(x1 * cs.x - x2 * cs.y, 0.f) & 0xffffu); o[32 + i] = (bf16_t)(cvt_pk_bf16(x1 * cs.y + x2 * cs.x, 0.f) & 0xffffu); }
}
__device__ __forceinline__ void final_norm(const float* const* in, float* out, uchar* ws, int G, int bid, int r0, int r1) {
    const bf16_t* XB = (const bf16_t*)(ws + WS_XB); const float* ssp = (const float*)(ws + WS_SSP); const float* ssps = (const float*)(ws + WS_SSPS);
    const int tid = otid(), lane = tid & 63, wid = tid >> 6;
    for (int row = r0 + bid * 8 + wid; row < r1; row += G * 8) { const float rs = row < PM ? rs_from16(ssp + (size_t)row * 16) : rs_from32(ssps + (row - PM) * 32);
        float* o = row < PM ? out + O_YP + (size_t)row * DM : out + O_YS + (size_t)(row - PM) * DM; const bf16_t* x = XB + (size_t)row * DM;
#pragma unroll
        for (int i = 0; i < 4; ++i) { const int c = 256 * i + 4 * lane; const u32x2 b = *(const u32x2*)(x + c);
            *(f32x4*)(o + c) = (f32x4){bf_lo(b.x), bf_hi(b.x), bf_lo(b.y), bf_hi(b.y)} * rs * *(const f32x4*)(in[25] + c); } }
}
}
#define XB_TMO      128
#define XB_XCNT(j)  (256  + 64 * (j))
#define XB_XSUB(j)  (1280 + 64 * (j))
#define XB_XGEN(j)  (2304 + 64 * (j))
#define XB_TOP      3328
#define XB_TOPGEN   3392
#define XCD_BAR_WORDS 3456
#define XB_SPIN_CAP (1u << 22)
__device__ __forceinline__ unsigned xb_ld(unsigned* p)              { return __hip_atomic_load(p, __ATOMIC_RELAXED, __HIP_MEMORY_SCOPE_AGENT); }
__device__ __forceinline__ unsigned xb_add(unsigned* p, unsigned v) { return __hip_atomic_fetch_add(p, v, __ATOMIC_RELAXED, __HIP_MEMORY_SCOPE_AGENT); }
__device__ __forceinline__ unsigned xb_xcc_id() { return (unsigned)__builtin_amdgcn_s_getreg((3 << 11) | 20) & 0xFu; }
#define XB_SPIN(cond, bar) do { unsigned _sp = 0; while (cond) { __builtin_amdgcn_s_sleep(1); \
    if ((++_sp & 255u) == 0u) { if (xb_ld(&(bar)[XB_TMO])) break; if (_sp > XB_SPIN_CAP) { atomicAdd(&(bar)[XB_TMO], 1u); break; } } } } while (0)
struct XcdBarrier { unsigned* bar; unsigned x; volatile LAS unsigned* st; };
__device__ __forceinline__ XcdBarrier xcd_barrier_post(unsigned* bar, volatile LAS unsigned* st) {
    XcdBarrier b; b.bar = bar; b.x = xb_xcc_id(); b.st = st;
    if (threadIdx.x == 0) (void)xb_add(&bar[XB_XCNT(b.x)], 1u);
    return b;
}
__device__ __forceinline__ void xcd_barrier_complete(unsigned* bar, unsigned x, unsigned& nloc, unsigned& nx) {
    const unsigned G = gridDim.x * gridDim.y * gridDim.z;
    unsigned sum, cnt, mine, sp = 0u;
    for (;;) {
        sum = 0u; cnt = 0u; mine = 0u;
#pragma unroll
        for (unsigned j = 0; j < 16; ++j) { const unsigned c = xb_ld(&bar[XB_XCNT(j)]); sum += c; cnt += (c > 0u) ? 1u : 0u; mine = (j == x) ? c : mine; }
        if (sum == G) break;
        __builtin_amdgcn_s_sleep(1);
        if ((++sp & 255u) == 0u) { if (xb_ld(&bar[XB_TMO])) break; if (sp > XB_SPIN_CAP) { atomicAdd(&bar[XB_TMO], 1u); break; } }
    }
    nloc = mine > 0u ? mine : 1u; nx = cnt > 0u ? cnt : 1u;
}
__device__ __forceinline__ void xcd_barrier(const XcdBarrier& b) {
    asm volatile("s_waitcnt vmcnt(0)" ::: "memory");
    __syncthreads();
    if (threadIdx.x == 0) {
        unsigned* bar = b.bar;
        __builtin_amdgcn_s_waitcnt(0);
        unsigned nloc = b.st[0], nx = b.st[1];
        if (nloc == 0u) { xcd_barrier_complete(bar, b.x, nloc, nx); b.st[0] = nloc; b.st[1] = nx; }
        const unsigned old = xb_add(&bar[XB_XSUB(b.x)], 1u);
        const unsigned gen = old / nloc;
        if (old + 1u == (gen + 1u) * nloc) {
            __builtin_amdgcn_fence(__ATOMIC_RELEASE, "agent");
            asm volatile("s_waitcnt vmcnt(0)" ::: "memory");
            const unsigned og = xb_add(&bar[XB_TOP], 1u);
            const unsigned tg = og / nx;
            if (og + 1u == (tg + 1u) * nx) xb_add(&bar[XB_TOPGEN], 1u);
            else XB_SPIN(xb_ld(&bar[XB_TOPGEN]) == tg, bar);
            __builtin_amdgcn_fence(__ATOMIC_ACQUIRE, "agent");
            xb_add(&bar[XB_XGEN(b.x)], 1u);
            asm volatile("s_waitcnt vmcnt(0)" ::: "memory");
        } else {
            XB_SPIN(xb_ld(&bar[XB_XGEN(b.x)]) == gen, bar);
            __builtin_amdgcn_fence(__ATOMIC_ACQUIRE, "agent");
            asm volatile("s_waitcnt vmcnt(0)" ::: "memory");
        }
    }
    __syncthreads();
}

constexpr int LDS_BYTES = 144 * 1024, MISC_OFF = 136 * 1024;
static_assert(pg8::STAGE_BYTES <= MISC_OFF && att::LDS_BYTES <= MISC_OFF && dec::LDS_BYTES <= MISC_OFF && sg::LDS_BYTES <= MISC_OFF && dec::SMEM_LDS <= MISC_OFF, "LDS budget");
constexpr int NPHASE = 17;
struct Params { const float* in[26]; float* out; uchar* ws; int ph_lo, ph_hi; };

template <class T> __device__ __forceinline__ T* launder(T* p) { asm volatile("" : "+s"(p)); return p; }
#define PHASE_PTRS \
    uchar* const ws = launder(P.ws); float* const out = launder(P.out); const float* const* in = P.in; (void)in; (void)out; \
    bf16_t* const XB = (bf16_t*)(ws + WS_XB); float* const XR = (float*)(ws + WS_XRES); bf16_t* const Z = (bf16_t*)(ws + WS_Z); bf16_t* const MX = (bf16_t*)(ws + WS_MIXED); \
    bf16_t* const PO = (bf16_t*)(ws + WS_POOLED); bf16_t* const QB = (bf16_t*)(ws + WS_Q); float* const ssp = (float*)(ws + WS_SSP); float* const ssps = (float*)(ws + WS_SSPS); \
    float* const ssq = (float*)(ws + WS_SSQ); float* const KVRAW = (float*)(ws + WS_KVRAW); bf16_t* const MEMB = (bf16_t*)(ws + WS_MEMB); \
    (void)XB; (void)XR; (void)Z; (void)MX; (void)PO; (void)QB; (void)ssp; (void)ssps; (void)ssq; (void)KVRAW; (void)MEMB;

__global__ void __launch_bounds__(512, 2) yoco_fwd(Params P) {
    extern __shared__ __attribute__((aligned(16))) uchar lds_raw[];
    LAS uchar* lds = (LAS uchar*)lds_raw;
    const int tid = threadIdx.x, G = gridDim.x, bid = blockIdx.x;
    volatile LAS unsigned* misc = (volatile LAS unsigned*)(lds + MISC_OFF);
    if (tid < 4) misc[tid] = 0u;
    __syncthreads();
    const int lo = P.ph_lo, hi = P.ph_hi; const bool multi = (hi - lo) > 1;
#ifdef TP_A
    if (bid == 0 && tid == 0) misc[15] = (unsigned)__builtin_amdgcn_s_memrealtime();
#endif
    XcdBarrier bar; bar.bar = (unsigned*)(P.ws + WS_CTL); bar.x = 0; bar.st = misc;
    if (multi) bar = xcd_barrier_post((unsigned*)(P.ws + WS_CTL), misc);
#ifndef EN_MASK
#define EN_MASK 0xffff
#endif
#define EN(t) ((EN_MASK >> (t)) & 1)
#ifndef REP_MASK
#define REP_MASK 0
#endif
#define NREP(t, first) ((((REP_MASK >> (t)) & 1) && (first)) ? 2 : 1)
#define IN(k) (lo <= (k) && (k) < hi)
#ifdef TP_A
#define SEAM(k) do { if (IN(k) && IN((k) + 1)) { xcd_barrier(bar); if (bid == 0 && tid == 0) misc[16 + (k)] = (unsigned)__builtin_amdgcn_s_memrealtime(); } } while (0)
#else
#define SEAM(k) do { if (IN(k) && IN((k) + 1)) xcd_barrier(bar); } while (0)
#endif
#define SUNITS(u, n) for (int u = G - 1 - bid; u < (n); u += G)

    if (EN(0) && IN(0)) for (int rep = 0; rep < NREP(0, true); ++rep) { if (rep) xcd_barrier(bar); PHASE_PTRS ew::prologue(in, out, ws, lds, G, bid); }
    SEAM(0);

#pragma unroll 1
    for (int l = 0; l < 2; ++l) {
        const int pb = 1 + 3 * l;
        if (EN(1) && IN(pb)) for (int rep = 0; rep < NREP(1, l == 0); ++rep) { if (rep) xcd_barrier(bar);
            PHASE_PTRS
            { pg8::Gemm g{XB, (const bf16_t*)(ws + WS_WINA) + (size_t)l * INA * DM, DM, DM, DM, 0}; pg8::StaticOrder S; S.init(PM / 256, INA / 256, G, bid);
              pg8::EpiZ E{Z, ssp, nullptr, nullptr}; pg8::gemm_phase(lds, g, S, E); }
            if (l == 0) { pg8::Gemm g{(const bf16_t*)(ws + WS_MHAT), (const bf16_t*)(ws + WS_WMEM), DM, DM, DM, 0}; pg8::StaticOrder S; S.init(2048 / 256, 4096 / 256, G, bid);
              pg8::EpiMem E{out + O_MEMK, MEMB}; pg8::gemm_phase(lds, g, S, E); }
            if (l == 0) {
                unsigned* zflag = (unsigned*)(ws + WS_CTL) + 4096 + 64 * 12;
                SUNITS(u, INA / 64) { sg::EpiZ E{Z, ssps, nullptr, nullptr}; sg::sgemm_unit(lds, XB + (size_t)PM * DM, DM, (const bf16_t*)(ws + WS_WINA) + (size_t)l * INA * DM, DM, DM, u * 64, E);
                    asm volatile("s_waitcnt vmcnt(0)" ::: "memory"); __syncthreads();
                    if (tid == 0) { __builtin_amdgcn_fence(__ATOMIC_RELEASE, "agent"); asm volatile("s_waitcnt vmcnt(0)" ::: "memory"); __hip_atomic_fetch_add(zflag, 1u, __ATOMIC_RELAXED, __HIP_MEMORY_SCOPE_AGENT); } }
                const int sv = bid - (G - 128);
                if (sv >= 0) {
                    if (tid == 0) { unsigned sp = 0; while (__hip_atomic_load(zflag, __ATOMIC_RELAXED, __HIP_MEMORY_SCOPE_AGENT) < (unsigned)(INA / 64)) { __builtin_amdgcn_s_sleep(2); if (++sp > (1u << 22)) break; }
                        __builtin_amdgcn_fence(__ATOMIC_ACQUIRE, "agent"); asm volatile("s_waitcnt vmcnt(0)" ::: "memory"); }
                    __syncthreads();
                    if (sv < 16) { const int u = sv, g = u >> 2;
                        ew::pool_sample_grp(l, in, out, ws, g, (u & 3) == 0);
                        asm volatile("s_waitcnt vmcnt(0)" ::: "memory"); __syncthreads();
                        sg::EpiGrp E{Z, MX, g * 256};
                        sg::sgemm_unit(lds, PO + (size_t)PM * DM + g * 256, DM, (const bf16_t*)(ws + WS_WGRP) + ((size_t)l * 4 + g) * 65536, 256, 256, (u & 3) * 64, E); }
                    else for (int u = sv - 16; u < SB * MEMH; u += 112) { const int b = u >> 2, h = u & 3; const size_t r0 = (size_t)PM + b * 4; const size_t ko = (((size_t)l * SB + b) * MEMT * MEMH + h) * 128;
                        dec::smem_unit(Z + r0 * LDZ + ZA_QM + h * 128, Z + r0 * LDZ + ZA_GM + h * 128, in[5] + ko, in[6] + ko, MX + r0 * OUTW + 1024 + h * 128, lds); }
                }
            }
        }
        SEAM(pb);
        if (EN(2) && IN(pb + 1)) {
            PHASE_PTRS
#if defined(TP_PT) && TP_PT == 56
            if (bid == 0 && tid == 0) misc[56] = (unsigned)__builtin_amdgcn_s_memrealtime();
#endif
            { pg8::StaticOrder S; S.init(PM / 256, 4, G, bid); pg8::Unit u;
              for (int i = 0; S.next(i, u); ++i) ew::pool_tile(l, out, ws, u.pm, u.pn);
              asm volatile("s_waitcnt vmcnt(0)" ::: "memory"); __syncthreads();
#if defined(TP_PT) && TP_PT == 57
            if (bid == 0 && tid == 0) misc[56] = (unsigned)__builtin_amdgcn_s_memrealtime();
#endif
              pg8::Gemm g{PO, (const bf16_t*)(ws + WS_WGRP) + (size_t)l * 4 * 65536, DM, 256, 256, 256};
              pg8::EpiGrp E{Z, MX}; pg8::gemm_phase(lds, g, S, E); }

#if defined(TP_PT) && TP_PT == 58
            if (bid == 0 && tid == 0) misc[56] = (unsigned)__builtin_amdgcn_s_memrealtime();
#endif
            for (int u0 = bid; u0 < PB * MEMH * 8; u0 += G) { const int u = (G == 256) ? ((u0 & 7) * 32 + (u0 >> 3)) : u0;
                const int b = u >> 5, h = (u >> 3) & 3, x = u & 7; const size_t r0 = (size_t)b * PT + 256 * x;
                const bf16_t* Kh = MEMB + (size_t)b * 256 * 4096 + l * 1024 + h * 128;
                att::attn_body<128, false, 1, LDZ, 4096>(Z + r0 * LDZ + ZA_QM + h * 128, Kh, Kh + 512, nullptr, nullptr, Z + r0 * LDZ + ZA_GM + h * 128, MX + r0 * OUTW + 1024 + h * 128, 4, 0, lds);
                __syncthreads(); }

#if defined(TP_PT) && TP_PT == 59
            if (bid == 0 && tid == 0) misc[56] = (unsigned)__builtin_amdgcn_s_memrealtime();
#endif
            if (l == 1) SUNITS(u, SB * MEMH) { const int b = u >> 2, h = u & 3; const size_t r0 = (size_t)PM + b * 4; const size_t ko = (((size_t)l * SB + b) * MEMT * MEMH + h) * 128;
                dec::smem_unit(Z + r0 * LDZ + ZA_QM + h * 128, Z + r0 * LDZ + ZA_GM + h * 128, in[5] + ko, in[6] + ko, MX + r0 * OUTW + 1024 + h * 128, lds); }
            if (l == 1) for (int u = bid; u < 16; u += G) { const int g = u >> 2;
                ew::pool_sample_grp(l, in, out, ws, g, (u & 3) == 0);
                asm volatile("s_waitcnt vmcnt(0)" ::: "memory"); __syncthreads();
                sg::EpiGrp E{Z, MX, g * 256};
                sg::sgemm_unit(lds, PO + (size_t)PM * DM + g * 256, DM, (const bf16_t*)(ws + WS_WGRP) + ((size_t)l * 4 + g) * 65536, 256, 256, (u & 3) * 64, E); }
        }
#ifdef TP_WG
        if (l == TP_L && bid == TP_WG && tid == 0) __hip_atomic_store((unsigned*)(P.ws + WS_CTL) + 6144, (unsigned)__builtin_amdgcn_s_memrealtime(), __ATOMIC_RELAXED, __HIP_MEMORY_SCOPE_AGENT);
#endif
        SEAM(pb + 1);
        if (EN(4) && IN(pb + 2)) {
            PHASE_PTRS
            unsigned* oflag = (unsigned*)(ws + WS_CTL) + 4096 + 64 * 11;
            if (l == 0) SUNITS(u, DM / 64) { sg::EpiOut E{XB, ssps};
                sg::sgemm_unit(lds, MX + (size_t)PM * OUTW, OUTW, (const bf16_t*)(ws + WS_WOUT) + (size_t)l * DM * OUTW, OUTW, OUTW, u * 64, E);
                asm volatile("s_waitcnt vmcnt(0)" ::: "memory"); __syncthreads();
                if (tid == 0) { __builtin_amdgcn_fence(__ATOMIC_RELEASE, "agent"); asm volatile("s_waitcnt vmcnt(0)" ::: "memory"); __hip_atomic_fetch_add(oflag, 1u, __ATOMIC_RELAXED, __HIP_MEMORY_SCOPE_AGENT); } }
            { pg8::Gemm g{MX, (const bf16_t*)(ws + WS_WOUT) + (size_t)l * DM * OUTW, OUTW, OUTW, OUTW, 0}; pg8::StaticOrder S; S.init(PM / 256, DM / 256, G, bid);
              pg8::EpiOut E{XB, ssp}; pg8::gemm_phase(lds, g, S, E); }
            if (l == 0) { bool waited = false;
              for (int u = bid; u < INA / 64; u += G) {
                if (!waited) { waited = true;
                    if (tid == 0) { unsigned sp = 0; while (__hip_atomic_load(oflag, __ATOMIC_RELAXED, __HIP_MEMORY_SCOPE_AGENT) < (unsigned)(DM / 64)) { __builtin_amdgcn_s_sleep(2); if (++sp > (1u << 22)) break; }
                        __builtin_amdgcn_fence(__ATOMIC_ACQUIRE, "agent"); asm volatile("s_waitcnt vmcnt(0)" ::: "memory"); }
                    __syncthreads(); }
                sg::EpiZ E{Z, ssps, nullptr, nullptr}; sg::sgemm_unit(lds, XB + (size_t)PM * DM, DM, (const bf16_t*)(ws + WS_WINA) + (size_t)(l + 1) * INA * DM, DM, DM, u * 64, E); } }
        }
        SEAM(pb + 2);
    }

#pragma unroll 1
    for (int j = 0; j < 2; ++j) {
        const int l = 2 + j, pb = 7 + 5 * j; const int NB = j == 0 ? NB2 : NB3;
        if (EN(5) && IN(pb)) for (int rep = 0; rep < NREP(5, j == 0); ++rep) { if (rep) xcd_barrier(bar);
            PHASE_PTRS
            const bf16_t* WB = (const bf16_t*)(ws + WS_WINB) + (size_t)j * NB2 * DM; float* kvr = j == 0 ? KVRAW : nullptr;
            unsigned* sflag = (unsigned*)(ws + WS_CTL) + 4096 + 64 * j;
            SUNITS(u, DM / 64) { sg::EpiOut E{XB, ssps};
                sg::sgemm_unit(lds, MX + (size_t)PM * OUTW, OUTW, (const bf16_t*)(ws + WS_WOUT) + (size_t)(l - 1) * DM * OUTW, OUTW, OUTW, u * 64, E);
                asm volatile("s_waitcnt vmcnt(0)" ::: "memory"); __syncthreads();
                if (tid == 0) { __builtin_amdgcn_fence(__ATOMIC_RELEASE, "agent"); asm volatile("s_waitcnt vmcnt(0)" ::: "memory"); __hip_atomic_fetch_add(sflag, 1u, __ATOMIC_RELAXED, __HIP_MEMORY_SCOPE_AGENT); } }
            { pg8::Gemm g{XB, WB, DM, DM, DM, 0}; pg8::StaticOrder S; S.init(PM / 256, NB / 256, G, bid);
              pg8::EpiZ E{Z, ssp, ssq, kvr}; pg8::gemm_phase(lds, g, S, E); }
            { bool waited = false;
              for (int u = G - 1 - DM / 64 - bid; u >= 0 && u < NB / 64; u += G) {
                if (!waited) { waited = true;
                    if (tid == 0) { unsigned sp = 0; while (__hip_atomic_load(sflag, __ATOMIC_RELAXED, __HIP_MEMORY_SCOPE_AGENT) < (unsigned)(DM / 64)) { __builtin_amdgcn_s_sleep(2); if (++sp > (1u << 22)) break; }
                        __builtin_amdgcn_fence(__ATOMIC_ACQUIRE, "agent"); asm volatile("s_waitcnt vmcnt(0)" ::: "memory"); }
                    __syncthreads(); }
                sg::EpiZ E{Z, ssps, ssq, kvr}; sg::sgemm_unit(lds, XB + (size_t)PM * DM, DM, WB, DM, DM, u * 64, E); } }
        }
        SEAM(pb);
        if (EN(6) && IN(pb + 1)) for (int rep = 0; rep < NREP(6, j == 0); ++rep) { if (rep) xcd_barrier(bar);
            PHASE_PTRS
            unsigned* qflag = (unsigned*)(ws + WS_CTL) + 4096 + 64 * (6 + j);
            SUNITS(u, QW / 64) { sg::EpiQ E{QB, ssq}; sg::sgemm_unit(lds, Z + (size_t)PM * LDZ + ZB_CQ, LDZ, (const bf16_t*)(ws + WS_WQUP) + (size_t)j * QW * QRANK, QRANK, QRANK, u * 64, E);
                asm volatile("s_waitcnt vmcnt(0)" ::: "memory"); __syncthreads();
                if (tid == 0) { __builtin_amdgcn_fence(__ATOMIC_RELEASE, "agent"); asm volatile("s_waitcnt vmcnt(0)" ::: "memory"); __hip_atomic_fetch_add(qflag, 1u, __ATOMIC_RELAXED, __HIP_MEMORY_SCOPE_AGENT); } }
            if (j == 0) ew::kvpost(in, out, ws, G, bid);
            { pg8::Gemm g{Z + ZB_CQ, (const bf16_t*)(ws + WS_WQUP) + (size_t)j * QW * QRANK, LDZ, QRANK, QRANK, 0}; pg8::StaticOrder S; S.init(PM / 256, QW / 256, G, bid);
              pg8::EpiQ E{QB, ssq}; pg8::gemm_phase(lds, g, S, E); }
            for (int u0 = bid; u0 < PB * MEMH * 8; u0 += G) { const int u = (G == 256) ? ((u0 & 7) * 32 + (u0 >> 3)) : u0;
                const int b = u >> 5, h = (u >> 3) & 3, x = u & 7; const size_t r0 = (size_t)b * PT + 256 * x;
                const bf16_t* Kh = MEMB + (size_t)b * 256 * 4096 + l * 1024 + h * 128;
                att::attn_body<128, false, 1, LDZ, 4096>(Z + r0 * LDZ + ZB_QM + h * 128, Kh, Kh + 512, nullptr, nullptr, Z + r0 * LDZ + ZB_GM + h * 128, MX + r0 * OUTW + 1024 + h * 128, 4, 0, lds);
                __syncthreads(); }
            SUNITS(u, SB * MEMH) { const int b = u >> 2, h = u & 3; const size_t r0 = (size_t)PM + b * 4; const size_t ko = (((size_t)l * SB + b) * MEMT * MEMH + h) * 128;
                dec::smem_unit(Z + r0 * LDZ + ZB_QM + h * 128, Z + r0 * LDZ + ZB_GM + h * 128, in[5] + ko, in[6] + ko, MX + r0 * OUTW + 1024 + h * 128, lds); }
            { const int cu = G - 1 - QW / 64 - bid;
              if (cu >= 0 && cu < MLAH * 4) {
                if (tid == 0) { unsigned sp = 0; while (__hip_atomic_load(qflag, __ATOMIC_RELAXED, __HIP_MEMORY_SCOPE_AGENT) < (unsigned)(QW / 64)) { __builtin_amdgcn_s_sleep(2); if (++sp > (1u << 22)) break; }
                    __builtin_amdgcn_fence(__ATOMIC_ACQUIRE, "agent"); asm volatile("s_waitcnt vmcnt(0)" ::: "memory"); }
                __syncthreads();
                { const int h = cu >> 2; sg::EpiAbsorb E{(bf16_t*)(ws + WS_QDEC), h};
                  sg::sgemm_unit(lds, QB + (size_t)PM * QW + h * QHD, QW, (const bf16_t*)(ws + WS_WKUPN) + h * 128, 1024, 128, (cu & 3) * 64, E); }
                ew::sq_rope(ws, MLAH * 4, cu); } }
        }
        SEAM(pb + 1);
        const int pM = pb + 2 + (j == 0 ? 1 : 0);
        if (j == 0) {
            if (EN(7) && IN(pb + 2)) {
                PHASE_PTRS
                { pg8::Gemm g{(const bf16_t*)(ws + WS_CKVB), (const bf16_t*)(ws + WS_WKV), KVR, KVR, KVR, 0}; pg8::StaticOrder S; S.init(PM / 256, 2048 / 256, G, bid);
                  pg8::EpiKV E{(bf16_t*)(ws + WS_KN)}; pg8::gemm_phase(lds, g, S, E); }
            }
            SEAM(pb + 2);
        }
        if (EN(8) && IN(pM)) for (int rep = 0; rep < NREP(8, j == 0); ++rep) { if (rep) xcd_barrier(bar);
            PHASE_PTRS
#pragma unroll 1
            for (int half = 0; half < 2; ++half) {
            if ((half ^ ((bid >> 3) & 1)) == 0) {
            for (int rep2 = 0; rep2 < NREP(13, j == 0); ++rep2)
            for (int u0 = bid; u0 < PB * MLAH * 4; u0 += G) { const int u = (G == 256) ? ((u0 & 7) * 32 + (u0 >> 3)) : u0;
                const int b = u >> 5, h = (u >> 2) & 7, xp = u & 3;
#pragma unroll 1
                for (int s = 0; s < 2; ++s) { const int x = s == 0 ? 7 - xp : xp; const size_t b0 = (size_t)b * PT, r0 = b0 + 256 * x;
                    att::attn_body<192, true, 1, QW, 1024>(QB + r0 * QW + h * QHD, (const bf16_t*)(ws + WS_KN) + b0 * 1024 + h * 128, (const bf16_t*)(ws + WS_VV) + b0 * 1024 + h * 128,
                        (const bf16_t*)(ws + WS_KROPEB) + b0 * ROPE, (const f32x2*)(ws + WS_ROPE) + (size_t)(256 * x) * 32, Z + r0 * LDZ + ZB_GT + h * 128, MX + r0 * OUTW + h * 128, 4 * (x + 1), 4 * x, lds);
                    __syncthreads(); } }
            } else {
            for (int rep3 = 0; rep3 < NREP(14, j == 0); ++rep3)
            for (int u = bid; u < SB * 8; u += G) { const int b = u >> 3, ch = u & 7;
                dec::decode_unit((const bf16_t*)(ws + WS_QDEC) + (size_t)b * 32 * 320, in[3], in[4], (const int*)in[7] + b * NPAGES + ch * 16,
                                 (float*)(ws + WS_OPART) + ((size_t)b * 8 + ch) * 32 * 256, (float*)(ws + WS_ML) + ((size_t)b * 8 + ch) * 32 * 2, lds);
                __syncthreads(); }
            } }
#ifdef DELAY_PROBE
            if (j == 0) { const unsigned long long t0 = __builtin_amdgcn_s_memrealtime(); while (__builtin_amdgcn_s_memrealtime() - t0 < 3000ull) __builtin_amdgcn_s_sleep(8); }
#endif
        }
        SEAM(pM);
        if (EN(11) && IN(pM + 1)) {
            PHASE_PTRS
            unsigned* cflag = (unsigned*)(ws + WS_CTL) + 4096 + 64 * (4 + j);
            constexpr int NCOMB = 128;
            if (bid < NCOMB) { const int ct = ew::otid();
                for (int w = bid * 8 + (ct >> 6); w < SB * 32; w += NCOMB * 8)
                    dec::combine_row(w >> 5, w & 31, ct & 63, (const bf16_t*)(ws + WS_QDEC), (const float*)(ws + WS_OPART), (const float*)(ws + WS_ML), out + O_CKVS, out + O_KRS, (bf16_t*)(ws + WS_OLAT));
                asm volatile("s_waitcnt vmcnt(0)" ::: "memory"); __syncthreads();
                if (tid == 0) { __builtin_amdgcn_fence(__ATOMIC_RELEASE, "agent"); asm volatile("s_waitcnt vmcnt(0)" ::: "memory"); __hip_atomic_fetch_add(cflag, 1u, __ATOMIC_RELAXED, __HIP_MEMORY_SCOPE_AGENT); } }
            { pg8::Gemm g{MX, (const bf16_t*)(ws + WS_WOUT) + (size_t)l * DM * OUTW, OUTW, OUTW, OUTW, 0}; pg8::StaticOrder S; S.init(PM / 256, DM / 256, G, bid);
              pg8::EpiOut E{XB, ssp}; pg8::gemm_phase(lds, g, S, E); }
            { bool waited = false;
              SUNITS(u, MLAH * 2) { const int h = u >> 1;
                if (!waited) { waited = true;
                    if (tid == 0) { unsigned sp = 0; while (__hip_atomic_load(cflag, __ATOMIC_RELAXED, __HIP_MEMORY_SCOPE_AGENT) < (unsigned)NCOMB) { __builtin_amdgcn_s_sleep(2); if (++sp > (1u << 22)) break; }
                        __builtin_amdgcn_fence(__ATOMIC_ACQUIRE, "agent"); asm volatile("s_waitcnt vmcnt(0)" ::: "memory"); }
                    __syncthreads(); }
                sg::EpiVup E{Z, MX, h};
                sg::sgemm_unit(lds, (const bf16_t*)(ws + WS_OLAT) + h * 256, 2048, (const bf16_t*)(ws + WS_WKV) + ((size_t)1024 + h * 128) * 256, 256, 256, (u & 1) * 64, E); } }
        }
        SEAM(pM + 1);
    }
    if (EN(12) && IN(16)) {
        PHASE_PTRS
        unsigned* sflag = (unsigned*)(ws + WS_CTL) + 4096 + 64 * 2;
        SUNITS(u, DM / 64) { sg::EpiOut E{XB, ssps};
            sg::sgemm_unit(lds, MX + (size_t)PM * OUTW, OUTW, (const bf16_t*)(ws + WS_WOUT) + (size_t)3 * DM * OUTW, OUTW, OUTW, u * 64, E);
            asm volatile("s_waitcnt vmcnt(0)" ::: "memory"); __syncthreads();
            if (tid == 0) { __builtin_amdgcn_fence(__ATOMIC_RELEASE, "agent"); asm volatile("s_waitcnt vmcnt(0)" ::: "memory"); __hip_atomic_fetch_add(sflag, 1u, __ATOMIC_RELAXED, __HIP_MEMORY_SCOPE_AGENT); } }
        const int nprod = (G > 2 * (DM / 64)) ? DM / 64 : 0;
        if (bid < G - nprod) ew::final_norm(in, out, ws, G - nprod, bid, 0, PM);
        if (bid < 16) {
            if (tid == 0) { unsigned sp = 0; while (__hip_atomic_load(sflag, __ATOMIC_RELAXED, __HIP_MEMORY_SCOPE_AGENT) < (unsigned)(DM / 64)) { __builtin_amdgcn_s_sleep(2); if (++sp > (1u << 22)) break; }
                __builtin_amdgcn_fence(__ATOMIC_ACQUIRE, "agent"); asm volatile("s_waitcnt vmcnt(0)" ::: "memory"); }
            __syncthreads();
            ew::final_norm(in, out, ws, 16, bid, PM, PM + SM); }
    }
#ifdef TP_A
    if (bid == 0 && tid == 0) { const unsigned dt = (TP_B >= 99 ? (unsigned)__builtin_amdgcn_s_memrealtime() : TP_B == 98 ? __hip_atomic_load((unsigned*)(P.ws + WS_CTL) + 6144, __ATOMIC_RELAXED, __HIP_MEMORY_SCOPE_AGENT) : misc[TP_B]) - misc[TP_A];
        const unsigned long long t0 = __builtin_amdgcn_s_memrealtime(); while (__builtin_amdgcn_s_memrealtime() - t0 < (unsigned long long)dt * TP_K) __builtin_amdgcn_s_sleep(8); }
#endif
#undef IN
#undef SEAM
#undef SUNITS
}

#ifndef MK_LAUNCHES
#define MK_LAUNCHES 1
#endif
extern "C" void kernel_launch(void* const* d_in, const int* in_sizes, int n_in, void* d_out, int out_size, void* d_ws, size_t ws_size, hipStream_t stream) {
    static int grid = 0;
    if (grid == 0) {
        if (n_in != 26 || (size_t)out_size != O_END || ws_size < WS_END) { fprintf(stderr, "kernel_launch: unexpected shapes: n_in %d out %d ws %zu (need out %zu ws %zu)\n", n_in, out_size, ws_size, (size_t)O_END, (size_t)WS_END); grid = -1; return; }
        int dev = 0, cus = 0, per_cu = 0;
        if (hipGetDevice(&dev) != hipSuccess || hipDeviceGetAttribute(&cus, hipDeviceAttributeMultiprocessorCount, dev) != hipSuccess) { grid = -1; return; }
        if (hipFuncSetAttribute((const void*)yoco_fwd, hipFuncAttributeMaxDynamicSharedMemorySize, LDS_BYTES) != hipSuccess) { fprintf(stderr, "kernel_launch: hipFuncSetAttribute failed\n"); grid = -1; return; }
        if (hipOccupancyMaxActiveBlocksPerMultiprocessor(&per_cu, (const void*)yoco_fwd, 512, LDS_BYTES) != hipSuccess || per_cu < 1) { fprintf(stderr, "kernel_launch: occupancy query says %d blocks per CU\n", per_cu); (void)hipGetLastError(); grid = -1; return; }
        grid = cus;
    }
    if (grid < 0) return;
    (void)hipMemsetAsync((char*)d_ws + WS_CTL, 0, CTL_BYTES, stream);
    Params p{};
    for (int i = 0; i < 26; ++i) p.in[i] = (const float*)d_in[i];
    p.out = (float*)d_out; p.ws = (uchar*)d_ws;
    if (MK_LAUNCHES == 1) { p.ph_lo = 0; p.ph_hi = NPHASE; hipLaunchKernelGGL(yoco_fwd, dim3(grid), dim3(512), LDS_BYTES, stream, p); }
    else for (int k = 0; k < NPHASE; ++k) { p.ph_lo = k; p.ph_hi = k + 1; hipLaunchKernelGGL(yoco_fwd, dim3(grid), dim3(512), LDS_BYTES, stream, p); }
    const hipError_t le = hipPeekAtLastError();
    if (le != hipSuccess) fprintf(stderr, "kernel_launch: launch failed: %s\n", hipGetErrorName(le));
}
```

```cpp
#include <hip/hip_runtime.h>
#include <cstdio>
#include <cstdint>

#define LAS __attribute__((address_space(3)))
typedef unsigned char uchar;
typedef unsigned short bf16_t;
typedef short bf16x8 __attribute__((ext_vector_type(8)));
typedef short s16x4 __attribute__((ext_vector_type(4)));
typedef float f32x2 __attribute__((ext_vector_type(2)));
typedef float f32x4 __attribute__((ext_vector_type(4)));
typedef float f32x16 __attribute__((ext_vector_type(16)));
typedef unsigned u32x2 __attribute__((ext_vector_type(2)));
typedef unsigned u32x4 __attribute__((ext_vector_type(4)));

constexpr int DM = 1024, PB = 8, PT = 2048, PM = PB * PT, SB = 32, ST = 4, SM = SB * ST, RP = 16640;
constexpr int KVR = 256, ROPE = 64, NOPE = 128, QRANK = 384, MLAH = 8, QHD = 192, QW = MLAH * QHD;
constexpr int MEMT = 256, MEMH = 4, MEMW = 512;
constexpr int INA = 3072, INB = 2432, OUTW = 1536, LDZ = 3072, NB2 = 2816, NB3 = 2560;
constexpr int NPAGES = 128, PAGE = 128, PAST = 16384, POOLBUF = 15;
constexpr float EPS = 1e-6f;
constexpr int ZA_U = 0, ZA_GT = 1024, ZA_QM = 2048, ZA_GM = 2560;
constexpr int ZB_CQ = 0, ZB_KR = 384, ZB_GT = 512, ZB_QM = 1536, ZB_GM = 2048, ZB_KV = 2560;

constexpr size_t O_YP = 0, O_YS = O_YP + (size_t)PM * DM, O_PSP = O_YS + (size_t)SM * DM, O_PSS = O_PSP + (size_t)2 * PB * 15 * DM, O_CKVP = O_PSS + (size_t)2 * SB * 15 * DM,
                 O_KRP = O_CKVP + (size_t)PM * KVR, O_CKVS = O_KRP + (size_t)PM * ROPE, O_KRS = O_CKVS + (size_t)SM * KVR, O_MEMK = O_KRS + (size_t)SM * ROPE,
                 O_MEMV = O_MEMK + (size_t)4 * PB * MEMT * MEMW, O_END = O_MEMV + (size_t)4 * PB * MEMT * MEMW;

constexpr size_t al256(size_t x) { return (x + 255) / 256 * 256; }
constexpr size_t WS_CTL = 0, CTL_BYTES = 65536;
constexpr size_t WS_ROPE = WS_CTL + CTL_BYTES;
constexpr size_t WS_WINA = al256(WS_ROPE + (size_t)2052 * 32 * 8);
constexpr size_t WS_WGRP = al256(WS_WINA + (size_t)2 * INA * DM * 2);
constexpr size_t WS_WINB = al256(WS_WGRP + (size_t)2 * 4 * 256 * 256 * 2);
constexpr size_t WS_WQUP = al256(WS_WINB + (size_t)2 * NB2 * DM * 2);
constexpr size_t WS_WKV  = al256(WS_WQUP + (size_t)2 * QW * QRANK * 2);
constexpr size_t WS_WKUPN = al256(WS_WKV + (size_t)2048 * 256 * 2);
constexpr size_t WS_WMEM = al256(WS_WKUPN + (size_t)256 * 1024 * 2);
constexpr size_t WS_WOUT = al256(WS_WMEM + (size_t)4096 * 1024 * 2);
constexpr size_t WS_MHAT = al256(WS_WOUT + (size_t)4 * DM * OUTW * 2);
constexpr size_t WS_MEMB = al256(WS_MHAT + (size_t)2048 * 1024 * 2);
constexpr size_t WS_XRES = al256(WS_MEMB + (size_t)2048 * 4096 * 2);
constexpr size_t WS_XB   = al256(WS_XRES + (size_t)RP * DM * 4);
constexpr size_t WS_SSP  = al256(WS_XB + (size_t)RP * DM * 2);
constexpr size_t WS_SSPS = al256(WS_SSP + (size_t)PM * 16 * 4);
constexpr size_t WS_SSQ  = al256(WS_SSPS + (size_t)SM * 32 * 4);
constexpr size_t WS_Z    = al256(WS_SSQ + (size_t)RP * 12 * 4);
constexpr size_t WS_POOLED = al256(WS_Z + (size_t)RP * LDZ * 2);
constexpr size_t WS_MIXED = al256(WS_POOLED + (size_t)RP * DM * 2);
constexpr size_t WS_Q    = al256(WS_MIXED + (size_t)RP * OUTW * 2);
constexpr size_t WS_KVRAW = al256(WS_Q + (size_t)RP * QW * 2);
constexpr size_t WS_CKVB = al256(WS_KVRAW + (size_t)RP * 320 * 4);
constexpr size_t WS_KROPEB = al256(WS_CKVB + (size_t)RP * 256 * 2);
constexpr size_t WS_KN   = al256(WS_KROPEB + (size_t)RP * 64 * 2);
constexpr size_t WS_VV   = al256(WS_KN + (size_t)PM * 1024 * 2);
constexpr size_t WS_QDEC = al256(WS_VV + (size_t)PM * 1024 * 2);
constexpr size_t WS_OPART = al256(WS_QDEC + (size_t)SB * 32 * 320 * 2);
constexpr size_t WS_ML   = al256(WS_OPART + (size_t)SB * 8 * 32 * 256 * 4);
constexpr size_t WS_OLAT = al256(WS_ML + (size_t)SB * 8 * 32 * 2 * 4);
constexpr size_t WS_END  = al256(WS_OLAT + (size_t)SM * 2048 * 2);

__device__ __forceinline__ unsigned cvt_pk_bf16(float lo, float hi) { unsigned r; asm volatile("v_cvt_pk_bf16_f32 %0, %1, %2" : "=v"(r) : "v"(lo), "v"(hi)); return r; }
__device__ __forceinline__ float bf_lo(unsigned w) { return __uint_as_float(w << 16); }
__device__ __forceinline__ float bf_hi(unsigned w) { return __uint_as_float(w & 0xffff0000u); }
__device__ __forceinline__ float bf2f(bf16_t b) { return __uint_as_float(((unsigned)b) << 16); }
__device__ __forceinline__ float silu(float x) { return x * __builtin_amdgcn_rcpf(1.0f + __expf(-x)); }
__device__ __forceinline__ void unpack8(const u32x4 w, float (&f)[8]) {
    f[0] = bf_lo(w.x); f[1] = bf_hi(w.x); f[2] = bf_lo(w.y); f[3] = bf_hi(w.y); f[4] = bf_lo(w.z); f[5] = bf_hi(w.z); f[6] = bf_lo(w.w); f[7] = bf_hi(w.w); }
__device__ __forceinline__ u32x4 pack8(const float (&f)[8]) { u32x4 w; w.x = cvt_pk_bf16(f[0], f[1]); w.y = cvt_pk_bf16(f[2], f[3]); w.z = cvt_pk_bf16(f[4], f[5]); w.w = cvt_pk_bf16(f[6], f[7]); return w; }
__device__ __forceinline__ float sum4(const f32x4 a) { return (a[0] + a[1]) + (a[2] + a[3]); }
__device__ __forceinline__ float rs_from16(const float* p) {
    const f32x4 a = *(const f32x4*)p, b = *(const f32x4*)(p + 4), c = *(const f32x4*)(p + 8), d = *(const f32x4*)(p + 12);
    return rsqrtf(((sum4(a) + sum4(b)) + (sum4(c) + sum4(d))) * (1.0f / 1024.0f) + EPS); }
__device__ __forceinline__ float rs_from32(const float* p) { float s = 0.f;
#pragma unroll
    for (int i = 0; i < 8; ++i) s += sum4(*(const f32x4*)(p + 4 * i));
    return rsqrtf(s * (1.0f / 1024.0f) + EPS); }
__device__ __forceinline__ float rsq_from12(const float* p) {
    const f32x4 a = *(const f32x4*)p, b = *(const f32x4*)(p + 4), c = *(const f32x4*)(p + 8);
    return rsqrtf((sum4(a) + sum4(b) + sum4(c)) * (1.0f / 384.0f) + EPS); }
__device__ __forceinline__ int crow(int r, int hi) { return (r & 3) + 8 * (r >> 2) + 4 * hi; }
static_assert(WS_VV == WS_KN + (size_t)PM * 1024 * 2, "VV must follow KN");
namespace pg8 {
constexpr int BM = 256, BK = 64, HALF = 128, HTB = HALF * BK * 2, STAGE_BYTES = 8 * HTB, NXCD = 8, WGM = 8;
__device__ __forceinline__ int lds_byte(int r, int c) { const int st = (r >> 4) * 2 + (c >> 5), rr = r & 15, cc = c & 31, ob = rr * 64 + cc * 2; return st * 1024 + (ob ^ (((ob >> 9) & 1) << 5)); }
__device__ __forceinline__ void stage_rc(int b, int& R, int& C) { const int st = b / 1024, sb = b % 1024, swz = sb ^ (((sb >> 9) & 1) << 5); R = (st >> 1) * 16 + swz / 64; C = (st & 1) * 32 + (swz % 64) / 2; }
__device__ __forceinline__ int perm32(int rho) { const int n = rho >> 4, i = rho & 15; return 8 * (i >> 2) + 4 * n + (i & 3); }

struct Unit { int pm, pn; };
struct Gemm { const bf16_t* A; const bf16_t* Bt; int lda, ldb, K, a_pn; };

struct StaticOrder {
    int nM, nN, nwg, G, c;
    __device__ __forceinline__ void init(int nM_, int nN_, int G_, int c_) { nM = nM_; nN = nN_; nwg = nM * nN; G = G_; c = c_; }
    __device__ __forceinline__ bool next(int i, Unit& u) const {
        const long L = (long)i * G + c; if (L >= nwg) return false;
        int wgid = (int)L; { const int q = nwg / NXCD, r = nwg % NXCD, xcd = wgid % NXCD, off = wgid / NXCD; wgid = (xcd < r ? xcd * (q + 1) : r * (q + 1) + (xcd - r) * q) + off; }
        const int nig = WGM * nN, gid = wgid / nig, fm = gid * WGM, gsz = (nM - fm) < WGM ? (nM - fm) : WGM;
        u.pm = fm + ((wgid % nig) % gsz); u.pn = (wgid % nig) / gsz; return true;
    }
};

template <class Epi>
__device__ __forceinline__ void gemm_phase(LAS uchar* lds, const Gemm g, const StaticOrder& S, const Epi& E) {
    int tid_ = threadIdx.x; asm volatile("" : "+v"(tid_));
    const int tid = tid_, wid = __builtin_amdgcn_readfirstlane(tid >> 6), lane = tid & 63, wr = wid >> 2, wc = wid & 3, fr = lane & 15, fq = lane >> 4;
    int K_ = g.K; asm volatile("" : "+s"(K_));
    const int K = K_, nt = K / BK;
    unsigned voffA[2], voffB[2];
#pragma unroll
    for (int i = 0; i < 2; ++i) { int R, C; stage_rc(tid * 16 + i * 8192, R, C); const int Rb = Epi::PERM ? ((R & ~31) + perm32(R & 31)) : R;
        voffA[i] = (unsigned)(R * g.lda + C) * 2u; voffB[i] = (unsigned)(Rb * g.ldb + C) * 2u; }
    const size_t kstep = (size_t)(BK * 2);
    const size_t hstepA = (size_t)HALF * g.lda * 2, hstepB = (size_t)HALF * g.ldb * 2;
    const size_t tstepA = 2 * hstepA, tstepB = 2 * hstepB;
    const unsigned ldsw = (unsigned)wid * 1024u;
    const int aoff = lds_byte(wr * 64 + fr, fq * 8), boff = lds_byte(wc * 32 + fr, fq * 8);
#define PG8_SA(b, h) (((b) * 2 + (h)) * HTB)
#define PG8_SB(b, h) ((4 + (b) * 2 + (h)) * HTB)
#define PG8_STAGE(bufoff, gbase, voff) do { _Pragma("unroll") for (int _i = 0; _i < 2; ++_i) \
        __builtin_amdgcn_global_load_lds((const unsigned*)((const char*)(gbase) + (voff)[_i]), (LAS unsigned*)(lds + (bufoff) + ldsw + _i * 8192), 16, 0, 0); } while (0)
#define PG8_LDA(dst, b, h) do { _Pragma("unroll") for (int m = 0; m < 4; ++m) _Pragma("unroll") for (int k = 0; k < 2; ++k) dst[m][k] = *(const LAS bf16x8*)(lds + PG8_SA(b, h) + aoff + m * 2048 + k * 1024); } while (0)
#define PG8_LDB(dst, b, h) do { _Pragma("unroll") for (int n = 0; n < 2; ++n) _Pragma("unroll") for (int k = 0; k < 2; ++k) dst[n][k] = *(const LAS bf16x8*)(lds + PG8_SB(b, h) + boff + n * 2048 + k * 1024); } while (0)
#define PG8_MMA(ai, bj, At, Bt) do { __builtin_amdgcn_s_setprio(1); _Pragma("unroll") for (int m = 0; m < 4; ++m) _Pragma("unroll") for (int n = 0; n < 2; ++n) _Pragma("unroll") for (int k = 0; k < 2; ++k) \
        acc[ai][bj][m][n] = __builtin_amdgcn_mfma_f32_16x16x32_bf16(Bt[n][k], At[m][k], acc[ai][bj][m][n], 0, 0, 0); __builtin_amdgcn_s_setprio(0); } while (0)
#define PG8_WAIT_V(n) asm volatile("s_waitcnt vmcnt(" #n ")" ::: "memory")
#define PG8_WAIT_L(n) asm volatile("s_waitcnt lgkmcnt(" #n ")" ::: "memory")
#define PG8_BAR __builtin_amdgcn_s_barrier()
#define PG8_SCHED __builtin_amdgcn_sched_barrier(0)
    Unit cur, nxt; int ui = 0;
    if (!S.next(0, cur)) return;
    f32x4 acc[2][2][4][2];
#pragma unroll
    for (int a = 0; a < 2; ++a)
#pragma unroll
        for (int b = 0; b < 2; ++b)
#pragma unroll
            for (int m = 0; m < 4; ++m)
#pragma unroll
                for (int n = 0; n < 2; ++n) acc[a][b][m][n] = (f32x4){0.f, 0.f, 0.f, 0.f};
    bf16x8 At[4][2], B0[2][2], B1[2][2];
    const char* cA = (const char*)g.A + (size_t)cur.pm * tstepA + (size_t)cur.pn * g.a_pn * 2; const char* cB = (const char*)g.Bt + (size_t)cur.pn * tstepB;
    PG8_STAGE(PG8_SB(0, 0), cB, voffB); PG8_STAGE(PG8_SA(0, 0), cA, voffA); PG8_STAGE(PG8_SB(0, 1), cB + hstepB, voffB); PG8_STAGE(PG8_SA(0, 1), cA + hstepA, voffA);
    if (wr == 1) PG8_BAR;
    PG8_WAIT_V(4); PG8_BAR;
    PG8_STAGE(PG8_SB(1, 0), cB + kstep, voffB); PG8_STAGE(PG8_SA(1, 0), cA + kstep, voffA); PG8_STAGE(PG8_SB(1, 1), cB + hstepB + kstep, voffB);
    PG8_WAIT_V(6); PG8_BAR;
    for (;;) {
        const bool has_next = S.next(ui + 1, nxt);
        const char* nA = has_next ? (const char*)g.A + (size_t)nxt.pm * tstepA + (size_t)nxt.pn * g.a_pn * 2 : cA; const char* nB = has_next ? (const char*)g.Bt + (size_t)nxt.pn * tstepB : cB;
        for (int t = 0; t < nt; t += 2) {
            const bool last = (t == nt - 2);
            const char* a1 = cA + (size_t)(t + 1) * kstep;
            const char* a2 = last ? nA : cA + (size_t)(t + 2) * kstep; const char* b2 = last ? nB : cB + (size_t)(t + 2) * kstep;
            const char* a3 = a2 + kstep; const char* b3 = b2 + kstep;
            PG8_LDB(B0, 0, 0); PG8_SCHED; PG8_LDA(At, 0, 0); PG8_STAGE(PG8_SA(1, 1), a1 + hstepA, voffA);
            PG8_WAIT_L(8); PG8_BAR; PG8_WAIT_L(0); PG8_MMA(0, 0, At, B0); PG8_BAR; PG8_SCHED;
            PG8_LDB(B1, 0, 1); PG8_STAGE(PG8_SB(0, 0), b2, voffB);
            PG8_BAR; PG8_WAIT_L(0); PG8_MMA(0, 1, At, B1); PG8_BAR;
            PG8_LDA(At, 0, 1); PG8_STAGE(PG8_SA(0, 0), a2, voffA);
            PG8_BAR; PG8_WAIT_L(0); PG8_MMA(1, 0, At, B0); PG8_BAR; PG8_SCHED;
            PG8_STAGE(PG8_SB(0, 1), b2 + hstepB, voffB);
            PG8_WAIT_V(6); PG8_BAR; PG8_MMA(1, 1, At, B1); PG8_BAR;
            PG8_LDB(B0, 1, 0); PG8_SCHED; PG8_LDA(At, 1, 0); PG8_STAGE(PG8_SA(0, 1), a2 + hstepA, voffA);
            PG8_WAIT_L(8); PG8_BAR; PG8_WAIT_L(0); PG8_MMA(0, 0, At, B0); PG8_BAR; PG8_SCHED;
            PG8_LDB(B1, 1, 1); PG8_STAGE(PG8_SB(1, 0), b3, voffB);
            PG8_BAR; PG8_WAIT_L(0); PG8_MMA(0, 1, At, B1); PG8_BAR;
            PG8_LDA(At, 1, 1); PG8_STAGE(PG8_SA(1, 0), a3, voffA);
            PG8_BAR; PG8_WAIT_L(0); PG8_MMA(1, 0, At, B0); PG8_BAR; PG8_SCHED;
            PG8_STAGE(PG8_SB(1, 1), b3 + hstepB, voffB);
            PG8_WAIT_V(6); PG8_BAR; PG8_MMA(1, 1, At, B1); PG8_BAR;
        }
        E(acc, cur, wr, wc, fr, fq);
        if (!has_next) break;
#pragma unroll
        for (int a = 0; a < 2; ++a)
#pragma unroll
            for (int b = 0; b < 2; ++b)
#pragma unroll
                for (int m = 0; m < 4; ++m)
#pragma unroll
                    for (int n = 0; n < 2; ++n) acc[a][b][m][n] = (f32x4){0.f, 0.f, 0.f, 0.f};
        cur = nxt; cA = nA; cB = nB; ++ui;
    }
    PG8_WAIT_V(0);
    if (wr == 0) PG8_BAR;
    PG8_BAR;
#undef PG8_SA
#undef PG8_SB
#undef PG8_STAGE
#undef PG8_LDA
#undef PG8_LDB
#undef PG8_MMA
#undef PG8_WAIT_V
#undef PG8_WAIT_L
#undef PG8_BAR
#undef PG8_SCHED
}

typedef f32x4 Acc[2][2][4][2];
struct EpiZ { static constexpr bool PERM = true;
    bf16_t* Z; const float* ssp; float* ssq; float* kvraw;
    __device__ __forceinline__ void operator()(const Acc& acc, const Unit& u, int wr, int wc, int fr, int fq) const {
        const int rbase = u.pm * BM + wr * 64 + fr, col0 = u.pn * BM + wc * 32 + 8 * fq;
        const bool kvt = (kvraw != nullptr) && u.pn == 10, wantq = (ssq != nullptr) && u.pn <= 1;
#pragma unroll
        for (int ai = 0; ai < 2; ++ai)
#pragma unroll
            for (int m = 0; m < 4; ++m) { const int row = rbase + ai * HALF + m * 16; const float rs = rs_from16(ssp + (size_t)row * 16);
#pragma unroll
                for (int bj = 0; bj < 2; ++bj) { const f32x4 v0 = acc[ai][bj][m][0] * rs, v1 = acc[ai][bj][m][1] * rs; const int c = col0 + bj * HALF;
                    if (!kvt) { u32x4 w; w.x = cvt_pk_bf16(v0[0], v0[1]); w.y = cvt_pk_bf16(v0[2], v0[3]); w.z = cvt_pk_bf16(v1[0], v1[1]); w.w = cvt_pk_bf16(v1[2], v1[3]);
                        *(u32x4*)(Z + (size_t)row * LDZ + c) = w; }
                    else { float* p = kvraw + (size_t)row * 320 + (c - ZB_KV); *(f32x4*)p = v0; *(f32x4*)(p + 4) = v1; }
                    if (kvraw != nullptr && u.pn == 1 && bj == 1 && wc < 2) { float* p = kvraw + (size_t)row * 320 + 256 + (c - ZB_KR); *(f32x4*)p = v0; *(f32x4*)(p + 4) = v1; }
                    if (wantq && (u.pn == 0 || bj == 0)) { float s = sum4(v0 * v0) + sum4(v1 * v1); s += __shfl_xor(s, 16); s += __shfl_xor(s, 32);
                        if (fq == 0) ssq[(size_t)row * 12 + (u.pn == 0 ? bj * 4 + wc : 8 + wc)] = s; } } }
    }
};
struct EpiGrp { static constexpr bool PERM = true;
    const bf16_t* Z; bf16_t* MX;
    __device__ __forceinline__ void operator()(const Acc& acc, const Unit& u, int wr, int wc, int fr, int fq) const {
        const int rbase = u.pm * BM + wr * 64 + fr, col0 = u.pn * BM + wc * 32 + 8 * fq;
#pragma unroll
        for (int ai = 0; ai < 2; ++ai)
#pragma unroll
            for (int m = 0; m < 4; ++m) { const int row = rbase + ai * HALF + m * 16;
                const u32x4 g0 = *(const u32x4*)(Z + (size_t)row * LDZ + ZA_GT + col0), g1 = *(const u32x4*)(Z + (size_t)row * LDZ + ZA_GT + col0 + HALF);
#pragma unroll
                for (int bj = 0; bj < 2; ++bj) { const int c = col0 + bj * HALF; float gt[8]; unpack8(bj ? g1 : g0, gt);
                    const f32x4 v0 = acc[ai][bj][m][0], v1 = acc[ai][bj][m][1]; float o[8];
#pragma unroll
                    for (int j = 0; j < 4; ++j) { o[j] = v0[j] * silu(gt[j]); o[4 + j] = v1[j] * silu(gt[4 + j]); }
                    *(u32x4*)(MX + (size_t)row * OUTW + c) = pack8(o); }
                asm volatile("" ::: "memory"); }
    }
};
struct EpiQ { static constexpr bool PERM = true;
    bf16_t* Q; const float* ssq;
    __device__ __forceinline__ void operator()(const Acc& acc, const Unit& u, int wr, int wc, int fr, int fq) const {
        const int rbase = u.pm * BM + wr * 64 + fr, col0 = u.pn * BM + wc * 32 + 8 * fq;
#pragma unroll
        for (int ai = 0; ai < 2; ++ai)
#pragma unroll
            for (int m = 0; m < 4; ++m) { const int row = rbase + ai * HALF + m * 16; const float rs = rsq_from12(ssq + (size_t)row * 12);
#pragma unroll
                for (int bj = 0; bj < 2; ++bj) { const f32x4 v0 = acc[ai][bj][m][0] * rs, v1 = acc[ai][bj][m][1] * rs;
                    u32x4 w; w.x = cvt_pk_bf16(v0[0], v0[1]); w.y = cvt_pk_bf16(v0[2], v0[3]); w.z = cvt_pk_bf16(v1[0], v1[1]); w.w = cvt_pk_bf16(v1[2], v1[3]);
                    *(u32x4*)(Q + (size_t)row * QW + col0 + bj * HALF) = w; } }
    }
};
struct EpiKV { static constexpr bool PERM = true;
    bf16_t* KN;
    __device__ __forceinline__ void operator()(const Acc& acc, const Unit& u, int wr, int wc, int fr, int fq) const {
        const int rbase = u.pm * BM + wr * 64 + fr, col0 = (u.pn & 3) * BM + wc * 32 + 8 * fq; bf16_t* O = KN + (size_t)(u.pn >> 2) * ((size_t)PM * 1024);
#pragma unroll
        for (int ai = 0; ai < 2; ++ai)
#pragma unroll
            for (int m = 0; m < 4; ++m) { const int row = rbase + ai * HALF + m * 16;
#pragma unroll
                for (int bj = 0; bj < 2; ++bj) { const f32x4 v0 = acc[ai][bj][m][0], v1 = acc[ai][bj][m][1];
                    u32x4 w; w.x = cvt_pk_bf16(v0[0], v0[1]); w.y = cvt_pk_bf16(v0[2], v0[3]); w.z = cvt_pk_bf16(v1[0], v1[1]); w.w = cvt_pk_bf16(v1[2], v1[3]);
                    *(u32x4*)(O + (size_t)row * 1024 + col0 + bj * HALF) = w; } }
    }
};
struct EpiMem { static constexpr bool PERM = true;
    float* OK; bf16_t* MB;
    __device__ __forceinline__ void operator()(const Acc& acc, const Unit& u, int wr, int wc, int fr, int fq) const {
        const int rbase = u.pm * BM + wr * 64 + fr, col0 = u.pn * BM + wc * 32 + 8 * fq;
#pragma unroll
        for (int ai = 0; ai < 2; ++ai)
#pragma unroll
            for (int m = 0; m < 4; ++m) { const int row = rbase + ai * HALF + m * 16;
#pragma unroll
                for (int bj = 0; bj < 2; ++bj) { const int c = col0 + bj * HALF; const int l = c >> 10, kv = (c >> 9) & 1, cc = c & 511; const f32x4 v0 = acc[ai][bj][m][0], v1 = acc[ai][bj][m][1];
                    float* o = OK + (size_t)kv * (O_MEMV - O_MEMK) + ((size_t)l * 2048 + row) * 512 + cc; *(f32x4*)o = v0; *(f32x4*)(o + 4) = v1;
                    u32x4 w; w.x = cvt_pk_bf16(v0[0], v0[1]); w.y = cvt_pk_bf16(v0[2], v0[3]); w.z = cvt_pk_bf16(v1[0], v1[1]); w.w = cvt_pk_bf16(v1[2], v1[3]);
                    *(u32x4*)(MB + (size_t)row * 4096 + c) = w; } }
    }
};
struct EpiOut { static constexpr bool PERM = false;
    bf16_t* XB; float* ssp;
    __device__ __forceinline__ void operator()(const Acc& acc, const Unit& u, int wr, int wc, int fr, int fq) const {
        const int rbase = u.pm * BM + wr * 64 + fr, col0 = u.pn * BM + wc * 32 + 4 * fq;
        u32x2 bw[2][4][2][2];
#pragma unroll
        for (int ai = 0; ai < 2; ++ai)
#pragma unroll
            for (int m = 0; m < 4; ++m)
#pragma unroll
                for (int bj = 0; bj < 2; ++bj)
#pragma unroll
                    for (int n = 0; n < 2; ++n) bw[ai][m][bj][n] = *(const u32x2*)(XB + (size_t)(rbase + ai * HALF + m * 16) * DM + col0 + bj * HALF + n * 16);
#pragma unroll
        for (int ai = 0; ai < 2; ++ai)
#pragma unroll
            for (int m = 0; m < 4; ++m) { const int row = rbase + ai * HALF + m * 16; float s = 0.f;
#pragma unroll
                for (int bj = 0; bj < 2; ++bj)
#pragma unroll
                    for (int n = 0; n < 2; ++n) { const size_t o = (size_t)row * DM + col0 + bj * HALF + n * 16; const u32x2 b = bw[ai][m][bj][n];
                        const f32x4 v = (f32x4){bf_lo(b.x), bf_hi(b.x), bf_lo(b.y), bf_hi(b.y)} + acc[ai][bj][m][n];
                        u32x2 w; w.x = cvt_pk_bf16(v[0], v[1]); w.y = cvt_pk_bf16(v[2], v[3]); *(u32x2*)(XB + o) = w; s += sum4(v * v); }
                s += __shfl_xor(s, 16); s += __shfl_xor(s, 32);
                if (fq == 0) ssp[(size_t)row * 16 + u.pn * 4 + wc] = s; }
    }
};
}
namespace sg {
constexpr int BUF = 24576, LDS_BYTES = 2 * BUF;
template <class Epi>
__device__ __forceinline__ void sgemm_unit(LAS uchar* lds, const bf16_t* A, int lda, const bf16_t* Bt, int ldb, int K, int n0, const Epi& E) {
    int tid_ = threadIdx.x; asm volatile("" : "+v"(tid_));
    const int tid = tid_, wid = tid >> 6, lane = tid & 63, r32 = lane & 31, hi = lane >> 5, rb = wid & 3, cb = wid >> 2;
    const int srow = tid >> 3, sch = tid & 7;
    const bf16_t* ap0 = A + (size_t)srow * lda + sch * 8; const bf16_t* ap1 = ap0 + (size_t)64 * lda; const bf16_t* bp = Bt + (size_t)(n0 + srow) * ldb + sch * 8;
    const int aw0 = srow * 128 + ((sch ^ (srow & 7)) << 4), aw1 = aw0 + 64 * 128, bw = 16384 + aw0;
    const int arow = rb * 32 + r32, brow = cb * 32 + r32;
    const int ard = arow * 128, brd = 16384 + brow * 128, asw = arow & 7, bsw = brow & 7;
    u32x4 ra0[4], ra1[4], rbv[4];
    f32x16 acc = {};
    const int nk = K / 64;
#define SG_LOAD(s, kt) do { ra0[s] = *(const u32x4*)(ap0 + (size_t)(kt) * 64); ra1[s] = *(const u32x4*)(ap1 + (size_t)(kt) * 64); rbv[s] = *(const u32x4*)(bp + (size_t)(kt) * 64); } while (0)
#define SG_WRITE(s, b) do { *(LAS u32x4*)(lds + (b) * BUF + aw0) = ra0[s]; *(LAS u32x4*)(lds + (b) * BUF + aw1) = ra1[s]; *(LAS u32x4*)(lds + (b) * BUF + bw) = rbv[s]; } while (0)
#define SG_COMPUTE(b) do { _Pragma("unroll") for (int kk = 0; kk < 4; ++kk) { \
        const bf16x8 af = *(const LAS bf16x8*)(lds + (b) * BUF + ard + (((2 * kk + hi) ^ asw) << 4)); \
        const bf16x8 bf = *(const LAS bf16x8*)(lds + (b) * BUF + brd + (((2 * kk + hi) ^ bsw) << 4)); \
        acc = __builtin_amdgcn_mfma_f32_32x32x16_bf16(bf, af, acc, 0, 0, 0); } } while (0)
    if ((nk & 3) == 0) {
        SG_LOAD(0, 0); SG_LOAD(1, 1); SG_LOAD(2, 2); SG_LOAD(3, 3);
        for (int kt = 0; kt < nk; kt += 4) { const int l = nk - 1;
            SG_WRITE(0, 0); __syncthreads(); SG_LOAD(0, (kt + 4 < nk ? kt + 4 : l)); SG_COMPUTE(0);
            SG_WRITE(1, 1); __syncthreads(); SG_LOAD(1, (kt + 5 < nk ? kt + 5 : l)); SG_COMPUTE(1);
            SG_WRITE(2, 0); __syncthreads(); SG_LOAD(2, (kt + 6 < nk ? kt + 6 : l)); SG_COMPUTE(0);
            SG_WRITE(3, 1); __syncthreads(); SG_LOAD(3, (kt + 7 < nk ? kt + 7 : l)); SG_COMPUTE(1);
        }
    } else {
        SG_LOAD(0, 0); SG_LOAD(1, 1);
        for (int kt = 0; kt < nk; kt += 2) { const int l = nk - 1;
            SG_WRITE(0, 0); __syncthreads(); SG_LOAD(0, (kt + 2 < nk ? kt + 2 : l));
            SG_COMPUTE(0);
            SG_WRITE(1, 1); __syncthreads(); SG_LOAD(1, (kt + 3 < nk ? kt + 3 : l));
            SG_COMPUTE(1);
        }
    }
#undef SG_LOAD
#undef SG_WRITE
#undef SG_COMPUTE
    E(acc, rb * 32 + r32, n0 + cb * 32, hi);
}

struct EpiZ { bf16_t* Z; const float* ssps; float* ssq; float* kvraw;
    __device__ __forceinline__ void operator()(const f32x16& acc, int row, int cbase, int hi) const {
        const float rs = rs_from32(ssps + row * 32); const size_t grow = (size_t)PM + row; float s = 0.f;
#pragma unroll
        for (int g = 0; g < 4; ++g) { const f32x4 v = (f32x4){acc[4 * g], acc[4 * g + 1], acc[4 * g + 2], acc[4 * g + 3]} * rs; const int c = cbase + 8 * g + 4 * hi;
            if (kvraw != nullptr && cbase >= ZB_KV) *(f32x4*)(kvraw + grow * 320 + (c - ZB_KV)) = v;
            else { u32x2 w; w.x = cvt_pk_bf16(v[0], v[1]); w.y = cvt_pk_bf16(v[2], v[3]); *(u32x2*)(Z + grow * LDZ + c) = w; }
            if (kvraw != nullptr && cbase >= ZB_KR && cbase < ZB_KR + 64) *(f32x4*)(kvraw + grow * 320 + 256 + (c - ZB_KR)) = v;
            s += sum4(v * v); }
        if (ssq != nullptr && cbase < QRANK) { s += __shfl_xor(s, 32); if (hi == 0) ssq[grow * 12 + (cbase >> 5)] = s; }
    }
};
struct EpiGrp { const bf16_t* Z; bf16_t* MX; int cofs;
    __device__ __forceinline__ void operator()(const f32x16& acc, int row, int cbase, int hi) const {
        const size_t grow = (size_t)PM + row;
#pragma unroll
        for (int g = 0; g < 4; ++g) { const int c = cofs + cbase + 8 * g + 4 * hi; const u32x2 gw = *(const u32x2*)(Z + grow * LDZ + ZA_GT + c);
            const float o0 = acc[4 * g] * silu(bf_lo(gw.x)), o1 = acc[4 * g + 1] * silu(bf_hi(gw.x)), o2 = acc[4 * g + 2] * silu(bf_lo(gw.y)), o3 = acc[4 * g + 3] * silu(bf_hi(gw.y));
            u32x2 w; w.x = cvt_pk_bf16(o0, o1); w.y = cvt_pk_bf16(o2, o3); *(u32x2*)(MX + grow * OUTW + c) = w; }
    }
};
struct EpiOut { bf16_t* XB; float* ssps;
    __device__ __forceinline__ void operator()(const f32x16& acc, int row, int cbase, int hi) const {
        const size_t grow = (size_t)PM + row; float s = 0.f;
#pragma unroll
        for (int g = 0; g < 4; ++g) { const int c = cbase + 8 * g + 4 * hi; const u32x2 b = *(const u32x2*)(XB + grow * DM + c);
            const f32x4 v = (f32x4){bf_lo(b.x), bf_hi(b.x), bf_lo(b.y), bf_hi(b.y)} + (f32x4){acc[4 * g], acc[4 * g + 1], acc[4 * g + 2], acc[4 * g + 3]};
            u32x2 w; w.x = cvt_pk_bf16(v[0], v[1]); w.y = cvt_pk_bf16(v[2], v[3]); *(u32x2*)(XB + grow * DM + c) = w; s += sum4(v * v); }
        s += __shfl_xor(s, 32); if (hi == 0) ssps[row * 32 + (cbase >> 5)] = s;
    }
};
struct EpiQ { bf16_t* Q; const float* ssq;
    __device__ __forceinline__ void operator()(const f32x16& acc, int row, int cbase, int hi) const {
        const size_t grow = (size_t)PM + row; const float rs = rsq_from12(ssq + grow * 12);
#pragma unroll
        for (int g = 0; g < 4; ++g) { const int c = cbase + 8 * g + 4 * hi; u32x2 w; w.x = cvt_pk_bf16(acc[4 * g] * rs, acc[4 * g + 1] * rs); w.y = cvt_pk_bf16(acc[4 * g + 2] * rs, acc[4 * g + 3] * rs);
            *(u32x2*)(Q + grow * QW + c) = w; }
    }
};
struct EpiAbsorb { bf16_t* QD; int h;
    __device__ __forceinline__ void operator()(const f32x16& acc, int row, int cbase, int hi) const {
        const int b = row >> 2, t = row & 3; bf16_t* o = QD + ((size_t)b * 32 + t * 8 + h) * 320;
#pragma unroll
        for (int g = 0; g < 4; ++g) { const int c = cbase + 8 * g + 4 * hi; u32x2 w; w.x = cvt_pk_bf16(acc[4 * g], acc[4 * g + 1]); w.y = cvt_pk_bf16(acc[4 * g + 2], acc[4 * g + 3]); *(u32x2*)(o + c) = w; }
    }
};
struct EpiVup { const bf16_t* Z; bf16_t* MX; int h;
    __device__ __forceinline__ void operator()(const f32x16& acc, int row, int cbase, int hi) const {
        const size_t grow = (size_t)PM + row;
#pragma unroll
        for (int g = 0; g < 4; ++g) { const int c = h * 128 + cbase + 8 * g + 4 * hi; const u32x2 gw = *(const u32x2*)(Z + grow * LDZ + ZB_GT + c);
            const float o0 = acc[4 * g] * silu(bf_lo(gw.x)), o1 = acc[4 * g + 1] * silu(bf_hi(gw.x)), o2 = acc[4 * g + 2] * silu(bf_lo(gw.y)), o3 = acc[4 * g + 3] * silu(bf_hi(gw.y));
            u32x2 w; w.x = cvt_pk_bf16(o0, o1); w.y = cvt_pk_bf16(o2, o3); *(u32x2*)(MX + grow * OUTW + c) = w; }
    }
};
}
namespace att {
constexpr int NW = 8, QBLK = 32, KVBLK = 64;
constexpr int SHM_V = KVBLK * 128 * 2, SHM_K = KVBLK * 128 * 2, SHM_KR = KVBLK * 64 * 2;
constexpr int OFF_V = 0, OFF_K = 2 * SHM_V, OFF_KR = OFF_K + 2 * SHM_K, OFF_WS = OFF_KR + 2 * SHM_KR, OFF_QR = OFF_WS + NW * 64 * 4, LDS_BYTES = OFF_QR + NW * 4096;
constexpr float THR = 8.f;
#define KSWZ(row, colB) ((row) * 256 + ((colB) ^ (((row) & 7) << 4)))
#define KRSWZ(row, colB) ((row) * 128 + ((colB) ^ (((row) & 7) << 4)))
#define SBAR() __builtin_amdgcn_sched_barrier(0)
template <int DQK> struct Cst { static constexpr float SCALE = (DQK == 128) ? 0.08838834764831845f : 0.07216878364870322f; };

template <int DQK>
__device__ __forceinline__ void partialSM(f32x16& p0, f32x16& p1, float& m_reg, float& mn, float& alpha) {
    constexpr float SCALE = Cst<DQK>::SCALE, C = SCALE * 1.4426950408889634f;
    float pmax = p0[0];
#pragma unroll
    for (int r = 1; r < 16; ++r) pmax = fmaxf(pmax, p0[r]);
#pragma unroll
    for (int r = 0; r < 16; ++r) pmax = fmaxf(pmax, p1[r]);
    { auto rr = __builtin_amdgcn_permlane32_swap(__float_as_uint(pmax), __float_as_uint(pmax), false, false);
      pmax = fmaxf(__uint_as_float(rr[0]), __uint_as_float(rr[1])); }
    if (__builtin_expect(__all(pmax - m_reg <= THR / SCALE), 1)) { mn = m_reg; alpha = 1.f; }
    else { mn = fmaxf(m_reg, pmax); alpha = __builtin_amdgcn_exp2f((m_reg - mn) * C); m_reg = mn; }
    const float mnC = -mn * C;
#pragma unroll
    for (int r = 0; r < 16; ++r) p0[r] = fmaf(p0[r], C, mnC);
#pragma unroll
    for (int r = 0; r < 16; ++r) p1[r] = fmaf(p1[r], C, mnC);
#pragma unroll
    for (int r = 0; r < 16; ++r) p0[r] = __builtin_amdgcn_exp2f(p0[r]);
}
__device__ __forceinline__ void finishSM(f32x16& p0, f32x16& p1, float alpha, float& l_reg, bf16x8& pa0, bf16x8& pa1, bf16x8& pa2, bf16x8& pa3) {
#pragma unroll
    for (int r = 0; r < 16; ++r) p1[r] = __builtin_amdgcn_exp2f(p1[r]);
    float ps = 0;
#pragma unroll
    for (int r = 0; r < 16; ++r) ps += p0[r];
#pragma unroll
    for (int r = 0; r < 16; ++r) ps += p1[r];
    { auto rr = __builtin_amdgcn_permlane32_swap(__float_as_uint(ps), __float_as_uint(ps), false, false);
      ps = __uint_as_float(rr[0]) + __uint_as_float(rr[1]); }
    l_reg = l_reg * alpha + ps;
#define PK4(P, BASE, OUT) do { unsigned a0 = cvt_pk_bf16(P[BASE + 0], P[BASE + 1]), a1 = cvt_pk_bf16(P[BASE + 2], P[BASE + 3]);   \
    unsigned b0 = cvt_pk_bf16(P[BASE + 4], P[BASE + 5]), b1 = cvt_pk_bf16(P[BASE + 6], P[BASE + 7]);                              \
    auto r0 = __builtin_amdgcn_permlane32_swap(a0, b0, false, false); auto r1 = __builtin_amdgcn_permlane32_swap(a1, b1, false, false); \
    u32x4 w = {r0[0], r1[0], r0[1], r1[1]}; OUT = *reinterpret_cast<bf16x8*>(&w); } while (0)
    PK4(p0, 0, pa0); PK4(p0, 8, pa1); PK4(p1, 0, pa2); PK4(p1, 8, pa3);
#undef PK4
}
template <int DQK>
__device__ __forceinline__ void qkt(f32x16& p0, f32x16& p1, const LAS uchar* Ks, const LAS uchar* Krs, const bf16x8* qr, const LAS uchar* qrl  , int r32, int hi) {
    p0 = f32x16{}; p1 = f32x16{};
#pragma unroll
    for (int d0 = 0; d0 < 8; ++d0) { const int cb = (d0 * 16 + hi * 8) * 2;
        const bf16x8 b0 = *(const LAS bf16x8*)(Ks + KSWZ(r32, cb));
        const bf16x8 b1 = *(const LAS bf16x8*)(Ks + KSWZ(32 + r32, cb));
        p0 = __builtin_amdgcn_mfma_f32_32x32x16_bf16(b0, qr[d0], p0, 0, 0, 0);
        p1 = __builtin_amdgcn_mfma_f32_32x32x16_bf16(b1, qr[d0], p1, 0, 0, 0); }
    if constexpr (DQK == 192) {
#pragma unroll
        for (int d0 = 0; d0 < 4; ++d0) { const int cb = (d0 * 16 + hi * 8) * 2;
            const bf16x8 b0 = *(const LAS bf16x8*)(Krs + KRSWZ(r32, cb));
            const bf16x8 b1 = *(const LAS bf16x8*)(Krs + KRSWZ(32 + r32, cb));
            const bf16x8 qf = *(const LAS bf16x8*)(qrl + d0 * 1024);
            p0 = __builtin_amdgcn_mfma_f32_32x32x16_bf16(b0, qf, p0, 0, 0, 0);
            p1 = __builtin_amdgcn_mfma_f32_32x32x16_bf16(b1, qf, p1, 0, 0, 0); }
    }
}
__device__ __forceinline__ int v_st(int k, int c) { const int kk = (k & ~0xC) | ((k & 4) << 1) | ((k & 8) >> 1); return ((kk >> 3) * 4 + (c >> 5)) * 512 + ((kk & 7) * 32 + (c & 31)) * 2; }
__device__ __forceinline__ int v_rd_base(int lane) { return ((lane & 3) << 3) | (((lane >> 2) & 3) << 6) | (((lane >> 4) & 1) << 5) | (((lane >> 5) & 1) << 8); }
constexpr int v_rd_off(int d0, int ks, int half) { return d0 * 512 + ks * 4096 + half * 2048; }
template <int OFF> __device__ __forceinline__ s16x4 tr_read(int vb) {
    s16x4 r; asm volatile("ds_read_b64_tr_b16 %0, %1 offset:%2" : "=&v"(r) : "v"(vb), "i"(OFF) : "memory"); return r;
}
template <int D0> __device__ __forceinline__ void pv_one(f32x16& od, int vb, bf16x8 pa0, bf16x8 pa1, bf16x8 pa2, bf16x8 pa3) {
    const s16x4 l0 = tr_read<v_rd_off(D0, 0, 0)>(vb), h0 = tr_read<v_rd_off(D0, 0, 1)>(vb), l1 = tr_read<v_rd_off(D0, 1, 0)>(vb), h1 = tr_read<v_rd_off(D0, 1, 1)>(vb);
    const s16x4 l2 = tr_read<v_rd_off(D0, 2, 0)>(vb), h2 = tr_read<v_rd_off(D0, 2, 1)>(vb), l3 = tr_read<v_rd_off(D0, 3, 0)>(vb), h3 = tr_read<v_rd_off(D0, 3, 1)>(vb);
    asm volatile("s_waitcnt lgkmcnt(0)" ::: "memory"); SBAR();
#define PK(L, H) (bf16x8){L[0], L[1], L[2], L[3], H[0], H[1], H[2], H[3]}
    od = __builtin_amdgcn_mfma_f32_32x32x16_bf16(pa0, PK(l0, h0), od, 0, 0, 0);
    od = __builtin_amdgcn_mfma_f32_32x32x16_bf16(pa1, PK(l1, h1), od, 0, 0, 0);
    od = __builtin_amdgcn_mfma_f32_32x32x16_bf16(pa2, PK(l2, h2), od, 0, 0, 0);
    od = __builtin_amdgcn_mfma_f32_32x32x16_bf16(pa3, PK(l3, h3), od, 0, 0, 0);
#undef PK
}
__device__ __forceinline__ void pv_d0(f32x16* o, int vb, bf16x8 pa0, bf16x8 pa1, bf16x8 pa2, bf16x8 pa3) {
    pv_one<0>(o[0], vb, pa0, pa1, pa2, pa3); pv_one<1>(o[1], vb, pa0, pa1, pa2, pa3); pv_one<2>(o[2], vb, pa0, pa1, pa2, pa3); pv_one<3>(o[3], vb, pa0, pa1, pa2, pa3);
}
__device__ __forceinline__ void causal_mask(f32x16& p0, f32x16& p1, int jj, int rowrel, int hi) {
#pragma unroll
    for (int r = 0; r < 16; ++r) { const int k0 = 64 * jj + crow(r, hi); if (k0 > rowrel) p0[r] = -1e30f; if (k0 + 32 > rowrel) p1[r] = -1e30f; }
}

template <int DQK, bool CAUSAL, int SD, int LDQ, int LDK>
__device__ __forceinline__ void attn_body(const bf16_t* __restrict__ Qb, const bf16_t* __restrict__ Kh, const bf16_t* __restrict__ Vh, const bf16_t* __restrict__ Krp,
                                          const f32x2* __restrict__ ropeq, const bf16_t* __restrict__ gate, bf16_t* __restrict__ outp, int NT, int diag0, LAS uchar* lds) {
    constexpr int NQ = 8;
    int tid_ = threadIdx.x; asm volatile("" : "+v"(tid_));
    const int tid = tid_, wid = tid >> 6, lane = tid & 63, r32 = lane & 31, hi = lane >> 5;
    LAS uchar* V_lds = lds + OFF_V; LAS uchar* K_lds = lds + OFF_K; LAS uchar* Kr_lds = lds + OFF_KR;
    LAS float* ws = (LAS float*)(lds + OFF_WS) + wid * 64; LAS float* li_l = ws; LAS float* al_l = ws + 32; LAS uchar* qrl = lds + OFF_QR + wid * 4096 + lane * 16;
    float m_reg = -1e30f, l_reg = 0; f32x16 o[4] = {}; bf16x8 qr[NQ];
    const bf16_t* Qw = Qb + (size_t)(wid * QBLK + r32) * LDQ + hi * 8;
#pragma unroll
    for (int d0 = 0; d0 < 8; ++d0) qr[d0] = *(const bf16x8*)(Qw + d0 * 16);
    if constexpr (DQK == 192) {
#pragma unroll
        for (int a = 0; a < 2; ++a) {
            const u32x4 w1 = *(const u32x4*)(Qw + 128 + 16 * a), w2 = *(const u32x4*)(Qw + 160 + 16 * a); float x1[8], x2[8], o1[8], o2[8]; unpack8(w1, x1); unpack8(w2, x2);
            const f32x2* tb = ropeq + (size_t)(wid * QBLK + r32) * 32 + 16 * a + 8 * hi;
#pragma unroll
            for (int j = 0; j < 8; ++j) { const f32x2 cs = tb[j]; o1[j] = x1[j] * cs.x - x2[j] * cs.y; o2[j] = x1[j] * cs.y + x2[j] * cs.x; }
            *(LAS u32x4*)(qrl + a * 1024) = pack8(o1); *(LAS u32x4*)(qrl + (2 + a) * 1024) = pack8(o2);
        }
    }
    const int sr = tid >> 4, sc = (tid & 15) * 8, vst0 = v_st(sr, sc), vst1 = v_st(32 + sr, sc);
    const int krow = tid >> 3, kcc = (tid & 7) * 8;
    const int vb0 = (int)(unsigned)(uintptr_t)V_lds + v_rd_base(lane);
    struct { bf16x8 vs0, vs1, ks0, ks1, kr; } sr_[SD];
#define SLOAD(i, k0) do { sr_[i].vs0 = *(const bf16x8*)(Vh + (size_t)((k0) + sr) * LDK + sc); sr_[i].vs1 = *(const bf16x8*)(Vh + (size_t)((k0) + 32 + sr) * LDK + sc); \
    sr_[i].ks0 = *(const bf16x8*)(Kh + (size_t)((k0) + sr) * LDK + sc); sr_[i].ks1 = *(const bf16x8*)(Kh + (size_t)((k0) + 32 + sr) * LDK + sc); \
    if constexpr (DQK == 192) sr_[i].kr = *(const bf16x8*)(Krp + (size_t)((k0) + krow) * 64 + kcc); } while (0)
#define SWRITE(b, i) do { *(LAS bf16x8*)(V_lds + (b) * SHM_V + vst0) = sr_[i].vs0; *(LAS bf16x8*)(V_lds + (b) * SHM_V + vst1) = sr_[i].vs1; const int kc = sc * 2; \
    *(LAS bf16x8*)(K_lds + (b) * SHM_K + KSWZ(sr, kc)) = sr_[i].ks0; *(LAS bf16x8*)(K_lds + (b) * SHM_K + KSWZ(32 + sr, kc)) = sr_[i].ks1; \
    if constexpr (DQK == 192) *(LAS bf16x8*)(Kr_lds + (b) * SHM_KR + KRSWZ(krow, kcc * 2)) = sr_[i].kr; } while (0)
#define SWAIT() do { if constexpr (SD == 2) { if constexpr (DQK == 192) asm volatile("s_waitcnt vmcnt(5)" ::: "memory"); else asm volatile("s_waitcnt vmcnt(4)" ::: "memory"); } \
    else asm volatile("s_waitcnt vmcnt(0)" ::: "memory"); } while (0)
#define RESC(a) do { if (__any((a) < 1.f)) { if (hi == 0) al_l[r32] = (a); asm volatile("s_waitcnt lgkmcnt(0)" ::: "memory"); \
    _Pragma("unroll") for (int d = 0; d < 4; ++d) _Pragma("unroll") for (int r = 0; r < 16; ++r) o[d][r] *= al_l[crow(r, hi)]; } } while (0)
#define MASK(P0, P1, tile) do { if constexpr (CAUSAL) { if ((tile) >= diag0) causal_mask(P0, P1, (tile) - diag0, wid * QBLK + r32, hi); } } while (0)
    f32x16 pA0, pA1, pB0, pB1; float mnA, mnB, alA, alB; bf16x8 pa0, pa1, pa2, pa3;
    constexpr int SE = 0, SO = SD - 1;
    SLOAD(SE, 0); asm volatile("s_waitcnt vmcnt(0)" ::: "memory"); SWRITE(0, SE); __syncthreads();
    qkt<DQK>(pA0, pA1, K_lds, Kr_lds, qr, qrl, r32, hi); MASK(pA0, pA1, 0); partialSM<DQK>(pA0, pA1, m_reg, mnA, alA);
    SLOAD(SO, KVBLK); if constexpr (SD == 2) { if (2 < NT) SLOAD(SE, 2 * KVBLK); }
    SWAIT(); SWRITE(1, SO); __syncthreads();
    for (int j = 1; j + 1 < NT; j += 2) {
        SBAR(); qkt<DQK>(pB0, pB1, K_lds + SHM_K, Kr_lds + SHM_KR, qr, qrl, r32, hi); MASK(pB0, pB1, j);
        finishSM(pA0, pA1, alA, l_reg, pa0, pa1, pa2, pa3); SBAR();
        SLOAD(SO, (j + SD) * KVBLK); SBAR();
        pv_d0(o, vb0, pa0, pa1, pa2, pa3); partialSM<DQK>(pB0, pB1, m_reg, mnB, alB);
        __syncthreads(); SWAIT(); SWRITE(0, SE);
        RESC(alB); __syncthreads();
        SBAR(); qkt<DQK>(pA0, pA1, K_lds, Kr_lds, qr, qrl, r32, hi); MASK(pA0, pA1, j + 1);
        finishSM(pB0, pB1, alB, l_reg, pa0, pa1, pa2, pa3); SBAR();
        if (SD == 1 || j + 3 < NT) SLOAD(SE, (j + 1 + SD) * KVBLK); SBAR();
        pv_d0(o, vb0 + SHM_V, pa0, pa1, pa2, pa3); partialSM<DQK>(pA0, pA1, m_reg, mnA, alA);
        __syncthreads(); SWAIT(); SWRITE(1, SO);
        RESC(alA); __syncthreads();
    }
    SBAR(); qkt<DQK>(pB0, pB1, K_lds + SHM_K, Kr_lds + SHM_KR, qr, qrl, r32, hi); MASK(pB0, pB1, NT - 1);
    finishSM(pA0, pA1, alA, l_reg, pa0, pa1, pa2, pa3); SBAR();
    pv_d0(o, vb0, pa0, pa1, pa2, pa3); partialSM<DQK>(pB0, pB1, m_reg, mnB, alB);
    __syncthreads(); RESC(alB);
    finishSM(pB0, pB1, alB, l_reg, pa0, pa1, pa2, pa3); SBAR();
    pv_d0(o, vb0 + SHM_V, pa0, pa1, pa2, pa3);
    if (hi == 0) li_l[r32] = l_reg; asm volatile("s_waitcnt lgkmcnt(0)" ::: "memory");
    float rli[16];
#pragma unroll
    for (int r = 0; r < 16; ++r) rli[r] = __builtin_amdgcn_rcpf(li_l[crow(r, hi)]);
    { LAS uchar* ot = lds + OFF_QR + wid * 4096; const int orow = lane >> 1, ocb = (lane & 1) * 32; const size_t grow = (size_t)(wid * QBLK + orow);
#pragma unroll
      for (int hf = 0; hf < 2; ++hf) {
#pragma unroll
          for (int r = 0; r < 16; ++r)
#pragma unroll
              for (int dd = 0; dd < 2; ++dd) *(LAS bf16_t*)(ot + crow(r, hi) * 128 + (dd * 32 + r32) * 2) = (bf16_t)(cvt_pk_bf16(o[2 * hf + dd][r] * rli[r], 0.f) & 0xffffu);
          asm volatile("s_waitcnt lgkmcnt(0)" ::: "memory");
#pragma unroll
          for (int c = 0; c < 4; ++c) { const u32x4 ov = *(const LAS u32x4*)(ot + orow * 128 + ocb * 2 + c * 16); const u32x4 gv = *(const u32x4*)(gate + grow * LDZ + hf * 64 + ocb + c * 8);
              float of[8], gf[8]; unpack8(ov, of); unpack8(gv, gf);
#pragma unroll
              for (int q = 0; q < 8; ++q) of[q] *= silu(gf[q]);
              *(u32x4*)(outp + grow * OUTW + hf * 64 + ocb + c * 8) = pack8(of); }
          asm volatile("s_waitcnt lgkmcnt(0)" ::: "memory"); } }
#undef SLOAD
#undef SWRITE
#undef SWAIT
#undef RESC
#undef MASK
}
}
namespace dec {
constexpr int BUFB = 40960, OFF_KR = 32768, OFF_WS = 2 * BUFB, LDS_BYTES = OFF_WS + 8 * 64 * 4 + 32 * 640 + 64;
__device__ __forceinline__ unsigned off_b(unsigned row, unsigned ch) { return 256u * row + 16u * (ch ^ (((row & 3) << 2) | ((row >> 2) & 3))); }
__device__ __forceinline__ unsigned row_read_addr(unsigned lane, unsigned s) { return off_b(lane & 31, 2 * s + (lane >> 5)); }
__device__ __forceinline__ unsigned tr_read_addr(unsigned lane, unsigned c, unsigned ks, unsigned t) {
    const unsigned h = lane >> 5, blk = (lane >> 4) & 1, q = (lane & 15) >> 2, p = lane & 3;
    return off_b(16 * ks + 8 * h + 4 * t + q, 4 * c + 2 * blk + (p >> 1)) + 8 * (p & 1);
}
__device__ __forceinline__ s16x4 tr_rd(unsigned addr) { s16x4 r; asm volatile("ds_read_b64_tr_b16 %0, %1" : "=&v"(r) : "v"(addr) : "memory"); return r; }

__device__ __forceinline__ void partialSM1(f32x16& p0, float& m_reg, float& alpha) {
    constexpr float SCALE = att::Cst<192>::SCALE, C = SCALE * 1.4426950408889634f;
    float pmax = p0[0];
#pragma unroll
    for (int r = 1; r < 16; ++r) pmax = fmaxf(pmax, p0[r]);
    { auto rr = __builtin_amdgcn_permlane32_swap(__float_as_uint(pmax), __float_as_uint(pmax), false, false);
      pmax = fmaxf(__uint_as_float(rr[0]), __uint_as_float(rr[1])); }
    float mn;
    if (__builtin_expect(__all(pmax - m_reg <= att::THR / SCALE), 1)) { mn = m_reg; alpha = 1.f; }
    else { mn = fmaxf(m_reg, pmax); alpha = __builtin_amdgcn_exp2f((m_reg - mn) * C); m_reg = mn; }
    const float mnC = -mn * C;
#pragma unroll
    for (int r = 0; r < 16; ++r) p0[r] = __builtin_amdgcn_exp2f(fmaf(p0[r], C, mnC));
}
__device__ __forceinline__ void finishSM1(const f32x16& p0, float alpha, float& l_reg, bf16x8& pa0, bf16x8& pa1) {
    float ps = 0;
#pragma unroll
    for (int r = 0; r < 16; ++r) ps += p0[r];
    { auto rr = __builtin_amdgcn_permlane32_swap(__float_as_uint(ps), __float_as_uint(ps), false, false);
      ps = __uint_as_float(rr[0]) + __uint_as_float(rr[1]); }
    l_reg = l_reg * alpha + ps;
#define PK4(P, BASE, OUT) do { unsigned a0 = cvt_pk_bf16(P[BASE + 0], P[BASE + 1]), a1 = cvt_pk_bf16(P[BASE + 2], P[BASE + 3]);   \
    unsigned b0 = cvt_pk_bf16(P[BASE + 4], P[BASE + 5]), b1 = cvt_pk_bf16(P[BASE + 6], P[BASE + 7]);                              \
    auto r0 = __builtin_amdgcn_permlane32_swap(a0, b0, false, false); auto r1 = __builtin_amdgcn_permlane32_swap(a1, b1, false, false); \
    u32x4 w = {r0[0], r1[0], r0[1], r1[1]}; OUT = *reinterpret_cast<bf16x8*>(&w); } while (0)
    PK4(p0, 0, pa0); PK4(p0, 8, pa1);
#undef PK4
}

constexpr int OFF_Q = OFF_WS + 8 * 64 * 4;
__device__ __forceinline__ void decode_unit(const bf16_t* __restrict__ Qd, const float* __restrict__ cckv, const float* __restrict__ ckr, const int* __restrict__ pt,
                                            float* __restrict__ Opart, float* __restrict__ ML, LAS uchar* lds) {
    int tid_ = threadIdx.x; asm volatile("" : "+v"(tid_));
    const int tid = tid_, wid = tid >> 6, lane = tid & 63, r32 = lane & 31, hi = lane >> 5, kb = wid & 1, dq = wid >> 1;
    LAS float* al_l = (LAS float*)(lds + OFF_WS) + wid * 64;
    for (int c = tid; c < 32 * 40; c += 512) { const int r = c / 40, ch = c - r * 40; *(LAS u32x4*)(lds + OFF_Q + r * 640 + ((ch ^ (r & 7)) << 4)) = *(const u32x4*)(Qd + (size_t)r * 320 + ch * 8); }
    LAS int* pgs = (LAS int*)(lds + OFF_Q + 32 * 640);
    if (tid < 16) pgs[tid] = pt[tid];
    __syncthreads();
    const LAS uchar* qb = lds + OFF_Q + r32 * 640; const int qsw = r32 & 7;
    float m_reg = -1e30f, l_reg = 0.f; f32x16 o0 = {}, o1 = {};
    f32x4 svA[10], svB[10];
    const int kc = lane & 15, kq = lane >> 4;
    const unsigned wck = (unsigned)((lane >> 5) * 2 * 8192) + ((lane & 1) << 3);
    const unsigned ldsb = (unsigned)(uintptr_t)lds;
    const int pw = dq >> 1, cw0 = (dq & 1) * 2;
    const unsigned tra[2][2][2] = {{{tr_read_addr(lane, cw0, 0, 0), tr_read_addr(lane, cw0, 0, 1)}, {tr_read_addr(lane, cw0, 1, 0), tr_read_addr(lane, cw0, 1, 1)}},
                                   {{tr_read_addr(lane, cw0 + 1, 0, 0), tr_read_addr(lane, cw0 + 1, 0, 1)}, {tr_read_addr(lane, cw0 + 1, 1, 0), tr_read_addr(lane, cw0 + 1, 1, 1)}}};
#define DLOAD(sv, j) do { const int page = pgs[(j) >> 1]; const size_t krow = (size_t)page * 128 + ((j) & 1) * 64 + wid * 8; \
    const float* s0 = cckv + krow * 256 + 4 * lane; const float* s1 = ckr + (krow + kq) * 64 + 4 * kc; \
    _Pragma("unroll") for (int i = 0; i < 8; ++i) sv[i] = __builtin_nontemporal_load((const f32x4*)(s0 + i * 256)); \
    sv[8] = __builtin_nontemporal_load((const f32x4*)s1); sv[9] = __builtin_nontemporal_load((const f32x4*)(s1 + 4 * 64)); } while (0)
#define DWRITE(sv, b) do { _Pragma("unroll") for (int i = 0; i < 8; ++i) { const int key = wid * 8 + i; u32x2 w; w.x = cvt_pk_bf16(sv[i][0], sv[i][1]); w.y = cvt_pk_bf16(sv[i][2], sv[i][3]); \
        *(LAS u32x2*)(lds + (b) * BUFB + wck + (key >> 5) * 8192 + off_b(key & 31, (lane & 31) >> 1)) = w; } \
    _Pragma("unroll") for (int i = 0; i < 2; ++i) { const int key = wid * 8 + kq + 4 * i; u32x2 w; w.x = cvt_pk_bf16(sv[8 + i][0], sv[8 + i][1]); w.y = cvt_pk_bf16(sv[8 + i][2], sv[8 + i][3]); \
        *(LAS u32x2*)(lds + (b) * BUFB + OFF_KR + key * 128 + (((kc >> 1) ^ (key & 7)) << 4) + ((kc & 1) << 3)) = w; } } while (0)
#define DCOMPUTE(b) do { const LAS uchar* B = lds + (b) * BUFB; f32x16 p0 = {}; \
      \
    _Pragma("unroll") for (int s0 = 0; s0 < 16; s0 += 4) { bf16x8 kf[4], qf[4]; \
        _Pragma("unroll") for (int i = 0; i < 4; ++i) { const int s = s0 + i; qf[i] = *(const LAS bf16x8*)(qb + (((2 * s + hi) ^ qsw) << 4)); \
            kf[i] = *(const LAS bf16x8*)(B + ((s >> 3) * 2 + kb) * 8192 + row_read_addr(lane, s & 7)); } \
        asm volatile("" ::: "memory"); \
        _Pragma("unroll") for (int i = 0; i < 4; ++i) p0 = __builtin_amdgcn_mfma_f32_32x32x16_bf16(kf[i], qf[i], p0, 0, 0, 0); \
        asm volatile("" ::: "memory"); } \
    { bf16x8 kf[4], qf[4]; \
        _Pragma("unroll") for (int s = 0; s < 4; ++s) { const int chk = 2 * s + hi; qf[s] = *(const LAS bf16x8*)(qb + (((32 + 2 * s + hi) ^ qsw) << 4)); \
            kf[s] = *(const LAS bf16x8*)(B + OFF_KR + (kb * 32 + r32) * 128 + ((chk ^ (r32 & 7)) << 4)); } \
        asm volatile("" ::: "memory"); \
        _Pragma("unroll") for (int s = 0; s < 4; ++s) p0 = __builtin_amdgcn_mfma_f32_32x32x16_bf16(kf[s], qf[s], p0, 0, 0, 0); } \
    float alpha; partialSM1(p0, m_reg, alpha); \
    if (__any(alpha < 1.f)) { if (hi == 0) al_l[r32] = alpha; asm volatile("s_waitcnt lgkmcnt(0)" ::: "memory"); \
        _Pragma("unroll") for (int r = 0; r < 16; ++r) { const float a = al_l[crow(r, hi)]; o0[r] *= a; o1[r] *= a; } } \
    bf16x8 pa[2]; finishSM1(p0, alpha, l_reg, pa[0], pa[1]); \
    const unsigned vb = ldsb + (b) * BUFB + (pw * 2 + kb) * 8192; s16x4 vl[2][2], vh[2][2]; \
    _Pragma("unroll") for (int dd = 0; dd < 2; ++dd) _Pragma("unroll") for (int ks = 0; ks < 2; ++ks) { vl[dd][ks] = tr_rd(vb + tra[dd][ks][0]); vh[dd][ks] = tr_rd(vb + tra[dd][ks][1]); } \
    asm volatile("s_waitcnt lgkmcnt(0)" ::: "memory"); __builtin_amdgcn_sched_barrier(0); \
    _Pragma("unroll") for (int ks = 0; ks < 2; ++ks) { \
        o0 = __builtin_amdgcn_mfma_f32_32x32x16_bf16(pa[ks], ((bf16x8){vl[0][ks][0], vl[0][ks][1], vl[0][ks][2], vl[0][ks][3], vh[0][ks][0], vh[0][ks][1], vh[0][ks][2], vh[0][ks][3]}), o0, 0, 0, 0); \
        o1 = __builtin_amdgcn_mfma_f32_32x32x16_bf16(pa[ks], ((bf16x8){vl[1][ks][0], vl[1][ks][1], vl[1][ks][2], vl[1][ks][3], vh[1][ks][0], vh[1][ks][1], vh[1][ks][2], vh[1][ks][3]}), o1, 0, 0, 0); } } while (0)
    constexpr int NT = 32;
    DLOAD(svA, 0); DLOAD(svB, 1); DWRITE(svA, 0); DLOAD(svA, 2); __syncthreads();
    for (int j = 0; j < NT; j += 2) {
        DCOMPUTE(0);
        DWRITE(svB, 1);
        { const int jn = (j + 3 < NT) ? j + 3 : NT - 1; DLOAD(svB, jn); }
        __syncthreads();
        DCOMPUTE(1);
        DWRITE(svA, 0);
        { const int jn = (j + 4 < NT) ? j + 4 : NT - 1; DLOAD(svA, jn); }
        __syncthreads();
    }
#undef DLOAD
#undef DWRITE
#undef DCOMPUTE
    LAS float* mlx = (LAS float*)lds + dq * 64;
    LAS float* ox = (LAS float*)(lds + 4096) + dq * 2048;
    if (kb == 1) { if (hi == 0) { mlx[r32 * 2] = m_reg; mlx[r32 * 2 + 1] = l_reg; }
#pragma unroll
        for (int r = 0; r < 16; ++r) { ox[crow(r, hi) * 32 + r32] = o0[r]; ox[1024 + crow(r, hi) * 32 + r32] = o1[r]; } }
    __syncthreads();
    if (kb == 0) { constexpr float C = att::Cst<192>::SCALE * 1.4426950408889634f;
        const float m1 = mlx[r32 * 2], l1 = mlx[r32 * 2 + 1], M = fmaxf(m_reg, m1), w0 = __builtin_amdgcn_exp2f((m_reg - M) * C), w1 = __builtin_amdgcn_exp2f((m1 - M) * C), L = l_reg * w0 + l1 * w1;
        if (hi == 0) { al_l[r32] = w0; al_l[32 + r32] = w1; } asm volatile("s_waitcnt lgkmcnt(0)" ::: "memory");
        if (dq == 0 && hi == 0) { ML[r32 * 2] = M; ML[r32 * 2 + 1] = L; }
#pragma unroll
        for (int r = 0; r < 16; ++r) { const int row = crow(r, hi); const float a0 = al_l[row], a1 = al_l[32 + row];
            Opart[(size_t)row * 256 + dq * 64 + r32] = o0[r] * a0 + ox[row * 32 + r32] * a1; Opart[(size_t)row * 256 + dq * 64 + 32 + r32] = o1[r] * a0 + ox[1024 + row * 32 + r32] * a1; } }
}

__device__ __forceinline__ void combine_row(int b, int row32, int lane, const bf16_t* __restrict__ Qdec, const float* __restrict__ Opart, const float* __restrict__ ML,
                                            const float* __restrict__ ckvn, const float* __restrict__ krn, bf16_t* __restrict__ olat) {
    constexpr float C = 0.07216878364870322f * 1.4426950408889634f;
    const int t = row32 >> 3, h = row32 & 7;
    const bf16_t* q = Qdec + ((size_t)b * 32 + row32) * 320;
    const u32x2 qw = *(const u32x2*)(q + 4 * lane); const float q0 = bf_lo(qw.x), q1 = bf_hi(qw.x), q2 = bf_lo(qw.y), q3 = bf_hi(qw.y); const float qrp = bf2f(q[256 + lane]);
    float sj[4]; f32x4 cn[4];
#pragma unroll
    for (int j = 0; j < 4; ++j) { cn[j] = *(const f32x4*)(ckvn + ((size_t)b * 4 + j) * 256 + 4 * lane); float s = q0 * cn[j][0] + q1 * cn[j][1] + q2 * cn[j][2] + q3 * cn[j][3] + qrp * krn[((size_t)b * 4 + j) * 64 + lane];
#pragma unroll
        for (int o = 32; o >= 1; o >>= 1) s += __shfl_xor(s, o);
        sj[j] = (j <= t) ? s : -1e30f; }
    float mc[8], lc[8], M = fmaxf(fmaxf(sj[0], sj[1]), fmaxf(sj[2], sj[3]));
#pragma unroll
    for (int c = 0; c < 8; ++c) { const f32x2 ml = *(const f32x2*)(ML + (((size_t)b * 8 + c) * 32 + row32) * 2); mc[c] = ml.x; lc[c] = ml.y; M = fmaxf(M, mc[c]); }
    float L = 0.f; f32x4 acc = {0.f, 0.f, 0.f, 0.f};
#pragma unroll
    for (int c = 0; c < 8; ++c) { const float w = __builtin_amdgcn_exp2f((mc[c] - M) * C); L += lc[c] * w; acc += *(const f32x4*)(Opart + (((size_t)b * 8 + c) * 32 + row32) * 256 + 4 * lane) * w; }
#pragma unroll
    for (int j = 0; j < 4; ++j) { const float e = (j <= t) ? __builtin_amdgcn_exp2f((sj[j] - M) * C) : 0.f; L += e; acc += cn[j] * e; }
    const float rl = 1.0f / L; u32x2 w; w.x = cvt_pk_bf16(acc[0] * rl, acc[1] * rl); w.y = cvt_pk_bf16(acc[2] * rl, acc[3] * rl);
    *(u32x2*)(olat + ((size_t)b * 4 + t) * 2048 + h * 256 + 4 * lane) = w;
}

constexpr int SMEM_LDS = 4096 + 32768;
__device__ __forceinline__ void smem_unit(const bf16_t* __restrict__ Zq  , const bf16_t* __restrict__ Zg  , const float* __restrict__ Kc, const float* __restrict__ Vc  ,
                                          bf16_t* __restrict__ outp  , LAS uchar* lds) {
    int tid_ = threadIdx.x; asm volatile("" : "+v"(tid_));
    const int tid = tid_, wid = tid >> 6, lane = tid & 63, l32 = lane & 31, hi = lane >> 5;
    LAS float* sc = (LAS float*)lds; LAS float* red = (LAS float*)(lds + 4096);
    float qv[4][4];
#pragma unroll
    for (int t = 0; t < 4; ++t) { const u32x2 w = *(const u32x2*)(Zq + (size_t)t * LDZ + 4 * l32); qv[t][0] = bf_lo(w.x); qv[t][1] = bf_hi(w.x); qv[t][2] = bf_lo(w.y); qv[t][3] = bf_hi(w.y); }
    f32x4 kreg[16], vreg[16]; const int d4 = (tid & 31) * 4, mg = tid >> 5;
#pragma unroll
    for (int i = 0; i < 16; ++i) kreg[i] = *(const f32x4*)(Kc + (size_t)(wid * 32 + 2 * i + hi) * 512 + 4 * l32);
#pragma unroll
    for (int mm = 0; mm < 16; ++mm) vreg[mm] = *(const f32x4*)(Vc + (size_t)(mg * 16 + mm) * 512 + d4);
#pragma unroll
    for (int i = 0; i < 16; ++i) { const int m = wid * 32 + 2 * i + hi; const f32x4 kv = kreg[i]; float p[4];
#pragma unroll
        for (int t = 0; t < 4; ++t) { p[t] = kv[0] * qv[t][0] + kv[1] * qv[t][1] + kv[2] * qv[t][2] + kv[3] * qv[t][3];
#pragma unroll
            for (int o = 16; o >= 1; o >>= 1) p[t] += __shfl_xor(p[t], o); }
        if (l32 == 0) {
#pragma unroll
            for (int t = 0; t < 4; ++t) sc[t * 256 + m] = p[t] * 0.08838834764831845f; } }
    __syncthreads();
    if (wid < 4) { float v[4], mx = -1e30f;
#pragma unroll
        for (int i = 0; i < 4; ++i) { v[i] = sc[wid * 256 + lane + 64 * i]; mx = fmaxf(mx, v[i]); }
#pragma unroll
        for (int o = 32; o >= 1; o >>= 1) mx = fmaxf(mx, __shfl_xor(mx, o));
        float s = 0.f;
#pragma unroll
        for (int i = 0; i < 4; ++i) { v[i] = __expf(v[i] - mx); s += v[i]; }
#pragma unroll
        for (int o = 32; o >= 1; o >>= 1) s += __shfl_xor(s, o);
        const float rs = 1.0f / s;
#pragma unroll
        for (int i = 0; i < 4; ++i) sc[wid * 256 + lane + 64 * i] = v[i] * rs; }
    __syncthreads();
    { f32x4 a[4] = {};
#pragma unroll
      for (int mm = 0; mm < 16; ++mm) { const int m = mg * 16 + mm; const f32x4 vv = vreg[mm];
#pragma unroll
          for (int t = 0; t < 4; ++t) a[t] += vv * sc[t * 256 + m]; }
#pragma unroll
      for (int t = 0; t < 4; ++t) *(LAS f32x4*)(red + (mg * 4 + t) * 128 + d4) = a[t]; }
    __syncthreads();
    { const int t = tid >> 7, d = tid & 127; float s = 0.f;
#pragma unroll
      for (int mg = 0; mg < 16; ++mg) s += red[(mg * 4 + t) * 128 + d];
      const float g = bf2f(Zg[(size_t)t * LDZ + d]);
      outp[(size_t)t * OUTW + d] = (bf16_t)(cvt_pk_bf16(s * silu(g), 0.f) & 0xffffu); }
    __syncthreads();
}
}
namespace ew {
__device__ __forceinline__ int otid() { int t = threadIdx.x; asm volatile("" : "+v"(t)); return t; }
struct TJ { const float* src; int sld, K, ncols; const float* gain; const float* cscale; bf16_t* dst; int dld; };
constexpr int NTJ = 32;
__device__ __forceinline__ TJ get_tj(int j, const float* const* in, uchar* ws) {
    TJ t; t.gain = nullptr; t.cscale = nullptr;
    bf16_t* WINA = (bf16_t*)(ws + WS_WINA); bf16_t* WGRP = (bf16_t*)(ws + WS_WGRP); bf16_t* WINB = (bf16_t*)(ws + WS_WINB); bf16_t* WQUP = (bf16_t*)(ws + WS_WQUP);
    bf16_t* WKV = (bf16_t*)(ws + WS_WKV); bf16_t* WMEM = (bf16_t*)(ws + WS_WMEM); bf16_t* WOUT = (bf16_t*)(ws + WS_WOUT);
    if (j < 2) { t.src = in[10] + (size_t)j * DM * INA; t.sld = INA; t.K = DM; t.ncols = INA; t.gain = in[9] + j * DM; t.dst = WINA + (size_t)j * INA * DM; t.dld = DM; }
    else if (j < 10) { const int i = j - 2; t.src = in[11] + (size_t)i * 65536; t.sld = 256; t.K = 256; t.ncols = 256; t.cscale = in[12] + i * 256; t.dst = WGRP + (size_t)i * 65536; t.dld = 256; }
    else if (j < 12) { const int i = j - 10; t.src = in[13] + (size_t)i * DM * INB; t.sld = INB; t.K = DM; t.ncols = QRANK; t.gain = in[9] + (2 + i) * DM; t.dst = WINB + (size_t)i * NB2 * DM; t.dld = DM; }
    else if (j < 14) { const int i = j - 12; t.src = in[13] + (size_t)i * DM * INB + QRANK; t.sld = INB; t.K = DM; t.ncols = INB - QRANK; t.gain = in[9] + (2 + i) * DM; t.dst = WINB + ((size_t)i * NB2 + ZB_GT) * DM; t.dld = DM; }
    else if (j == 14) { t.src = in[17] + KVR; t.sld = 320; t.K = DM; t.ncols = ROPE; t.gain = in[16]; t.dst = WINB + (size_t)ZB_KR * DM; t.dld = DM; }
    else if (j == 15) { t.src = in[17]; t.sld = 320; t.K = DM; t.ncols = KVR; t.gain = in[16]; t.dst = WINB + (size_t)ZB_KV * DM; t.dld = DM; }
    else if (j < 18) { const int i = j - 16; t.src = in[15] + (size_t)i * QRANK * QW; t.sld = QW; t.K = QRANK; t.ncols = QW; t.gain = in[14] + i * QRANK; t.dst = WQUP + (size_t)i * QW * QRANK; t.dld = QRANK; }
    else if (j == 18) { t.src = in[19]; t.sld = 1024; t.K = 256; t.ncols = 1024; t.dst = WKV; t.dld = 256; }
    else if (j == 19) { t.src = in[20]; t.sld = 1024; t.K = 256; t.ncols = 1024; t.dst = WKV + (size_t)1024 * 256; t.dld = 256; }
    else if (j < 28) { const int i = j - 20, l = i >> 1, kv = i & 1; t.src = (kv ? in[23] : in[22]) + (size_t)l * DM * MEMW; t.sld = MEMW; t.K = DM; t.ncols = MEMW; t.gain = in[21] + l * DM; t.dst = WMEM + (size_t)(l * 2 + kv) * MEMW * DM; t.dld = DM; }
    else { const int l = j - 28; t.src = in[24] + (size_t)l * OUTW * DM; t.sld = DM; t.K = OUTW; t.ncols = DM; t.dst = WOUT + (size_t)l * DM * OUTW; t.dld = OUTW; }
    return t;
}
__device__ __forceinline__ int tj_tiles(int j) {
    if (j < 2) return 16 * 48; if (j < 10) return 16; if (j < 12) return 16 * 6; if (j < 14) return 16 * 32; if (j == 14) return 16; if (j == 15) return 64;
    if (j < 18) return 6 * 24; if (j < 20) return 4 * 16; if (j < 28) return 16 * 8; return 24 * 16;
}
constexpr int TJ_TOTAL = 2 * 768 + 8 * 16 + 2 * 96 + 2 * 512 + 16 + 64 + 2 * 144 + 2 * 64 + 8 * 128 + 4 * 384;
__device__ __forceinline__ void tt_load(const TJ& t, int tile, int tid, f32x4& a, f32x4& b) {
    const int nkt = t.K / 64, kt = tile % nkt, nt = tile / nkt, k0 = kt * 64, n0 = nt * 64;
    const int k = tid >> 3, n8 = (tid & 7) * 8; const float* s = t.src + (size_t)(k0 + k) * t.sld + n0 + n8; const float g = t.gain ? t.gain[k0 + k] : 1.0f;
    a = *(const f32x4*)s * g; b = *(const f32x4*)(s + 4) * g;
}
__device__ __forceinline__ void tt_store(const TJ& t, int tile, LAS float* tl, int tid, const f32x4 a, const f32x4 b) {
    const int nkt = t.K / 64, kt = tile % nkt, nt = tile / nkt, k0 = kt * 64, n0 = nt * 64;
    { const int k = tid >> 3, n8 = (tid & 7) * 8;
#pragma unroll
      for (int j = 0; j < 4; ++j) { tl[k * 65 + n8 + j] = a[j]; tl[k * 65 + n8 + 4 + j] = b[j]; } }
    __syncthreads();
    { const int n = tid >> 3, k8 = (tid & 7) * 8; const float cs = t.cscale ? t.cscale[n0 + n] : 1.0f; float v[8];
#pragma unroll
      for (int j = 0; j < 8; ++j) v[j] = tl[(k8 + j) * 65 + n] * cs;
      *(u32x4*)(t.dst + (size_t)(n0 + n) * t.dld + k0 + k8) = pack8(v); }
    __syncthreads();
}
__device__ __forceinline__ void tj_of(int gt, int& j, int& r) { j = 0; r = gt; for (; j < NTJ; ++j) { const int n = tj_tiles(j); if (r < n) break; r -= n; } }
__device__ __forceinline__ void sincos_d(float angf, float& c, float& s) {
    const double x = (double)angf; const double kd = rint(x * 0.63661977236758134308); const int q = (int)((long long)kd & 3);
    double r = fma(-kd, 1.57079632679489655800e+00, x); r = fma(-kd, 6.12323399573676603587e-17, r);
    const double r2 = r * r;
    double sp = -7.6471637318198164759e-13; sp = fma(sp, r2, 1.6059043836821614599e-10); sp = fma(sp, r2, -2.5052108385441718775e-08); sp = fma(sp, r2, 2.7557319223985890653e-06);
    sp = fma(sp, r2, -1.9841269841269841270e-04); sp = fma(sp, r2, 8.3333333333333333333e-03); sp = fma(sp, r2, -1.6666666666666666667e-01); const double sn = fma(sp * r2, r, r);
    double cp = 4.7794773323873852974e-14; cp = fma(cp, r2, -1.1470745597729724714e-11); cp = fma(cp, r2, 2.0876756987868098979e-09); cp = fma(cp, r2, -2.7557319223985890653e-07);
    cp = fma(cp, r2, 2.4801587301587301587e-05); cp = fma(cp, r2, -1.3888888888888888889e-03); cp = fma(cp, r2, 4.1666666666666666667e-02); cp = fma(cp, r2, -0.5); const double cn = fma(cp, r2, 1.0);
    const double ss = (q == 0) ? sn : (q == 1) ? cn : (q == 2) ? -sn : -cn, cc = (q == 0) ? cn : (q == 1) ? -sn : (q == 2) ? -cn : sn;
    c = (float)cc; s = (float)ss;
}

__device__ __forceinline__ void prologue(const float* const* in, float* out, uchar* ws, LAS uchar* lds, int G, int bid) {
    const int tid = otid(), lane = tid & 63, wid = tid >> 6;
    { const int wv = __builtin_amdgcn_readfirstlane(tid >> 6); LAS float* tl = (LAS float*)(lds + wv * (64 * 68 * 4)); const int kr = lane >> 4, c4 = (lane & 15) * 4;
      const int tq = TJ_TOTAL / G, trm = TJ_TOTAL % G, tlo = bid * tq + (bid < trm ? bid : trm), thi = tlo + tq + (bid < trm ? 1 : 0);
      int gt = tlo + wv; const int gs = 8;
      if (gt < thi) { int j, r; tj_of(gt, j, r); TJ t = get_tj(j, in, ws); f32x4 v[16];
#define TT_LOAD(T, R) do { const int nnt_ = (T).ncols / 64, n0_ = ((R) % nnt_) * 64, k0_ = ((R) / nnt_) * 64; const float* s_ = (T).src + (size_t)(k0_ + kr) * (T).sld + n0_ + c4; \
          _Pragma("unroll") for (int i = 0; i < 16; ++i) v[i] = *(const f32x4*)(s_ + (size_t)(4 * i) * (T).sld); } while (0)
          TT_LOAD(t, r);
          for (;;) {
#pragma unroll
              for (int i = 0; i < 16; ++i) { LAS float* w = tl + (4 * i + kr) * 65 + c4; w[0] = v[i][0]; w[1] = v[i][1]; w[2] = v[i][2]; w[3] = v[i][3]; }
              const int gn = gt + gs; const bool more = gn < thi; TJ tn = t; int rn = r;
              if (more) { int jn; tj_of(gn, jn, rn); tn = get_tj(jn, in, ws); TT_LOAD(tn, rn); }
              { const int nnt = t.ncols / 64, n0 = (r % nnt) * 64, k0 = (r / nnt) * 64, kc = (lane >> 3) * 8, nl = lane & 7;
                f32x4 g0 = {1.f, 1.f, 1.f, 1.f}, g1 = g0; if (t.gain) { g0 = *(const f32x4*)(t.gain + k0 + kc); g1 = *(const f32x4*)(t.gain + k0 + kc + 4); }
                asm volatile("s_waitcnt lgkmcnt(0)" ::: "memory");
#pragma unroll
                for (int i = 0; i < 8; ++i) { const int n = 8 * i + nl; const float cs = t.cscale ? t.cscale[n0 + n] : 1.0f; float o[8];
#pragma unroll
                    for (int e = 0; e < 8; ++e) o[e] = tl[(kc + e) * 65 + n] * (e < 4 ? g0[e & 3] : g1[e & 3]) * cs;
                    *(u32x4*)(t.dst + (size_t)(n0 + n) * t.dld + k0 + kc) = pack8(o); } }
              if (!more) break;
              t = tn; r = rn; gt = gn;
          }
#undef TT_LOAD
      } }
#ifdef TP_A
    if (bid == 0 && tid == 0) ((volatile LAS unsigned*)(lds + 136 * 1024))[48] = (unsigned)__builtin_amdgcn_s_memrealtime();
#endif
    const size_t gtid = (size_t)bid * 512 + tid, gstride = (size_t)G * 512;
    { bf16_t* WINB = (bf16_t*)(ws + WS_WINB);
      for (size_t i = gtid; i < (size_t)(64 + 128) * DM / 8; i += gstride) { const size_t e = i * 8; bf16_t* p = (e < (size_t)64 * DM) ? WINB + (size_t)448 * DM + e : WINB + ((size_t)NB2 + 384) * DM + (e - (size_t)64 * DM);
          *(u32x4*)p = (u32x4){0u, 0u, 0u, 0u}; }
      bf16_t* WKUPN = (bf16_t*)(ws + WS_WKUPN);
      for (size_t i = gtid; i < (size_t)256 * 1024 / 8; i += gstride) { const float* s = in[19] + i * 8; const f32x4 a = *(const f32x4*)s, b = *(const f32x4*)(s + 4);
          const float v[8] = {a[0], a[1], a[2], a[3], b[0], b[1], b[2], b[3]}; *(u32x4*)(WKUPN + i * 8) = pack8(v); } }
#ifdef TP_A
    if (bid == 0 && tid == 0) ((volatile LAS unsigned*)(lds + 136 * 1024))[49] = (unsigned)__builtin_amdgcn_s_memrealtime();
#endif
    { bf16_t* XB = (bf16_t*)(ws + WS_XB); bf16_t* MH = (bf16_t*)(ws + WS_MHAT); float* ssp = (float*)(ws + WS_SSP); float* ssps = (float*)(ws + WS_SSPS);
      const int nrows = PM + SM + 2048;
      for (int row = bid * 8 + wid; row < nrows; row += G * 8) {
          const float* src = row < PM ? in[0] + (size_t)row * DM : row < PM + SM ? in[1] + (size_t)(row - PM) * DM : in[8] + (size_t)(row - PM - SM) * DM;
          f32x4 v[4]; float s = 0.f;
#pragma unroll
          for (int i = 0; i < 4; ++i) { v[i] = *(const f32x4*)(src + 256 * i + 4 * lane); s += sum4(v[i] * v[i]); }
#pragma unroll
          for (int o = 32; o >= 1; o >>= 1) s += __shfl_xor(s, o);
          float sc = 1.0f; bf16_t* dst;
          if (row < PM + SM) { dst = XB + (size_t)row * DM; if (row < PM) { if (lane < 16) ssp[(size_t)row * 16 + lane] = lane == 0 ? s : 0.f; } else { if (lane < 32) ssps[(row - PM) * 32 + lane] = lane == 0 ? s : 0.f; } }
          else { dst = MH + (size_t)(row - PM - SM) * DM; sc = rsqrtf(s * (1.0f / 1024.0f) + EPS); }
#pragma unroll
          for (int i = 0; i < 4; ++i) { u32x2 w; w.x = cvt_pk_bf16(v[i][0] * sc, v[i][1] * sc); w.y = cvt_pk_bf16(v[i][2] * sc, v[i][3] * sc); *(u32x2*)(dst + 256 * i + 4 * lane) = w; } } }
#ifdef TP_A
    if (bid == 0 && tid == 0) ((volatile LAS unsigned*)(lds + 136 * 1024))[50] = (unsigned)__builtin_amdgcn_s_memrealtime();
#endif
    { f32x2* tab = (f32x2*)(ws + WS_ROPE);
      for (size_t e = gtid; e < (size_t)2052 * 32; e += gstride) { const int p = (int)(e >> 5), i = (int)(e & 31); const int pos = p < 2048 ? p : PAST + (p - 2048);
          const float inv = (float)exp2(-(double)i * (13.287712379549449 / 32.0)); const float ang = (float)pos * inv; float c, s; sincos_d(ang, c, s); tab[e] = (f32x2){c, s}; } }
#ifdef TP_A
    if (bid == 0 && tid == 0) ((volatile LAS unsigned*)(lds + 136 * 1024))[51] = (unsigned)__builtin_amdgcn_s_memrealtime();
#endif
    { for (size_t e = gtid; e < (size_t)2 * SB * 11 * DM / 4; e += gstride) { const size_t f = e * 4; const int c = (int)(f % DM); const size_t rr = f / DM; const int i = (int)(rr % 11); const size_t lb = rr / 11;
          *(f32x4*)(out + O_PSS + (lb * 15 + i) * DM + c) = *(const f32x4*)(in[2] + (lb * 15 + 4 + i) * DM + c); } }
#ifdef TP_A
    if (bid == 0 && tid == 0) ((volatile LAS unsigned*)(lds + 136 * 1024))[52] = (unsigned)__builtin_amdgcn_s_memrealtime();
#endif
}

template <int W> __device__ __forceinline__ void pool16(const bf16_t* __restrict__ zc, bf16_t* __restrict__ po, float* __restrict__ ps, bool bstart) {
    u32x2 uu[15 + W];
#pragma unroll
    for (int i = 0; i < W - 1; ++i) uu[i] = bstart ? (u32x2){0u, 0u} : *(const u32x2*)(zc - (ptrdiff_t)(W - 1 - i) * LDZ);
#pragma unroll
    for (int k = 0; k < 16; ++k) uu[W - 1 + k] = *(const u32x2*)(zc + (size_t)k * LDZ);
    float s0 = 0.f, s1 = 0.f, s2 = 0.f, s3 = 0.f;
#pragma unroll
    for (int i = 0; i < W - 1; ++i) { s0 += bf_lo(uu[i].x); s1 += bf_hi(uu[i].x); s2 += bf_lo(uu[i].y); s3 += bf_hi(uu[i].y); }
#pragma unroll
    for (int k = 0; k < 16; ++k) { const u32x2 c = uu[W - 1 + k]; const float c0 = bf_lo(c.x), c1 = bf_hi(c.x), c2 = bf_lo(c.y), c3 = bf_hi(c.y);
        s0 += c0; s1 += c1; s2 += c2; s3 += c3;
        const float rn = (bstart && k < W - 1) ? 1.0f / (float)(k + 1) : 1.0f / (float)W;
        u32x2 o; o.x = cvt_pk_bf16(s0 * rn - c0, s1 * rn - c1); o.y = cvt_pk_bf16(s2 * rn - c2, s3 * rn - c3); *(u32x2*)(po + (size_t)k * DM) = o;
        if (ps != nullptr && k >= 1) *(f32x4*)(ps + (size_t)(k - 1) * DM) = (f32x4){c0, c1, c2, c3};
        const u32x2 d = uu[k]; s0 -= bf_lo(d.x); s1 -= bf_hi(d.x); s2 -= bf_lo(d.y); s3 -= bf_hi(d.y); }
}
__device__ __forceinline__ void pool_tile(int l, float* out, uchar* ws, int pm, int g) {
    const bf16_t* Z = (const bf16_t*)(ws + WS_Z); bf16_t* PO = (bf16_t*)(ws + WS_POOLED);
    const int tid = otid(), lane = tid & 63, wid = tid >> 6;
#pragma unroll 1
    for (int blk = wid; blk < 16; blk += 8) { const int r0 = pm * 256 + blk * 16, t0 = r0 & (PT - 1), c4 = g * 256 + lane * 4;
        const bf16_t* zc = Z + (size_t)r0 * LDZ + c4; bf16_t* po = PO + (size_t)r0 * DM + c4; const bool bstart = (t0 == 0);
        float* ps = (t0 == PT - 16) ? out + O_PSP + (((size_t)l * PB + (r0 >> 11)) * 15) * DM + c4 : nullptr;
        if (g == 0) pool16<2>(zc, po, ps, bstart); else if (g == 1) pool16<4>(zc, po, ps, bstart); else if (g == 2) pool16<8>(zc, po, ps, bstart); else pool16<16>(zc, po, ps, bstart); }
}
__device__ __forceinline__ void pool_sample(int l, const float* const* in, float* out, uchar* ws, int G, int bid) {
    const bf16_t* Z = (const bf16_t*)(ws + WS_Z); bf16_t* PO = (bf16_t*)(ws + WS_POOLED);
    const int tid = otid();
    const size_t gtid = (size_t)bid * 512 + tid, gstride = (size_t)G * 512;
    for (size_t idx = gtid; idx < (size_t)SB * 128; idx += gstride) { const int b = (int)(idx >> 7), cv = (int)(idx & 127), g = cv >> 5, w = 2 << g;
        const float* prev = in[2] + ((size_t)l * SB + b) * 15 * DM + cv * 8; const bf16_t* us = Z + ((size_t)PM + b * 4) * LDZ + cv * 8; float x[19][8];
#pragma unroll
        for (int e = 0; e < 15; ++e) { const f32x4 a = *(const f32x4*)(prev + (size_t)e * DM), bb = *(const f32x4*)(prev + (size_t)e * DM + 4);
            x[e][0] = a[0]; x[e][1] = a[1]; x[e][2] = a[2]; x[e][3] = a[3]; x[e][4] = bb[0]; x[e][5] = bb[1]; x[e][6] = bb[2]; x[e][7] = bb[3]; }
#pragma unroll
        for (int t = 0; t < 4; ++t) unpack8(*(const u32x4*)(us + (size_t)t * LDZ), x[15 + t]);
        const float rn = 1.0f / (float)w;
#pragma unroll
        for (int t = 0; t < 4; ++t) { float sm[8] = {0.f, 0.f, 0.f, 0.f, 0.f, 0.f, 0.f, 0.f};
#pragma unroll
            for (int e = 18; e >= 0; --e) { if (e <= 15 + t) { const float m = (e > 15 + t - w) ? 1.0f : 0.0f;
#pragma unroll
                for (int jj = 0; jj < 8; ++jj) sm[jj] = fmaf(m, x[e][jj], sm[jj]); } }
            float o[8];
#pragma unroll
            for (int jj = 0; jj < 8; ++jj) o[jj] = sm[jj] * rn - x[15 + t][jj];
            *(u32x4*)(PO + ((size_t)PM + b * 4 + t) * DM + cv * 8) = pack8(o);
            float* q = out + O_PSS + (((size_t)l * SB + b) * 15 + 11 + t) * DM + cv * 8;
            *(f32x4*)q = (f32x4){x[15 + t][0], x[15 + t][1], x[15 + t][2], x[15 + t][3]}; *(f32x4*)(q + 4) = (f32x4){x[15 + t][4], x[15 + t][5], x[15 + t][6], x[15 + t][7]}; } }
}

__device__ __forceinline__ void pool_sample_grp(int l, const float* const* in, float* out, uchar* ws, int g, bool wstate) {
    const bf16_t* Z = (const bf16_t*)(ws + WS_Z); bf16_t* PO = (bf16_t*)(ws + WS_POOLED);
    const int tid = otid(); const int w = 2 << g; const float rn = 1.0f / (float)w;
#pragma unroll 1
    for (int it = tid; it < SB * 32; it += 512) { const int b = it >> 5, cv = g * 32 + (it & 31);
        const float* prev = in[2] + ((size_t)l * SB + b) * 15 * DM + cv * 8; const bf16_t* us = Z + ((size_t)PM + b * 4) * LDZ + cv * 8; float x[19][8];
#pragma unroll
        for (int e = 0; e < 15; ++e) { const f32x4 a = *(const f32x4*)(prev + (size_t)e * DM), bb = *(const f32x4*)(prev + (size_t)e * DM + 4);
            x[e][0] = a[0]; x[e][1] = a[1]; x[e][2] = a[2]; x[e][3] = a[3]; x[e][4] = bb[0]; x[e][5] = bb[1]; x[e][6] = bb[2]; x[e][7] = bb[3]; }
#pragma unroll
        for (int t = 0; t < 4; ++t) unpack8(*(const u32x4*)(us + (size_t)t * LDZ), x[15 + t]);
#pragma unroll
        for (int t = 0; t < 4; ++t) { float sm[8] = {0.f, 0.f, 0.f, 0.f, 0.f, 0.f, 0.f, 0.f};
#pragma unroll
            for (int e = 18; e >= 0; --e) { if (e <= 15 + t) { const float m = (e > 15 + t - w) ? 1.0f : 0.0f;
#pragma unroll
                for (int jj = 0; jj < 8; ++jj) sm[jj] = fmaf(m, x[e][jj], sm[jj]); } }
            float o[8];
#pragma unroll
            for (int jj = 0; jj < 8; ++jj) o[jj] = sm[jj] * rn - x[15 + t][jj];
            *(u32x4*)(PO + ((size_t)PM + b * 4 + t) * DM + cv * 8) = pack8(o);
            if (wstate) { float* q = out + O_PSS + (((size_t)l * SB + b) * 15 + 11 + t) * DM + cv * 8;
                *(f32x4*)q = (f32x4){x[15 + t][0], x[15 + t][1], x[15 + t][2], x[15 + t][3]}; *(f32x4*)(q + 4) = (f32x4){x[15 + t][4], x[15 + t][5], x[15 + t][6], x[15 + t][7]}; } } }
}

__device__ __forceinline__ void kvpost(const float* const* in, float* out, uchar* ws, int G, int bid) {
    const float* KV = (const float*)(ws + WS_KVRAW); bf16_t* CB = (bf16_t*)(ws + WS_CKVB); bf16_t* KB = (bf16_t*)(ws + WS_KROPEB); const f32x2* tab = (const f32x2*)(ws + WS_ROPE);
    const int tid = otid(), lane = tid & 63, wid = tid >> 6; const f32x4 gl = *(const f32x4*)(in[18] + 4 * lane);
    for (int row = bid * 8 + wid; row < PM + SM; row += G * 8) { const float* p = KV + (size_t)row * 320; const f32x4 v = *(const f32x4*)(p + 4 * lane); float s = sum4(v * v);
#pragma unroll
        for (int o = 32; o >= 1; o >>= 1) s += __shfl_xor(s, o);
        const float rs = rsqrtf(s * (1.0f / 256.0f) + EPS); const f32x4 c = v * rs * gl;
        float* oc = row < PM ? out + O_CKVP + (size_t)row * KVR : out + O_CKVS + (size_t)(row - PM) * KVR; float* ok = row < PM ? out + O_KRP + (size_t)row * ROPE : out + O_KRS + (size_t)(row - PM) * ROPE;
        *(f32x4*)(oc + 4 * lane) = c; u32x2 w; w.x = cvt_pk_bf16(c[0], c[1]); w.y = cvt_pk_bf16(c[2], c[3]); *(u32x2*)(CB + (size_t)row * KVR + 4 * lane) = w;
        if (lane < 32) { const int ti = row < PM ? (row & (PT - 1)) : 2048 + ((row - PM) & 3); const f32x2 cs = tab[(size_t)ti * 32 + lane]; const float x1 = p[256 + lane], x2 = p[288 + lane];
            const float o1 = x1 * cs.x - x2 * cs.y, o2 = x1 * cs.y + x2 * cs.x; ok[lane] = o1; ok[32 + lane] = o2;
            KB[(size_t)row * ROPE + lane] = (bf16_t)(cvt_pk_bf16(o1, 0.f) & 0xffffu); KB[(size_t)row * ROPE + 32 + lane] = (bf16_t)(cvt_pk_bf16(o2, 0.f) & 0xffffu); } }
}
__device__ __forceinline__ void sq_rope(uchar* ws, int G, int bid) {
    const bf16_t* Q = (const bf16_t*)(ws + WS_Q); bf16_t* QD = (bf16_t*)(ws + WS_QDEC); const f32x2* tab = (const f32x2*)(ws + WS_ROPE);
    for (size_t e = (size_t)bid * 512 + otid(); e < (size_t)SM * MLAH * 32; e += (size_t)G * 512) { const int i = (int)(e & 31), h = (int)((e >> 5) & 7), r = (int)(e >> 8), b = r >> 2, t = r & 3;
        const bf16_t* q = Q + ((size_t)PM + r) * QW + h * QHD + NOPE; const float x1 = bf2f(q[i]), x2 = bf2f(q[32 + i]); const f32x2 cs = tab[(size_t)(2048 + t) * 32 + i];
        bf16_t* o = QD + ((size_t)b * 32 + t * 8 + h) * 320 + 256; o[i] = (bf16_t)(cvt_pk_bf16(x1 * cs.x - x2 * cs.y, 0.f) & 0xffffu); o[32 + i] = (bf16_t)(cvt_pk_bf16(x1 * cs.y + x2 * cs.x, 0.f) & 0xffffu); }
}
__device__ __forceinline__ void final_norm(const float* const* in, float* out, uchar* ws, int G, int bid, int r0, int r1) {
    const bf16_t* XB = (const bf16_t*)(ws + WS_XB); const float* ssp = (const float*)(ws + WS_SSP); const float* ssps = (const float*)(ws + WS_SSPS);
    const int tid = otid(), lane = tid & 63, wid = tid >> 6;
    for (int row = r0 + bid * 8 + wid; row < r1; row += G * 8) { const float rs = row < PM ? rs_from16(ssp + (size_t)row * 16) : rs_from32(ssps + (row - PM) * 32);
        float* o = row < PM ? out + O_YP + (size_t)row * DM : out + O_YS + (size_t)(row - PM) * DM; const bf16_t* x = XB + (size_t)row * DM;
#pragma unroll
        for (int i = 0; i < 4; ++i) { const int c = 256 * i + 4 * lane; const u32x2 b = *(const u32x2*)(x + c);
            *(f32x4*)(o + c) = (f32x4){bf_lo(b.x), bf_hi(b.x), bf_lo(b.y), bf_hi(b.y)} * rs * *(const f32x4*)(in[25] + c); } }
}
}
#define XB_TMO      128
#define XB_XCNT(j)  (256  + 64 * (j))
#define XB_XSUB(j)  (1280 + 64 * (j))
#define XB_XGEN(j)  (2304 + 64 * (j))
#define XB_TOP      3328
#define XB_TOPGEN   3392
#define XCD_BAR_WORDS 3456
#define XB_SPIN_CAP (1u << 22)
__device__ __forceinline__ unsigned xb_ld(unsigned* p)              { return __hip_atomic_load(p, __ATOMIC_RELAXED, __HIP_MEMORY_SCOPE_AGENT); }
__device__ __forceinline__ unsigned xb_add(unsigned* p, unsigned v) { return __hip_atomic_fetch_add(p, v, __ATOMIC_RELAXED, __HIP_MEMORY_SCOPE_AGENT); }
__device__ __forceinline__ unsigned xb_xcc_id() { return (unsigned)__builtin_amdgcn_s_getreg((3 << 11) | 20) & 0xFu; }
#define XB_SPIN(cond, bar) do { unsigned _sp = 0; while (cond) { __builtin_amdgcn_s_sleep(1); \
    if ((++_sp & 255u) == 0u) { if (xb_ld(&(bar)[XB_TMO])) break; if (_sp > XB_SPIN_CAP) { atomicAdd(&(bar)[XB_TMO], 1u); break; } } } } while (0)
struct XcdBarrier { unsigned* bar; unsigned x; volatile LAS unsigned* st; };
__device__ __forceinline__ XcdBarrier xcd_barrier_post(unsigned* bar, volatile LAS unsigned* st) {
    XcdBarrier b; b.bar = bar; b.x = xb_xcc_id(); b.st = st;
    if (threadIdx.x == 0) (void)xb_add(&bar[XB_XCNT(b.x)], 1u);
    return b;
}
__device__ __forceinline__ void xcd_barrier_complete(unsigned* bar, unsigned x, unsigned& nloc, unsigned& nx) {
    const unsigned G = gridDim.x * gridDim.y * gridDim.z;
    unsigned sum, cnt, mine, sp = 0u;
    for (;;) {
        sum = 0u; cnt = 0u; mine = 0u;
#pragma unroll
        for (unsigned j = 0; j < 16; ++j) { const unsigned c = xb_ld(&bar[XB_XCNT(j)]); sum += c; cnt += (c > 0u) ? 1u : 0u; mine = (j == x) ? c : mine; }
        if (sum == G) break;
        __builtin_amdgcn_s_sleep(1);
        if ((++sp & 255u) == 0u) { if (xb_ld(&bar[XB_TMO])) break; if (sp > XB_SPIN_CAP) { atomicAdd(&bar[XB_TMO], 1u); break; } }
    }
    nloc = mine > 0u ? mine : 1u; nx = cnt > 0u ? cnt : 1u;
}
__device__ __forceinline__ void xcd_barrier(const XcdBarrier& b) {
    asm volatile("s_waitcnt vmcnt(0)" ::: "memory");
    __syncthreads();
    if (threadIdx.x == 0) {
        unsigned* bar = b.bar;
        __builtin_amdgcn_s_waitcnt(0);
        unsigned nloc = b.st[0], nx = b.st[1];
        if (nloc == 0u) { xcd_barrier_complete(bar, b.x, nloc, nx); b.st[0] = nloc; b.st[1] = nx; }
        const unsigned old = xb_add(&bar[XB_XSUB(b.x)], 1u);
        const unsigned gen = old / nloc;
        if (old + 1u == (gen + 1u) * nloc) {
            __builtin_amdgcn_fence(__ATOMIC_RELEASE, "agent");
            asm volatile("s_waitcnt vmcnt(0)" ::: "memory");
            const unsigned og = xb_add(&bar[XB_TOP], 1u);
            const unsigned tg = og / nx;
            if (og + 1u == (tg + 1u) * nx) xb_add(&bar[XB_TOPGEN], 1u);
            else XB_SPIN(xb_ld(&bar[XB_TOPGEN]) == tg, bar);
            __builtin_amdgcn_fence(__ATOMIC_ACQUIRE, "agent");
            xb_add(&bar[XB_XGEN(b.x)], 1u);
            asm volatile("s_waitcnt vmcnt(0)" ::: "memory");
        } else {
            XB_SPIN(xb_ld(&bar[XB_XGEN(b.x)]) == gen, bar);
            __builtin_amdgcn_fence(__ATOMIC_ACQUIRE, "agent");
            asm volatile("s_waitcnt vmcnt(0)" ::: "memory");
        }
    }
    __syncthreads();
}

constexpr int LDS_BYTES = 144 * 1024, MISC_OFF = 136 * 1024;
static_assert(pg8::STAGE_BYTES <= MISC_OFF && att::LDS_BYTES <= MISC_OFF && dec::LDS_BYTES <= MISC_OFF && sg::LDS_BYTES <= MISC_OFF && dec::SMEM_LDS <= MISC_OFF, "LDS budget");
constexpr int NPHASE = 17;
struct Params { const float* in[26]; float* out; uchar* ws; int ph_lo, ph_hi; };

template <class T> __device__ __forceinline__ T* launder(T* p) { asm volatile("" : "+s"(p)); return p; }
#define PHASE_PTRS \
    uchar* const ws = launder(P.ws); float* const out = launder(P.out); const float* const* in = P.in; (void)in; (void)out; \
    bf16_t* const XB = (bf16_t*)(ws + WS_XB); float* const XR = (float*)(ws + WS_XRES); bf16_t* const Z = (bf16_t*)(ws + WS_Z); bf16_t* const MX = (bf16_t*)(ws + WS_MIXED); \
    bf16_t* const PO = (bf16_t*)(ws + WS_POOLED); bf16_t* const QB = (bf16_t*)(ws + WS_Q); float* const ssp = (float*)(ws + WS_SSP); float* const ssps = (float*)(ws + WS_SSPS); \
    float* const ssq = (float*)(ws + WS_SSQ); float* const KVRAW = (float*)(ws + WS_KVRAW); bf16_t* const MEMB = (bf16_t*)(ws + WS_MEMB); \
    (void)XB; (void)XR; (void)Z; (void)MX; (void)PO; (void)QB; (void)ssp; (void)ssps; (void)ssq; (void)KVRAW; (void)MEMB;

__global__ void __launch_bounds__(512, 2) yoco_fwd(Params P) {
    extern __shared__ __attribute__((aligned(16))) uchar lds_raw[];
    LAS uchar* lds = (LAS uchar*)lds_raw;
    const int tid = threadIdx.x, G = gridDim.x, bid = blockIdx.x;
    volatile LAS unsigned* misc = (volatile LAS unsigned*)(lds + MISC_OFF);
    if (tid < 4) misc[tid] = 0u;
    __syncthreads();
    const int lo = P.ph_lo, hi = P.ph_hi; const bool multi = (hi - lo) > 1;
#ifdef TP_A
    if (bid == 0 && tid == 0) misc[15] = (unsigned)__builtin_amdgcn_s_memrealtime();
#endif
    XcdBarrier bar; bar.bar = (unsigned*)(P.ws + WS_CTL); bar.x = 0; bar.st = misc;
    if (multi) bar = xcd_barrier_post((unsigned*)(P.ws + WS_CTL), misc);
#ifndef EN_MASK
#define EN_MASK 0xffff
#endif
#define EN(t) ((EN_MASK >> (t)) & 1)
#ifndef REP_MASK
#define REP_MASK 0
#endif
#define NREP(t, first) ((((REP_MASK >> (t)) & 1) && (first)) ? 2 : 1)
#define IN(k) (lo <= (k) && (k) < hi)
#ifdef TP_A
#define SEAM(k) do { if (IN(k) && IN((k) + 1)) { xcd_barrier(bar); if (bid == 0 && tid == 0) misc[16 + (k)] = (unsigned)__builtin_amdgcn_s_memrealtime(); } } while (0)
#else
#define SEAM(k) do { if (IN(k) && IN((k) + 1)) xcd_barrier(bar); } while (0)
#endif
#define SUNITS(u, n) for (int u = G - 1 - bid; u < (n); u += G)

    if (EN(0) && IN(0)) for (int rep = 0; rep < NREP(0, true); ++rep) { if (rep) xcd_barrier(bar); PHASE_PTRS ew::prologue(in, out, ws, lds, G, bid); }
    SEAM(0);

#pragma unroll 1
    for (int l = 0; l < 2; ++l) {
        const int pb = 1 + 3 * l;
        if (EN(1) && IN(pb)) for (int rep = 0; rep < NREP(1, l == 0); ++rep) { if (rep) xcd_barrier(bar);
            PHASE_PTRS
            if (l == 0) {
                unsigned* zflag = (unsigned*)(ws + WS_CTL) + 4096 + 64 * 12;
                SUNITS(u, INA / 64) { sg::EpiZ E{Z, ssps, nullptr, nullptr}; sg::sgemm_unit(lds, XB + (size_t)PM * DM, DM, (const bf16_t*)(ws + WS_WINA) + (size_t)l * INA * DM, DM, DM, u * 64, E);
                    asm volatile("s_waitcnt vmcnt(0)" ::: "memory"); __syncthreads();
                    if (tid == 0) { __builtin_amdgcn_fence(__ATOMIC_RELEASE, "agent"); asm volatile("s_waitcnt vmcnt(0)" ::: "memory"); __hip_atomic_fetch_add(zflag, 1u, __ATOMIC_RELAXED, __HIP_MEMORY_SCOPE_AGENT); } }
            }
            { pg8::Gemm g{XB, (const bf16_t*)(ws + WS_WINA) + (size_t)l * INA * DM, DM, DM, DM, 0}; pg8::StaticOrder S; S.init(PM / 256, INA / 256, G, bid);
              pg8::EpiZ E{Z, ssp, nullptr, nullptr}; pg8::gemm_phase(lds, g, S, E); }

#if defined(TP_PT) && TP_PT == 60
            if (bid == TP_WG && tid == 0) (void)atomicCAS((unsigned*)(P.ws + WS_CTL) + 6144, 0u, (unsigned)__builtin_amdgcn_s_memrealtime());
#endif
            if (l == 0) { pg8::Gemm g{(const bf16_t*)(ws + WS_MHAT), (const bf16_t*)(ws + WS_WMEM), DM, DM, DM, 0}; pg8::StaticOrder S; S.init(2048 / 256, 4096 / 256, G, bid);
              pg8::EpiMem E{out + O_MEMK, MEMB}; pg8::gemm_phase(lds, g, S, E); }

#if defined(TP_PT) && TP_PT == 61
            if (bid == TP_WG && tid == 0) (void)atomicCAS((unsigned*)(P.ws + WS_CTL) + 6144, 0u, (unsigned)__builtin_amdgcn_s_memrealtime());
#endif
            if (l == 0) {
                unsigned* zflag = (unsigned*)(ws + WS_CTL) + 4096 + 64 * 12;
                const int sv = bid - (G - 128);
                if (sv >= 0) {
                    if (tid == 0) { unsigned sp = 0; while (__hip_atomic_load(zflag, __ATOMIC_RELAXED, __HIP_MEMORY_SCOPE_AGENT) < (unsigned)(INA / 64)) { __builtin_amdgcn_s_sleep(2); if (++sp > (1u << 22)) break; }
                        __builtin_amdgcn_fence(__ATOMIC_ACQUIRE, "agent"); asm volatile("s_waitcnt vmcnt(0)" ::: "memory"); }
                    __syncthreads();
                    if (sv < 16) { const int u = sv, g = u >> 2;
                        ew::pool_sample_grp(l, in, out, ws, g, (u & 3) == 0);
                        asm volatile("s_waitcnt vmcnt(0)" ::: "memory"); __syncthreads();
                        sg::EpiGrp E{Z, MX, g * 256};
                        sg::sgemm_unit(lds, PO + (size_t)PM * DM + g * 256, DM, (const bf16_t*)(ws + WS_WGRP) + ((size_t)l * 4 + g) * 65536, 256, 256, (u & 3) * 64, E); }
                    else for (int u = sv - 16; u < SB * MEMH; u += 112) { const int b = u >> 2, h = u & 3; const size_t r0 = (size_t)PM + b * 4; const size_t ko = (((size_t)l * SB + b) * MEMT * MEMH + h) * 128;
                        dec::smem_unit(Z + r0 * LDZ + ZA_QM + h * 128, Z + r0 * LDZ + ZA_GM + h * 128, in[5] + ko, in[6] + ko, MX + r0 * OUTW + 1024 + h * 128, lds); }
                }
            }
        }

#if defined(TP_PT) && TP_PT == 62
        if (bid == TP_WG && tid == 0) (void)atomicCAS((unsigned*)(P.ws + WS_CTL) + 6144, 0u, (unsigned)__builtin_amdgcn_s_memrealtime());
#endif
        SEAM(pb);
        if (EN(2) && IN(pb + 1)) {
            PHASE_PTRS
#if defined(TP_PT) && TP_PT == 56
            if (bid == 0 && tid == 0) misc[56] = (unsigned)__builtin_amdgcn_s_memrealtime();
#endif
            { pg8::StaticOrder S; S.init(PM / 256, 4, G, bid); pg8::Unit u;
              for (int i = 0; S.next(i, u); ++i) ew::pool_tile(l, out, ws, u.pm, u.pn);
              asm volatile("s_waitcnt vmcnt(0)" ::: "memory"); __syncthreads();
#if defined(TP_PT) && TP_PT == 57
            if (bid == 0 && tid == 0) misc[56] = (unsigned)__builtin_amdgcn_s_memrealtime();
#endif
              pg8::Gemm g{PO, (const bf16_t*)(ws + WS_WGRP) + (size_t)l * 4 * 65536, DM, 256, 256, 256};
              pg8::EpiGrp E{Z, MX}; pg8::gemm_phase(lds, g, S, E); }

#if defined(TP_PT) && TP_PT == 58
            if (bid == 0 && tid == 0) misc[56] = (unsigned)__builtin_amdgcn_s_memrealtime();
#endif
            for (int u0 = bid; u0 < PB * MEMH * 8; u0 += G) { const int u = (G == 256) ? ((u0 & 7) * 32 + (u0 >> 3)) : u0;
                const int b = u >> 5, h = (u >> 3) & 3, x = u & 7; const size_t r0 = (size_t)b * PT + 256 * x;
                const bf16_t* Kh = MEMB + (size_t)b * 256 * 4096 + l * 1024 + h * 128;
                att::attn_body<128, false, 1, LDZ, 4096>(Z + r0 * LDZ + ZA_QM + h * 128, Kh, Kh + 512, nullptr, nullptr, Z + r0 * LDZ + ZA_GM + h * 128, MX + r0 * OUTW + 1024 + h * 128, 4, 0, lds);
                __syncthreads(); }

#if defined(TP_PT) && TP_PT == 59
            if (bid == 0 && tid == 0) misc[56] = (unsigned)__builtin_amdgcn_s_memrealtime();
#endif
            if (l == 1) SUNITS(u, SB * MEMH) { const int b = u >> 2, h = u & 3; const size_t r0 = (size_t)PM + b * 4; const size_t ko = (((size_t)l * SB + b) * MEMT * MEMH + h) * 128;
                dec::smem_unit(Z + r0 * LDZ + ZA_QM + h * 128, Z + r0 * LDZ + ZA_GM + h * 128, in[5] + ko, in[6] + ko, MX + r0 * OUTW + 1024 + h * 128, lds); }
            if (l == 1) for (int u = bid; u < 16; u += G) { const int g = u >> 2;
                ew::pool_sample_grp(l, in, out, ws, g, (u & 3) == 0);
                asm volatile("s_waitcnt vmcnt(0)" ::: "memory"); __syncthreads();
                sg::EpiGrp E{Z, MX, g * 256};
                sg::sgemm_unit(lds, PO + (size_t)PM * DM + g * 256, DM, (const bf16_t*)(ws + WS_WGRP) + ((size_t)l * 4 + g) * 65536, 256, 256, (u & 3) * 64, E); }
        }
#ifdef TP_WG
        if (l == TP_L && bid == TP_WG && tid == 0) __hip_atomic_store((unsigned*)(P.ws + WS_CTL) + 6144, (unsigned)__builtin_amdgcn_s_memrealtime(), __ATOMIC_RELAXED, __HIP_MEMORY_SCOPE_AGENT);
#endif
        SEAM(pb + 1);
        if (EN(4) && IN(pb + 2)) {
            PHASE_PTRS
            unsigned* oflag = (unsigned*)(ws + WS_CTL) + 4096 + 64 * 11;
            if (l == 0) SUNITS(u, DM / 64) { sg::EpiOut E{XB, ssps};
                sg::sgemm_unit(lds, MX + (size_t)PM * OUTW, OUTW, (const bf16_t*)(ws + WS_WOUT) + (size_t)l * DM * OUTW, OUTW, OUTW, u * 64, E);
                asm volatile("s_waitcnt vmcnt(0)" ::: "memory"); __syncthreads();
                if (tid == 0) { __builtin_amdgcn_fence(__ATOMIC_RELEASE, "agent"); asm volatile("s_waitcnt vmcnt(0)" ::: "memory"); __hip_atomic_fetch_add(oflag, 1u, __ATOMIC_RELAXED, __HIP_MEMORY_SCOPE_AGENT); } }
            { pg8::Gemm g{MX, (const bf16_t*)(ws + WS_WOUT) + (size_t)l * DM * OUTW, OUTW, OUTW, OUTW, 0}; pg8::StaticOrder S; S.init(PM / 256, DM / 256, G, bid);
              pg8::EpiOut E{XB, ssp}; pg8::gemm_phase(lds, g, S, E); }
            if (l == 0) { bool waited = false;
              for (int u = bid; u < INA / 64; u += G) {
                if (!waited) { waited = true;
                    if (tid == 0) { unsigned sp = 0; while (__hip_atomic_load(oflag, __ATOMIC_RELAXED, __HIP_MEMORY_SCOPE_AGENT) < (unsigned)(DM / 64)) { __builtin_amdgcn_s_sleep(2); if (++sp > (1u << 22)) break; }
                        __builtin_amdgcn_fence(__ATOMIC_ACQUIRE, "agent"); asm volatile("s_waitcnt vmcnt(0)" ::: "memory"); }
                    __syncthreads(); }
                sg::EpiZ E{Z, ssps, nullptr, nullptr}; sg::sgemm_unit(lds, XB + (size_t)PM * DM, DM, (const bf16_t*)(ws + WS_WINA) + (size_t)(l + 1) * INA * DM, DM, DM, u * 64, E); } }
        }
        SEAM(pb + 2);
    }

#pragma unroll 1
    for (int j = 0; j < 2; ++j) {
        const int l = 2 + j, pb = 7 + 5 * j; const int NB = j == 0 ? NB2 : NB3;
        if (EN(5) && IN(pb)) for (int rep = 0; rep < NREP(5, j == 0); ++rep) { if (rep) xcd_barrier(bar);
            PHASE_PTRS
            const bf16_t* WB = (const bf16_t*)(ws + WS_WINB) + (size_t)j * NB2 * DM; float* kvr = j == 0 ? KVRAW : nullptr;
            unsigned* sflag = (unsigned*)(ws + WS_CTL) + 4096 + 64 * j;
            SUNITS(u, DM / 64) { sg::EpiOut E{XB, ssps};
                sg::sgemm_unit(lds, MX + (size_t)PM * OUTW, OUTW, (const bf16_t*)(ws + WS_WOUT) + (size_t)(l - 1) * DM * OUTW, OUTW, OUTW, u * 64, E);
                asm volatile("s_waitcnt vmcnt(0)" ::: "memory"); __syncthreads();
                if (tid == 0) { __builtin_amdgcn_fence(__ATOMIC_RELEASE, "agent"); asm volatile("s_waitcnt vmcnt(0)" ::: "memory"); __hip_atomic_fetch_add(sflag, 1u, __ATOMIC_RELAXED, __HIP_MEMORY_SCOPE_AGENT); } }
            { pg8::Gemm g{XB, WB, DM, DM, DM, 0}; pg8::StaticOrder S; S.init(PM / 256, NB / 256, G, bid);
              pg8::EpiZ E{Z, ssp, ssq, kvr}; pg8::gemm_phase(lds, g, S, E); }
            { bool waited = false;
              for (int u = G - 1 - DM / 64 - bid; u >= 0 && u < NB / 64; u += G) {
                if (!waited) { waited = true;
                    if (tid == 0) { unsigned sp = 0; while (__hip_atomic_load(sflag, __ATOMIC_RELAXED, __HIP_MEMORY_SCOPE_AGENT) < (unsigned)(DM / 64)) { __builtin_amdgcn_s_sleep(2); if (++sp > (1u << 22)) break; }
                        __builtin_amdgcn_fence(__ATOMIC_ACQUIRE, "agent"); asm volatile("s_waitcnt vmcnt(0)" ::: "memory"); }
                    __syncthreads(); }
                sg::EpiZ E{Z, ssps, ssq, kvr}; sg::sgemm_unit(lds, XB + (size_t)PM * DM, DM, WB, DM, DM, u * 64, E); } }
        }
        SEAM(pb);
        if (EN(6) && IN(pb + 1)) for (int rep = 0; rep < NREP(6, j == 0); ++rep) { if (rep) xcd_barrier(bar);
            PHASE_PTRS
            unsigned* qflag = (unsigned*)(ws + WS_CTL) + 4096 + 64 * (6 + j);
            SUNITS(u, QW / 64) { sg::EpiQ E{QB, ssq}; sg::sgemm_unit(lds, Z + (size_t)PM * LDZ + ZB_CQ, LDZ, (const bf16_t*)(ws + WS_WQUP) + (size_t)j * QW * QRANK, QRANK, QRANK, u * 64, E);
                asm volatile("s_waitcnt vmcnt(0)" ::: "memory"); __syncthreads();
                if (tid == 0) { __builtin_amdgcn_fence(__ATOMIC_RELEASE, "agent"); asm volatile("s_waitcnt vmcnt(0)" ::: "memory"); __hip_atomic_fetch_add(qflag, 1u, __ATOMIC_RELAXED, __HIP_MEMORY_SCOPE_AGENT); } }
            if (j == 0) ew::kvpost(in, out, ws, G, bid);
            { pg8::Gemm g{Z + ZB_CQ, (const bf16_t*)(ws + WS_WQUP) + (size_t)j * QW * QRANK, LDZ, QRANK, QRANK, 0}; pg8::StaticOrder S; S.init(PM / 256, QW / 256, G, bid);
              pg8::EpiQ E{QB, ssq}; pg8::gemm_phase(lds, g, S, E); }
            for (int u0 = bid; u0 < PB * MEMH * 8; u0 += G) { const int u = (G == 256) ? ((u0 & 7) * 32 + (u0 >> 3)) : u0;
                const int b = u >> 5, h = (u >> 3) & 3, x = u & 7; const size_t r0 = (size_t)b * PT + 256 * x;
                const bf16_t* Kh = MEMB + (size_t)b * 256 * 4096 + l * 1024 + h * 128;
                att::attn_body<128, false, 1, LDZ, 4096>(Z + r0 * LDZ + ZB_QM + h * 128, Kh, Kh + 512, nullptr, nullptr, Z + r0 * LDZ + ZB_GM + h * 128, MX + r0 * OUTW + 1024 + h * 128, 4, 0, lds);
                __syncthreads(); }
            SUNITS(u, SB * MEMH) { const int b = u >> 2, h = u & 3; const size_t r0 = (size_t)PM + b * 4; const size_t ko = (((size_t)l * SB + b) * MEMT * MEMH + h) * 128;
                dec::smem_unit(Z + r0 * LDZ + ZB_QM + h * 128, Z + r0 * LDZ + ZB_GM + h * 128, in[5] + ko, in[6] + ko, MX + r0 * OUTW + 1024 + h * 128, lds); }
            { const int cu = G - 1 - QW / 64 - bid;
              if (cu >= 0 && cu < MLAH * 4) {
                if (tid == 0) { unsigned sp = 0; while (__hip_atomic_load(qflag, __ATOMIC_RELAXED, __HIP_MEMORY_SCOPE_AGENT) < (unsigned)(QW / 64)) { __builtin_amdgcn_s_sleep(2); if (++sp > (1u << 22)) break; }
                    __builtin_amdgcn_fence(__ATOMIC_ACQUIRE, "agent"); asm volatile("s_waitcnt vmcnt(0)" ::: "memory"); }
                __syncthreads();
                { const int h = cu >> 2; sg::EpiAbsorb E{(bf16_t*)(ws + WS_QDEC), h};
                  sg::sgemm_unit(lds, QB + (size_t)PM * QW + h * QHD, QW, (const bf16_t*)(ws + WS_WKUPN) + h * 128, 1024, 128, (cu & 3) * 64, E); }
                ew::sq_rope(ws, MLAH * 4, cu); } }
        }
        SEAM(pb + 1);
        const int pM = pb + 2 + (j == 0 ? 1 : 0);
        if (j == 0) {
            if (EN(7) && IN(pb + 2)) {
                PHASE_PTRS
                { pg8::Gemm g{(const bf16_t*)(ws + WS_CKVB), (const bf16_t*)(ws + WS_WKV), KVR, KVR, KVR, 0}; pg8::StaticOrder S; S.init(PM / 256, 2048 / 256, G, bid);
                  pg8::EpiKV E{(bf16_t*)(ws + WS_KN)}; pg8::gemm_phase(lds, g, S, E); }
            }
            SEAM(pb + 2);
        }
        if (EN(8) && IN(pM)) for (int rep = 0; rep < NREP(8, j == 0); ++rep) { if (rep) xcd_barrier(bar);
            PHASE_PTRS
#pragma unroll 1
            for (int half = 0; half < 2; ++half) {
            if ((half ^ ((bid >> 3) & 1)) == 0) {
            for (int rep2 = 0; rep2 < NREP(13, j == 0); ++rep2)
            for (int u0 = bid; u0 < PB * MLAH * 4; u0 += G) { const int u = (G == 256) ? ((u0 & 7) * 32 + (u0 >> 3)) : u0;
                const int b = u >> 5, h = (u >> 2) & 7, xp = u & 3;
#pragma unroll 1
                for (int s = 0; s < 2; ++s) { const int x = s == 0 ? 7 - xp : xp; const size_t b0 = (size_t)b * PT, r0 = b0 + 256 * x;
                    att::attn_body<192, true, 1, QW, 1024>(QB + r0 * QW + h * QHD, (const bf16_t*)(ws + WS_KN) + b0 * 1024 + h * 128, (const bf16_t*)(ws + WS_VV) + b0 * 1024 + h * 128,
                        (const bf16_t*)(ws + WS_KROPEB) + b0 * ROPE, (const f32x2*)(ws + WS_ROPE) + (size_t)(256 * x) * 32, Z + r0 * LDZ + ZB_GT + h * 128, MX + r0 * OUTW + h * 128, 4 * (x + 1), 4 * x, lds);
                    __syncthreads(); } }
            } else {
            for (int rep3 = 0; rep3 < NREP(14, j == 0); ++rep3)
            for (int u = bid; u < SB * 8; u += G) { const int b = u >> 3, ch = u & 7;
                dec::decode_unit((const bf16_t*)(ws + WS_QDEC) + (size_t)b * 32 * 320, in[3], in[4], (const int*)in[7] + b * NPAGES + ch * 16,
                                 (float*)(ws + WS_OPART) + ((size_t)b * 8 + ch) * 32 * 256, (float*)(ws + WS_ML) + ((size_t)b * 8 + ch) * 32 * 2, lds);
                __syncthreads(); }
            } }
#ifdef DELAY_PROBE
            if (j == 0) { const unsigned long long t0 = __builtin_amdgcn_s_memrealtime(); while (__builtin_amdgcn_s_memrealtime() - t0 < 3000ull) __builtin_amdgcn_s_sleep(8); }
#endif
        }
        SEAM(pM);
        if (EN(11) && IN(pM + 1)) {
            PHASE_PTRS
            unsigned* cflag = (unsigned*)(ws + WS_CTL) + 4096 + 64 * (4 + j);
            constexpr int NCOMB = 128;
            if (bid < NCOMB) { const int ct = ew::otid();
                for (int w = bid * 8 + (ct >> 6); w < SB * 32; w += NCOMB * 8)
                    dec::combine_row(w >> 5, w & 31, ct & 63, (const bf16_t*)(ws + WS_QDEC), (const float*)(ws + WS_OPART), (const float*)(ws + WS_ML), out + O_CKVS, out + O_KRS, (bf16_t*)(ws + WS_OLAT));
                asm volatile("s_waitcnt vmcnt(0)" ::: "memory"); __syncthreads();
                if (tid == 0) { __builtin_amdgcn_fence(__ATOMIC_RELEASE, "agent"); asm volatile("s_waitcnt vmcnt(0)" ::: "memory"); __hip_atomic_fetch_add(cflag, 1u, __ATOMIC_RELAXED, __HIP_MEMORY_SCOPE_AGENT); } }
            { pg8::Gemm g{MX, (const bf16_t*)(ws + WS_WOUT) + (size_t)l * DM * OUTW, OUTW, OUTW, OUTW, 0}; pg8::StaticOrder S; S.init(PM / 256, DM / 256, G, bid);
              pg8::EpiOut E{XB, ssp}; pg8::gemm_phase(lds, g, S, E); }
            { bool waited = false;
              SUNITS(u, MLAH * 2) { const int h = u >> 1;
                if (!waited) { waited = true;
                    if (tid == 0) { unsigned sp = 0; while (__hip_atomic_load(cflag, __ATOMIC_RELAXED, __HIP_MEMORY_SCOPE_AGENT) < (unsigned)NCOMB) { __builtin_amdgcn_s_sleep(2); if (++sp > (1u << 22)) break; }
                        __builtin_amdgcn_fence(__ATOMIC_ACQUIRE, "agent"); asm volatile("s_waitcnt vmcnt(0)" ::: "memory"); }
                    __syncthreads(); }
                sg::EpiVup E{Z, MX, h};
                sg::sgemm_unit(lds, (const bf16_t*)(ws + WS_OLAT) + h * 256, 2048, (const bf16_t*)(ws + WS_WKV) + ((size_t)1024 + h * 128) * 256, 256, 256, (u & 1) * 64, E); } }
        }
        SEAM(pM + 1);
    }
    if (EN(12) && IN(16)) {
        PHASE_PTRS
        unsigned* sflag = (unsigned*)(ws + WS_CTL) + 4096 + 64 * 2;
        SUNITS(u, DM / 64) { sg::EpiOut E{XB, ssps};
            sg::sgemm_unit(lds, MX + (size_t)PM * OUTW, OUTW, (const bf16_t*)(ws + WS_WOUT) + (size_t)3 * DM * OUTW, OUTW, OUTW, u * 64, E);
            asm volatile("s_waitcnt vmcnt(0)" ::: "memory"); __syncthreads();
            if (tid == 0) { __builtin_amdgcn_fence(__ATOMIC_RELEASE, "agent"); asm volatile("s_waitcnt vmcnt(0)" ::: "memory"); __hip_atomic_fetch_add(sflag, 1u, __ATOMIC_RELAXED, __HIP_MEMORY_SCOPE_AGENT); } }
        const int nprod = (G > 2 * (DM / 64)) ? DM / 64 : 0;
        if (bid < G - nprod) ew::final_norm(in, out, ws, G - nprod, bid, 0, PM);
        if (bid < 16) {
            if (tid == 0) { unsigned sp = 0; while (__hip_atomic_load(sflag, __ATOMIC_RELAXED, __HIP_MEMORY_SCOPE_AGENT) < (unsigned)(DM / 64)) { __builtin_amdgcn_s_sleep(2); if (++sp > (1u << 22)) break; }
                __builtin_amdgcn_fence(__ATOMIC_ACQUIRE, "agent"); asm volatile("s_waitcnt vmcnt(0)" ::: "memory"); }
            __syncthreads();
            ew::final_norm(in, out, ws, 16, bid, PM, PM + SM); }
    }
#ifdef TP_A
    if (bid == 0 && tid == 0) { const unsigned dt = (TP_B >= 99 ? (unsigned)__builtin_amdgcn_s_memrealtime() : TP_B == 98 ? __hip_atomic_load((unsigned*)(P.ws + WS_CTL) + 6144, __ATOMIC_RELAXED, __HIP_MEMORY_SCOPE_AGENT) : misc[TP_B]) - misc[TP_A];
        const unsigned long long t0 = __builtin_amdgcn_s_memrealtime(); while (__builtin_amdgcn_s_memrealtime() - t0 < (unsigned long long)dt * TP_K) __builtin_amdgcn_s_sleep(8); }
#endif
#undef IN
#undef SEAM
#undef SUNITS
}

#ifndef MK_LAUNCHES
#define MK_LAUNCHES 1
#endif
extern "C" void kernel_launch(void* const* d_in, const int* in_sizes, int n_in, void* d_out, int out_size, void* d_ws, size_t ws_size, hipStream_t stream) {
    static int grid = 0;
    if (grid == 0) {
        if (n_in != 26 || (size_t)out_size != O_END || ws_size < WS_END) { fprintf(stderr, "kernel_launch: unexpected shapes: n_in %d out %d ws %zu (need out %zu ws %zu)\n", n_in, out_size, ws_size, (size_t)O_END, (size_t)WS_END); grid = -1; return; }
        int dev = 0, cus = 0, per_cu = 0;
        if (hipGetDevice(&dev) != hipSuccess || hipDeviceGetAttribute(&cus, hipDeviceAttributeMultiprocessorCount, dev) != hipSuccess) { grid = -1; return; }
        if (hipFuncSetAttribute((const void*)yoco_fwd, hipFuncAttributeMaxDynamicSharedMemorySize, LDS_BYTES) != hipSuccess) { fprintf(stderr, "kernel_launch: hipFuncSetAttribute failed\n"); grid = -1; return; }
        if (hipOccupancyMaxActiveBlocksPerMultiprocessor(&per_cu, (const void*)yoco_fwd, 512, LDS_BYTES) != hipSuccess || per_cu < 1) { fprintf(stderr, "kernel_launch: occupancy query says %d blocks per CU\n", per_cu); (void)hipGetLastError(); grid = -1; return; }
        grid = cus;
    }
    if (grid < 0) return;
    (void)hipMemsetAsync((char*)d_ws + WS_CTL, 0, CTL_BYTES, stream);
    Params p{};
    for (int i = 0; i < 26; ++i) p.in[i] = (const float*)d_in[i];
    p.out = (float*)d_out; p.ws = (uchar*)d_ws;
    if (MK_LAUNCHES == 1) { p.ph_lo = 0; p.ph_hi = NPHASE; hipLaunchKernelGGL(yoco_fwd, dim3(grid), dim3(512), LDS_BYTES, stream, p); }
    else for (int k = 0; k < NPHASE; ++k) { p.ph_lo = k; p.ph_hi = k + 1; hipLaunchKernelGGL(yoco_fwd, dim3(grid), dim3(512), LDS_BYTES, stream, p); }
    const hipError_t le = hipPeekAtLastError();
    if (le != hipSuccess) fprintf(stderr, "kernel_launch: launch failed: %s\n", hipGetErrorName(le));
}
```

```cpp
#include <hip/hip_runtime.h>
#include <cstdio>
#include <cstdint>

#define LAS __attribute__((address_space(3)))
typedef unsigned char uchar;
typedef unsigned short bf16_t;
typedef short bf16x8 __attribute__((ext_vector_type(8)));
typedef short s16x4 __attribute__((ext_vector_type(4)));
typedef float f32x2 __attribute__((ext_vector_type(2)));
typedef float f32x4 __attribute__((ext_vector_type(4)));
typedef float f32x16 __attribute__((ext_vector_type(16)));
typedef unsigned u32x2 __attribute__((ext_vector_type(2)));
typedef unsigned u32x4 __attribute__((ext_vector_type(4)));

constexpr int DM = 1024, PB = 8, PT = 2048, PM = PB * PT, SB = 32, ST = 4, SM = SB * ST, RP = 16640;
constexpr int KVR = 256, ROPE = 64, NOPE = 128, QRANK = 384, MLAH = 8, QHD = 192, QW = MLAH * QHD;
constexpr int MEMT = 256, MEMH = 4, MEMW = 512;
constexpr int INA = 3072, INB = 2432, OUTW = 1536, LDZ = 3072, NB2 = 2816, NB3 = 2560;
constexpr int NPAGES = 128, PAGE = 128, PAST = 16384, POOLBUF = 15;
constexpr float EPS = 1e-6f;
constexpr int ZA_U = 0, ZA_GT = 1024, ZA_QM = 2048, ZA_GM = 2560;
constexpr int ZB_CQ = 0, ZB_KR = 384, ZB_GT = 512, ZB_QM = 1536, ZB_GM = 2048, ZB_KV = 2560;

constexpr size_t O_YP = 0, O_YS = O_YP + (size_t)PM * DM, O_PSP = O_YS + (size_t)SM * DM, O_PSS = O_PSP + (size_t)2 * PB * 15 * DM, O_CKVP = O_PSS + (size_t)2 * SB * 15 * DM,
                 O_KRP = O_CKVP + (size_t)PM * KVR, O_CKVS = O_KRP + (size_t)PM * ROPE, O_KRS = O_CKVS + (size_t)SM * KVR, O_MEMK = O_KRS + (size_t)SM * ROPE,
                 O_MEMV = O_MEMK + (size_t)4 * PB * MEMT * MEMW, O_END = O_MEMV + (size_t)4 * PB * MEMT * MEMW;

constexpr size_t al256(size_t x) { return (x + 255) / 256 * 256; }
constexpr size_t WS_CTL = 0, CTL_BYTES = 65536;
constexpr size_t WS_ROPE = WS_CTL + CTL_BYTES;
constexpr size_t WS_SSP  = al256(WS_ROPE + (size_t)2052 * 32 * 8);
constexpr size_t WS_SSPS = al256(WS_SSP + (size_t)PM * 16 * 4);
constexpr size_t WS_SSQ  = al256(WS_SSPS + (size_t)SM * 32 * 4);
constexpr size_t WS_Z    = al256(WS_SSQ + (size_t)RP * 12 * 4);
constexpr size_t WS_POOLED = al256(WS_Z + (size_t)RP * LDZ * 2);
constexpr size_t WS_MIXED = al256(WS_POOLED + (size_t)RP * DM * 2);
constexpr size_t WS_Q    = al256(WS_MIXED + (size_t)RP * OUTW * 2);
constexpr size_t WS_KVRAW = al256(WS_Q + (size_t)RP * QW * 2);
constexpr size_t WS_CKVB = al256(WS_KVRAW + (size_t)RP * 320 * 4);
constexpr size_t WS_KROPEB = al256(WS_CKVB + (size_t)RP * 256 * 2);
constexpr size_t WS_KN   = al256(WS_KROPEB + (size_t)RP * 64 * 2);
constexpr size_t WS_VV   = al256(WS_KN + (size_t)PM * 1024 * 2);
constexpr size_t WS_QDEC = al256(WS_VV + (size_t)PM * 1024 * 2);
constexpr size_t WS_OPART = al256(WS_QDEC + (size_t)SB * 32 * 320 * 2);
constexpr size_t WS_ML   = al256(WS_OPART + (size_t)SB * 8 * 32 * 256 * 4);
constexpr size_t WS_OLAT = al256(WS_ML + (size_t)SB * 8 * 32 * 2 * 4);
constexpr size_t WS_WINA = al256(WS_OLAT + (size_t)SM * 2048 * 2);
constexpr size_t WS_WGRP = al256(WS_WINA + (size_t)2 * INA * DM * 2);
constexpr size_t WS_WINB = al256(WS_WGRP + (size_t)2 * 4 * 256 * 256 * 2);
constexpr size_t WS_WQUP = al256(WS_WINB + (size_t)2 * NB2 * DM * 2);
constexpr size_t WS_WKV  = al256(WS_WQUP + (size_t)2 * QW * QRANK * 2);
constexpr size_t WS_WKUPN = al256(WS_WKV + (size_t)2048 * 256 * 2);
constexpr size_t WS_WMEM = al256(WS_WKUPN + (size_t)256 * 1024 * 2);
constexpr size_t WS_WOUT = al256(WS_WMEM + (size_t)4096 * 1024 * 2);
constexpr size_t WS_MHAT = al256(WS_WOUT + (size_t)4 * DM * OUTW * 2);
constexpr size_t WS_MEMB = al256(WS_MHAT + (size_t)2048 * 1024 * 2);
constexpr size_t WS_XRES = al256(WS_MEMB + (size_t)2048 * 4096 * 2);
constexpr size_t WS_XB   = WS_XRES;
constexpr size_t WS_END  = al256(WS_XB + (size_t)RP * DM * 2);

__device__ __forceinline__ unsigned cvt_pk_bf16(float lo, float hi) { unsigned r; asm volatile("v_cvt_pk_bf16_f32 %0, %1, %2" : "=v"(r) : "v"(lo), "v"(hi)); return r; }
__device__ __forceinline__ float bf_lo(unsigned w) { return __uint_as_float(w << 16); }
__device__ __forceinline__ float bf_hi(unsigned w) { return __uint_as_float(w & 0xffff0000u); }
__device__ __forceinline__ float bf2f(bf16_t b) { return __uint_as_float(((unsigned)b) << 16); }
__device__ __forceinline__ float silu(float x) { return x * __builtin_amdgcn_rcpf(1.0f + __expf(-x)); }
__device__ __forceinline__ void unpack8(const u32x4 w, float (&f)[8]) {
    f[0] = bf_lo(w.x); f[1] = bf_hi(w.x); f[2] = bf_lo(w.y); f[3] = bf_hi(w.y); f[4] = bf_lo(w.z); f[5] = bf_hi(w.z); f[6] = bf_lo(w.w); f[7] = bf_hi(w.w); }
__device__ __forceinline__ u32x4 pack8(const float (&f)[8]) { u32x4 w; w.x = cvt_pk_bf16(f[0], f[1]); w.y = cvt_pk_bf16(f[2], f[3]); w.z = cvt_pk_bf16(f[4], f[5]); w.w = cvt_pk_bf16(f[6], f[7]); return w; }
__device__ __forceinline__ float sum4(const f32x4 a) { return (a[0] + a[1]) + (a[2] + a[3]); }
__device__ __forceinline__ float rs_from16(const float* p) {
    const f32x4 a = *(const f32x4*)p, b = *(const f32x4*)(p + 4), c = *(const f32x4*)(p + 8), d = *(const f32x4*)(p + 12);
    return rsqrtf(((sum4(a) + sum4(b)) + (sum4(c) + sum4(d))) * (1.0f / 1024.0f) + EPS); }
__device__ __forceinline__ float rs_from32(const float* p) { float s = 0.f;
#pragma unroll
    for (int i = 0; i < 8; ++i) s += sum4(*(const f32x4*)(p + 4 * i));
    return rsqrtf(s * (1.0f / 1024.0f) + EPS); }
__device__ __forceinline__ float rsq_from12(const float* p) {
    const f32x4 a = *(const f32x4*)p, b = *(const f32x4*)(p + 4), c = *(const f32x4*)(p + 8);
    return rsqrtf((sum4(a) + sum4(b) + sum4(c)) * (1.0f / 384.0f) + EPS); }
__device__ __forceinline__ int crow(int r, int hi) { return (r & 3) + 8 * (r >> 2) + 4 * hi; }
static_assert(WS_VV == WS_KN + (size_t)PM * 1024 * 2, "VV must follow KN");
namespace pg8 {
constexpr int BM = 256, BK = 64, HALF = 128, HTB = HALF * BK * 2, STAGE_BYTES = 8 * HTB, NXCD = 8, WGM = 8;
__device__ __forceinline__ int lds_byte(int r, int c) { const int st = (r >> 4) * 2 + (c >> 5), rr = r & 15, cc = c & 31, ob = rr * 64 + cc * 2; return st * 1024 + (ob ^ (((ob >> 9) & 1) << 5)); }
__device__ __forceinline__ void stage_rc(int b, int& R, int& C) { const int st = b / 1024, sb = b % 1024, swz = sb ^ (((sb >> 9) & 1) << 5); R = (st >> 1) * 16 + swz / 64; C = (st & 1) * 32 + (swz % 64) / 2; }
__device__ __forceinline__ int perm32(int rho) { const int n = rho >> 4, i = rho & 15; return 8 * (i >> 2) + 4 * n + (i & 3); }

struct Unit { int pm, pn; };
struct Gemm { const bf16_t* A; const bf16_t* Bt; int lda, ldb, K, a_pn; };

struct StaticOrder {
    int nM, nN, nwg, G, c;
    __device__ __forceinline__ void init(int nM_, int nN_, int G_, int c_) { nM = nM_; nN = nN_; nwg = nM * nN; G = G_; c = c_; }
    __device__ __forceinline__ bool next(int i, Unit& u) const {
        const long L = (long)i * G + c; if (L >= nwg) return false;
        int wgid = (int)L; { const int q = nwg / NXCD, r = nwg % NXCD, xcd = wgid % NXCD, off = wgid / NXCD; wgid = (xcd < r ? xcd * (q + 1) : r * (q + 1) + (xcd - r) * q) + off; }
        const int nig = WGM * nN, gid = wgid / nig, fm = gid * WGM, gsz = (nM - fm) < WGM ? (nM - fm) : WGM;
        u.pm = fm + ((wgid % nig) % gsz); u.pn = (wgid % nig) / gsz; return true;
    }
};

template <class Epi>
__device__ __forceinline__ void gemm_phase(LAS uchar* lds, const Gemm g, const StaticOrder& S, const Epi& E) {
    int tid_ = threadIdx.x; asm volatile("" : "+v"(tid_));
    const int tid = tid_, wid = __builtin_amdgcn_readfirstlane(tid >> 6), lane = tid & 63, wr = wid >> 2, wc = wid & 3, fr = lane & 15, fq = lane >> 4;
    int K_ = g.K; asm volatile("" : "+s"(K_));
    const int K = K_, nt = K / BK;
    unsigned voffA[2], voffB[2];
#pragma unroll
    for (int i = 0; i < 2; ++i) { int R, C; stage_rc(tid * 16 + i * 8192, R, C); const int Rb = Epi::PERM ? ((R & ~31) + perm32(R & 31)) : R;
        voffA[i] = (unsigned)(R * g.lda + C) * 2u; voffB[i] = (unsigned)(Rb * g.ldb + C) * 2u; }
    const size_t kstep = (size_t)(BK * 2);
    const size_t hstepA = (size_t)HALF * g.lda * 2, hstepB = (size_t)HALF * g.ldb * 2;
    const size_t tstepA = 2 * hstepA, tstepB = 2 * hstepB;
    const unsigned ldsw = (unsigned)wid * 1024u;
    const int aoff = lds_byte(wr * 64 + fr, fq * 8), boff = lds_byte(wc * 32 + fr, fq * 8);
#define PG8_SA(b, h) (((b) * 2 + (h)) * HTB)
#define PG8_SB(b, h) ((4 + (b) * 2 + (h)) * HTB)
#define PG8_STAGE(bufoff, gbase, voff) do { _Pragma("unroll") for (int _i = 0; _i < 2; ++_i) \
        __builtin_amdgcn_global_load_lds((const unsigned*)((const char*)(gbase) + (voff)[_i]), (LAS unsigned*)(lds + (bufoff) + ldsw + _i * 8192), 16, 0, 0); } while (0)
#define PG8_LDA(dst, b, h) do { _Pragma("unroll") for (int m = 0; m < 4; ++m) _Pragma("unroll") for (int k = 0; k < 2; ++k) dst[m][k] = *(const LAS bf16x8*)(lds + PG8_SA(b, h) + aoff + m * 2048 + k * 1024); } while (0)
#define PG8_LDB(dst, b, h) do { _Pragma("unroll") for (int n = 0; n < 2; ++n) _Pragma("unroll") for (int k = 0; k < 2; ++k) dst[n][k] = *(const LAS bf16x8*)(lds + PG8_SB(b, h) + boff + n * 2048 + k * 1024); } while (0)
#define PG8_MMA(ai, bj, At, Bt) do { __builtin_amdgcn_s_setprio(1); _Pragma("unroll") for (int m = 0; m < 4; ++m) _Pragma("unroll") for (int n = 0; n < 2; ++n) _Pragma("unroll") for (int k = 0; k < 2; ++k) \
        acc[ai][bj][m][n] = __builtin_amdgcn_mfma_f32_16x16x32_bf16(Bt[n][k], At[m][k], acc[ai][bj][m][n], 0, 0, 0); __builtin_amdgcn_s_setprio(0); } while (0)
#define PG8_WAIT_V(n) asm volatile("s_waitcnt vmcnt(" #n ")" ::: "memory")
#define PG8_WAIT_L(n) asm volatile("s_waitcnt lgkmcnt(" #n ")" ::: "memory")
#define PG8_BAR __builtin_amdgcn_s_barrier()
#define PG8_SCHED __builtin_amdgcn_sched_barrier(0)
    Unit cur, nxt; int ui = 0;
    if (!S.next(0, cur)) return;
    f32x4 acc[2][2][4][2];
#pragma unroll
    for (int a = 0; a < 2; ++a)
#pragma unroll
        for (int b = 0; b < 2; ++b)
#pragma unroll
            for (int m = 0; m < 4; ++m)
#pragma unroll
                for (int n = 0; n < 2; ++n) acc[a][b][m][n] = (f32x4){0.f, 0.f, 0.f, 0.f};
    bf16x8 At[4][2], B0[2][2], B1[2][2];
    const char* cA = (const char*)g.A + (size_t)cur.pm * tstepA + (size_t)cur.pn * g.a_pn * 2; const char* cB = (const char*)g.Bt + (size_t)cur.pn * tstepB;
    PG8_STAGE(PG8_SB(0, 0), cB, voffB); PG8_STAGE(PG8_SA(0, 0), cA, voffA); PG8_STAGE(PG8_SB(0, 1), cB + hstepB, voffB); PG8_STAGE(PG8_SA(0, 1), cA + hstepA, voffA);
    if (wr == 1) PG8_BAR;
    PG8_WAIT_V(4); PG8_BAR;
    PG8_STAGE(PG8_SB(1, 0), cB + kstep, voffB); PG8_STAGE(PG8_SA(1, 0), cA + kstep, voffA); PG8_STAGE(PG8_SB(1, 1), cB + hstepB + kstep, voffB);
    PG8_WAIT_V(6); PG8_BAR;
    for (;;) {
        const bool has_next = S.next(ui + 1, nxt);
        const char* nA = has_next ? (const char*)g.A + (size_t)nxt.pm * tstepA + (size_t)nxt.pn * g.a_pn * 2 : cA; const char* nB = has_next ? (const char*)g.Bt + (size_t)nxt.pn * tstepB : cB;
        for (int t = 0; t < nt; t += 2) {
            const bool last = (t == nt - 2);
            const char* a1 = cA + (size_t)(t + 1) * kstep;
            const char* a2 = last ? nA : cA + (size_t)(t + 2) * kstep; const char* b2 = last ? nB : cB + (size_t)(t + 2) * kstep;
            const char* a3 = a2 + kstep; const char* b3 = b2 + kstep;
            PG8_LDB(B0, 0, 0); PG8_SCHED; PG8_LDA(At, 0, 0); PG8_STAGE(PG8_SA(1, 1), a1 + hstepA, voffA);
            PG8_WAIT_L(8); PG8_BAR; PG8_WAIT_L(0); PG8_MMA(0, 0, At, B0); PG8_BAR; PG8_SCHED;
            PG8_LDB(B1, 0, 1); PG8_STAGE(PG8_SB(0, 0), b2, voffB);
            PG8_BAR; PG8_WAIT_L(0); PG8_MMA(0, 1, At, B1); PG8_BAR;
            PG8_LDA(At, 0, 1); PG8_STAGE(PG8_SA(0, 0), a2, voffA);
            PG8_BAR; PG8_WAIT_L(0); PG8_MMA(1, 0, At, B0); PG8_BAR; PG8_SCHED;
            PG8_STAGE(PG8_SB(0, 1), b2 + hstepB, voffB);
            PG8_WAIT_V(6); PG8_BAR; PG8_MMA(1, 1, At, B1); PG8_BAR;
            PG8_LDB(B0, 1, 0); PG8_SCHED; PG8_LDA(At, 1, 0); PG8_STAGE(PG8_SA(0, 1), a2 + hstepA, voffA);
            PG8_WAIT_L(8); PG8_BAR; PG8_WAIT_L(0); PG8_MMA(0, 0, At, B0); PG8_BAR; PG8_SCHED;
            PG8_LDB(B1, 1, 1); PG8_STAGE(PG8_SB(1, 0), b3, voffB);
            PG8_BAR; PG8_WAIT_L(0); PG8_MMA(0, 1, At, B1); PG8_BAR;
            PG8_LDA(At, 1, 1); PG8_STAGE(PG8_SA(1, 0), a3, voffA);
            PG8_BAR; PG8_WAIT_L(0); PG8_MMA(1, 0, At, B0); PG8_BAR; PG8_SCHED;
            PG8_STAGE(PG8_SB(1, 1), b3 + hstepB, voffB);
            PG8_WAIT_V(6); PG8_BAR; PG8_MMA(1, 1, At, B1); PG8_BAR;
        }
        E(acc, cur, wr, wc, fr, fq);
        if (!has_next) break;
#pragma unroll
        for (int a = 0; a < 2; ++a)
#pragma unroll
            for (int b = 0; b < 2; ++b)
#pragma unroll
                for (int m = 0; m < 4; ++m)
#pragma unroll
                    for (int n = 0; n < 2; ++n) acc[a][b][m][n] = (f32x4){0.f, 0.f, 0.f, 0.f};
        cur = nxt; cA = nA; cB = nB; ++ui;
    }
    PG8_WAIT_V(0);
    if (wr == 0) PG8_BAR;
    PG8_BAR;
#undef PG8_SA
#undef PG8_SB
#undef PG8_STAGE
#undef PG8_LDA
#undef PG8_LDB
#undef PG8_MMA
#undef PG8_WAIT_V
#undef PG8_WAIT_L
#undef PG8_BAR
#undef PG8_SCHED
}

typedef f32x4 Acc[2][2][4][2];
struct EpiZ { static constexpr bool PERM = true;
    bf16_t* Z; const float* ssp; float* ssq; float* kvraw;
    __device__ __forceinline__ void operator()(const Acc& acc, const Unit& u, int wr, int wc, int fr, int fq) const {
        const int rbase = u.pm * BM + wr * 64 + fr, col0 = u.pn * BM + wc * 32 + 8 * fq;
        const bool kvt = (kvraw != nullptr) && u.pn == 10, wantq = (ssq != nullptr) && u.pn <= 1;
#pragma unroll
        for (int ai = 0; ai < 2; ++ai)
#pragma unroll
            for (int m = 0; m < 4; ++m) { const int row = rbase + ai * HALF + m * 16; const float rs = rs_from16(ssp + (size_t)row * 16);
#pragma unroll
                for (int bj = 0; bj < 2; ++bj) { const f32x4 v0 = acc[ai][bj][m][0] * rs, v1 = acc[ai][bj][m][1] * rs; const int c = col0 + bj * HALF;
                    if (!kvt) { u32x4 w; w.x = cvt_pk_bf16(v0[0], v0[1]); w.y = cvt_pk_bf16(v0[2], v0[3]); w.z = cvt_pk_bf16(v1[0], v1[1]); w.w = cvt_pk_bf16(v1[2], v1[3]);
                        *(u32x4*)(Z + (size_t)row * LDZ + c) = w; }
                    else { float* p = kvraw + (size_t)row * 320 + (c - ZB_KV); *(f32x4*)p = v0; *(f32x4*)(p + 4) = v1; }
                    if (kvraw != nullptr && u.pn == 1 && bj == 1 && wc < 2) { float* p = kvraw + (size_t)row * 320 + 256 + (c - ZB_KR); *(f32x4*)p = v0; *(f32x4*)(p + 4) = v1; }
                    if (wantq && (u.pn == 0 || bj == 0)) { float s = sum4(v0 * v0) + sum4(v1 * v1); s += __shfl_xor(s, 16); s += __shfl_xor(s, 32);
                        if (fq == 0) ssq[(size_t)row * 12 + (u.pn == 0 ? bj * 4 + wc : 8 + wc)] = s; } } }
    }
};
struct EpiGrp { static constexpr bool PERM = true;
    const bf16_t* Z; bf16_t* MX;
    __device__ __forceinline__ void operator()(const Acc& acc, const Unit& u, int wr, int wc, int fr, int fq) const {
        const int rbase = u.pm * BM + wr * 64 + fr, col0 = u.pn * BM + wc * 32 + 8 * fq;
#pragma unroll
        for (int ai = 0; ai < 2; ++ai)
#pragma unroll
            for (int m = 0; m < 4; ++m) { const int row = rbase + ai * HALF + m * 16;
                const u32x4 g0 = *(const u32x4*)(Z + (size_t)row * LDZ + ZA_GT + col0), g1 = *(const u32x4*)(Z + (size_t)row * LDZ + ZA_GT + col0 + HALF);
#pragma unroll
                for (int bj = 0; bj < 2; ++bj) { const int c = col0 + bj * HALF; float gt[8]; unpack8(bj ? g1 : g0, gt);
                    const f32x4 v0 = acc[ai][bj][m][0], v1 = acc[ai][bj][m][1]; float o[8];
#pragma unroll
                    for (int j = 0; j < 4; ++j) { o[j] = v0[j] * silu(gt[j]); o[4 + j] = v1[j] * silu(gt[4 + j]); }
                    *(u32x4*)(MX + (size_t)row * OUTW + c) = pack8(o); }
                asm volatile("" ::: "memory"); }
    }
};
struct EpiQ { static constexpr bool PERM = true;
    bf16_t* Q; const float* ssq;
    __device__ __forceinline__ void operator()(const Acc& acc, const Unit& u, int wr, int wc, int fr, int fq) const {
        const int rbase = u.pm * BM + wr * 64 + fr, col0 = u.pn * BM + wc * 32 + 8 * fq;
#pragma unroll
        for (int ai = 0; ai < 2; ++ai)
#pragma unroll
            for (int m = 0; m < 4; ++m) { const int row = rbase + ai * HALF + m * 16; const float rs = rsq_from12(ssq + (size_t)row * 12);
#pragma unroll
                for (int bj = 0; bj < 2; ++bj) { const f32x4 v0 = acc[ai][bj][m][0] * rs, v1 = acc[ai][bj][m][1] * rs;
                    u32x4 w; w.x = cvt_pk_bf16(v0[0], v0[1]); w.y = cvt_pk_bf16(v0[2], v0[3]); w.z = cvt_pk_bf16(v1[0], v1[1]); w.w = cvt_pk_bf16(v1[2], v1[3]);
                    *(u32x4*)(Q + (size_t)row * QW + col0 + bj * HALF) = w; } }
    }
};
struct EpiKV { static constexpr bool PERM = true;
    bf16_t* KN;
    __device__ __forceinline__ void operator()(const Acc& acc, const Unit& u, int wr, int wc, int fr, int fq) const {
        const int rbase = u.pm * BM + wr * 64 + fr, col0 = (u.pn & 3) * BM + wc * 32 + 8 * fq; bf16_t* O = KN + (size_t)(u.pn >> 2) * ((size_t)PM * 1024);
#pragma unroll
        for (int ai = 0; ai < 2; ++ai)
#pragma unroll
            for (int m = 0; m < 4; ++m) { const int row = rbase + ai * HALF + m * 16;
#pragma unroll
                for (int bj = 0; bj < 2; ++bj) { const f32x4 v0 = acc[ai][bj][m][0], v1 = acc[ai][bj][m][1];
                    u32x4 w; w.x = cvt_pk_bf16(v0[0], v0[1]); w.y = cvt_pk_bf16(v0[2], v0[3]); w.z = cvt_pk_bf16(v1[0], v1[1]); w.w = cvt_pk_bf16(v1[2], v1[3]);
                    *(u32x4*)(O + (size_t)row * 1024 + col0 + bj * HALF) = w; } }
    }
};
struct EpiMem { static constexpr bool PERM = true;
    float* OK; bf16_t* MB;
    __device__ __forceinline__ void operator()(const Acc& acc, const Unit& u, int wr, int wc, int fr, int fq) const {
        const int rbase = u.pm * BM + wr * 64 + fr, col0 = u.pn * BM + wc * 32 + 8 * fq;
#pragma unroll
        for (int ai = 0; ai < 2; ++ai)
#pragma unroll
            for (int m = 0; m < 4; ++m) { const int row = rbase + ai * HALF + m * 16;
#pragma unroll
                for (int bj = 0; bj < 2; ++bj) { const int c = col0 + bj * HALF; const int l = c >> 10, kv = (c >> 9) & 1, cc = c & 511; const f32x4 v0 = acc[ai][bj][m][0], v1 = acc[ai][bj][m][1];
                    float* o = OK + (size_t)kv * (O_MEMV - O_MEMK) + ((size_t)l * 2048 + row) * 512 + cc; *(f32x4*)o = v0; *(f32x4*)(o + 4) = v1;
                    u32x4 w; w.x = cvt_pk_bf16(v0[0], v0[1]); w.y = cvt_pk_bf16(v0[2], v0[3]); w.z = cvt_pk_bf16(v1[0], v1[1]); w.w = cvt_pk_bf16(v1[2], v1[3]);
                    *(u32x4*)(MB + (size_t)row * 4096 + c) = w; } }
    }
};
struct EpiOut { static constexpr bool PERM = false;
    bf16_t* XB; float* ssp;
    __device__ __forceinline__ void operator()(const Acc& acc, const Unit& u, int wr, int wc, int fr, int fq) const {
        const int rbase = u.pm * BM + wr * 64 + fr, col0 = u.pn * BM + wc * 32 + 4 * fq;
        u32x2 bw[2][4][2][2];
#pragma unroll
        for (int ai = 0; ai < 2; ++ai)
#pragma unroll
            for (int m = 0; m < 4; ++m)
#pragma unroll
                for (int bj = 0; bj < 2; ++bj)
#pragma unroll
                    for (int n = 0; n < 2; ++n) bw[ai][m][bj][n] = *(const u32x2*)(XB + (size_t)(rbase + ai * HALF + m * 16) * DM + col0 + bj * HALF + n * 16);
#pragma unroll
        for (int ai = 0; ai < 2; ++ai)
#pragma unroll
            for (int m = 0; m < 4; ++m) { const int row = rbase + ai * HALF + m * 16; float s = 0.f;
#pragma unroll
                for (int bj = 0; bj < 2; ++bj)
#pragma unroll
                    for (int n = 0; n < 2; ++n) { const size_t o = (size_t)row * DM + col0 + bj * HALF + n * 16; const u32x2 b = bw[ai][m][bj][n];
                        const f32x4 v = (f32x4){bf_lo(b.x), bf_hi(b.x), bf_lo(b.y), bf_hi(b.y)} + acc[ai][bj][m][n];
                        u32x2 w; w.x = cvt_pk_bf16(v[0], v[1]); w.y = cvt_pk_bf16(v[2], v[3]); *(u32x2*)(XB + o) = w; s += sum4(v * v); }
                s += __shfl_xor(s, 16); s += __shfl_xor(s, 32);
                if (fq == 0) ssp[(size_t)row * 16 + u.pn * 4 + wc] = s; }
    }
};
}
namespace sg {
constexpr int BUF = 24576, LDS_BYTES = 2 * BUF;
template <class Epi>
__device__ __forceinline__ void sgemm_unit(LAS uchar* lds, const bf16_t* A, int lda, const bf16_t* Bt, int ldb, int K, int n0, const Epi& E) {
    int tid_ = threadIdx.x; asm volatile("" : "+v"(tid_));
    const int tid = tid_, wid = tid >> 6, lane = tid & 63, r32 = lane & 31, hi = lane >> 5, rb = wid & 3, cb = wid >> 2;
    const int srow = tid >> 3, sch = tid & 7;
    const bf16_t* ap0 = A + (size_t)srow * lda + sch * 8; const bf16_t* ap1 = ap0 + (size_t)64 * lda; const bf16_t* bp = Bt + (size_t)(n0 + srow) * ldb + sch * 8;
    const int aw0 = srow * 128 + ((sch ^ (srow & 7)) << 4), aw1 = aw0 + 64 * 128, bw = 16384 + aw0;
    const int arow = rb * 32 + r32, brow = cb * 32 + r32;
    const int ard = arow * 128, brd = 16384 + brow * 128, asw = arow & 7, bsw = brow & 7;
    u32x4 ra0[4], ra1[4], rbv[4];
    f32x16 acc = {};
    const int nk = K / 64;
#define SG_LOAD(s, kt) do { ra0[s] = *(const u32x4*)(ap0 + (size_t)(kt) * 64); ra1[s] = *(const u32x4*)(ap1 + (size_t)(kt) * 64); rbv[s] = *(const u32x4*)(bp + (size_t)(kt) * 64); } while (0)
#define SG_WRITE(s, b) do { *(LAS u32x4*)(lds + (b) * BUF + aw0) = ra0[s]; *(LAS u32x4*)(lds + (b) * BUF + aw1) = ra1[s]; *(LAS u32x4*)(lds + (b) * BUF + bw) = rbv[s]; } while (0)
#define SG_COMPUTE(b) do { _Pragma("unroll") for (int kk = 0; kk < 4; ++kk) { \
        const bf16x8 af = *(const LAS bf16x8*)(lds + (b) * BUF + ard + (((2 * kk + hi) ^ asw) << 4)); \
        const bf16x8 bf = *(const LAS bf16x8*)(lds + (b) * BUF + brd + (((2 * kk + hi) ^ bsw) << 4)); \
        acc = __builtin_amdgcn_mfma_f32_32x32x16_bf16(bf, af, acc, 0, 0, 0); } } while (0)
    if ((nk & 3) == 0) {
        SG_LOAD(0, 0); SG_LOAD(1, 1); SG_LOAD(2, 2); SG_LOAD(3, 3);
        for (int kt = 0; kt < nk; kt += 4) { const int l = nk - 1;
            SG_WRITE(0, 0); __syncthreads(); SG_LOAD(0, (kt + 4 < nk ? kt + 4 : l)); SG_COMPUTE(0);
            SG_WRITE(1, 1); __syncthreads(); SG_LOAD(1, (kt + 5 < nk ? kt + 5 : l)); SG_COMPUTE(1);
            SG_WRITE(2, 0); __syncthreads(); SG_LOAD(2, (kt + 6 < nk ? kt + 6 : l)); SG_COMPUTE(0);
            SG_WRITE(3, 1); __syncthreads(); SG_LOAD(3, (kt + 7 < nk ? kt + 7 : l)); SG_COMPUTE(1);
        }
    } else {
        SG_LOAD(0, 0); SG_LOAD(1, 1);
        for (int kt = 0; kt < nk; kt += 2) { const int l = nk - 1;
            SG_WRITE(0, 0); __syncthreads(); SG_LOAD(0, (kt + 2 < nk ? kt + 2 : l));
            SG_COMPUTE(0);
            SG_WRITE(1, 1); __syncthreads(); SG_LOAD(1, (kt + 3 < nk ? kt + 3 : l));
            SG_COMPUTE(1);
        }
    }
#undef SG_LOAD
#undef SG_WRITE
#undef SG_COMPUTE
    E(acc, rb * 32 + r32, n0 + cb * 32, hi);
}

struct EpiZ { bf16_t* Z; const float* ssps; float* ssq; float* kvraw;
    __device__ __forceinline__ void operator()(const f32x16& acc, int row, int cbase, int hi) const {
        const float rs = rs_from32(ssps + row * 32); const size_t grow = (size_t)PM + row; float s = 0.f;
#pragma unroll
        for (int g = 0; g < 4; ++g) { const f32x4 v = (f32x4){acc[4 * g], acc[4 * g + 1], acc[4 * g + 2], acc[4 * g + 3]} * rs; const int c = cbase + 8 * g + 4 * hi;
            if (kvraw != nullptr && cbase >= ZB_KV) *(f32x4*)(kvraw + grow * 320 + (c - ZB_KV)) = v;
            else { u32x2 w; w.x = cvt_pk_bf16(v[0], v[1]); w.y = cvt_pk_bf16(v[2], v[3]); *(u32x2*)(Z + grow * LDZ + c) = w; }
            if (kvraw != nullptr && cbase >= ZB_KR && cbase < ZB_KR + 64) *(f32x4*)(kvraw + grow * 320 + 256 + (c - ZB_KR)) = v;
            s += sum4(v * v); }
        if (ssq != nullptr && cbase < QRANK) { s += __shfl_xor(s, 32); if (hi == 0) ssq[grow * 12 + (cbase >> 5)] = s; }
    }
};
struct EpiGrp { const bf16_t* Z; bf16_t* MX; int cofs;
    __device__ __forceinline__ void operator()(const f32x16& acc, int row, int cbase, int hi) const {
        const size_t grow = (size_t)PM + row;
#pragma unroll
        for (int g = 0; g < 4; ++g) { const int c = cofs + cbase + 8 * g + 4 * hi; const u32x2 gw = *(const u32x2*)(Z + grow * LDZ + ZA_GT + c);
            const float o0 = acc[4 * g] * silu(bf_lo(gw.x)), o1 = acc[4 * g + 1] * silu(bf_hi(gw.x)), o2 = acc[4 * g + 2] * silu(bf_lo(gw.y)), o3 = acc[4 * g + 3] * silu(bf_hi(gw.y));
            u32x2 w; w.x = cvt_pk_bf16(o0, o1); w.y = cvt_pk_bf16(o2, o3); *(u32x2*)(MX + grow * OUTW + c) = w; }
    }
};
struct EpiOut { bf16_t* XB; float* ssps;
    __device__ __forceinline__ void operator()(const f32x16& acc, int row, int cbase, int hi) const {
        const size_t grow = (size_t)PM + row; float s = 0.f;
#pragma unroll
        for (int g = 0; g < 4; ++g) { const int c = cbase + 8 * g + 4 * hi; const u32x2 b = *(const u32x2*)(XB + grow * DM + c);
            const f32x4 v = (f32x4){bf_lo(b.x), bf_hi(b.x), bf_lo(b.y), bf_hi(b.y)} + (f32x4){acc[4 * g], acc[4 * g + 1], acc[4 * g + 2], acc[4 * g + 3]};
            u32x2 w; w.x = cvt_pk_bf16(v[0], v[1]); w.y = cvt_pk_bf16(v[2], v[3]); *(u32x2*)(XB + grow * DM + c) = w; s += sum4(v * v); }
        s += __shfl_xor(s, 32); if (hi == 0) ssps[row * 32 + (cbase >> 5)] = s;
    }
};
struct EpiQ { bf16_t* Q; const float* ssq;
    __device__ __forceinline__ void operator()(const f32x16& acc, int row, int cbase, int hi) const {
        const size_t grow = (size_t)PM + row; const float rs = rsq_from12(ssq + grow * 12);
#pragma unroll
        for (int g = 0; g < 4; ++g) { const int c = cbase + 8 * g + 4 * hi; u32x2 w; w.x = cvt_pk_bf16(acc[4 * g] * rs, acc[4 * g + 1] * rs); w.y = cvt_pk_bf16(acc[4 * g + 2] * rs, acc[4 * g + 3] * rs);
            *(u32x2*)(Q + grow * QW + c) = w; }
    }
};
struct EpiAbsorb { bf16_t* QD; int h;
    __device__ __forceinline__ void operator()(const f32x16& acc, int row, int cbase, int hi) const {
        const int b = row >> 2, t = row & 3; bf16_t* o = QD + ((size_t)b * 32 + t * 8 + h) * 320;
#pragma unroll
        for (int g = 0; g < 4; ++g) { const int c = cbase + 8 * g + 4 * hi; u32x2 w; w.x = cvt_pk_bf16(acc[4 * g], acc[4 * g + 1]); w.y = cvt_pk_bf16(acc[4 * g + 2], acc[4 * g + 3]); *(u32x2*)(o + c) = w; }
    }
};
struct EpiVup { const bf16_t* Z; bf16_t* MX; int h;
    __device__ __forceinline__ void operator()(const f32x16& acc, int row, int cbase, int hi) const {
        const size_t grow = (size_t)PM + row;
#pragma unroll
        for (int g = 0; g < 4; ++g) { const int c = h * 128 + cbase + 8 * g + 4 * hi; const u32x2 gw = *(const u32x2*)(Z + grow * LDZ + ZB_GT + c);
            const float o0 = acc[4 * g] * silu(bf_lo(gw.x)), o1 = acc[4 * g + 1] * silu(bf_hi(gw.x)), o2 = acc[4 * g + 2] * silu(bf_lo(gw.y)), o3 = acc[4 * g + 3] * silu(bf_hi(gw.y));
            u32x2 w; w.x = cvt_pk_bf16(o0, o1); w.y = cvt_pk_bf16(o2, o3); *(u32x2*)(MX + grow * OUTW + c) = w; }
    }
};
}
namespace att {
constexpr int NW = 8, QBLK = 32, KVBLK = 64;
constexpr int SHM_V = KVBLK * 128 * 2, SHM_K = KVBLK * 128 * 2, SHM_KR = KVBLK * 64 * 2;
constexpr int OFF_V = 0, OFF_K = 2 * SHM_V, OFF_KR = OFF_K + 2 * SHM_K, OFF_WS = OFF_KR + 2 * SHM_KR, OFF_QR = OFF_WS + NW * 64 * 4, LDS_BYTES = OFF_QR + NW * 4096;
constexpr float THR = 8.f;
#define KSWZ(row, colB) ((row) * 256 + ((colB) ^ (((row) & 7) << 4)))
#define KRSWZ(row, colB) ((row) * 128 + ((colB) ^ (((row) & 7) << 4)))
#define SBAR() __builtin_amdgcn_sched_barrier(0)
template <int DQK> struct Cst { static constexpr float SCALE = (DQK == 128) ? 0.08838834764831845f : 0.07216878364870322f; };

template <int DQK>
__device__ __forceinline__ void partialSM(f32x16& p0, f32x16& p1, float& m_reg, float& mn, float& alpha) {
    constexpr float SCALE = Cst<DQK>::SCALE, C = SCALE * 1.4426950408889634f;
    float pmax = p0[0];
#pragma unroll
    for (int r = 1; r < 16; ++r) pmax = fmaxf(pmax, p0[r]);
#pragma unroll
    for (int r = 0; r < 16; ++r) pmax = fmaxf(pmax, p1[r]);
    { auto rr = __builtin_amdgcn_permlane32_swap(__float_as_uint(pmax), __float_as_uint(pmax), false, false);
      pmax = fmaxf(__uint_as_float(rr[0]), __uint_as_float(rr[1])); }
    if (__builtin_expect(__all(pmax - m_reg <= THR / SCALE), 1)) { mn = m_reg; alpha = 1.f; }
    else { mn = fmaxf(m_reg, pmax); alpha = __builtin_amdgcn_exp2f((m_reg - mn) * C); m_reg = mn; }
    const float mnC = -mn * C;
#pragma unroll
    for (int r = 0; r < 16; ++r) p0[r] = fmaf(p0[r], C, mnC);
#pragma unroll
    for (int r = 0; r < 16; ++r) p1[r] = fmaf(p1[r], C, mnC);
#pragma unroll
    for (int r = 0; r < 16; ++r) p0[r] = __builtin_amdgcn_exp2f(p0[r]);
}
__device__ __forceinline__ void finishSM(f32x16& p0, f32x16& p1, float alpha, float& l_reg, bf16x8& pa0, bf16x8& pa1, bf16x8& pa2, bf16x8& pa3) {
#pragma unroll
    for (int r = 0; r < 16; ++r) p1[r] = __builtin_amdgcn_exp2f(p1[r]);
    float ps = 0;
#pragma unroll
    for (int r = 0; r < 16; ++r) ps += p0[r];
#pragma unroll
    for (int r = 0; r < 16; ++r) ps += p1[r];
    { auto rr = __builtin_amdgcn_permlane32_swap(__float_as_uint(ps), __float_as_uint(ps), false, false);
      ps = __uint_as_float(rr[0]) + __uint_as_float(rr[1]); }
    l_reg = l_reg * alpha + ps;
#define PK4(P, BASE, OUT) do { unsigned a0 = cvt_pk_bf16(P[BASE + 0], P[BASE + 1]), a1 = cvt_pk_bf16(P[BASE + 2], P[BASE + 3]);   \
    unsigned b0 = cvt_pk_bf16(P[BASE + 4], P[BASE + 5]), b1 = cvt_pk_bf16(P[BASE + 6], P[BASE + 7]);                              \
    auto r0 = __builtin_amdgcn_permlane32_swap(a0, b0, false, false); auto r1 = __builtin_amdgcn_permlane32_swap(a1, b1, false, false); \
    u32x4 w = {r0[0], r1[0], r0[1], r1[1]}; OUT = *reinterpret_cast<bf16x8*>(&w); } while (0)
    PK4(p0, 0, pa0); PK4(p0, 8, pa1); PK4(p1, 0, pa2); PK4(p1, 8, pa3);
#undef PK4
}
template <int DQK>
__device__ __forceinline__ void qkt(f32x16& p0, f32x16& p1, const LAS uchar* Ks, const LAS uchar* Krs, const bf16x8* qr, const LAS uchar* qrl  , int r32, int hi) {
    p0 = f32x16{}; p1 = f32x16{};
#pragma unroll
    for (int d0 = 0; d0 < 8; ++d0) { const int cb = (d0 * 16 + hi * 8) * 2;
        const bf16x8 b0 = *(const LAS bf16x8*)(Ks + KSWZ(r32, cb));
        const bf16x8 b1 = *(const LAS bf16x8*)(Ks + KSWZ(32 + r32, cb));
        p0 = __builtin_amdgcn_mfma_f32_32x32x16_bf16(b0, qr[d0], p0, 0, 0, 0);
        p1 = __builtin_amdgcn_mfma_f32_32x32x16_bf16(b1, qr[d0], p1, 0, 0, 0); }
    if constexpr (DQK == 192) {
#pragma unroll
        for (int d0 = 0; d0 < 4; ++d0) { const int cb = (d0 * 16 + hi * 8) * 2;
            const bf16x8 b0 = *(const LAS bf16x8*)(Krs + KRSWZ(r32, cb));
            const bf16x8 b1 = *(const LAS bf16x8*)(Krs + KRSWZ(32 + r32, cb));
            const bf16x8 qf = *(const LAS bf16x8*)(qrl + d0 * 1024);
            p0 = __builtin_amdgcn_mfma_f32_32x32x16_bf16(b0, qf, p0, 0, 0, 0);
            p1 = __builtin_amdgcn_mfma_f32_32x32x16_bf16(b1, qf, p1, 0, 0, 0); }
    }
}
__device__ __forceinline__ int v_st(int k, int c) { const int kk = (k & ~0xC) | ((k & 4) << 1) | ((k & 8) >> 1); return ((kk >> 3) * 4 + (c >> 5)) * 512 + ((kk & 7) * 32 + (c & 31)) * 2; }
__device__ __forceinline__ int v_rd_base(int lane) { return ((lane & 3) << 3) | (((lane >> 2) & 3) << 6) | (((lane >> 4) & 1) << 5) | (((lane >> 5) & 1) << 8); }
constexpr int v_rd_off(int d0, int ks, int half) { return d0 * 512 + ks * 4096 + half * 2048; }
template <int OFF> __device__ __forceinline__ s16x4 tr_read(int vb) {
    s16x4 r; asm volatile("ds_read_b64_tr_b16 %0, %1 offset:%2" : "=&v"(r) : "v"(vb), "i"(OFF) : "memory"); return r;
}
template <int D0> __device__ __forceinline__ void pv_one(f32x16& od, int vb, bf16x8 pa0, bf16x8 pa1, bf16x8 pa2, bf16x8 pa3) {
    const s16x4 l0 = tr_read<v_rd_off(D0, 0, 0)>(vb), h0 = tr_read<v_rd_off(D0, 0, 1)>(vb), l1 = tr_read<v_rd_off(D0, 1, 0)>(vb), h1 = tr_read<v_rd_off(D0, 1, 1)>(vb);
    const s16x4 l2 = tr_read<v_rd_off(D0, 2, 0)>(vb), h2 = tr_read<v_rd_off(D0, 2, 1)>(vb), l3 = tr_read<v_rd_off(D0, 3, 0)>(vb), h3 = tr_read<v_rd_off(D0, 3, 1)>(vb);
    asm volatile("s_waitcnt lgkmcnt(0)" ::: "memory"); SBAR();
#define PK(L, H) (bf16x8){L[0], L[1], L[2], L[3], H[0], H[1], H[2], H[3]}
    od = __builtin_amdgcn_mfma_f32_32x32x16_bf16(pa0, PK(l0, h0), od, 0, 0, 0);
    od = __builtin_amdgcn_mfma_f32_32x32x16_bf16(pa1, PK(l1, h1), od, 0, 0, 0);
    od = __builtin_amdgcn_mfma_f32_32x32x16_bf16(pa2, PK(l2, h2), od, 0, 0, 0);
    od = __builtin_amdgcn_mfma_f32_32x32x16_bf16(pa3, PK(l3, h3), od, 0, 0, 0);
#undef PK
}
__device__ __forceinline__ void pv_d0(f32x16* o, int vb, bf16x8 pa0, bf16x8 pa1, bf16x8 pa2, bf16x8 pa3) {
    pv_one<0>(o[0], vb, pa0, pa1, pa2, pa3); pv_one<1>(o[1], vb, pa0, pa1, pa2, pa3); pv_one<2>(o[2], vb, pa0, pa1, pa2, pa3); pv_one<3>(o[3], vb, pa0, pa1, pa2, pa3);
}
__device__ __forceinline__ void causal_mask(f32x16& p0, f32x16& p1, int jj, int rowrel, int hi) {
#pragma unroll
    for (int r = 0; r < 16; ++r) { const int k0 = 64 * jj + crow(r, hi); if (k0 > rowrel) p0[r] = -1e30f; if (k0 + 32 > rowrel) p1[r] = -1e30f; }
}

template <int DQK, bool CAUSAL, int SD, int LDQ, int LDK>
__device__ __forceinline__ void attn_body(const bf16_t* __restrict__ Qb, const bf16_t* __restrict__ Kh, const bf16_t* __restrict__ Vh, const bf16_t* __restrict__ Krp,
                                          const f32x2* __restrict__ ropeq, const bf16_t* __restrict__ gate, bf16_t* __restrict__ outp, int NT, int diag0, LAS uchar* lds) {
    constexpr int NQ = 8;
    int tid_ = threadIdx.x; asm volatile("" : "+v"(tid_));
    const int tid = tid_, wid = tid >> 6, lane = tid & 63, r32 = lane & 31, hi = lane >> 5;
    LAS uchar* V_lds = lds + OFF_V; LAS uchar* K_lds = lds + OFF_K; LAS uchar* Kr_lds = lds + OFF_KR;
    LAS float* ws = (LAS float*)(lds + OFF_WS) + wid * 64; LAS float* li_l = ws; LAS float* al_l = ws + 32; LAS uchar* qrl = lds + OFF_QR + wid * 4096 + lane * 16;
    float m_reg = -1e30f, l_reg = 0; f32x16 o[4] = {}; bf16x8 qr[NQ];
    const bf16_t* Qw = Qb + (size_t)(wid * QBLK + r32) * LDQ + hi * 8;
#pragma unroll
    for (int d0 = 0; d0 < 8; ++d0) qr[d0] = *(const bf16x8*)(Qw + d0 * 16);
    if constexpr (DQK == 192) {
#pragma unroll
        for (int a = 0; a < 2; ++a) {
            const u32x4 w1 = *(const u32x4*)(Qw + 128 + 16 * a), w2 = *(const u32x4*)(Qw + 160 + 16 * a); float x1[8], x2[8], o1[8], o2[8]; unpack8(w1, x1); unpack8(w2, x2);
            const f32x2* tb = ropeq + (size_t)(wid * QBLK + r32) * 32 + 16 * a + 8 * hi;
#pragma unroll
            for (int j = 0; j < 8; ++j) { const f32x2 cs = tb[j]; o1[j] = x1[j] * cs.x - x2[j] * cs.y; o2[j] = x1[j] * cs.y + x2[j] * cs.x; }
            *(LAS u32x4*)(qrl + a * 1024) = pack8(o1); *(LAS u32x4*)(qrl + (2 + a) * 1024) = pack8(o2);
        }
    }
    const int sr = tid >> 4, sc = (tid & 15) * 8, vst0 = v_st(sr, sc), vst1 = v_st(32 + sr, sc);
    const int krow = tid >> 3, kcc = (tid & 7) * 8;
    const int vb0 = (int)(unsigned)(uintptr_t)V_lds + v_rd_base(lane);
    struct { bf16x8 vs0, vs1, ks0, ks1, kr; } sr_[SD];
#define SLOAD(i, k0) do { sr_[i].vs0 = *(const bf16x8*)(Vh + (size_t)((k0) + sr) * LDK + sc); sr_[i].vs1 = *(const bf16x8*)(Vh + (size_t)((k0) + 32 + sr) * LDK + sc); \
    sr_[i].ks0 = *(const bf16x8*)(Kh + (size_t)((k0) + sr) * LDK + sc); sr_[i].ks1 = *(const bf16x8*)(Kh + (size_t)((k0) + 32 + sr) * LDK + sc); \
    if constexpr (DQK == 192) sr_[i].kr = *(const bf16x8*)(Krp + (size_t)((k0) + krow) * 64 + kcc); } while (0)
#define SWRITE(b, i) do { *(LAS bf16x8*)(V_lds + (b) * SHM_V + vst0) = sr_[i].vs0; *(LAS bf16x8*)(V_lds + (b) * SHM_V + vst1) = sr_[i].vs1; const int kc = sc * 2; \
    *(LAS bf16x8*)(K_lds + (b) * SHM_K + KSWZ(sr, kc)) = sr_[i].ks0; *(LAS bf16x8*)(K_lds + (b) * SHM_K + KSWZ(32 + sr, kc)) = sr_[i].ks1; \
    if constexpr (DQK == 192) *(LAS bf16x8*)(Kr_lds + (b) * SHM_KR + KRSWZ(krow, kcc * 2)) = sr_[i].kr; } while (0)
#define SWAIT() do { if constexpr (SD == 2) { if constexpr (DQK == 192) asm volatile("s_waitcnt vmcnt(5)" ::: "memory"); else asm volatile("s_waitcnt vmcnt(4)" ::: "memory"); } \
    else asm volatile("s_waitcnt vmcnt(0)" ::: "memory"); } while (0)
#define RESC(a) do { if (__any((a) < 1.f)) { if (hi == 0) al_l[r32] = (a); asm volatile("s_waitcnt lgkmcnt(0)" ::: "memory"); \
    _Pragma("unroll") for (int d = 0; d < 4; ++d) _Pragma("unroll") for (int r = 0; r < 16; ++r) o[d][r] *= al_l[crow(r, hi)]; } } while (0)
#define MASK(P0, P1, tile) do { if constexpr (CAUSAL) { if ((tile) >= diag0) causal_mask(P0, P1, (tile) - diag0, wid * QBLK + r32, hi); } } while (0)
    f32x16 pA0, pA1, pB0, pB1; float mnA, mnB, alA, alB; bf16x8 pa0, pa1, pa2, pa3;
    constexpr int SE = 0, SO = SD - 1;
    SLOAD(SE, 0); asm volatile("s_waitcnt vmcnt(0)" ::: "memory"); SWRITE(0, SE); __syncthreads();
    qkt<DQK>(pA0, pA1, K_lds, Kr_lds, qr, qrl, r32, hi); MASK(pA0, pA1, 0); partialSM<DQK>(pA0, pA1, m_reg, mnA, alA);
    SLOAD(SO, KVBLK); if constexpr (SD == 2) { if (2 < NT) SLOAD(SE, 2 * KVBLK); }
    SWAIT(); SWRITE(1, SO); __syncthreads();
    for (int j = 1; j + 1 < NT; j += 2) {
        SBAR(); qkt<DQK>(pB0, pB1, K_lds + SHM_K, Kr_lds + SHM_KR, qr, qrl, r32, hi); MASK(pB0, pB1, j);
        finishSM(pA0, pA1, alA, l_reg, pa0, pa1, pa2, pa3); SBAR();
        SLOAD(SO, (j + SD) * KVBLK); SBAR();
        pv_d0(o, vb0, pa0, pa1, pa2, pa3); partialSM<DQK>(pB0, pB1, m_reg, mnB, alB);
        __syncthreads(); SWAIT(); SWRITE(0, SE);
        RESC(alB); __syncthreads();
        SBAR(); qkt<DQK>(pA0, pA1, K_lds, Kr_lds, qr, qrl, r32, hi); MASK(pA0, pA1, j + 1);
        finishSM(pB0, pB1, alB, l_reg, pa0, pa1, pa2, pa3); SBAR();
        if (SD == 1 || j + 3 < NT) SLOAD(SE, (j + 1 + SD) * KVBLK); SBAR();
        pv_d0(o, vb0 + SHM_V, pa0, pa1, pa2, pa3); partialSM<DQK>(pA0, pA1, m_reg, mnA, alA);
        __syncthreads(); SWAIT(); SWRITE(1, SO);
        RESC(alA); __syncthreads();
    }
    SBAR(); qkt<DQK>(pB0, pB1, K_lds + SHM_K, Kr_lds + SHM_KR, qr, qrl, r32, hi); MASK(pB0, pB1, NT - 1);
    finishSM(pA0, pA1, alA, l_reg, pa0, pa1, pa2, pa3); SBAR();
    pv_d0(o, vb0, pa0, pa1, pa2, pa3); partialSM<DQK>(pB0, pB1, m_reg, mnB, alB);
    __syncthreads(); RESC(alB);
    finishSM(pB0, pB1, alB, l_reg, pa0, pa1, pa2, pa3); SBAR();
    pv_d0(o, vb0 + SHM_V, pa0, pa1, pa2, pa3);
    if (hi == 0) li_l[r32] = l_reg; asm volatile("s_waitcnt lgkmcnt(0)" ::: "memory");
    float rli[16];
#pragma unroll
    for (int r = 0; r < 16; ++r) rli[r] = __builtin_amdgcn_rcpf(li_l[crow(r, hi)]);
    { LAS uchar* ot = lds + OFF_QR + wid * 4096; const int orow = lane >> 1, ocb = (lane & 1) * 32; const size_t grow = (size_t)(wid * QBLK + orow);
#pragma unroll
      for (int hf = 0; hf < 2; ++hf) {
#pragma unroll
          for (int r = 0; r < 16; ++r)
#pragma unroll
              for (int dd = 0; dd < 2; ++dd) *(LAS bf16_t*)(ot + crow(r, hi) * 128 + (dd * 32 + r32) * 2) = (bf16_t)(cvt_pk_bf16(o[2 * hf + dd][r] * rli[r], 0.f) & 0xffffu);
          asm volatile("s_waitcnt lgkmcnt(0)" ::: "memory");
#pragma unroll
          for (int c = 0; c < 4; ++c) { const u32x4 ov = *(const LAS u32x4*)(ot + orow * 128 + ocb * 2 + c * 16); const u32x4 gv = *(const u32x4*)(gate + grow * LDZ + hf * 64 + ocb + c * 8);
              float of[8], gf[8]; unpack8(ov, of); unpack8(gv, gf);
#pragma unroll
              for (int q = 0; q < 8; ++q) of[q] *= silu(gf[q]);
              *(u32x4*)(outp + grow * OUTW + hf * 64 + ocb + c * 8) = pack8(of); }
          asm volatile("s_waitcnt lgkmcnt(0)" ::: "memory"); } }
#undef SLOAD
#undef SWRITE
#undef SWAIT
#undef RESC
#undef MASK
}
}
namespace dec {
constexpr int BUFB = 40960, OFF_KR = 32768, OFF_WS = 2 * BUFB, LDS_BYTES = OFF_WS + 8 * 64 * 4 + 32 * 640 + 64;
__device__ __forceinline__ unsigned off_b(unsigned row, unsigned ch) { return 256u * row + 16u * (ch ^ (((row & 3) << 2) | ((row >> 2) & 3))); }
__device__ __forceinline__ unsigned row_read_addr(unsigned lane, unsigned s) { return off_b(lane & 31, 2 * s + (lane >> 5)); }
__device__ __forceinline__ unsigned tr_read_addr(unsigned lane, unsigned c, unsigned ks, unsigned t) {
    const unsigned h = lane >> 5, blk = (lane >> 4) & 1, q = (lane & 15) >> 2, p = lane & 3;
    return off_b(16 * ks + 8 * h + 4 * t + q, 4 * c + 2 * blk + (p >> 1)) + 8 * (p & 1);
}
__device__ __forceinline__ s16x4 tr_rd(unsigned addr) { s16x4 r; asm volatile("ds_read_b64_tr_b16 %0, %1" : "=&v"(r) : "v"(addr) : "memory"); return r; }

__device__ __forceinline__ void partialSM1(f32x16& p0, float& m_reg, float& alpha) {
    constexpr float SCALE = att::Cst<192>::SCALE, C = SCALE * 1.4426950408889634f;
    float pmax = p0[0];
#pragma unroll
    for (int r = 1; r < 16; ++r) pmax = fmaxf(pmax, p0[r]);
    { auto rr = __builtin_amdgcn_permlane32_swap(__float_as_uint(pmax), __float_as_uint(pmax), false, false);
      pmax = fmaxf(__uint_as_float(rr[0]), __uint_as_float(rr[1])); }
    float mn;
    if (__builtin_expect(__all(pmax - m_reg <= att::THR / SCALE), 1)) { mn = m_reg; alpha = 1.f; }
    else { mn = fmaxf(m_reg, pmax); alpha = __builtin_amdgcn_exp2f((m_reg - mn) * C); m_reg = mn; }
    const float mnC = -mn * C;
#pragma unroll
    for (int r = 0; r < 16; ++r) p0[r] = __builtin_amdgcn_exp2f(fmaf(p0[r], C, mnC));
}
__device__ __forceinline__ void finishSM1(const f32x16& p0, float alpha, float& l_reg, bf16x8& pa0, bf16x8& pa1) {
    float ps = 0;
#pragma unroll
    for (int r = 0; r < 16; ++r) ps += p0[r];
    { auto rr = __builtin_amdgcn_permlane32_swap(__float_as_uint(ps), __float_as_uint(ps), false, false);
      ps = __uint_as_float(rr[0]) + __uint_as_float(rr[1]); }
    l_reg = l_reg * alpha + ps;
#define PK4(P, BASE, OUT) do { unsigned a0 = cvt_pk_bf16(P[BASE + 0], P[BASE + 1]), a1 = cvt_pk_bf16(P[BASE + 2], P[BASE + 3]);   \
    unsigned b0 = cvt_pk_bf16(P[BASE + 4], P[BASE + 5]), b1 = cvt_pk_bf16(P[BASE + 6], P[BASE + 7]);                              \
    auto r0 = __builtin_amdgcn_permlane32_swap(a0, b0, false, false); auto r1 = __builtin_amdgcn_permlane32_swap(a1, b1, false, false); \
    u32x4 w = {r0[0], r1[0], r0[1], r1[1]}; OUT = *reinterpret_cast<bf16x8*>(&w); } while (0)
    PK4(p0, 0, pa0); PK4(p0, 8, pa1);
#undef PK4
}

constexpr int OFF_Q = OFF_WS + 8 * 64 * 4;
__device__ __forceinline__ void decode_unit(const bf16_t* __restrict__ Qd, const float* __restrict__ cckv, const float* __restrict__ ckr, const int* __restrict__ pt,
                                            float* __restrict__ Opart, float* __restrict__ ML, LAS uchar* lds) {
    int tid_ = threadIdx.x; asm volatile("" : "+v"(tid_));
    const int tid = tid_, wid = tid >> 6, lane = tid & 63, r32 = lane & 31, hi = lane >> 5, kb = wid & 1, dq = wid >> 1;
    LAS float* al_l = (LAS float*)(lds + OFF_WS) + wid * 64;
    for (int c = tid; c < 32 * 40; c += 512) { const int r = c / 40, ch = c - r * 40; *(LAS u32x4*)(lds + OFF_Q + r * 640 + ((ch ^ (r & 7)) << 4)) = *(const u32x4*)(Qd + (size_t)r * 320 + ch * 8); }
    LAS int* pgs = (LAS int*)(lds + OFF_Q + 32 * 640);
    if (tid < 16) pgs[tid] = pt[tid];
    __syncthreads();
    const LAS uchar* qb = lds + OFF_Q + r32 * 640; const int qsw = r32 & 7;
    float m_reg = -1e30f, l_reg = 0.f; f32x16 o0 = {}, o1 = {};
    f32x4 svA[10], svB[10];
    const int kc = lane & 15, kq = lane >> 4;
    const unsigned wck = (unsigned)((lane >> 5) * 2 * 8192) + ((lane & 1) << 3);
    const unsigned ldsb = (unsigned)(uintptr_t)lds;
    const int pw = dq >> 1, cw0 = (dq & 1) * 2;
    const unsigned tra[2][2][2] = {{{tr_read_addr(lane, cw0, 0, 0), tr_read_addr(lane, cw0, 0, 1)}, {tr_read_addr(lane, cw0, 1, 0), tr_read_addr(lane, cw0, 1, 1)}},
                                   {{tr_read_addr(lane, cw0 + 1, 0, 0), tr_read_addr(lane, cw0 + 1, 0, 1)}, {tr_read_addr(lane, cw0 + 1, 1, 0), tr_read_addr(lane, cw0 + 1, 1, 1)}}};
#define DLOAD(sv, j) do { const int page = pgs[(j) >> 1]; const size_t krow = (size_t)page * 128 + ((j) & 1) * 64 + wid * 8; \
    const float* s0 = cckv + krow * 256 + 4 * lane; const float* s1 = ckr + (krow + kq) * 64 + 4 * kc; \
    _Pragma("unroll") for (int i = 0; i < 8; ++i) sv[i] = __builtin_nontemporal_load((const f32x4*)(s0 + i * 256)); \
    sv[8] = __builtin_nontemporal_load((const f32x4*)s1); sv[9] = __builtin_nontemporal_load((const f32x4*)(s1 + 4 * 64)); } while (0)
#define DWRITE(sv, b) do { _Pragma("unroll") for (int i = 0; i < 8; ++i) { const int key = wid * 8 + i; u32x2 w; w.x = cvt_pk_bf16(sv[i][0], sv[i][1]); w.y = cvt_pk_bf16(sv[i][2], sv[i][3]); \
        *(LAS u32x2*)(lds + (b) * BUFB + wck + (key >> 5) * 8192 + off_b(key & 31, (lane & 31) >> 1)) = w; } \
    _Pragma("unroll") for (int i = 0; i < 2; ++i) { const int key = wid * 8 + kq + 4 * i; u32x2 w; w.x = cvt_pk_bf16(sv[8 + i][0], sv[8 + i][1]); w.y = cvt_pk_bf16(sv[8 + i][2], sv[8 + i][3]); \
        *(LAS u32x2*)(lds + (b) * BUFB + OFF_KR + key * 128 + (((kc >> 1) ^ (key & 7)) << 4) + ((kc & 1) << 3)) = w; } } while (0)
#define DCOMPUTE(b) do { const LAS uchar* B = lds + (b) * BUFB; f32x16 p0 = {}; \
      \
    _Pragma("unroll") for (int s0 = 0; s0 < 16; s0 += 4) { bf16x8 kf[4], qf[4]; \
        _Pragma("unroll") for (int i = 0; i < 4; ++i) { const int s = s0 + i; qf[i] = *(const LAS bf16x8*)(qb + (((2 * s + hi) ^ qsw) << 4)); \
            kf[i] = *(const LAS bf16x8*)(B + ((s >> 3) * 2 + kb) * 8192 + row_read_addr(lane, s & 7)); } \
        asm volatile("" ::: "memory"); \
        _Pragma("unroll") for (int i = 0; i < 4; ++i) p0 = __builtin_amdgcn_mfma_f32_32x32x16_bf16(kf[i], qf[i], p0, 0, 0, 0); \
        asm volatile("" ::: "memory"); } \
    { bf16x8 kf[4], qf[4]; \
        _Pragma("unroll") for (int s = 0; s < 4; ++s) { const int chk = 2 * s + hi; qf[s] = *(const LAS bf16x8*)(qb + (((32 + 2 * s + hi) ^ qsw) << 4)); \
            kf[s] = *(const LAS bf16x8*)(B + OFF_KR + (kb * 32 + r32) * 128 + ((chk ^ (r32 & 7)) << 4)); } \
        asm volatile("" ::: "memory"); \
        _Pragma("unroll") for (int s = 0; s < 4; ++s) p0 = __builtin_amdgcn_mfma_f32_32x32x16_bf16(kf[s], qf[s], p0, 0, 0, 0); } \
    float alpha; partialSM1(p0, m_reg, alpha); \
    if (__any(alpha < 1.f)) { if (hi == 0) al_l[r32] = alpha; asm volatile("s_waitcnt lgkmcnt(0)" ::: "memory"); \
        _Pragma("unroll") for (int r = 0; r < 16; ++r) { const float a = al_l[crow(r, hi)]; o0[r] *= a; o1[r] *= a; } } \
    bf16x8 pa[2]; finishSM1(p0, alpha, l_reg, pa[0], pa[1]); \
    const unsigned vb = ldsb + (b) * BUFB + (pw * 2 + kb) * 8192; s16x4 vl[2][2], vh[2][2]; \
    _Pragma("unroll") for (int dd = 0; dd < 2; ++dd) _Pragma("unroll") for (int ks = 0; ks < 2; ++ks) { vl[dd][ks] = tr_rd(vb + tra[dd][ks][0]); vh[dd][ks] = tr_rd(vb + tra[dd][ks][1]); } \
    asm volatile("s_waitcnt lgkmcnt(0)" ::: "memory"); __builtin_amdgcn_sched_barrier(0); \
    _Pragma("unroll") for (int ks = 0; ks < 2; ++ks) { \
        o0 = __builtin_amdgcn_mfma_f32_32x32x16_bf16(pa[ks], ((bf16x8){vl[0][ks][0], vl[0][ks][1], vl[0][ks][2], vl[0][ks][3], vh[0][ks][0], vh[0][ks][1], vh[0][ks][2], vh[0][ks][3]}), o0, 0, 0, 0); \
        o1 = __builtin_amdgcn_mfma_f32_32x32x16_bf16(pa[ks], ((bf16x8){vl[1][ks][0], vl[1][ks][1], vl[1][ks][2], vl[1][ks][3], vh[1][ks][0], vh[1][ks][1], vh[1][ks][2], vh[1][ks][3]}), o1, 0, 0, 0); } } while (0)
    constexpr int NT = 32;
    DLOAD(svA, 0); DLOAD(svB, 1); DWRITE(svA, 0); DLOAD(svA, 2); __syncthreads();
    for (int j = 0; j < NT; j += 2) {
        DCOMPUTE(0);
        DWRITE(svB, 1);
        { const int jn = (j + 3 < NT) ? j + 3 : NT - 1; DLOAD(svB, jn); }
        __syncthreads();
        DCOMPUTE(1);
        DWRITE(svA, 0);
        { const int jn = (j + 4 < NT) ? j + 4 : NT - 1; DLOAD(svA, jn); }
        __syncthreads();
    }
#undef DLOAD
#undef DWRITE
#undef DCOMPUTE
    LAS float* mlx = (LAS float*)lds + dq * 64;
    LAS float* ox = (LAS float*)(lds + 4096) + dq * 2048;
    if (kb == 1) { if (hi == 0) { mlx[r32 * 2] = m_reg; mlx[r32 * 2 + 1] = l_reg; }
#pragma unroll
        for (int r = 0; r < 16; ++r) { ox[crow(r, hi) * 32 + r32] = o0[r]; ox[1024 + crow(r, hi) * 32 + r32] = o1[r]; } }
    __syncthreads();
    if (kb == 0) { constexpr float C = att::Cst<192>::SCALE * 1.4426950408889634f;
        const float m1 = mlx[r32 * 2], l1 = mlx[r32 * 2 + 1], M = fmaxf(m_reg, m1), w0 = __builtin_amdgcn_exp2f((m_reg - M) * C), w1 = __builtin_amdgcn_exp2f((m1 - M) * C), L = l_reg * w0 + l1 * w1;
        if (hi == 0) { al_l[r32] = w0; al_l[32 + r32] = w1; } asm volatile("s_waitcnt lgkmcnt(0)" ::: "memory");
        if (dq == 0 && hi == 0) { ML[r32 * 2] = M; ML[r32 * 2 + 1] = L; }
#pragma unroll
        for (int r = 0; r < 16; ++r) { const int row = crow(r, hi); const float a0 = al_l[row], a1 = al_l[32 + row];
            Opart[(size_t)row * 256 + dq * 64 + r32] = o0[r] * a0 + ox[row * 32 + r32] * a1; Opart[(size_t)row * 256 + dq * 64 + 32 + r32] = o1[r] * a0 + ox[1024 + row * 32 + r32] * a1; } }
}

__device__ __forceinline__ void combine_row(int b, int row32, int lane, const bf16_t* __restrict__ Qdec, const float* __restrict__ Opart, const float* __restrict__ ML,
                                            const float* __restrict__ ckvn, const float* __restrict__ krn, bf16_t* __restrict__ olat) {
    constexpr float C = 0.07216878364870322f * 1.4426950408889634f;
    const int t = row32 >> 3, h = row32 & 7;
    const bf16_t* q = Qdec + ((size_t)b * 32 + row32) * 320;
    const u32x2 qw = *(const u32x2*)(q + 4 * lane); const float q0 = bf_lo(qw.x), q1 = bf_hi(qw.x), q2 = bf_lo(qw.y), q3 = bf_hi(qw.y); const float qrp = bf2f(q[256 + lane]);
    float sj[4]; f32x4 cn[4];
#pragma unroll
    for (int j = 0; j < 4; ++j) { cn[j] = *(const f32x4*)(ckvn + ((size_t)b * 4 + j) * 256 + 4 * lane); float s = q0 * cn[j][0] + q1 * cn[j][1] + q2 * cn[j][2] + q3 * cn[j][3] + qrp * krn[((size_t)b * 4 + j) * 64 + lane];
#pragma unroll
        for (int o = 32; o >= 1; o >>= 1) s += __shfl_xor(s, o);
        sj[j] = (j <= t) ? s : -1e30f; }
    float mc[8], lc[8], M = fmaxf(fmaxf(sj[0], sj[1]), fmaxf(sj[2], sj[3]));
#pragma unroll
    for (int c = 0; c < 8; ++c) { const f32x2 ml = *(const f32x2*)(ML + (((size_t)b * 8 + c) * 32 + row32) * 2); mc[c] = ml.x; lc[c] = ml.y; M = fmaxf(M, mc[c]); }
    float L = 0.f; f32x4 acc = {0.f, 0.f, 0.f, 0.f};
#pragma unroll
    for (int c = 0; c < 8; ++c) { const float w = __builtin_amdgcn_exp2f((mc[c] - M) * C); L += lc[c] * w; acc += *(const f32x4*)(Opart + (((size_t)b * 8 + c) * 32 + row32) * 256 + 4 * lane) * w; }
#pragma unroll
    for (int j = 0; j < 4; ++j) { const float e = (j <= t) ? __builtin_amdgcn_exp2f((sj[j] - M) * C) : 0.f; L += e; acc += cn[j] * e; }
    const float rl = 1.0f / L; u32x2 w; w.x = cvt_pk_bf16(acc[0] * rl, acc[1] * rl); w.y = cvt_pk_bf16(acc[2] * rl, acc[3] * rl);
    *(u32x2*)(olat + ((size_t)b * 4 + t) * 2048 + h * 256 + 4 * lane) = w;
}

constexpr int SMEM_LDS = 4096 + 32768;
__device__ __forceinline__ void smem_unit(const bf16_t* __restrict__ Zq  , const bf16_t* __restrict__ Zg  , const float* __restrict__ Kc, const float* __restrict__ Vc  ,
                                          bf16_t* __restrict__ outp  , LAS uchar* lds) {
    int tid_ = threadIdx.x; asm volatile("" : "+v"(tid_));
    const int tid = tid_, wid = tid >> 6, lane = tid & 63, l32 = lane & 31, hi = lane >> 5;
    LAS float* sc = (LAS float*)lds; LAS float* red = (LAS float*)(lds + 4096);
    float qv[4][4];
#pragma unroll
    for (int t = 0; t < 4; ++t) { const u32x2 w = *(const u32x2*)(Zq + (size_t)t * LDZ + 4 * l32); qv[t][0] = bf_lo(w.x); qv[t][1] = bf_hi(w.x); qv[t][2] = bf_lo(w.y); qv[t][3] = bf_hi(w.y); }
    f32x4 kreg[16], vreg[16]; const int d4 = (tid & 31) * 4, mg = tid >> 5;
#pragma unroll
    for (int i = 0; i < 16; ++i) kreg[i] = *(const f32x4*)(Kc + (size_t)(wid * 32 + 2 * i + hi) * 512 + 4 * l32);
#pragma unroll
    for (int mm = 0; mm < 16; ++mm) vreg[mm] = *(const f32x4*)(Vc + (size_t)(mg * 16 + mm) * 512 + d4);
#pragma unroll
    for (int i = 0; i < 16; ++i) { const int m = wid * 32 + 2 * i + hi; const f32x4 kv = kreg[i]; float p[4];
#pragma unroll
        for (int t = 0; t < 4; ++t) { p[t] = kv[0] * qv[t][0] + kv[1] * qv[t][1] + kv[2] * qv[t][2] + kv[3] * qv[t][3];
#pragma unroll
            for (int o = 16; o >= 1; o >>= 1) p[t] += __shfl_xor(p[t], o); }
        if (l32 == 0) {
#pragma unroll
            for (int t = 0; t < 4; ++t) sc[t * 256 + m] = p[t] * 0.08838834764831845f; } }
    __syncthreads();
    if (wid < 4) { float v[4], mx = -1e30f;
#pragma unroll
        for (int i = 0; i < 4; ++i) { v[i] = sc[wid * 256 + lane + 64 * i]; mx = fmaxf(mx, v[i]); }
#pragma unroll
        for (int o = 32; o >= 1; o >>= 1) mx = fmaxf(mx, __shfl_xor(mx, o));
        float s = 0.f;
#pragma unroll
        for (int i = 0; i < 4; ++i) { v[i] = __expf(v[i] - mx); s += v[i]; }
#pragma unroll
        for (int o = 32; o >= 1; o >>= 1) s += __shfl_xor(s, o);
        const float rs = 1.0f / s;
#pragma unroll
        for (int i = 0; i < 4; ++i) sc[wid * 256 + lane + 64 * i] = v[i] * rs; }
    __syncthreads();
    { f32x4 a[4] = {};
#pragma unroll
      for (int mm = 0; mm < 16; ++mm) { const int m = mg * 16 + mm; const f32x4 vv = vreg[mm];
#pragma unroll
          for (int t = 0; t < 4; ++t) a[t] += vv * sc[t * 256 + m]; }
#pragma unroll
      for (int t = 0; t < 4; ++t) *(LAS f32x4*)(red + (mg * 4 + t) * 128 + d4) = a[t]; }
    __syncthreads();
    { const int t = tid >> 7, d = tid & 127; float s = 0.f;
#pragma unroll
      for (int mg = 0; mg < 16; ++mg) s += red[(mg * 4 + t) * 128 + d];
      const float g = bf2f(Zg[(size_t)t * LDZ + d]);
      outp[(size_t)t * OUTW + d] = (bf16_t)(cvt_pk_bf16(s * silu(g), 0.f) & 0xffffu); }
    __syncthreads();
}
}
namespace ew {
__device__ __forceinline__ int otid() { int t = threadIdx.x; asm volatile("" : "+v"(t)); return t; }
struct TJ { const float* src; int sld, K, ncols; const float* gain; const float* cscale; bf16_t* dst; int dld; };
constexpr int NTJ = 32;
__device__ __forceinline__ TJ get_tj(int j, const float* const* in, uchar* ws) {
    TJ t; t.gain = nullptr; t.cscale = nullptr;
    bf16_t* WINA = (bf16_t*)(ws + WS_WINA); bf16_t* WGRP = (bf16_t*)(ws + WS_WGRP); bf16_t* WINB = (bf16_t*)(ws + WS_WINB); bf16_t* WQUP = (bf16_t*)(ws + WS_WQUP);
    bf16_t* WKV = (bf16_t*)(ws + WS_WKV); bf16_t* WMEM = (bf16_t*)(ws + WS_WMEM); bf16_t* WOUT = (bf16_t*)(ws + WS_WOUT);
    if (j < 2) { t.src = in[10] + (size_t)j * DM * INA; t.sld = INA; t.K = DM; t.ncols = INA; t.gain = in[9] + j * DM; t.dst = WINA + (size_t)j * INA * DM; t.dld = DM; }
    else if (j < 10) { const int i = j - 2; t.src = in[11] + (size_t)i * 65536; t.sld = 256; t.K = 256; t.ncols = 256; t.cscale = in[12] + i * 256; t.dst = WGRP + (size_t)i * 65536; t.dld = 256; }
    else if (j < 12) { const int i = j - 10; t.src = in[13] + (size_t)i * DM * INB; t.sld = INB; t.K = DM; t.ncols = QRANK; t.gain = in[9] + (2 + i) * DM; t.dst = WINB + (size_t)i * NB2 * DM; t.dld = DM; }
    else if (j < 14) { const int i = j - 12; t.src = in[13] + (size_t)i * DM * INB + QRANK; t.sld = INB; t.K = DM; t.ncols = INB - QRANK; t.gain = in[9] + (2 + i) * DM; t.dst = WINB + ((size_t)i * NB2 + ZB_GT) * DM; t.dld = DM; }
    else if (j == 14) { t.src = in[17] + KVR; t.sld = 320; t.K = DM; t.ncols = ROPE; t.gain = in[16]; t.dst = WINB + (size_t)ZB_KR * DM; t.dld = DM; }
    else if (j == 15) { t.src = in[17]; t.sld = 320; t.K = DM; t.ncols = KVR; t.gain = in[16]; t.dst = WINB + (size_t)ZB_KV * DM; t.dld = DM; }
    else if (j < 18) { const int i = j - 16; t.src = in[15] + (size_t)i * QRANK * QW; t.sld = QW; t.K = QRANK; t.ncols = QW; t.gain = in[14] + i * QRANK; t.dst = WQUP + (size_t)i * QW * QRANK; t.dld = QRANK; }
    else if (j == 18) { t.src = in[19]; t.sld = 1024; t.K = 256; t.ncols = 1024; t.dst = WKV; t.dld = 256; }
    else if (j == 19) { t.src = in[20]; t.sld = 1024; t.K = 256; t.ncols = 1024; t.dst = WKV + (size_t)1024 * 256; t.dld = 256; }
    else if (j < 28) { const int i = j - 20, l = i >> 1, kv = i & 1; t.src = (kv ? in[23] : in[22]) + (size_t)l * DM * MEMW; t.sld = MEMW; t.K = DM; t.ncols = MEMW; t.gain = in[21] + l * DM; t.dst = WMEM + (size_t)(l * 2 + kv) * MEMW * DM; t.dld = DM; }
    else { const int l = j - 28; t.src = in[24] + (size_t)l * OUTW * DM; t.sld = DM; t.K = OUTW; t.ncols = DM; t.dst = WOUT + (size_t)l * DM * OUTW; t.dld = OUTW; }
    return t;
}
__device__ __forceinline__ int tj_tiles(int j) {
    if (j < 2) return 16 * 48; if (j < 10) return 16; if (j < 12) return 16 * 6; if (j < 14) return 16 * 32; if (j == 14) return 16; if (j == 15) return 64;
    if (j < 18) return 6 * 24; if (j < 20) return 4 * 16; if (j < 28) return 16 * 8; return 24 * 16;
}
constexpr int TJ_TOTAL = 2 * 768 + 8 * 16 + 2 * 96 + 2 * 512 + 16 + 64 + 2 * 144 + 2 * 64 + 8 * 128 + 4 * 384;
__device__ __forceinline__ void tt_load(const TJ& t, int tile, int tid, f32x4& a, f32x4& b) {
    const int nkt = t.K / 64, kt = tile % nkt, nt = tile / nkt, k0 = kt * 64, n0 = nt * 64;
    const int k = tid >> 3, n8 = (tid & 7) * 8; const float* s = t.src + (size_t)(k0 + k) * t.sld + n0 + n8; const float g = t.gain ? t.gain[k0 + k] : 1.0f;
    a = *(const f32x4*)s * g; b = *(const f32x4*)(s + 4) * g;
}
__device__ __forceinline__ void tt_store(const TJ& t, int tile, LAS float* tl, int tid, const f32x4 a, const f32x4 b) {
    const int nkt = t.K / 64, kt = tile % nkt, nt = tile / nkt, k0 = kt * 64, n0 = nt * 64;
    { const int k = tid >> 3, n8 = (tid & 7) * 8;
#pragma unroll
      for (int j = 0; j < 4; ++j) { tl[k * 65 + n8 + j] = a[j]; tl[k * 65 + n8 + 4 + j] = b[j]; } }
    __syncthreads();
    { const int n = tid >> 3, k8 = (tid & 7) * 8; const float cs = t.cscale ? t.cscale[n0 + n] : 1.0f; float v[8];
#pragma unroll
      for (int j = 0; j < 8; ++j) v[j] = tl[(k8 + j) * 65 + n] * cs;
      *(u32x4*)(t.dst + (size_t)(n0 + n) * t.dld + k0 + k8) = pack8(v); }
    __syncthreads();
}
__device__ __forceinline__ void tj_of(int gt, int& j, int& r) { j = 0; r = gt; for (; j < NTJ; ++j) { const int n = tj_tiles(j); if (r < n) break; r -= n; } }
__device__ __forceinline__ void sincos_d(float angf, float& c, float& s) {
    const double x = (double)angf; const double kd = rint(x * 0.63661977236758134308); const int q = (int)((long long)kd & 3);
    double r = fma(-kd, 1.57079632679489655800e+00, x); r = fma(-kd, 6.12323399573676603587e-17, r);
    const double r2 = r * r;
    double sp = -7.6471637318198164759e-13; sp = fma(sp, r2, 1.6059043836821614599e-10); sp = fma(sp, r2, -2.5052108385441718775e-08); sp = fma(sp, r2, 2.7557319223985890653e-06);
    sp = fma(sp, r2, -1.9841269841269841270e-04); sp = fma(sp, r2, 8.3333333333333333333e-03); sp = fma(sp, r2, -1.6666666666666666667e-01); const double sn = fma(sp * r2, r, r);
    double cp = 4.7794773323873852974e-14; cp = fma(cp, r2, -1.1470745597729724714e-11); cp = fma(cp, r2, 2.0876756987868098979e-09); cp = fma(cp, r2, -2.7557319223985890653e-07);
    cp = fma(cp, r2, 2.4801587301587301587e-05); cp = fma(cp, r2, -1.3888888888888888889e-03); cp = fma(cp, r2, 4.1666666666666666667e-02); cp = fma(cp, r2, -0.5); const double cn = fma(cp, r2, 1.0);
    const double ss = (q == 0) ? sn : (q == 1) ? cn : (q == 2) ? -sn : -cn, cc = (q == 0) ? cn : (q == 1) ? -sn : (q == 2) ? -cn : sn;
    c = (float)cc; s = (float)ss;
}

__device__ __forceinline__ void prologue(const float* const* in, float* out, uchar* ws, LAS uchar* lds, int G, int bid) {
    const int tid = otid(), lane = tid & 63, wid = tid >> 6;
    { const int wv = __builtin_amdgcn_readfirstlane(tid >> 6); LAS float* tl = (LAS float*)(lds + wv * (64 * 68 * 4)); const int kr = lane >> 4, c4 = (lane & 15) * 4;
      const int tq = TJ_TOTAL / G, trm = TJ_TOTAL % G, tlo = bid * tq + (bid < trm ? bid : trm), thi = tlo + tq + (bid < trm ? 1 : 0);
      int gt = tlo + wv; const int gs = 8;
      if (gt < thi) { int j, r; tj_of(gt, j, r); TJ t = get_tj(j, in, ws); f32x4 v[16];
#define TT_LOAD(T, R) do { const int nnt_ = (T).ncols / 64, n0_ = ((R) % nnt_) * 64, k0_ = ((R) / nnt_) * 64; const float* s_ = (T).src + (size_t)(k0_ + kr) * (T).sld + n0_ + c4; \
          _Pragma("unroll") for (int i = 0; i < 16; ++i) v[i] = __builtin_nontemporal_load((const f32x4*)(s_ + (size_t)(4 * i) * (T).sld)); } while (0)
          TT_LOAD(t, r);
          for (;;) {
#pragma unroll
              for (int i = 0; i < 16; ++i) { LAS float* w = tl + (4 * i + kr) * 65 + c4; w[0] = v[i][0]; w[1] = v[i][1]; w[2] = v[i][2]; w[3] = v[i][3]; }
              const int gn = gt + gs; const bool more = gn < thi; TJ tn = t; int rn = r;
              if (more) { int jn; tj_of(gn, jn, rn); tn = get_tj(jn, in, ws); TT_LOAD(tn, rn); }
              { const int nnt = t.ncols / 64, n0 = (r % nnt) * 64, k0 = (r / nnt) * 64, kc = (lane >> 3) * 8, nl = lane & 7;
                f32x4 g0 = {1.f, 1.f, 1.f, 1.f}, g1 = g0; if (t.gain) { g0 = *(const f32x4*)(t.gain + k0 + kc); g1 = *(const f32x4*)(t.gain + k0 + kc + 4); }
                asm volatile("s_waitcnt lgkmcnt(0)" ::: "memory");
#pragma unroll
                for (int i = 0; i < 8; ++i) { const int n = 8 * i + nl; const float cs = t.cscale ? t.cscale[n0 + n] : 1.0f; float o[8];
#pragma unroll
                    for (int e = 0; e < 8; ++e) o[e] = tl[(kc + e) * 65 + n] * (e < 4 ? g0[e & 3] : g1[e & 3]) * cs;
                    *(u32x4*)(t.dst + (size_t)(n0 + n) * t.dld + k0 + kc) = pack8(o); } }
              if (!more) break;
              t = tn; r = rn; gt = gn;
          }
#undef TT_LOAD
      } }
#ifdef TP_A
    if (bid == 0 && tid == 0) ((volatile LAS unsigned*)(lds + 136 * 1024))[48] = (unsigned)__builtin_amdgcn_s_memrealtime();
#endif
    const size_t gtid = (size_t)bid * 512 + tid, gstride = (size_t)G * 512;
    { bf16_t* WINB = (bf16_t*)(ws + WS_WINB);
      for (size_t i = gtid; i < (size_t)(64 + 128) * DM / 8; i += gstride) { const size_t e = i * 8; bf16_t* p = (e < (size_t)64 * DM) ? WINB + (size_t)448 * DM + e : WINB + ((size_t)NB2 + 384) * DM + (e - (size_t)64 * DM);
          *(u32x4*)p = (u32x4){0u, 0u, 0u, 0u}; }
      bf16_t* WKUPN = (bf16_t*)(ws + WS_WKUPN);
      for (size_t i = gtid; i < (size_t)256 * 1024 / 8; i += gstride) { const float* s = in[19] + i * 8; const f32x4 a = *(const f32x4*)s, b = *(const f32x4*)(s + 4);
          const float v[8] = {a[0], a[1], a[2], a[3], b[0], b[1], b[2], b[3]}; *(u32x4*)(WKUPN + i * 8) = pack8(v); } }
#ifdef TP_A
    if (bid == 0 && tid == 0) ((volatile LAS unsigned*)(lds + 136 * 1024))[49] = (unsigned)__builtin_amdgcn_s_memrealtime();
#endif
    { bf16_t* XB = (bf16_t*)(ws + WS_XB); bf16_t* MH = (bf16_t*)(ws + WS_MHAT); float* ssp = (float*)(ws + WS_SSP); float* ssps = (float*)(ws + WS_SSPS);
      const int nrows = PM + SM + 2048;
      for (int row = bid * 8 + wid; row < nrows; row += G * 8) {
          const float* src = row < PM ? in[0] + (size_t)row * DM : row < PM + SM ? in[1] + (size_t)(row - PM) * DM : in[8] + (size_t)(row - PM - SM) * DM;
          f32x4 v[4]; float s = 0.f;
#pragma unroll
          for (int i = 0; i < 4; ++i) { v[i] = __builtin_nontemporal_load((const f32x4*)(src + 256 * i + 4 * lane)); s += sum4(v[i] * v[i]); }
#pragma unroll
          for (int o = 32; o >= 1; o >>= 1) s += __shfl_xor(s, o);
          float sc = 1.0f; bf16_t* dst;
          if (row < PM + SM) { dst = XB + (size_t)row * DM; if (row < PM) { if (lane < 16) ssp[(size_t)row * 16 + lane] = lane == 0 ? s : 0.f; } else { if (lane < 32) ssps[(row - PM) * 32 + lane] = lane == 0 ? s : 0.f; } }
          else { dst = MH + (size_t)(row - PM - SM) * DM; sc = rsqrtf(s * (1.0f / 1024.0f) + EPS); }
#pragma unroll
          for (int i = 0; i < 4; ++i) { u32x2 w; w.x = cvt_pk_bf16(v[i][0] * sc, v[i][1] * sc); w.y = cvt_pk_bf16(v[i][2] * sc, v[i][3] * sc); *(u32x2*)(dst + 256 * i + 4 * lane) = w; } } }
#ifdef TP_A
    if (bid == 0 && tid == 0) ((volatile LAS unsigned*)(lds + 136 * 1024))[50] = (unsigned)__builtin_amdgcn_s_memrealtime();
#endif
    { f32x2* tab = (f32x2*)(ws + WS_ROPE);
      for (size_t e = gtid; e < (size_t)2052 * 32; e += gstride) { const int p = (int)(e >> 5), i = (int)(e & 31); const int pos = p < 2048 ? p : PAST + (p - 2048);
          const float inv = (float)exp2(-(double)i * (13.287712379549449 / 32.0)); const float ang = (float)pos * inv; float c, s; sincos_d(ang, c, s); tab[e] = (f32x2){c, s}; } }
#ifdef TP_A
    if (bid == 0 && tid == 0) ((volatile LAS unsigned*)(lds + 136 * 1024))[51] = (unsigned)__builtin_amdgcn_s_memrealtime();
#endif
    { for (size_t e = gtid; e < (size_t)2 * SB * 11 * DM / 4; e += gstride) { const size_t f = e * 4; const int c = (int)(f % DM); const size_t rr = f / DM; const int i = (int)(rr % 11); const size_t lb = rr / 11;
          *(f32x4*)(out + O_PSS + (lb * 15 + i) * DM + c) = *(const f32x4*)(in[2] + (lb * 15 + 4 + i) * DM + c); } }
#ifdef TP_A
    if (bid == 0 && tid == 0) ((volatile LAS unsigned*)(lds + 136 * 1024))[52] = (unsigned)__builtin_amdgcn_s_memrealtime();
#endif
}

template <int W> __device__ __forceinline__ void pool16(const bf16_t* __restrict__ zc, bf16_t* __restrict__ po, float* __restrict__ ps, bool bstart) {
    u32x2 uu[15 + W];
#pragma unroll
    for (int i = 0; i < W - 1; ++i) uu[i] = bstart ? (u32x2){0u, 0u} : *(const u32x2*)(zc - (ptrdiff_t)(W - 1 - i) * LDZ);
#pragma unroll
    for (int k = 0; k < 16; ++k) uu[W - 1 + k] = *(const u32x2*)(zc + (size_t)k * LDZ);
    float s0 = 0.f, s1 = 0.f, s2 = 0.f, s3 = 0.f;
#pragma unroll
    for (int i = 0; i < W - 1; ++i) { s0 += bf_lo(uu[i].x); s1 += bf_hi(uu[i].x); s2 += bf_lo(uu[i].y); s3 += bf_hi(uu[i].y); }
#pragma unroll
    for (int k = 0; k < 16; ++k) { const u32x2 c = uu[W - 1 + k]; const float c0 = bf_lo(c.x), c1 = bf_hi(c.x), c2 = bf_lo(c.y), c3 = bf_hi(c.y);
        s0 += c0; s1 += c1; s2 += c2; s3 += c3;
        const float rn = (bstart && k < W - 1) ? 1.0f / (float)(k + 1) : 1.0f / (float)W;
        u32x2 o; o.x = cvt_pk_bf16(s0 * rn - c0, s1 * rn - c1); o.y = cvt_pk_bf16(s2 * rn - c2, s3 * rn - c3); *(u32x2*)(po + (size_t)k * DM) = o;
        if (ps != nullptr && k >= 1) *(f32x4*)(ps + (size_t)(k - 1) * DM) = (f32x4){c0, c1, c2, c3};
        const u32x2 d = uu[k]; s0 -= bf_lo(d.x); s1 -= bf_hi(d.x); s2 -= bf_lo(d.y); s3 -= bf_hi(d.y); }
}
__device__ __forceinline__ void pool_tile(int l, float* out, uchar* ws, int pm, int g) {
    const bf16_t* Z = (const bf16_t*)(ws + WS_Z); bf16_t* PO = (bf16_t*)(ws + WS_POOLED);
    const int tid = otid(), lane = tid & 63, wid = tid >> 6;
#pragma unroll 1
    for (int blk = wid; blk < 16; blk += 8) { const int r0 = pm * 256 + blk * 16, t0 = r0 & (PT - 1), c4 = g * 256 + lane * 4;
        const bf16_t* zc = Z + (size_t)r0 * LDZ + c4; bf16_t* po = PO + (size_t)r0 * DM + c4; const bool bstart = (t0 == 0);
        float* ps = (t0 == PT - 16) ? out + O_PSP + (((size_t)l * PB + (r0 >> 11)) * 15) * DM + c4 : nullptr;
        if (g == 0) pool16<2>(zc, po, ps, bstart); else if (g == 1) pool16<4>(zc, po, ps, bstart); else if (g == 2) pool16<8>(zc, po, ps, bstart); else pool16<16>(zc, po, ps, bstart); }
}
__device__ __forceinline__ void pool_sample(int l, const float* const* in, float* out, uchar* ws, int G, int bid) {
    const bf16_t* Z = (const bf16_t*)(ws + WS_Z); bf16_t* PO = (bf16_t*)(ws + WS_POOLED);
    const int tid = otid();
    const size_t gtid = (size_t)bid * 512 + tid, gstride = (size_t)G * 512;
    for (size_t idx = gtid; idx < (size_t)SB * 128; idx += gstride) { const int b = (int)(idx >> 7), cv = (int)(idx & 127), g = cv >> 5, w = 2 << g;
        const float* prev = in[2] + ((size_t)l * SB + b) * 15 * DM + cv * 8; const bf16_t* us = Z + ((size_t)PM + b * 4) * LDZ + cv * 8; float x[19][8];
#pragma unroll
        for (int e = 0; e < 15; ++e) { const f32x4 a = *(const f32x4*)(prev + (size_t)e * DM), bb = *(const f32x4*)(prev + (size_t)e * DM + 4);
            x[e][0] = a[0]; x[e][1] = a[1]; x[e][2] = a[2]; x[e][3] = a[3]; x[e][4] = bb[0]; x[e][5] = bb[1]; x[e][6] = bb[2]; x[e][7] = bb[3]; }
#pragma unroll
        for (int t = 0; t < 4; ++t) unpack8(*(const u32x4*)(us + (size_t)t * LDZ), x[15 + t]);
        const float rn = 1.0f / (float)w;
#pragma unroll
        for (int t = 0; t < 4; ++t) { float sm[8] = {0.f, 0.f, 0.f, 0.f, 0.f, 0.f, 0.f, 0.f};
#pragma unroll
            for (int e = 18; e >= 0; --e) { if (e <= 15 + t) { const float m = (e > 15 + t - w) ? 1.0f : 0.0f;
#pragma unroll
                for (int jj = 0; jj < 8; ++jj) sm[jj] = fmaf(m, x[e][jj], sm[jj]); } }
            float o[8];
#pragma unroll
            for (int jj = 0; jj < 8; ++jj) o[jj] = sm[jj] * rn - x[15 + t][jj];
            *(u32x4*)(PO + ((size_t)PM + b * 4 + t) * DM + cv * 8) = pack8(o);
            float* q = out + O_PSS + (((size_t)l * SB + b) * 15 + 11 + t) * DM + cv * 8;
            *(f32x4*)q = (f32x4){x[15 + t][0], x[15 + t][1], x[15 + t][2], x[15 + t][3]}; *(f32x4*)(q + 4) = (f32x4){x[15 + t][4], x[15 + t][5], x[15 + t][6], x[15 + t][7]}; } }
}

__device__ __forceinline__ void pool_sample_grp(int l, const float* const* in, float* out, uchar* ws, int g, bool wstate) {
    const bf16_t* Z = (const bf16_t*)(ws + WS_Z); bf16_t* PO = (bf16_t*)(ws + WS_POOLED);
    const int tid = otid(); const int w = 2 << g; const float rn = 1.0f / (float)w;
#pragma unroll 1
    for (int it = tid; it < SB * 32; it += 512) { const int b = it >> 5, cv = g * 32 + (it & 31);
        const float* prev = in[2] + ((size_t)l * SB + b) * 15 * DM + cv * 8; const bf16_t* us = Z + ((size_t)PM + b * 4) * LDZ + cv * 8; float x[19][8];
#pragma unroll
        for (int e = 0; e < 15; ++e) { const f32x4 a = *(const f32x4*)(prev + (size_t)e * DM), bb = *(const f32x4*)(prev + (size_t)e * DM + 4);
            x[e][0] = a[0]; x[e][1] = a[1]; x[e][2] = a[2]; x[e][3] = a[3]; x[e][4] = bb[0]; x[e][5] = bb[1]; x[e][6] = bb[2]; x[e][7] = bb[3]; }
#pragma unroll
        for (int t = 0; t < 4; ++t) unpack8(*(const u32x4*)(us + (size_t)t * LDZ), x[15 + t]);
#pragma unroll
        for (int t = 0; t < 4; ++t) { float sm[8] = {0.f, 0.f, 0.f, 0.f, 0.f, 0.f, 0.f, 0.f};
#pragma unroll
            for (int e = 18; e >= 0; --e) { if (e <= 15 + t) { const float m = (e > 15 + t - w) ? 1.0f : 0.0f;
#pragma unroll
                for (int jj = 0; jj < 8; ++jj) sm[jj] = fmaf(m, x[e][jj], sm[jj]); } }
            float o[8];
#pragma unroll
            for (int jj = 0; jj < 8; ++jj) o[jj] = sm[jj] * rn - x[15 + t][jj];
            *(u32x4*)(PO + ((size_t)PM + b * 4 + t) * DM + cv * 8) = pack8(o);
            if (wstate) { float* q = out + O_PSS + (((size_t)l * SB + b) * 15 + 11 + t) * DM + cv * 8;
                *(f32x4*)q = (f32x4){x[15 + t][0], x[15 + t][1], x[15 + t][2], x[15 + t][3]}; *(f32x4*)(q + 4) = (f32x4){x[15 + t][4], x[15 + t][5], x[15 + t][6], x[15 + t][7]}; } } }
}

__device__ __forceinline__ void kvpost(const float* const* in, float* out, uchar* ws, int G, int bid) {
    const float* KV = (const float*)(ws + WS_KVRAW); bf16_t* CB = (bf16_t*)(ws + WS_CKVB); bf16_t* KB = (bf16_t*)(ws + WS_KROPEB); const f32x2* tab = (const f32x2*)(ws + WS_ROPE);
    const int tid = otid(), lane = tid & 63, wid = tid >> 6; const f32x4 gl = *(const f32x4*)(in[18] + 4 * lane);
    for (int row = bid * 8 + wid; row < PM + SM; row += G * 8) { const float* p = KV + (size_t)row * 320; const f32x4 v = *(const f32x4*)(p + 4 * lane); float s = sum4(v * v);
#pragma unroll
        for (int o = 32; o >= 1; o >>= 1) s += __shfl_xor(s, o);
        const float rs = rsqrtf(s * (1.0f / 256.0f) + EPS); const f32x4 c = v * rs * gl;
        float* oc = row < PM ? out + O_CKVP + (size_t)row * KVR : out + O_CKVS + (size_t)(row - PM) * KVR; float* ok = row < PM ? out + O_KRP + (size_t)row * ROPE : out + O_KRS + (size_t)(row - PM) * ROPE;
        *(f32x4*)(oc + 4 * lane) = c; u32x2 w; w.x = cvt_pk_bf16(c[0], c[1]); w.y = cvt_pk_bf16(c[2], c[3]); *(u32x2*)(CB + (size_t)row * KVR + 4 * lane) = w;
        if (lane < 32) { const int ti = row < PM ? (row & (PT - 1)) : 2048 + ((row - PM) & 3); const f32x2 cs = tab[(size_t)ti * 32 + lane]; const float x1 = p[256 + lane], x2 = p[288 + lane];
            const float o1 = x1 * cs.x - x2 * cs.y, o2 = x1 * cs.y + x2 * cs.x; ok[lane] = o1; ok[32 + lane] = o2;
            KB[(size_t)row * ROPE + lane] = (bf16_t)(cvt_pk_bf16(o1, 0.f) & 0xffffu); KB[(size_t)row * ROPE + 32 + lane] = (bf16_t)(cvt_pk_bf16(o2, 0.f) & 0xffffu); } }
}
__device__ __forceinline__ void sq_rope(uchar* ws, int G, int bid) {
    const bf16_t* Q = (const bf16_t*)(ws + WS_Q); bf16_t* QD = (bf16_t*)(ws + WS_QDEC); const f32x2* tab = (const f32x2*)(ws + WS_ROPE);
    for (size_t e = (size_t)bid * 512 + otid(); e < (size_t)SM * MLAH * 32; e += (size_t)G * 512) { const int i = (int)(e & 31), h = (int)((e >> 5) & 7), r = (int)(e >> 8), b = r >> 2, t = r & 3;
        const bf16_t* q = Q + ((size_t)PM + r) * QW + h * QHD + NOPE; const float x1 = bf2f(q[i]), x2 = bf2f(q[32 + i]); const f32x2 cs = tab[(size_t)(2048 + t) * 32 + i];
        bf16_t* o = QD + ((size_t)b * 32 + t * 8 + h) * 320 + 256; o[i] = (bf16_t)(cvt_pk_bf16(x1 * cs.x - x2 * cs.y, 0.f) & 0xffffu); o[32 + i] = (bf16_t)(cvt_pk_bf16(x1 * cs.y + x2 * cs.x, 0.f) & 0xffffu); }
}
__device__ __forceinline__ void final_norm(const float* const* in, float* out, uchar* ws, int G, int bid, int r0, int r1) {
    const bf16_t* XB = (const bf16_t*)(ws + WS_XB); const float* ssp = (const float*)(ws + WS_SSP); const float* ssps = (const float*)(ws + WS_SSPS);
    const int tid = otid(), lane = tid & 63, wid = tid >> 6;
    for (int row = r0 + bid * 8 + wid; row < r1; row += G * 8) { const float rs = row < PM ? rs_from16(ssp + (size_t)row * 16) : rs_from32(ssps + (row - PM) * 32);
        float* o = row < PM ? out + O_YP + (size_t)row * DM : out + O_YS + (size_t)(row - PM) * DM; const bf16_t* x = XB + (size_t)row * DM;
#pragma unroll
        for (int i = 0; i < 4; ++i) { const int c = 256 * i + 4 * lane; const u32x2 b = *(const u32x2*)(x + c);
            *(f32x4*)(o + c) = (f32x4){bf_lo(b.x), bf_hi(b.x), bf_lo(b.y), bf_hi(b.y)} * rs * *(const f32x4*)(in[25] + c); } }
}
}
#define XB_TMO      128
#define XB_XCNT(j)  (256  + 64 * (j))
#define XB_XSUB(j)  (1280 + 64 * (j))
#define XB_XGEN(j)  (2304 + 64 * (j))
#define XB_TOP      3328
#define XB_TOPGEN   3392
#define XCD_BAR_WORDS 3456
#define XB_SPIN_CAP (1u << 22)
__device__ __forceinline__ unsigned xb_ld(unsigned* p)              { return __hip_atomic_load(p, __ATOMIC_RELAXED, __HIP_MEMORY_SCOPE_AGENT); }
__device__ __forceinline__ unsigned xb_add(unsigned* p, unsigned v) { return __hip_atomic_fetch_add(p, v, __ATOMIC_RELAXED, __HIP_MEMORY_SCOPE_AGENT); }
__device__ __forceinline__ unsigned xb_xcc_id() { return (unsigned)__builtin_amdgcn_s_getreg((3 << 11) | 20) & 0xFu; }
#define XB_SPIN(cond, bar) do { unsigned _sp = 0; while (cond) { __builtin_amdgcn_s_sleep(1); \
    if ((++_sp & 255u) == 0u) { if (xb_ld(&(bar)[XB_TMO])) break; if (_sp > XB_SPIN_CAP) { atomicAdd(&(bar)[XB_TMO], 1u); break; } } } } while (0)
struct XcdBarrier { unsigned* bar; unsigned x; volatile LAS unsigned* st; };
__device__ __forceinline__ XcdBarrier xcd_barrier_post(unsigned* bar, volatile LAS unsigned* st) {
    XcdBarrier b; b.bar = bar; b.x = xb_xcc_id(); b.st = st;
    if (threadIdx.x == 0) (void)xb_add(&bar[XB_XCNT(b.x)], 1u);
    return b;
}
__device__ __forceinline__ void xcd_barrier_complete(unsigned* bar, unsigned x, unsigned& nloc, unsigned& nx) {
    const unsigned G = gridDim.x * gridDim.y * gridDim.z;
    unsigned sum, cnt, mine, sp = 0u;
    for (;;) {
        sum = 0u; cnt = 0u; mine = 0u;
#pragma unroll
        for (unsigned j = 0; j < 16; ++j) { const unsigned c = xb_ld(&bar[XB_XCNT(j)]); sum += c; cnt += (c > 0u) ? 1u : 0u; mine = (j == x) ? c : mine; }
        if (sum == G) break;
        __builtin_amdgcn_s_sleep(1);
        if ((++sp & 255u) == 0u) { if (xb_ld(&bar[XB_TMO])) break; if (sp > XB_SPIN_CAP) { atomicAdd(&bar[XB_TMO], 1u); break; } }
    }
    nloc = mine > 0u ? mine : 1u; nx = cnt > 0u ? cnt : 1u;
}
__device__ __forceinline__ void xcd_barrier(const XcdBarrier& b) {
    asm volatile("s_waitcnt vmcnt(0)" ::: "memory");
    __syncthreads();
    if (threadIdx.x == 0) {
        unsigned* bar = b.bar;
        __builtin_amdgcn_s_waitcnt(0);
        unsigned nloc = b.st[0], nx = b.st[1];
        if (nloc == 0u) { xcd_barrier_complete(bar, b.x, nloc, nx); b.st[0] = nloc; b.st[1] = nx; }
        const unsigned old = xb_add(&bar[XB_XSUB(b.x)], 1u);
        const unsigned gen = old / nloc;
        if (old + 1u == (gen + 1u) * nloc) {
            __builtin_amdgcn_fence(__ATOMIC_RELEASE, "agent");
            asm volatile("s_waitcnt vmcnt(0)" ::: "memory");
            const unsigned og = xb_add(&bar[XB_TOP], 1u);
            const unsigned tg = og / nx;
            __builtin_amdgcn_fence(__ATOMIC_ACQUIRE, "agent");
            if (og + 1u == (tg + 1u) * nx) xb_add(&bar[XB_TOPGEN], 1u);
            else XB_SPIN(xb_ld(&bar[XB_TOPGEN]) == tg, bar);
            asm volatile("" ::: "memory");
            xb_add(&bar[XB_XGEN(b.x)], 1u);
            asm volatile("s_waitcnt vmcnt(0)" ::: "memory");
        } else {
            __builtin_amdgcn_fence(__ATOMIC_ACQUIRE, "agent");
            XB_SPIN(xb_ld(&bar[XB_XGEN(b.x)]) == gen, bar);
            asm volatile("s_waitcnt vmcnt(0)" ::: "memory");
        }
    }
    __syncthreads();
}

constexpr int LDS_BYTES = 144 * 1024, MISC_OFF = 136 * 1024;
static_assert(pg8::STAGE_BYTES <= MISC_OFF && att::LDS_BYTES <= MISC_OFF && dec::LDS_BYTES <= MISC_OFF && sg::LDS_BYTES <= MISC_OFF && dec::SMEM_LDS <= MISC_OFF, "LDS budget");
constexpr int NPHASE = 17;
struct Params { const float* in[26]; float* out; uchar* ws; int ph_lo, ph_hi; };

template <class T> __device__ __forceinline__ T* launder(T* p) { asm volatile("" : "+s"(p)); return p; }
#define PHASE_PTRS \
    uchar* const ws = launder(P.ws); float* const out = launder(P.out); const float* const* in = P.in; (void)in; (void)out; \
    bf16_t* const XB = (bf16_t*)(ws + WS_XB); float* const XR = (float*)(ws + WS_XRES); bf16_t* const Z = (bf16_t*)(ws + WS_Z); bf16_t* const MX = (bf16_t*)(ws + WS_MIXED); \
    bf16_t* const PO = (bf16_t*)(ws + WS_POOLED); bf16_t* const QB = (bf16_t*)(ws + WS_Q); float* const ssp = (float*)(ws + WS_SSP); float* const ssps = (float*)(ws + WS_SSPS); \
    float* const ssq = (float*)(ws + WS_SSQ); float* const KVRAW = (float*)(ws + WS_KVRAW); bf16_t* const MEMB = (bf16_t*)(ws + WS_MEMB); \
    (void)XB; (void)XR; (void)Z; (void)MX; (void)PO; (void)QB; (void)ssp; (void)ssps; (void)ssq; (void)KVRAW; (void)MEMB;

__global__ void __launch_bounds__(512, 2) yoco_fwd(Params P) {
    extern __shared__ __attribute__((aligned(16))) uchar lds_raw[];
    LAS uchar* lds = (LAS uchar*)lds_raw;
    const int tid = threadIdx.x, G = gridDim.x, bid = blockIdx.x;
    volatile LAS unsigned* misc = (volatile LAS unsigned*)(lds + MISC_OFF);
    if (tid < 4) misc[tid] = 0u;
    __syncthreads();
    const int lo = P.ph_lo, hi = P.ph_hi; const bool multi = (hi - lo) > 1;
#ifdef TP_A
    if (bid == 0 && tid == 0) misc[15] = (unsigned)__builtin_amdgcn_s_memrealtime();
#endif
    XcdBarrier bar; bar.bar = (unsigned*)(P.ws + WS_CTL); bar.x = 0; bar.st = misc;
    if (multi) bar = xcd_barrier_post((unsigned*)(P.ws + WS_CTL), misc);
#ifndef EN_MASK
#define EN_MASK 0xffff
#endif
#define EN(t) ((EN_MASK >> (t)) & 1)
#ifndef REP_MASK
#define REP_MASK 0
#endif
#define NREP(t, first) ((((REP_MASK >> (t)) & 1) && (first)) ? 2 : 1)
#define IN(k) (lo <= (k) && (k) < hi)
#ifdef TP_A
#define SEAM(k) do { if (IN(k) && IN((k) + 1)) { xcd_barrier(bar); if (bid == 0 && tid == 0) misc[16 + (k)] = (unsigned)__builtin_amdgcn_s_memrealtime(); } } while (0)
#else
#define SEAM(k) do { if (IN(k) && IN((k) + 1)) xcd_barrier(bar); } while (0)
#endif
#define SUNITS(u, n) for (int u = G - 1 - bid; u < (n); u += G)

    if (EN(0) && IN(0)) for (int rep = 0; rep < NREP(0, true); ++rep) { if (rep) xcd_barrier(bar); PHASE_PTRS ew::prologue(in, out, ws, lds, G, bid); }
    SEAM(0);

#pragma unroll 1
    for (int l = 0; l < 2; ++l) {
        const int pb = 1 + 3 * l;
        if (EN(1) && IN(pb)) for (int rep = 0; rep < NREP(1, l == 0); ++rep) { if (rep) xcd_barrier(bar);
            PHASE_PTRS
            if (l == 0) {
                unsigned* zflag = (unsigned*)(ws + WS_CTL) + 4096 + 64 * 12;
                SUNITS(u, INA / 64) { sg::EpiZ E{Z, ssps, nullptr, nullptr}; sg::sgemm_unit(lds, XB + (size_t)PM * DM, DM, (const bf16_t*)(ws + WS_WINA) + (size_t)l * INA * DM, DM, DM, u * 64, E);
                    asm volatile("s_waitcnt vmcnt(0)" ::: "memory"); __syncthreads();
                    if (tid == 0) { __builtin_amdgcn_fence(__ATOMIC_RELEASE, "agent"); asm volatile("s_waitcnt vmcnt(0)" ::: "memory"); __hip_atomic_fetch_add(zflag, 1u, __ATOMIC_RELAXED, __HIP_MEMORY_SCOPE_AGENT); } }
            }
            { pg8::Gemm g{XB, (const bf16_t*)(ws + WS_WINA) + (size_t)l * INA * DM, DM, DM, DM, 0}; pg8::StaticOrder S; S.init(PM / 256, INA / 256, G, bid);
              pg8::EpiZ E{Z, ssp, nullptr, nullptr}; pg8::gemm_phase(lds, g, S, E); }

#if defined(TP_PT) && TP_PT == 60
            if (bid == TP_WG && tid == 0) (void)atomicCAS((unsigned*)(P.ws + WS_CTL) + 6144, 0u, (unsigned)__builtin_amdgcn_s_memrealtime());
#endif
            if (l == 0) { pg8::Gemm g{(const bf16_t*)(ws + WS_MHAT), (const bf16_t*)(ws + WS_WMEM), DM, DM, DM, 0}; pg8::StaticOrder S; S.init(2048 / 256, 4096 / 256, G, bid);
              pg8::EpiMem E{out + O_MEMK, MEMB}; pg8::gemm_phase(lds, g, S, E); }

#if defined(TP_PT) && TP_PT == 61
            if (bid == TP_WG && tid == 0) (void)atomicCAS((unsigned*)(P.ws + WS_CTL) + 6144, 0u, (unsigned)__builtin_amdgcn_s_memrealtime());
#endif
            if (l == 0) {
                unsigned* zflag = (unsigned*)(ws + WS_CTL) + 4096 + 64 * 12;
                const int sv = bid - (G - 128);
                if (sv >= 0) {
                    if (tid == 0) { unsigned sp = 0; while (__hip_atomic_load(zflag, __ATOMIC_RELAXED, __HIP_MEMORY_SCOPE_AGENT) < (unsigned)(INA / 64)) { __builtin_amdgcn_s_sleep(2); if (++sp > (1u << 22)) break; }
                        __builtin_amdgcn_fence(__ATOMIC_ACQUIRE, "agent"); asm volatile("s_waitcnt vmcnt(0)" ::: "memory"); }
                    __syncthreads();
                    if (sv < 16) { const int u = sv, g = u >> 2;
                        ew::pool_sample_grp(l, in, out, ws, g, (u & 3) == 0);
                        asm volatile("s_waitcnt vmcnt(0)" ::: "memory"); __syncthreads();
                        sg::EpiGrp E{Z, MX, g * 256};
                        sg::sgemm_unit(lds, PO + (size_t)PM * DM + g * 256, DM, (const bf16_t*)(ws + WS_WGRP) + ((size_t)l * 4 + g) * 65536, 256, 256, (u & 3) * 64, E); }
                    else for (int u = sv - 16; u < SB * MEMH; u += 112) { const int b = u >> 2, h = u & 3; const size_t r0 = (size_t)PM + b * 4; const size_t ko = (((size_t)l * SB + b) * MEMT * MEMH + h) * 128;
                        dec::smem_unit(Z + r0 * LDZ + ZA_QM + h * 128, Z + r0 * LDZ + ZA_GM + h * 128, in[5] + ko, in[6] + ko, MX + r0 * OUTW + 1024 + h * 128, lds); }
                }
            }
        }

#if defined(TP_PT) && TP_PT == 62
        if (bid == TP_WG && tid == 0) (void)atomicCAS((unsigned*)(P.ws + WS_CTL) + 6144, 0u, (unsigned)__builtin_amdgcn_s_memrealtime());
#endif
        SEAM(pb);
        if (EN(2) && IN(pb + 1)) {
            PHASE_PTRS
#if defined(TP_PT) && TP_PT == 56
            if (bid == 0 && tid == 0) misc[56] = (unsigned)__builtin_amdgcn_s_memrealtime();
#endif
            { pg8::StaticOrder S; S.init(PM / 256, 4, G, bid); pg8::Unit u;
              for (int i = 0; S.next(i, u); ++i) ew::pool_tile(l, out, ws, u.pm, u.pn);
              asm volatile("s_waitcnt vmcnt(0)" ::: "memory"); __syncthreads();
#if defined(TP_PT) && TP_PT == 57
            if (bid == 0 && tid == 0) misc[56] = (unsigned)__builtin_amdgcn_s_memrealtime();
#endif
              pg8::Gemm g{PO, (const bf16_t*)(ws + WS_WGRP) + (size_t)l * 4 * 65536, DM, 256, 256, 256};
              pg8::EpiGrp E{Z, MX}; pg8::gemm_phase(lds, g, S, E); }

#if defined(TP_PT) && TP_PT == 58
            if (bid == 0 && tid == 0) misc[56] = (unsigned)__builtin_amdgcn_s_memrealtime();
#endif
            for (int u0 = bid; u0 < PB * MEMH * 8; u0 += G) { const int u = (G == 256) ? ((u0 & 7) * 32 + (u0 >> 3)) : u0;
                const int b = u >> 5, h = (u >> 3) & 3, x = u & 7; const size_t r0 = (size_t)b * PT + 256 * x;
                const bf16_t* Kh = MEMB + (size_t)b * 256 * 4096 + l * 1024 + h * 128;
                att::attn_body<128, false, 1, LDZ, 4096>(Z + r0 * LDZ + ZA_QM + h * 128, Kh, Kh + 512, nullptr, nullptr, Z + r0 * LDZ + ZA_GM + h * 128, MX + r0 * OUTW + 1024 + h * 128, 4, 0, lds);
                __syncthreads(); }

#if defined(TP_PT) && TP_PT == 59
            if (bid == 0 && tid == 0) misc[56] = (unsigned)__builtin_amdgcn_s_memrealtime();
#endif
            if (l == 1) SUNITS(u, SB * MEMH) { const int b = u >> 2, h = u & 3; const size_t r0 = (size_t)PM + b * 4; const size_t ko = (((size_t)l * SB + b) * MEMT * MEMH + h) * 128;
                dec::smem_unit(Z + r0 * LDZ + ZA_QM + h * 128, Z + r0 * LDZ + ZA_GM + h * 128, in[5] + ko, in[6] + ko, MX + r0 * OUTW + 1024 + h * 128, lds); }
            if (l == 1) for (int u = bid; u < 16; u += G) { const int g = u >> 2;
                ew::pool_sample_grp(l, in, out, ws, g, (u & 3) == 0);
                asm volatile("s_waitcnt vmcnt(0)" ::: "memory"); __syncthreads();
                sg::EpiGrp E{Z, MX, g * 256};
                sg::sgemm_unit(lds, PO + (size_t)PM * DM + g * 256, DM, (const bf16_t*)(ws + WS_WGRP) + ((size_t)l * 4 + g) * 65536, 256, 256, (u & 3) * 64, E); }
        }
#ifdef TP_WG
        if (l == TP_L && bid == TP_WG && tid == 0) __hip_atomic_store((unsigned*)(P.ws + WS_CTL) + 6144, (unsigned)__builtin_amdgcn_s_memrealtime(), __ATOMIC_RELAXED, __HIP_MEMORY_SCOPE_AGENT);
#endif
        SEAM(pb + 1);
        if (EN(4) && IN(pb + 2)) {
            PHASE_PTRS
            unsigned* oflag = (unsigned*)(ws + WS_CTL) + 4096 + 64 * 11;
            if (l == 0) SUNITS(u, DM / 64) { sg::EpiOut E{XB, ssps};
                sg::sgemm_unit(lds, MX + (size_t)PM * OUTW, OUTW, (const bf16_t*)(ws + WS_WOUT) + (size_t)l * DM * OUTW, OUTW, OUTW, u * 64, E);
                asm volatile("s_waitcnt vmcnt(0)" ::: "memory"); __syncthreads();
                if (tid == 0) { __builtin_amdgcn_fence(__ATOMIC_RELEASE, "agent"); asm volatile("s_waitcnt vmcnt(0)" ::: "memory"); __hip_atomic_fetch_add(oflag, 1u, __ATOMIC_RELAXED, __HIP_MEMORY_SCOPE_AGENT); } }
            { pg8::Gemm g{MX, (const bf16_t*)(ws + WS_WOUT) + (size_t)l * DM * OUTW, OUTW, OUTW, OUTW, 0}; pg8::StaticOrder S; S.init(PM / 256, DM / 256, G, bid);
              pg8::EpiOut E{XB, ssp}; pg8::gemm_phase(lds, g, S, E); }
            if (l == 0) { bool waited = false;
              for (int u = bid; u < INA / 64; u += G) {
                if (!waited) { waited = true;
                    if (tid == 0) { unsigned sp = 0; while (__hip_atomic_load(oflag, __ATOMIC_RELAXED, __HIP_MEMORY_SCOPE_AGENT) < (unsigned)(DM / 64)) { __builtin_amdgcn_s_sleep(2); if (++sp > (1u << 22)) break; }
                        __builtin_amdgcn_fence(__ATOMIC_ACQUIRE, "agent"); asm volatile("s_waitcnt vmcnt(0)" ::: "memory"); }
                    __syncthreads(); }
                sg::EpiZ E{Z, ssps, nullptr, nullptr}; sg::sgemm_unit(lds, XB + (size_t)PM * DM, DM, (const bf16_t*)(ws + WS_WINA) + (size_t)(l + 1) * INA * DM, DM, DM, u * 64, E); } }
        }
        SEAM(pb + 2);
    }

#pragma unroll 1
    for (int j = 0; j < 2; ++j) {
        const int l = 2 + j, pb = 7 + 5 * j; const int NB = j == 0 ? NB2 : NB3;
        if (EN(5) && IN(pb)) for (int rep = 0; rep < NREP(5, j == 0); ++rep) { if (rep) xcd_barrier(bar);
            PHASE_PTRS
            const bf16_t* WB = (const bf16_t*)(ws + WS_WINB) + (size_t)j * NB2 * DM; float* kvr = j == 0 ? KVRAW : nullptr;
            unsigned* sflag = (unsigned*)(ws + WS_CTL) + 4096 + 64 * j;
            SUNITS(u, DM / 64) { sg::EpiOut E{XB, ssps};
                sg::sgemm_unit(lds, MX + (size_t)PM * OUTW, OUTW, (const bf16_t*)(ws + WS_WOUT) + (size_t)(l - 1) * DM * OUTW, OUTW, OUTW, u * 64, E);
                asm volatile("s_waitcnt vmcnt(0)" ::: "memory"); __syncthreads();
                if (tid == 0) { __builtin_amdgcn_fence(__ATOMIC_RELEASE, "agent"); asm volatile("s_waitcnt vmcnt(0)" ::: "memory"); __hip_atomic_fetch_add(sflag, 1u, __ATOMIC_RELAXED, __HIP_MEMORY_SCOPE_AGENT); } }
            { pg8::Gemm g{XB, WB, DM, DM, DM, 0}; pg8::StaticOrder S; S.init(PM / 256, NB / 256, G, bid);
              pg8::EpiZ E{Z, ssp, ssq, kvr}; pg8::gemm_phase(lds, g, S, E); }
            { bool waited = false;
              for (int u = G - 1 - DM / 64 - bid; u >= 0 && u < NB / 64; u += G) {
                if (!waited) { waited = true;
                    if (tid == 0) { unsigned sp = 0; while (__hip_atomic_load(sflag, __ATOMIC_RELAXED, __HIP_MEMORY_SCOPE_AGENT) < (unsigned)(DM / 64)) { __builtin_amdgcn_s_sleep(2); if (++sp > (1u << 22)) break; }
                        __builtin_amdgcn_fence(__ATOMIC_ACQUIRE, "agent"); asm volatile("s_waitcnt vmcnt(0)" ::: "memory"); }
                    __syncthreads(); }
                sg::EpiZ E{Z, ssps, ssq, kvr}; sg::sgemm_unit(lds, XB + (size_t)PM * DM, DM, WB, DM, DM, u * 64, E); } }
        }
        SEAM(pb);
        if (EN(6) && IN(pb + 1)) for (int rep = 0; rep < NREP(6, j == 0); ++rep) { if (rep) xcd_barrier(bar);
            PHASE_PTRS
            unsigned* qflag = (unsigned*)(ws + WS_CTL) + 4096 + 64 * (6 + j);
            SUNITS(u, QW / 64) { sg::EpiQ E{QB, ssq}; sg::sgemm_unit(lds, Z + (size_t)PM * LDZ + ZB_CQ, LDZ, (const bf16_t*)(ws + WS_WQUP) + (size_t)j * QW * QRANK, QRANK, QRANK, u * 64, E);
                asm volatile("s_waitcnt vmcnt(0)" ::: "memory"); __syncthreads();
                if (tid == 0) { __builtin_amdgcn_fence(__ATOMIC_RELEASE, "agent"); asm volatile("s_waitcnt vmcnt(0)" ::: "memory"); __hip_atomic_fetch_add(qflag, 1u, __ATOMIC_RELAXED, __HIP_MEMORY_SCOPE_AGENT); } }
            if (j == 0) { if (G >= 256) { if (bid < 96) ew::kvpost(in, out, ws, G - 32, bid); else if (bid >= 128) ew::kvpost(in, out, ws, G - 32, bid - 32); }
                          else ew::kvpost(in, out, ws, G, bid); }
            { pg8::Gemm g{Z + ZB_CQ, (const bf16_t*)(ws + WS_WQUP) + (size_t)j * QW * QRANK, LDZ, QRANK, QRANK, 0}; pg8::StaticOrder S; S.init(PM / 256, QW / 256, G, bid);
              pg8::EpiQ E{QB, ssq}; pg8::gemm_phase(lds, g, S, E); }
            for (int u0 = bid; u0 < PB * MEMH * 8; u0 += G) { const int u = (G == 256) ? ((u0 & 7) * 32 + (u0 >> 3)) : u0;
                const int b = u >> 5, h = (u >> 3) & 3, x = u & 7; const size_t r0 = (size_t)b * PT + 256 * x;
                const bf16_t* Kh = MEMB + (size_t)b * 256 * 4096 + l * 1024 + h * 128;
                att::attn_body<128, false, 1, LDZ, 4096>(Z + r0 * LDZ + ZB_QM + h * 128, Kh, Kh + 512, nullptr, nullptr, Z + r0 * LDZ + ZB_GM + h * 128, MX + r0 * OUTW + 1024 + h * 128, 4, 0, lds);
                __syncthreads(); }
            SUNITS(u, SB * MEMH) { const int b = u >> 2, h = u & 3; const size_t r0 = (size_t)PM + b * 4; const size_t ko = (((size_t)l * SB + b) * MEMT * MEMH + h) * 128;
                dec::smem_unit(Z + r0 * LDZ + ZB_QM + h * 128, Z + r0 * LDZ + ZB_GM + h * 128, in[5] + ko, in[6] + ko, MX + r0 * OUTW + 1024 + h * 128, lds); }
            { const int cu = (G >= 256) ? 127 - bid : G - 1 - QW / 64 - bid;
              if (cu >= 0 && cu < MLAH * 4) {
                if (tid == 0) { unsigned sp = 0; while (__hip_atomic_load(qflag, __ATOMIC_RELAXED, __HIP_MEMORY_SCOPE_AGENT) < (unsigned)(QW / 64)) { __builtin_amdgcn_s_sleep(2); if (++sp > (1u << 22)) break; }
                    __builtin_amdgcn_fence(__ATOMIC_ACQUIRE, "agent"); asm volatile("s_waitcnt vmcnt(0)" ::: "memory"); }
                __syncthreads();
                { const int h = cu >> 2; sg::EpiAbsorb E{(bf16_t*)(ws + WS_QDEC), h};
                  sg::sgemm_unit(lds, QB + (size_t)PM * QW + h * QHD, QW, (const bf16_t*)(ws + WS_WKUPN) + h * 128, 1024, 128, (cu & 3) * 64, E); }
                ew::sq_rope(ws, MLAH * 4, cu); } }
        }
        SEAM(pb + 1);
        const int pM = pb + 2 + (j == 0 ? 1 : 0);
        if (j == 0) {
            if (EN(7) && IN(pb + 2)) {
                PHASE_PTRS
                { pg8::Gemm g{(const bf16_t*)(ws + WS_CKVB), (const bf16_t*)(ws + WS_WKV), KVR, KVR, KVR, 0}; pg8::StaticOrder S; S.init(PM / 256, 2048 / 256, G, bid);
                  pg8::EpiKV E{(bf16_t*)(ws + WS_KN)}; pg8::gemm_phase(lds, g, S, E); }
            }
            SEAM(pb + 2);
        }
        if (EN(8) && IN(pM)) for (int rep = 0; rep < NREP(8, j == 0); ++rep) { if (rep) xcd_barrier(bar);
            PHASE_PTRS
#pragma unroll 1
            for (int half = 0; half < 2; ++half) {
            if ((half ^ ((bid >> 3) & 1)) == 0) {
            for (int rep2 = 0; rep2 < NREP(13, j == 0); ++rep2)
            for (int u0 = bid; u0 < PB * MLAH * 4; u0 += G) { const int u = (G == 256) ? ((u0 & 7) * 32 + (u0 >> 3)) : u0;
                const int b = u >> 5, h = (u >> 2) & 7, xp = u & 3;
#pragma unroll 1
                for (int s = 0; s < 2; ++s) { const int x = s == 0 ? 7 - xp : xp; const size_t b0 = (size_t)b * PT, r0 = b0 + 256 * x;
                    att::attn_body<192, true, 1, QW, 1024>(QB + r0 * QW + h * QHD, (const bf16_t*)(ws + WS_KN) + b0 * 1024 + h * 128, (const bf16_t*)(ws + WS_VV) + b0 * 1024 + h * 128,
                        (const bf16_t*)(ws + WS_KROPEB) + b0 * ROPE, (const f32x2*)(ws + WS_ROPE) + (size_t)(256 * x) * 32, Z + r0 * LDZ + ZB_GT + h * 128, MX + r0 * OUTW + h * 128, 4 * (x + 1), 4 * x, lds);
                    __syncthreads(); } }
            } else {
            for (int rep3 = 0; rep3 < NREP(14, j == 0); ++rep3)
            for (int u = bid; u < SB * 8; u += G) { const int b = u >> 3, ch = u & 7;
                dec::decode_unit((const bf16_t*)(ws + WS_QDEC) + (size_t)b * 32 * 320, in[3], in[4], (const int*)in[7] + b * NPAGES + ch * 16,
                                 (float*)(ws + WS_OPART) + ((size_t)b * 8 + ch) * 32 * 256, (float*)(ws + WS_ML) + ((size_t)b * 8 + ch) * 32 * 2, lds);
                __syncthreads(); }
            } }
#ifdef DELAY_PROBE
            if (j == 0) { const unsigned long long t0 = __builtin_amdgcn_s_memrealtime(); while (__builtin_amdgcn_s_memrealtime() - t0 < 3000ull) __builtin_amdgcn_s_sleep(8); }
#endif
        }
        SEAM(pM);
        if (EN(11) && IN(pM + 1)) {
            PHASE_PTRS
            unsigned* cflag = (unsigned*)(ws + WS_CTL) + 4096 + 64 * (4 + j);
            constexpr int NCOMB = 128;
            if (bid < NCOMB) { const int ct = ew::otid();
                for (int w = bid * 8 + (ct >> 6); w < SB * 32; w += NCOMB * 8)
                    dec::combine_row(w >> 5, w & 31, ct & 63, (const bf16_t*)(ws + WS_QDEC), (const float*)(ws + WS_OPART), (const float*)(ws + WS_ML), out + O_CKVS, out + O_KRS, (bf16_t*)(ws + WS_OLAT));
                asm volatile("s_waitcnt vmcnt(0)" ::: "memory"); __syncthreads();
                if (tid == 0) { __builtin_amdgcn_fence(__ATOMIC_RELEASE, "agent"); asm volatile("s_waitcnt vmcnt(0)" ::: "memory"); __hip_atomic_fetch_add(cflag, 1u, __ATOMIC_RELAXED, __HIP_MEMORY_SCOPE_AGENT); } }
            { pg8::Gemm g{MX, (const bf16_t*)(ws + WS_WOUT) + (size_t)l * DM * OUTW, OUTW, OUTW, OUTW, 0}; pg8::StaticOrder S; S.init(PM / 256, DM / 256, G, bid);
              pg8::EpiOut E{XB, ssp}; pg8::gemm_phase(lds, g, S, E); }
            { bool waited = false;
              SUNITS(u, MLAH * 2) { const int h = u >> 1;
                if (!waited) { waited = true;
                    if (tid == 0) { unsigned sp = 0; while (__hip_atomic_load(cflag, __ATOMIC_RELAXED, __HIP_MEMORY_SCOPE_AGENT) < (unsigned)NCOMB) { __builtin_amdgcn_s_sleep(2); if (++sp > (1u << 22)) break; }
                        __builtin_amdgcn_fence(__ATOMIC_ACQUIRE, "agent"); asm volatile("s_waitcnt vmcnt(0)" ::: "memory"); }
                    __syncthreads(); }
                sg::EpiVup E{Z, MX, h};
                sg::sgemm_unit(lds, (const bf16_t*)(ws + WS_OLAT) + h * 256, 2048, (const bf16_t*)(ws + WS_WKV) + ((size_t)1024 + h * 128) * 256, 256, 256, (u & 1) * 64, E); } }
        }
        SEAM(pM + 1);
    }
    if (EN(12) && IN(16)) {
        PHASE_PTRS
        unsigned* sflag = (unsigned*)(ws + WS_CTL) + 4096 + 64 * 2;
        SUNITS(u, DM / 64) { sg::EpiOut E{XB, ssps};
            sg::sgemm_unit(lds, MX + (size_t)PM * OUTW, OUTW, (const bf16_t*)(ws + WS_WOUT) + (size_t)3 * DM * OUTW, OUTW, OUTW, u * 64, E);
            asm volatile("s_waitcnt vmcnt(0)" ::: "memory"); __syncthreads();
            if (tid == 0) { __builtin_amdgcn_fence(__ATOMIC_RELEASE, "agent"); asm volatile("s_waitcnt vmcnt(0)" ::: "memory"); __hip_atomic_fetch_add(sflag, 1u, __ATOMIC_RELAXED, __HIP_MEMORY_SCOPE_AGENT); } }
        const int nprod = (G > 2 * (DM / 64)) ? DM / 64 : 0;
        if (bid < G - nprod) ew::final_norm(in, out, ws, G - nprod, bid, 0, PM);
        if (bid < 16) {
            if (tid == 0) { unsigned sp = 0; while (__hip_atomic_load(sflag, __ATOMIC_RELAXED, __HIP_MEMORY_SCOPE_AGENT) < (unsigned)(DM / 64)) { __builtin_amdgcn_s_sleep(2); if (++sp > (1u << 22)) break; }
                __builtin_amdgcn_fence(__ATOMIC_ACQUIRE, "agent"); asm volatile("s_waitcnt vmcnt(0)" ::: "memory"); }
            __syncthreads();
            ew::final_norm(in, out, ws, 16, bid, PM, PM + SM); }
    }
#ifdef TP_A
    if (bid == 0 && tid == 0) { const unsigned dt = (TP_B >= 99 ? (unsigned)__builtin_amdgcn_s_memrealtime() : TP_B == 98 ? __hip_atomic_load((unsigned*)(P.ws + WS_CTL) + 6144, __ATOMIC_RELAXED, __HIP_MEMORY_SCOPE_AGENT) : misc[TP_B]) - misc[TP_A];
        const unsigned long long t0 = __builtin_amdgcn_s_memrealtime(); while (__builtin_amdgcn_s_memrealtime() - t0 < (unsigned long long)dt * TP_K) __builtin_amdgcn_s_sleep(8); }
#endif
#undef IN
#undef SEAM
#undef SUNITS
}

#ifndef MK_LAUNCHES
#define MK_LAUNCHES 1
#endif
extern "C" void kernel_launch(void* const* d_in, const int* in_sizes, int n_in, void* d_out, int out_size, void* d_ws, size_t ws_size, hipStream_t stream) {
    static int grid = 0;
    if (grid == 0) {
        if (n_in != 26 || (size_t)out_size != O_END || ws_size < WS_END) { fprintf(stderr, "kernel_launch: unexpected shapes: n_in %d out %d ws %zu (need out %zu ws %zu)\n", n_in, out_size, ws_size, (size_t)O_END, (size_t)WS_END); grid = -1; return; }
        int dev = 0, cus = 0, per_cu = 0;
        if (hipGetDevice(&dev) != hipSuccess || hipDeviceGetAttribute(&cus, hipDeviceAttributeMultiprocessorCount, dev) != hipSuccess) { grid = -1; return; }
        if (hipFuncSetAttribute((const void*)yoco_fwd, hipFuncAttributeMaxDynamicSharedMemorySize, LDS_BYTES) != hipSuccess) { fprintf(stderr, "kernel_launch: hipFuncSetAttribute failed\n"); grid = -1; return; }
        if (hipOccupancyMaxActiveBlocksPerMultiprocessor(&per_cu, (const void*)yoco_fwd, 512, LDS_BYTES) != hipSuccess || per_cu < 1) { fprintf(stderr, "kernel_launch: occupancy query says %d blocks per CU\n", per_cu); (void)hipGetLastError(); grid = -1; return; }
        grid = cus;
    }
    if (grid < 0) return;
    uchar* const wsb = (uchar*)d_ws + ((ws_size - WS_END) & ~(size_t)4095);
    (void)hipMemsetAsync((char*)wsb + WS_CTL, 0, CTL_BYTES, stream);
    Params p{};
    for (int i = 0; i < 26; ++i) p.in[i] = (const float*)d_in[i];
    p.out = (float*)d_out; p.ws = wsb;
    if (MK_LAUNCHES == 1) { p.ph_lo = 0; p.ph_hi = NPHASE; hipLaunchKernelGGL(yoco_fwd, dim3(grid), dim3(512), LDS_BYTES, stream, p); }
    else for (int k = 0; k < NPHASE; ++k) { p.ph_lo = k; p.ph_hi = k + 1; hipLaunchKernelGGL(yoco_fwd, dim3(grid), dim3(512), LDS_BYTES, stream, p); }
    const hipError_t le = hipPeekAtLastError();
    if (le != hipSuccess) fprintf(stderr, "kernel_launch: launch failed: %s\n", hipGetErrorName(le));
}
```
